# Optimizing an MI355X kernel written in HIP

```python
import math, functools
import jax, jax.numpy as jnp
from jax import lax
import numpy as np

D_MODEL = 1024
BATCH = 4
SEQ = 4096
DEPTH = 1
DEC_BATCH = 128
DEC_SEQ = 4
PAST_LEN = 2048
PAGE_SIZE = 128

A_GROUPS = ((128, 1), (512, 4), (2048, 16))
A_HEADS_PER_GROUP = 4
A_HEADS = 12
A_HEAD_DIM = 128
A_WIDTH = A_HEADS * A_HEAD_DIM
A_OUT = A_HEADS_PER_GROUP * A_HEAD_DIM
A_BLOCK = 128
G_HEADS = 8
G_DK = 128
G_DV = 128
G_QK = G_HEADS * G_DK
G_V = G_HEADS * G_DV
G_CONV_CH = 2 * G_QK + G_V
G_CONV = 4
G_CHUNK = 64
N_BRANCH = 2
D_FF = 2816
NORM_EPS = 1e-6
IN_SIZES = (A_WIDTH, A_WIDTH, A_WIDTH, G_CONV_CH, G_V, G_HEADS, G_HEADS, N_BRANCH * D_MODEL)
IN_WIDTH = 3 * A_WIDTH + G_CONV_CH + G_V + 2 * G_HEADS + N_BRANCH * D_MODEL

kernel_name = 'hybrid_dilated_attn_gated_deltanet_step'


def _rms(x, w):
    xf = x.astype(jnp.float32)
    y = xf * lax.rsqrt(jnp.mean(xf * xf, axis=-1, keepdims=True) + NORM_EPS)
    return (y * w.astype(jnp.float32)).astype(x.dtype)


def _swiglu(x, w_gu, w_down):
    gate, up = jnp.split(x @ w_gu, 2, axis=-1)
    return (jax.nn.silu(gate) * up) @ w_down


def _split_cols(u, sizes):
    idx, acc = [], 0
    for s in sizes[:-1]:
        acc += s
        idx.append(acc)
    return jnp.split(u, idx, axis=-1)


def _alibi_slopes():
    return jnp.exp2(-8.0 * jnp.arange(1, A_HEADS + 1, dtype=jnp.float32) / A_HEADS)


def _dilated_prompt(q, k, v, window, dil, slopes):
    B, T, H, E = q.shape
    n = T // dil
    nb = -(-n // A_BLOCK)
    npad = nb * A_BLOCK
    wsub = window // dil

    def to_sub(a):
        a = a.reshape(B, n, dil, H, E).transpose(0, 2, 1, 3, 4)
        return jnp.pad(a, ((0, 0), (0, 0), (A_BLOCK, npad - n), (0, 0), (0, 0)))

    def band(a):
        a = to_sub(a)
        prev = a[:, :, :npad].reshape(B, dil, nb, A_BLOCK, H, E)
        cur = a[:, :, A_BLOCK:].reshape(B, dil, nb, A_BLOCK, H, E)
        return jnp.concatenate([prev, cur], axis=3)

    qs = to_sub(q)[:, :, A_BLOCK:].reshape(B, dil, nb, A_BLOCK, H, E)
    kb, vb = band(k), band(v)
    s = jnp.einsum('brnqhe,brnkhe->brnhqk', qs, kb, preferred_element_type=jnp.float32) * (E ** -0.5)
    qi = jnp.arange(A_BLOCK)[:, None]
    kj = jnp.arange(2 * A_BLOCK)[None, :]
    delta = A_BLOCK + qi - kj
    kpos = jnp.arange(nb)[:, None, None] * A_BLOCK + kj[None] - A_BLOCK
    valid = (delta >= 0) & (delta <= wsub) & (kpos >= 0)
    bias = -slopes.astype(jnp.float32)[:, None, None] * (dil * delta).astype(jnp.float32)
    s = jnp.where(valid[:, None], s + bias, -jnp.inf)
    m = jnp.max(s, axis=-1, keepdims=True)
    p = jnp.exp(s - m)
    den = jnp.sum(p, axis=-1)
    o = jnp.einsum('brnhqk,brnkhe->brnqhe', p, vb.astype(jnp.float32)) / jnp.swapaxes(den, -1, -2)[..., None]
    lse = jnp.swapaxes(m[..., 0] + jnp.log(den), -1, -2)
    o = o.reshape(B, dil, npad, H, E)[:, :, :n].transpose(0, 2, 1, 3, 4).reshape(B, T, H, E)
    lse = lse.reshape(B, dil, npad, H)[:, :, :n].transpose(0, 2, 1, 3).reshape(B, T, H)
    return o, lse


def _dilated_sample(q, k, v, kv_buf, window, dil, slopes):
    Bd, S, H, E = q.shape
    wb = kv_buf.shape[1]
    kc = jnp.concatenate([kv_buf[:, :, 0].astype(k.dtype), k], axis=1)
    vc = jnp.concatenate([kv_buf[:, :, 1].astype(v.dtype), v], axis=1)
    j = jnp.arange(window // dil + 1)
    idx = wb + jnp.arange(S)[:, None] - dil * j[None, :]
    valid = idx >= 0
    idx = jnp.maximum(idx, 0)
    kg = kc[:, idx]
    vg = vc[:, idx]
    s = jnp.einsum('bshe,bsjhe->bhsj', q, kg, preferred_element_type=jnp.float32) * (E ** -0.5)
    s = jnp.where(valid, s - slopes.astype(jnp.float32)[:, None, None] * (dil * j).astype(jnp.float32), -jnp.inf)
    m = jnp.max(s, axis=-1, keepdims=True)
    p = jnp.exp(s - m)
    den = jnp.sum(p, axis=-1)
    o = jnp.einsum('bhsj,bsjhe->bshe', p, vg.astype(jnp.float32)) / jnp.swapaxes(den, 1, 2)[..., None]
    lse = jnp.swapaxes(m[..., 0] + jnp.log(den), 1, 2)
    return o, lse


def _merge_groups(outs, lses, dtype):
    o = jnp.stack(outs, axis=0)
    w = jax.nn.softmax(jnp.stack(lses, axis=0), axis=0)
    o = jnp.sum(w[..., None] * o, axis=0)
    B, T = o.shape[:2]
    return o.reshape(B, T, A_OUT).astype(dtype)


def _group_heads(gi):
    return slice(gi * A_HEADS_PER_GROUP, (gi + 1) * A_HEADS_PER_GROUP)


def _attn_prompt(q, k, v, slopes):
    T = q.shape[1]
    outs, lses, rows = [], [], []
    for gi, (win, dil) in enumerate(A_GROUPS):
        hs = _group_heads(gi)
        kg, vg = k[:, :, hs], v[:, :, hs]
        o, l = _dilated_prompt(q[:, :, hs], kg, vg, win, dil, slopes[hs])
        keep = min(win, T)
        rows.append(jnp.stack([kg[:, T - keep:], vg[:, T - keep:]], axis=2))
        outs.append(o)
        lses.append(l)
    return _merge_groups(outs, lses, q.dtype), rows


def _attn_sample(q, k, v, bufs, slopes):
    outs, lses, rows = [], [], []
    for gi, (win, dil) in enumerate(A_GROUPS):
        hs = _group_heads(gi)
        kg, vg = k[:, :, hs], v[:, :, hs]
        o, l = _dilated_sample(q[:, :, hs], kg, vg, bufs[gi], win, dil, slopes[hs])
        rows.append(jnp.stack([kg, vg], axis=2))
        outs.append(o)
        lses.append(l)
    return _merge_groups(outs, lses, q.dtype), rows


def _short_conv(u, buf, w):
    T = u.shape[1]
    full = jnp.concatenate([buf, u], axis=1)
    y = full[:, :T] * w[0]
    for j in range(1, G_CONV):
        y = y + full[:, j:j + T] * w[j]
    return y, full[:, T:]


def _l2norm(x):
    return x * lax.rsqrt(jnp.sum(x * x, axis=-1, keepdims=True) + NORM_EPS)


def _gated_delta_chunked(q, k, v, g, beta, s0):
    B, T, H, _ = q.shape
    C = min(G_CHUNK, T)
    nc = -(-T // C)
    pad = nc * C - T

    def chunks(a):
        a = jnp.pad(a, ((0, 0), (0, pad)) + ((0, 0),) * (a.ndim - 2))
        a = a.reshape((B, nc, C) + a.shape[2:])
        return jnp.moveaxis(a, (1, 3), (0, 2))

    qc, kc, vc, gc, bc = (chunks(a) for a in (q, k, v, g, beta))
    gc = jnp.cumsum(gc, axis=-1)
    incl = jnp.tril(jnp.ones((C, C), bool))
    strict = jnp.tril(jnp.ones((C, C), bool), -1)
    decay = jnp.exp(jnp.where(incl, gc[..., :, None] - gc[..., None, :], -jnp.inf))
    kb = kc * bc[..., None]
    a_low = jnp.where(strict, jnp.einsum('nbhik,nbhjk->nbhij', kb, kc) * decay, 0.0)
    t_mat = a_low + jnp.eye(C, dtype=a_low.dtype)
    solve = functools.partial(lax.linalg.triangular_solve, left_side=True, lower=True, unit_diagonal=True)
    u = solve(t_mat, vc * bc[..., None])
    w = solve(t_mat, kb * jnp.exp(gc)[..., None])
    qk = jnp.einsum('nbhik,nbhjk->nbhij', qc, kc) * decay
    qg = qc * jnp.exp(gc)[..., None]
    kd = kc * jnp.exp(gc[..., -1:] - gc)[..., None]
    g_end = jnp.exp(gc[..., -1])

    def step(s, xs):
        u_i, w_i, qk_i, qg_i, kd_i, ge_i = xs
        v_new = u_i - jnp.einsum('bhck,bhkv->bhcv', w_i, s)
        o_i = jnp.einsum('bhck,bhkv->bhcv', qg_i, s) + jnp.einsum('bhcj,bhjv->bhcv', qk_i, v_new)
        s = s * ge_i[..., None, None] + jnp.einsum('bhck,bhcv->bhkv', kd_i, v_new)
        return s, o_i

    s_end, o = lax.scan(step, s0, (u, w, qk, qg, kd, g_end))
    o = jnp.transpose(o, (1, 0, 3, 2, 4)).reshape(B, nc * C, H, -1)[:, :T]
    return o, s_end


def _gated_deltanet(qkv, z, b_logit, a_logit, conv_buf, s0, conv_w, a_log, dt_bias, norm_w):
    B, T, _ = qkv.shape
    y, conv_new = _short_conv(qkv, conv_buf.astype(qkv.dtype), conv_w)
    y = jax.nn.silu(y.astype(jnp.float32))
    q, k, v = jnp.split(y, [G_QK, 2 * G_QK], axis=-1)
    q = _l2norm(q.reshape(B, T, G_HEADS, G_DK)) * (G_DK ** -0.5)
    k = _l2norm(k.reshape(B, T, G_HEADS, G_DK))
    v = v.reshape(B, T, G_HEADS, G_DV)
    beta = jax.nn.sigmoid(b_logit.astype(jnp.float32))
    g = -jnp.exp(a_log.astype(jnp.float32)) * jax.nn.softplus(a_logit.astype(jnp.float32) + dt_bias.astype(jnp.float32))
    o, s_new = _gated_delta_chunked(q, k, v, g, beta, s0.astype(jnp.float32))
    o = o * lax.rsqrt(jnp.mean(o * o, axis=-1, keepdims=True) + NORM_EPS) * norm_w.astype(jnp.float32)
    o = o * jax.nn.silu(z.astype(jnp.float32).reshape(B, T, G_HEADS, G_DV))
    return o.reshape(B, T, G_V).astype(qkv.dtype), conv_new, s_new


def _layer(x, attn_a, conv_buf, s0, norm_ffn1, w_ffn1_gu, w_ffn1_down, norm_mix, w_in, conv_w,
           gdn_a_log, gdn_dt_bias, gdn_norm, w_proj_a, w_proj_b, w_out, norm_ffn2, w_ffn2_gu, w_ffn2_down):
    B, T, _ = x.shape
    x = x + 0.5 * _swiglu(_rms(x, norm_ffn1), w_ffn1_gu, w_ffn1_down)
    h = _rms(x, norm_mix)
    qa, ka, va, qkv_b, z_b, b_b, a_b, gate = _split_cols(h @ w_in, IN_SIZES)
    heads = lambda t: t.reshape(B, T, A_HEADS, A_HEAD_DIM)
    o_a, kv_rows = attn_a(heads(qa), heads(ka), heads(va))
    o_b, conv_new, s_new = _gated_deltanet(qkv_b, z_b, b_b, a_b, conv_buf, s0, conv_w,
                                           gdn_a_log, gdn_dt_bias, gdn_norm)
    gt = jax.nn.sigmoid(gate.astype(jnp.float32))
    merged = (gt[..., :D_MODEL] * (o_a @ w_proj_a).astype(jnp.float32)
              + gt[..., D_MODEL:] * (o_b @ w_proj_b).astype(jnp.float32))
    x = x + merged.astype(x.dtype) @ w_out
    x = x + 0.5 * _swiglu(_rms(x, norm_ffn2), w_ffn2_gu, w_ffn2_down)
    return x, kv_rows, conv_new, s_new


def setup_inputs(seed: int = 0) -> dict:
    key = jax.random.key(seed)
    ks = jax.random.split(key, 24)
    f32 = jnp.float32
    nrm = lambda k, shape, scale: jax.random.normal(k, shape, f32) * scale
    gain = lambda k, shape: 1.0 + 0.02 * jax.random.normal(k, shape, f32)
    wins = [min(w, PAST_LEN) for (w, _) in A_GROUPS]
    kv_shape = lambda wb: (DEPTH, DEC_BATCH, wb, 2, A_HEADS_PER_GROUP, A_HEAD_DIM)
    dt = jnp.exp(jax.random.uniform(ks[14], (DEPTH, G_HEADS), f32, math.log(1e-3), math.log(0.1)))
    return {
        'x_prompt': nrm(ks[0], (BATCH, SEQ, D_MODEL), 1.0),
        'x_sample': nrm(ks[1], (DEC_BATCH, DEC_SEQ, D_MODEL), 1.0),
        'cache_kv_w128': nrm(ks[2], kv_shape(wins[0]), 1.0),
        'cache_kv_w512': nrm(ks[3], kv_shape(wins[1]), 1.0),
        'cache_kv_w2048': nrm(ks[4], kv_shape(wins[2]), 1.0),
        'state_conv': nrm(ks[5], (DEPTH, DEC_BATCH, G_CONV - 1, G_CONV_CH), 1.0),
        'state_ssm': nrm(ks[6], (DEPTH, DEC_BATCH, G_HEADS, G_DK, G_DV), 0.1),
        'norm_ffn1': gain(ks[7], (DEPTH, D_MODEL)),
        'w_ffn1_gu': nrm(ks[8], (DEPTH, D_MODEL, 2 * D_FF), D_MODEL ** -0.5),
        'w_ffn1_down': nrm(ks[9], (DEPTH, D_FF, D_MODEL), D_FF ** -0.5),
        'norm_mix': gain(ks[10], (DEPTH, D_MODEL)),
        'w_in': nrm(ks[11], (DEPTH, D_MODEL, IN_WIDTH), D_MODEL ** -0.5),
        'conv_w': nrm(ks[12], (DEPTH, G_CONV, G_CONV_CH), G_CONV ** -0.5),
        'gdn_a_log': jnp.log(jax.random.uniform(ks[13], (DEPTH, G_HEADS), f32, 1.0, 16.0)),
        'gdn_dt_bias': dt + jnp.log(-jnp.expm1(-dt)),
        'gdn_norm': gain(ks[15], (DEPTH, G_DV)),
        'w_proj_a': nrm(ks[16], (DEPTH, A_OUT, D_MODEL), A_OUT ** -0.5),
        'w_proj_b': nrm(ks[17], (DEPTH, G_V, D_MODEL), G_V ** -0.5),
        'w_out': nrm(ks[18], (DEPTH, D_MODEL, D_MODEL), D_MODEL ** -0.5),
        'norm_ffn2': gain(ks[19], (DEPTH, D_MODEL)),
        'w_ffn2_gu': nrm(ks[20], (DEPTH, D_MODEL, 2 * D_FF), D_MODEL ** -0.5),
        'w_ffn2_down': nrm(ks[21], (DEPTH, D_FF, D_MODEL), D_FF ** -0.5),
        'norm_out': gain(ks[22], (D_MODEL,)),
    }


def reference(x_prompt, x_sample, cache_kv_w128, cache_kv_w512, cache_kv_w2048, state_conv, state_ssm,
              norm_ffn1, w_ffn1_gu, w_ffn1_down, norm_mix, w_in, conv_w, gdn_a_log, gdn_dt_bias, gdn_norm,
              w_proj_a, w_proj_b, w_out, norm_ffn2, w_ffn2_gu, w_ffn2_down, norm_out):
    slopes = _alibi_slopes()
    xp, xs = x_prompt, x_sample
    bp = xp.shape[0]
    p_rows = [[], [], []]
    s_rows = [[], [], []]
    p_conv, p_ssm, s_conv, s_ssm = [], [], [], []
    for l in range(DEPTH):
        lw = (norm_ffn1[l], w_ffn1_gu[l], w_ffn1_down[l], norm_mix[l], w_in[l], conv_w[l],
              gdn_a_log[l], gdn_dt_bias[l], gdn_norm[l], w_proj_a[l], w_proj_b[l], w_out[l],
              norm_ffn2[l], w_ffn2_gu[l], w_ffn2_down[l])
        conv0 = jnp.zeros((bp, G_CONV - 1, G_CONV_CH), xp.dtype)
        ssm0 = jnp.zeros((bp, G_HEADS, G_DK, G_DV), jnp.float32)
        attn_p = functools.partial(_attn_prompt, slopes=slopes)
        xp, rows, cb, sb = _layer(xp, attn_p, conv0, ssm0, *lw)
        for gi in range(len(A_GROUPS)):
            p_rows[gi].append(rows[gi])
        p_conv.append(cb)
        p_ssm.append(sb)
        bufs = (cache_kv_w128[l], cache_kv_w512[l], cache_kv_w2048[l])
        attn_s = functools.partial(_attn_sample, bufs=bufs, slopes=slopes)
        xs, rows, cb, sb = _layer(xs, attn_s, state_conv[l], state_ssm[l], *lw)
        for gi in range(len(A_GROUPS)):
            s_rows[gi].append(rows[gi])
        s_conv.append(cb)
        s_ssm.append(sb)
    y_prompt = _rms(xp, norm_out)
    y_sample = _rms(xs, norm_out)
    return (y_prompt, y_sample,
            jnp.stack(p_rows[0]), jnp.stack(p_rows[1]), jnp.stack(p_rows[2]), jnp.stack(p_conv), jnp.stack(p_ssm),
            jnp.stack(s_rows[0]), jnp.stack(s_rows[1]), jnp.stack(s_rows[2]), jnp.stack(s_conv), jnp.stack(s_ssm))
```

```cpp
#include <hip/hip_runtime.h>
#include <cstdio>
#include <cstdint>
#define MK_N_LAUNCHES 1
namespace pg8 {
#define PG8_LAS __attribute__((address_space(3)))
typedef unsigned short bf16_t;
typedef short bf16x8 __attribute__((ext_vector_type(8)));
typedef float f32x4 __attribute__((ext_vector_type(4)));
typedef unsigned u32x4 __attribute__((ext_vector_type(4)));
constexpr int BM = 256, BK = 64, HALF = 128, HTB = HALF * BK * 2  , STAGE_BYTES = 8 * HTB, NXCD = 8, WGM = 8;

__host__ __device__ __forceinline__ int lds_byte(int r, int c) { const int st = (r >> 4) * 2 + (c >> 5), rr = r & 15, cc = c & 31, ob = rr * 64 + cc * 2; return st * 1024 + (ob ^ (((ob >> 9) & 1) << 5)); }
__host__ __device__ __forceinline__ void stage_rc(int b, int& R, int& C) { const int st = b / 1024, sb = b % 1024, swz = sb ^ (((sb >> 9) & 1) << 5); R = (st >> 1) * 16 + swz / 64; C = (st & 1) * 32 + (swz % 64) / 2; }
__host__ __device__ __forceinline__ int perm32(int rho) { const int n = rho >> 4, i = rho & 15; return 8 * (i >> 2) + 4 * n + (i & 3); }

struct Unit { int pm, pn; };
struct Gemm { const bf16_t* A; const bf16_t* Bt; int M, N, K; };
struct StaticOrder {
    int nM, nN, nwg, G, c;
    __host__ __device__ void init(int M, int N, int G_, int c_) { nM = M / BM; nN = N / BM; nwg = nM * nN; G = G_; c = c_; }
    __host__ __device__ bool next(int i, Unit& u) const {
        const long L = (long)i * G + c; if (L >= nwg) return false;
        int wgid = (int)L; { const int q = nwg / NXCD, r = nwg % NXCD, xcd = wgid % NXCD, off = wgid / NXCD; wgid = (xcd < r ? xcd * (q + 1) : r * (q + 1) + (xcd - r) * q) + off; }
        const int nig = WGM * nN, gid = wgid / nig, fm = gid * WGM, gsz = (nM - fm) < WGM ? (nM - fm) : WGM;
        u.pm = fm + ((wgid % nig) % gsz); u.pn = (wgid % nig) / gsz; return true;
    }
    __device__ __forceinline__ void a_ready(const Unit&) const {}
    __device__ __forceinline__ void done(const Unit&) const {}
};
__device__ __forceinline__ unsigned cvt_pk_bf16(float lo, float hi) { unsigned r; asm volatile("v_cvt_pk_bf16_f32 %0, %1, %2" : "=v"(r) : "v"(lo), "v"(hi)); return r; }
typedef float f32x2 __attribute__((ext_vector_type(2)));
template <class Epi, class Sched, bool ALIGN_EPI = false, bool SP2 = false>
__device__ __forceinline__ void gemm_phase(PG8_LAS unsigned char* lds, const Gemm g, const Sched& S, const Epi& E) {
    const int tid = threadIdx.x, wid = __builtin_amdgcn_readfirstlane(tid >> 6), lane = tid & 63, wr = wid >> 2, wc = wid & 3, fr = lane & 15, fq = lane >> 4;
    const int K = g.K, nt = K / BK;
    unsigned voffA[2], voffB[2];
#pragma unroll
    for (int i = 0; i < 2; ++i) { int R, C; stage_rc(tid * 16 + i * 8192, R, C); const int Rb = Epi::PERM ? ((R & ~31) + perm32(R & 31)) : R;
        voffA[i] = (unsigned)(R * K + C) * 2u; voffB[i] = (unsigned)(Rb * K + C) * 2u; }
    const size_t kstep = (size_t)(BK * 2);
    const size_t hstep = (size_t)HALF * K * 2;
    const size_t tstep = 2 * hstep;
    const unsigned ldsw = (unsigned)wid * 1024u;
    const int aoff = lds_byte(wr * 64 + fr, fq * 8), boff = lds_byte(wc * 32 + fr, fq * 8);
#define PG8_SA(b, h) (((b) * 2 + (h)) * HTB)
#define PG8_SB(b, h) ((4 + (b) * 2 + (h)) * HTB)
#define PG8_STAGE(bufoff, gbase, voff) do { _Pragma("unroll") for (int _i = 0; _i < 2; ++_i) \
        __builtin_amdgcn_global_load_lds((const unsigned*)((const char*)(gbase) + (voff)[_i]), (PG8_LAS unsigned*)(lds + (bufoff) + ldsw + _i * 8192), 16, 0, 0); } while (0)
#define PG8_LDA(dst, b, h) do { _Pragma("unroll") for (int m = 0; m < 4; ++m) _Pragma("unroll") for (int k = 0; k < 2; ++k) dst[m][k] = *(const PG8_LAS bf16x8*)(lds + PG8_SA(b, h) + aoff + m * 2048 + k * 1024); } while (0)
#define PG8_LDB(dst, b, h) do { _Pragma("unroll") for (int n = 0; n < 2; ++n) _Pragma("unroll") for (int k = 0; k < 2; ++k) dst[n][k] = *(const PG8_LAS bf16x8*)(lds + PG8_SB(b, h) + boff + n * 2048 + k * 1024); } while (0)
#define PG8_MMA(ai, bj, At, Bt) do { __builtin_amdgcn_s_setprio(1); _Pragma("unroll") for (int m = 0; m < 4; ++m) _Pragma("unroll") for (int n = 0; n < 2; ++n) _Pragma("unroll") for (int k = 0; k < 2; ++k) \
        acc[ai][bj][m][n] = __builtin_amdgcn_mfma_f32_16x16x32_bf16(Bt[n][k], At[m][k], acc[ai][bj][m][n], 0, 0, 0); __builtin_amdgcn_s_setprio(0); } while (0)
#define PG8_WAIT_V(n) asm volatile("s_waitcnt vmcnt(" #n ")" ::: "memory")
#define PG8_WAIT_L(n) asm volatile("s_waitcnt lgkmcnt(" #n ")" ::: "memory")
#define PG8_BAR __builtin_amdgcn_s_barrier()
#define PG8_SCHED __builtin_amdgcn_sched_barrier(0)
    Unit cur, nxt; int ui = 0;
    if (!S.next(0, cur)) return;
    f32x4 acc[2][2][4][2];
#pragma unroll
    for (int a = 0; a < 2; ++a)
#pragma unroll
        for (int b = 0; b < 2; ++b)
#pragma unroll
            for (int m = 0; m < 4; ++m)
#pragma unroll
                for (int n = 0; n < 2; ++n) acc[a][b][m][n] = (f32x4){0.f, 0.f, 0.f, 0.f};
    bf16x8 At[4][2], B0[2][2], B1[2][2];
    const char* cA = (const char*)g.A + (size_t)cur.pm * tstep; const char* cB = (const char*)g.Bt + (size_t)cur.pn * tstep;
    S.a_ready(cur);
    if constexpr (SP2) {
        PG8_STAGE(PG8_SB(0, 0), cB, voffB); PG8_STAGE(PG8_SB(0, 1), cB + hstep, voffB); PG8_STAGE(PG8_SA(0, 0), cA, voffA); PG8_STAGE(PG8_SA(0, 1), cA + hstep, voffA);
        if (wr == 1) PG8_BAR;
        PG8_WAIT_V(2); PG8_BAR;
        PG8_STAGE(PG8_SB(1, 0), cB + kstep, voffB); PG8_STAGE(PG8_SA(1, 0), cA + kstep, voffA); PG8_STAGE(PG8_SB(1, 1), cB + hstep + kstep, voffB);
        PG8_WAIT_V(6); PG8_BAR;
    } else {
        PG8_STAGE(PG8_SB(0, 0), cB, voffB); PG8_STAGE(PG8_SA(0, 0), cA, voffA); PG8_STAGE(PG8_SB(0, 1), cB + hstep, voffB); PG8_STAGE(PG8_SA(0, 1), cA + hstep, voffA);
        if (wr == 1) PG8_BAR;
        PG8_WAIT_V(4); PG8_BAR;
        PG8_STAGE(PG8_SB(1, 0), cB + kstep, voffB); PG8_STAGE(PG8_SA(1, 0), cA + kstep, voffA); PG8_STAGE(PG8_SB(1, 1), cB + hstep + kstep, voffB);
        PG8_WAIT_V(6); PG8_BAR;
    }
    for (;;) {
        const bool has_next = S.next(ui + 1, nxt);
        const char* nA = has_next ? (const char*)g.A + (size_t)nxt.pm * tstep : cA; const char* nB = has_next ? (const char*)g.Bt + (size_t)nxt.pn * tstep : cB;
        for (int t = 0; t < nt; t += 2) {
            const bool last = (t == nt - 2);
            const char* a1 = cA + (size_t)(t + 1) * kstep;
            const char* a2 = last ? nA : cA + (size_t)(t + 2) * kstep; const char* b2 = last ? nB : cB + (size_t)(t + 2) * kstep;
            const char* a3 = a2 + kstep; const char* b3 = b2 + kstep;
            if (last && has_next) S.a_ready(nxt);
            if constexpr (SP2) {
            PG8_LDB(B0, 0, 0); PG8_LDB(B1, 0, 1); PG8_SCHED; PG8_LDA(At, 0, 0); PG8_STAGE(PG8_SA(1, 1), a1 + hstep, voffA);
            PG8_WAIT_V(8); PG8_WAIT_L(0); PG8_BAR; PG8_MMA(0, 0, At, B0); PG8_MMA(0, 1, At, B1); PG8_BAR; PG8_SCHED;
            PG8_LDA(At, 0, 1); PG8_STAGE(PG8_SB(0, 0), b2, voffB); PG8_STAGE(PG8_SB(0, 1), b2 + hstep, voffB); PG8_STAGE(PG8_SA(0, 0), a2, voffA);
            PG8_WAIT_V(8); PG8_WAIT_L(0); PG8_BAR; PG8_MMA(1, 0, At, B0); PG8_MMA(1, 1, At, B1); PG8_BAR; PG8_SCHED;
            PG8_LDB(B0, 1, 0); PG8_LDB(B1, 1, 1); PG8_SCHED; PG8_LDA(At, 1, 0); PG8_STAGE(PG8_SA(0, 1), a2 + hstep, voffA);
            PG8_WAIT_V(8); PG8_WAIT_L(0); PG8_BAR; PG8_MMA(0, 0, At, B0); PG8_MMA(0, 1, At, B1); PG8_BAR; PG8_SCHED;
            PG8_LDA(At, 1, 1); PG8_STAGE(PG8_SB(1, 0), b3, voffB); PG8_STAGE(PG8_SB(1, 1), b3 + hstep, voffB); PG8_STAGE(PG8_SA(1, 0), a3, voffA);
            PG8_WAIT_V(8); PG8_WAIT_L(0); PG8_BAR; PG8_MMA(1, 0, At, B0); PG8_MMA(1, 1, At, B1); PG8_BAR; PG8_SCHED;
            } else {
            PG8_LDB(B0, 0, 0); PG8_SCHED; PG8_LDA(At, 0, 0); PG8_STAGE(PG8_SA(1, 1), a1 + hstep, voffA);
            PG8_WAIT_L(8); PG8_BAR; PG8_WAIT_L(0); PG8_MMA(0, 0, At, B0); PG8_BAR; PG8_SCHED;
            PG8_LDB(B1, 0, 1); PG8_STAGE(PG8_SB(0, 0), b2, voffB);
            PG8_BAR; PG8_WAIT_L(0); PG8_MMA(0, 1, At, B1); PG8_BAR;
            PG8_LDA(At, 0, 1); PG8_STAGE(PG8_SA(0, 0), a2, voffA);
            PG8_BAR; PG8_WAIT_L(0); PG8_MMA(1, 0, At, B0); PG8_BAR; PG8_SCHED;
            PG8_STAGE(PG8_SB(0, 1), b2 + hstep, voffB);
            PG8_WAIT_V(6); PG8_BAR; PG8_MMA(1, 1, At, B1); PG8_BAR;
            PG8_LDB(B0, 1, 0); PG8_SCHED; PG8_LDA(At, 1, 0); PG8_STAGE(PG8_SA(0, 1), a2 + hstep, voffA);
            PG8_WAIT_L(8); PG8_BAR; PG8_WAIT_L(0); PG8_MMA(0, 0, At, B0); PG8_BAR; PG8_SCHED;
            PG8_LDB(B1, 1, 1); PG8_STAGE(PG8_SB(1, 0), b3, voffB);
            PG8_BAR; PG8_WAIT_L(0); PG8_MMA(0, 1, At, B1); PG8_BAR;
            PG8_LDA(At, 1, 1); PG8_STAGE(PG8_SA(1, 0), a3, voffA);
            PG8_BAR; PG8_WAIT_L(0); PG8_MMA(1, 0, At, B0); PG8_BAR; PG8_SCHED;
            PG8_STAGE(PG8_SB(1, 1), b3 + hstep, voffB);
            PG8_WAIT_V(6); PG8_BAR; PG8_MMA(1, 1, At, B1); PG8_BAR;
            }
        }
        if constexpr (ALIGN_EPI) { if (wr == 0) PG8_BAR; }
        if constexpr (!Epi::AFTER_DRAIN) { E(acc, cur, wr, wc, fr, fq); S.done(cur); }
        if (!has_next) break;
#pragma unroll
        for (int a = 0; a < 2; ++a)
#pragma unroll
            for (int b = 0; b < 2; ++b)
#pragma unroll
                for (int m = 0; m < 4; ++m)
#pragma unroll
                    for (int n = 0; n < 2; ++n) acc[a][b][m][n] = (f32x4){0.f, 0.f, 0.f, 0.f};
        cur = nxt; cA = nA; cB = nB; ++ui;
        if constexpr (ALIGN_EPI) { if (wr == 1) PG8_BAR; }
    }
    PG8_WAIT_V(0);
    if constexpr (!ALIGN_EPI) { if (wr == 0) PG8_BAR; }
    PG8_BAR;
    if constexpr (Epi::AFTER_DRAIN) { E.fused(acc, cur, wr, wc, fr, fq, lds, wid, lane); S.done(cur); }
#undef PG8_SA
#undef PG8_SB
#undef PG8_STAGE
#undef PG8_LDA
#undef PG8_LDB
#undef PG8_MMA
#undef PG8_WAIT_V
#undef PG8_WAIT_L
#undef PG8_BAR
#undef PG8_SCHED
}
}

constexpr int D = 1024, MP = 16384, MS = 512, MT = MP + MS, FF = 2816, NGU = 2 * FF;
constexpr int SEQ = 4096, NB = 4, DB = 128, DS = 4;
constexpr int NIN = 10768, NINP = 11008;
constexpr int U_QA = 0, U_KA = 1536, U_VA = 3072, U_QKVB = 4608, U_Z = 7680, U_GATE = 8704, U_BA = 10752;
constexpr float EPS = 1e-6f;

namespace pg8 {
typedef unsigned u32x2 __attribute__((ext_vector_type(2)));
__device__ __forceinline__ float sigm(float x) { return 1.f / (1.f + __expf(-x)); }
__device__ __forceinline__ float bf2f(unsigned short b) { return __uint_as_float(((unsigned)b) << 16); }
__device__ __forceinline__ float bflo(unsigned w) { return __uint_as_float(w << 16); }
__device__ __forceinline__ float bfhi(unsigned w) { return __uint_as_float(w & 0xffff0000u); }

struct EpiSwiglu {
    static constexpr bool PERM = true, AFTER_DRAIN = false;
    bf16_t* O; const float* rs; int mode;
    __device__ __forceinline__ void operator()(const f32x4 (&acc)[2][2][4][2], const Unit& u, int wr, int wc, int fr, int fq) const {
        const int row0 = u.pm * BM + wr * 64 + fr, col0 = u.pn * 128 + wc * 32 + 8 * fq;
#pragma unroll
        for (int ai = 0; ai < 2; ++ai)
#pragma unroll
            for (int m = 0; m < 4; ++m) {
                const int row = row0 + ai * HALF + m * 16;
                float r = rs[row]; if (mode) r = rsqrtf(r * (1.0f / D) + EPS);
                float o[8];
#pragma unroll
                for (int n = 0; n < 2; ++n)
#pragma unroll
                    for (int j = 0; j < 4; ++j) { const float g = acc[ai][0][m][n][j] * r, up = acc[ai][1][m][n][j] * r; o[4 * n + j] = g * sigm(g) * up; }
                u32x4 w; w.x = cvt_pk_bf16(o[0], o[1]); w.y = cvt_pk_bf16(o[2], o[3]); w.z = cvt_pk_bf16(o[4], o[5]); w.w = cvt_pk_bf16(o[6], o[7]);
                *(u32x4*)(O + (size_t)row * FF + col0) = w;
            }
    }
};
struct EpiResid {
    static constexpr bool PERM = false, AFTER_DRAIN = false;
    const float* base; const float* base2; float* out; bf16_t* xb; float* ssq; float scale;
    __device__ __forceinline__ void operator()(const f32x4 (&acc)[2][2][4][2], const Unit& u, int wr, int wc, int fr, int fq) const {
        const int row0 = u.pm * BM + wr * 64 + fr, col0 = u.pn * BM + wc * 32 + 4 * fq;
        const float* base = (u.pm * BM < MP) ? this->base : base2;
#pragma unroll
        for (int ai = 0; ai < 2; ++ai)
#pragma unroll
            for (int m = 0; m < 4; ++m) {
                const int row = row0 + ai * HALF + m * 16; const size_t off = (size_t)row * D + col0; float s = 0.f;
#pragma unroll
                for (int bj = 0; bj < 2; ++bj)
#pragma unroll
                    for (int n = 0; n < 2; ++n) {
                        const f32x4 b = *(const f32x4*)(base + off + bj * HALF + n * 16); const f32x4 v = b + acc[ai][bj][m][n] * scale;
                        *(f32x4*)(out + off + bj * HALF + n * 16) = v;
                        if (xb) { u32x2 w; w.x = cvt_pk_bf16(v[0], v[1]); w.y = cvt_pk_bf16(v[2], v[3]); *(u32x2*)(xb + off + bj * HALF + n * 16) = w; }
                        s += (v[0] * v[0] + v[1] * v[1]) + (v[2] * v[2] + v[3] * v[3]);
                    }
                s += __shfl_xor(s, 16); s += __shfl_xor(s, 32);
                if (fq == 0) atomicAdd(ssq + row, s);
            }
    }
};
struct EpiU {
    static constexpr bool PERM = true, AFTER_DRAIN = false;
    bf16_t* U; float* BA; const float* ssq;
    __device__ __forceinline__ void operator()(const f32x4 (&acc)[2][2][4][2], const Unit& u, int wr, int wc, int fr, int fq) const {
        const int row0 = u.pm * BM + wr * 64 + fr, col0 = u.pn * BM + wc * 32 + 8 * fq;
        const bool ba = (u.pn * BM == U_BA);
#pragma unroll
        for (int ai = 0; ai < 2; ++ai)
#pragma unroll
            for (int m = 0; m < 4; ++m) {
                const int row = row0 + ai * HALF + m * 16; const float r = rsqrtf(ssq[row] * (1.0f / D) + EPS);
                if (!ba) {
#pragma unroll
                    for (int bj = 0; bj < 2; ++bj) { const f32x4 v0 = acc[ai][bj][m][0] * r, v1 = acc[ai][bj][m][1] * r;
                        u32x4 w; w.x = cvt_pk_bf16(v0[0], v0[1]); w.y = cvt_pk_bf16(v0[2], v0[3]); w.z = cvt_pk_bf16(v1[0], v1[1]); w.w = cvt_pk_bf16(v1[2], v1[3]);
                        *(u32x4*)(U + (size_t)row * NINP + col0 + bj * HALF) = w; }
                } else if (wc == 0 && fq < 2) {
                    *(f32x4*)(BA + (size_t)row * 16 + 8 * fq) = acc[ai][0][m][0] * r; *(f32x4*)(BA + (size_t)row * 16 + 8 * fq + 4) = acc[ai][0][m][1] * r;
                }
            }
    }
};
template <int SECOND> struct EpiGate {
    static constexpr bool PERM = true, AFTER_DRAIN = false;
    const bf16_t* U; const bf16_t* M1; bf16_t* O;
    __device__ __forceinline__ void operator()(const f32x4 (&acc)[2][2][4][2], const Unit& u, int wr, int wc, int fr, int fq) const {
        const int row0 = u.pm * BM + wr * 64 + fr, col0 = u.pn * BM + wc * 32 + 8 * fq;
#pragma unroll
        for (int ai = 0; ai < 2; ++ai)
#pragma unroll
            for (int m = 0; m < 4; ++m) {
                const int row = row0 + ai * HALF + m * 16;
#pragma unroll
                for (int bj = 0; bj < 2; ++bj) {
                    const int col = col0 + bj * HALF;
                    const u32x4 g = *(const u32x4*)(U + (size_t)row * NINP + U_GATE + SECOND * D + col);
                    float o[8]; const f32x4 a0 = acc[ai][bj][m][0], a1 = acc[ai][bj][m][1];
                    o[0] = sigm(bflo(g.x)) * a0[0]; o[1] = sigm(bfhi(g.x)) * a0[1]; o[2] = sigm(bflo(g.y)) * a0[2]; o[3] = sigm(bfhi(g.y)) * a0[3];
                    o[4] = sigm(bflo(g.z)) * a1[0]; o[5] = sigm(bfhi(g.z)) * a1[1]; o[6] = sigm(bflo(g.w)) * a1[2]; o[7] = sigm(bfhi(g.w)) * a1[3];
                    if (SECOND) { const u32x4 p = *(const u32x4*)(M1 + (size_t)row * D + col);
                        o[0] += bflo(p.x); o[1] += bfhi(p.x); o[2] += bflo(p.y); o[3] += bfhi(p.y); o[4] += bflo(p.z); o[5] += bfhi(p.z); o[6] += bflo(p.w); o[7] += bfhi(p.w); }
                    u32x4 w; w.x = cvt_pk_bf16(o[0], o[1]); w.y = cvt_pk_bf16(o[2], o[3]); w.z = cvt_pk_bf16(o[4], o[5]); w.w = cvt_pk_bf16(o[6], o[7]);
                    *(u32x4*)(O + (size_t)row * D + col) = w;
                }
            }
    }
};
}

#define GAS __attribute__((address_space(1)))
#define LAS __attribute__((address_space(3)))
typedef unsigned short bf16;
typedef unsigned v4u __attribute__((ext_vector_type(4)));
typedef unsigned v2u __attribute__((ext_vector_type(2)));
typedef float f32x4 __attribute__((ext_vector_type(4)));
typedef float f32x2 __attribute__((ext_vector_type(2)));
typedef short bf16x8 __attribute__((ext_vector_type(8)));
typedef short bf16x4 __attribute__((ext_vector_type(4)));
typedef GAS unsigned gu32;
#define RLX_AGENT __ATOMIC_RELAXED, __HIP_MEMORY_SCOPE_AGENT
#define LDS_WAIT() asm volatile("s_waitcnt lgkmcnt(0)" ::: "memory")
#define VM_WAIT() asm volatile("s_waitcnt vmcnt(0)" ::: "memory")
__device__ __forceinline__ unsigned f2bf(float f) { unsigned u = __builtin_bit_cast(unsigned, f); return (u + 0x7fffu + ((u >> 16) & 1u)) >> 16; }
__device__ __forceinline__ unsigned pk2(float lo, float hi) { return f2bf(lo) | (f2bf(hi) << 16); }
__device__ __forceinline__ float bf2f(unsigned short b) { return __uint_as_float(((unsigned)b) << 16); }
__device__ __forceinline__ float bflo(unsigned w) { return __uint_as_float(w << 16); }
__device__ __forceinline__ float bfhi(unsigned w) { return __uint_as_float(w & 0xffff0000u); }
__device__ __forceinline__ float sigm(float x) { return 1.f / (1.f + __expf(-x)); }
__device__ __forceinline__ float siluf(float x) { return x / (1.f + __expf(-x)); }
__device__ __forceinline__ float wave_sum(float v) {
#pragma unroll
    for (int o = 1; o < 64; o <<= 1) v += __shfl_xor(v, o);
    return v;
}
__device__ __forceinline__ float wave_max(float v) {
#pragma unroll
    for (int o = 1; o < 64; o <<= 1) v = fmaxf(v, __shfl_xor(v, o));
    return v;
}
__device__ __forceinline__ f32x4 mfma16(bf16x8 a, bf16x8 b, f32x4 c) { return __builtin_amdgcn_mfma_f32_16x16x32_bf16(a, b, c, 0, 0, 0); }
__device__ __forceinline__ bf16x8 pack8(f32x4 a, f32x4 b) {
    v4u w; w.x = pk2(a[0], a[1]); w.y = pk2(a[2], a[3]); w.z = pk2(b[0], b[1]); w.w = pk2(b[2], b[3]); return __builtin_bit_cast(bf16x8, w);
}
#define WG_BARRIER() __syncthreads()
#define XB_TMO      128
#define XB_XCNT(j)  (256  + 64 * (j))
#define XB_XSUB(j)  (1280 + 64 * (j))
#define XB_XGEN(j)  (2304 + 64 * (j))
#define XB_TOP      3328
#define XB_TOPGEN   3392
#define XCD_BAR_WORDS 3456
#define XB_SPIN_CAP (1u << 18)

__device__ __forceinline__ unsigned xb_ld(unsigned* p)              { return __hip_atomic_load(p, __ATOMIC_RELAXED, __HIP_MEMORY_SCOPE_AGENT); }
__device__ __forceinline__ unsigned xb_add(unsigned* p, unsigned v) { return __hip_atomic_fetch_add(p, v, __ATOMIC_RELAXED, __HIP_MEMORY_SCOPE_AGENT); }
__device__ __forceinline__ unsigned xb_xcc_id() { return (unsigned)__builtin_amdgcn_s_getreg((3 << 11) | 20) & 0xFu; }
#define XB_SPIN(cond, bar) do { unsigned _sp = 0; while (cond) { __builtin_amdgcn_s_sleep(1); \
    if ((++_sp & 255u) == 0u) { if (xb_ld(&(bar)[XB_TMO])) break; if (_sp > XB_SPIN_CAP) { atomicAdd(&(bar)[XB_TMO], 1u); break; } } } } while (0)

struct XcdBarrier {
    unsigned* bar; unsigned x;
    volatile LAS unsigned* st;
};

__device__ __forceinline__ XcdBarrier xcd_barrier_post(unsigned* bar, volatile LAS unsigned* st) {
    XcdBarrier b; b.bar = bar; b.x = xb_xcc_id(); b.st = st;
    if (threadIdx.x == 0) (void)xb_add(&bar[XB_XCNT(b.x)], 1u);
    return b;
}
__device__ __forceinline__ void xcd_barrier_complete(unsigned* bar, unsigned x, unsigned& nloc, unsigned& nx) {
    const unsigned G = gridDim.x * gridDim.y * gridDim.z;
    unsigned sum, cnt, mine, sp = 0u;
    for (;;) {
        sum = 0u; cnt = 0u; mine = 0u;
#pragma unroll
        for (unsigned j = 0; j < 16; ++j) { const unsigned c = xb_ld(&bar[XB_XCNT(j)]); sum += c; cnt += (c > 0u) ? 1u : 0u; mine = (j == x) ? c : mine; }
        if (sum == G) break;
        __builtin_amdgcn_s_sleep(1);
        if ((++sp & 255u) == 0u) { if (xb_ld(&bar[XB_TMO])) break; if (sp > XB_SPIN_CAP) { atomicAdd(&bar[XB_TMO], 1u); break; } }
    }
    nloc = mine > 0u ? mine : 1u; nx = cnt > 0u ? cnt : 1u;
}

__device__ __forceinline__ void xcd_barrier(const XcdBarrier& b) {
    asm volatile("s_waitcnt vmcnt(0)" ::: "memory");
    __syncthreads();
    if (threadIdx.x == 0) {
        unsigned* bar = b.bar;
        __builtin_amdgcn_s_waitcnt(0);
        unsigned nloc = b.st[0], nx = b.st[1];
        if (nloc == 0u) { xcd_barrier_complete(bar, b.x, nloc, nx); b.st[0] = nloc; b.st[1] = nx; }
        const unsigned old = xb_add(&bar[XB_XSUB(b.x)], 1u);
        const unsigned gen = old / nloc;
        if (old + 1u == (gen + 1u) * nloc) {
            __builtin_amdgcn_fence(__ATOMIC_RELEASE, "agent");
            asm volatile("s_waitcnt vmcnt(0)" ::: "memory");
            const unsigned og = xb_add(&bar[XB_TOP], 1u);
            const unsigned tg = og / nx;
            if (og + 1u == (tg + 1u) * nx) xb_add(&bar[XB_TOPGEN], 1u);
            else XB_SPIN(xb_ld(&bar[XB_TOPGEN]) == tg, bar);
            __builtin_amdgcn_fence(__ATOMIC_ACQUIRE, "agent");
            xb_add(&bar[XB_XGEN(b.x)], 1u);
            asm volatile("s_waitcnt vmcnt(0)" ::: "memory");
        } else {
            XB_SPIN(xb_ld(&bar[XB_XGEN(b.x)]) == gen, bar);
            __builtin_amdgcn_fence(__ATOMIC_ACQUIRE, "agent");
            asm volatile("s_waitcnt vmcnt(0)" ::: "memory");
        }
    }
    __syncthreads();
}


constexpr size_t MiB = 1u << 20;
constexpr size_t al256(size_t x) { return (x + 255) & ~(size_t)255; }
constexpr size_t WS_CTL = 0, CTL_ZERO_BYTES = 1 * MiB;
constexpr size_t WS_W1A = 1 * MiB;
constexpr size_t WS_W1B = WS_W1A + (size_t)NGU * D * 2;
constexpr size_t WS_WIN = WS_W1B + (size_t)D * FF * 2;
constexpr size_t WS_WPA = WS_WIN + (size_t)NINP * D * 2;
constexpr size_t WS_WPB = WS_WPA + (size_t)D * 512 * 2;
constexpr size_t WS_WOUT = WS_WPB + (size_t)D * D * 2;
constexpr size_t WS_W2A = WS_WOUT + (size_t)D * D * 2;
constexpr size_t WS_W2B = WS_W2A + (size_t)NGU * D * 2;
constexpr size_t WS_XB = al256(WS_W2B + (size_t)D * FF * 2);
constexpr size_t WS_RSTD1 = WS_XB + (size_t)MT * D * 2;
constexpr size_t WS_ACT = al256(WS_RSTD1 + (size_t)MT * 4);
constexpr size_t WS_X1 = WS_ACT + (size_t)MT * FF * 2;
constexpr size_t WS_X1B = WS_X1 + (size_t)MT * D * 4;
constexpr size_t WS_U = WS_X1B + (size_t)MT * D * 2;
constexpr size_t WS_BA = WS_U + (size_t)MT * NINP * 2;
constexpr size_t REC_BYTES = 73728;
constexpr int NREC = NB * 8 * 64;
constexpr size_t WS_REC = WS_BA + (size_t)MT * 16 * 4;
constexpr size_t WS_GE = WS_REC + (size_t)NREC * REC_BYTES;
constexpr size_t WS_OB = al256(WS_GE + (size_t)NREC * 4);
constexpr size_t WS_OG = WS_OB + (size_t)MT * D * 2;
constexpr size_t WS_LSE = WS_OG + (size_t)MT * 1536 * 2;
constexpr size_t WS_OA = al256(WS_LSE + (size_t)MT * 12 * 4);
constexpr size_t WS_M1 = WS_OA + (size_t)MT * 512 * 2;
constexpr size_t WS_MG = WS_M1 + (size_t)MT * D * 2;
constexpr size_t WS_X2 = WS_MG + (size_t)MT * D * 2;
constexpr size_t WS_X2B = WS_X2 + (size_t)MT * D * 4;
constexpr size_t WS_END = WS_X2B + (size_t)MT * D * 2;
constexpr int CW_TMO = 0;
constexpr int CW_BAR = 4096;
constexpr int CW_Q = 8192;
constexpr int CW_SSQ2 = 16384, CW_SSQ3 = CW_SSQ2 + 17408, CW_SSQ4 = CW_SSQ3 + 17408;
static_assert((CW_SSQ4 + 17408) * 4 <= (int)CTL_ZERO_BYTES, "CTL words inside the memset region");

constexpr size_t O_Y = 0;
constexpr size_t O_KVP0 = (size_t)MT * D;
constexpr size_t O_KVP1 = O_KVP0 + 524288;
constexpr size_t O_KVP2 = O_KVP1 + 2097152;
constexpr size_t O_CONVP = O_KVP2 + 8388608;
constexpr size_t O_SSMP = O_CONVP + 36864;
constexpr size_t O_KVS0 = O_SSMP + 524288;
constexpr size_t O_KVS1 = O_KVS0 + 524288;
constexpr size_t O_KVS2 = O_KVS1 + 524288;
constexpr size_t O_CONVS = O_KVS2 + 524288;
constexpr size_t O_SSMS = O_CONVS + 1179648;
constexpr size_t O_END = O_SSMS + 16777216;

constexpr int NWAVES = 8;
constexpr int RING_OFF = 0;
constexpr int LDSCTL_OFF = 151552, MISC_OFF = LDSCTL_OFF + 320;
constexpr int LDS_BYTES = 155648;

struct Frame {
    LAS unsigned char* lds;
    LAS unsigned char* ldv;
    volatile LAS unsigned* MISC;
    gu32* ctl;
    int tid, lane, wave, G, bx;
    const float* const* in; float* out; unsigned char* ws;
};
#define IN_XP 0
#define IN_XS 1
#define IN_C128 2
#define IN_C512 3
#define IN_C2048 4
#define IN_SCONV 5
#define IN_SSSM 6
#define IN_NF1 7
#define IN_W1GU 8
#define IN_W1D 9
#define IN_NMIX 10
#define IN_WIN 11
#define IN_CONVW 12
#define IN_ALOG 13
#define IN_DTB 14
#define IN_GNORM 15
#define IN_WPA 16
#define IN_WPB 17
#define IN_WOUT 18
#define IN_NF2 19
#define IN_W2GU 20
#define IN_W2D 21
#define IN_NOUT 22

template <class Map>
__device__ __forceinline__ void p0_transpose_item(const float* W, int K, int N, bf16* WT, const float* gain, LAS float* scr, int item, int lane, Map map) {
    const int nblk = (N + 31) / 32, kb = item / nblk, nb = item % nblk, k0 = 64 * kb, n0 = 32 * nb;
    const int nc = n0 + (lane & 31); const bool okc = nc < N;
#pragma unroll 8
    for (int i = 0; i < 32; ++i) { const int kk = 2 * i + (lane >> 5); float v = okc ? W[(size_t)(k0 + kk) * N + nc] : 0.f; if (gain) v *= gain[k0 + kk]; scr[kk * 33 + (lane & 31)] = v; }
    LDS_WAIT(); asm volatile("" ::: "memory");
    const int c = lane & 7;
#pragma unroll
    for (int j = 0; j < 4; ++j) { const int n = (lane >> 3) + 8 * j; const LAS float* s = scr + (8 * c) * 33 + n;
        v4u o; o.x = pk2(s[0 * 33], s[1 * 33]); o.y = pk2(s[2 * 33], s[3 * 33]); o.z = pk2(s[4 * 33], s[5 * 33]); o.w = pk2(s[6 * 33], s[7 * 33]);
        if (n0 + n < N) *(GAS v4u*)(WT + (size_t)map(n0 + n) * K + k0 + 8 * c) = o; }
    LDS_WAIT(); asm volatile("" ::: "memory");
}
struct MapId { __device__ __forceinline__ int operator()(int c) const { return c; } };
struct MapGU { __device__ __forceinline__ int operator()(int c) const { return c < FF ? 256 * (c >> 7) + (c & 127) : 256 * ((c - FF) >> 7) + 128 + ((c - FF) & 127); } };
struct MapIn { __device__ __forceinline__ int operator()(int c) const { return c < 8704 ? c : (c < 8720 ? U_BA + (c - 8704) : c - 16); } };

__device__ __forceinline__ void p0_prologue(Frame& F) {
    LAS float* scr = (LAS float*)(F.ldv + RING_OFF + F.wave * 16384);
    const int gw = F.bx * NWAVES + F.wave, NGW = F.G * NWAVES;
    bf16* W1A = (bf16*)(F.ws + WS_W1A); bf16* W1B = (bf16*)(F.ws + WS_W1B); bf16* WIN = (bf16*)(F.ws + WS_WIN); bf16* WPA = (bf16*)(F.ws + WS_WPA);
    bf16* WPB = (bf16*)(F.ws + WS_WPB); bf16* WOUT = (bf16*)(F.ws + WS_WOUT); bf16* W2A = (bf16*)(F.ws + WS_W2A); bf16* W2B = (bf16*)(F.ws + WS_W2B);
    constexpr int I_GU = (D / 64) * (NGU / 32), I_DN = (FF / 64) * (D / 32), I_IN = (D / 64) * ((NIN + 31) / 32), I_PA = (512 / 64) * (D / 32), I_DD = (D / 64) * (D / 32);
    constexpr int NITEMS = 2 * I_GU + 2 * I_DN + I_IN + I_PA + 2 * I_DD;
    for (int it = gw; it < NITEMS; it += NGW) {
        int r = it;
        if (r < I_GU) { p0_transpose_item(F.in[IN_W1GU], D, NGU, W1A, F.in[IN_NF1], scr, r, F.lane, MapGU()); continue; } r -= I_GU;
        if (r < I_GU) { p0_transpose_item(F.in[IN_W2GU], D, NGU, W2A, F.in[IN_NF2], scr, r, F.lane, MapGU()); continue; } r -= I_GU;
        if (r < I_DN) { p0_transpose_item(F.in[IN_W1D], FF, D, W1B, nullptr, scr, r, F.lane, MapId()); continue; } r -= I_DN;
        if (r < I_DN) { p0_transpose_item(F.in[IN_W2D], FF, D, W2B, nullptr, scr, r, F.lane, MapId()); continue; } r -= I_DN;
        if (r < I_IN) { p0_transpose_item(F.in[IN_WIN], D, NIN, WIN, F.in[IN_NMIX], scr, r, F.lane, MapIn()); continue; } r -= I_IN;
        if (r < I_PA) { p0_transpose_item(F.in[IN_WPA], 512, D, WPA, nullptr, scr, r, F.lane, MapId()); continue; } r -= I_PA;
        if (r < I_DD) { p0_transpose_item(F.in[IN_WPB], D, D, WPB, nullptr, scr, r, F.lane, MapId()); continue; } r -= I_DD;
        p0_transpose_item(F.in[IN_WOUT], D, D, WOUT, nullptr, scr, r, F.lane, MapId());
    }
    { const int gt = F.bx * 512 + F.tid, NT = F.G * 512; GAS v4u* z = (GAS v4u*)(WIN + (size_t)NIN * D);
      for (int i = gt; i < (NINP - NIN) * D / 8; i += NT) z[i] = (v4u){0u, 0u, 0u, 0u}; }
    bf16* XB = (bf16*)(F.ws + WS_XB); float* RSTD1 = (float*)(F.ws + WS_RSTD1);
    for (int m = gw; m < MT; m += NGW) {
        const float* xrow = (m < MP) ? F.in[IN_XP] + (size_t)m * D : F.in[IN_XS] + (size_t)(m - MP) * D;
        const GAS f32x4* xr = (const GAS f32x4*)xrow + F.lane; f32x4 v[4]; float s = 0.f;
#pragma unroll
        for (int j = 0; j < 4; ++j) { v[j] = xr[64 * j]; s += (v[j].x * v[j].x + v[j].y * v[j].y) + (v[j].z * v[j].z + v[j].w * v[j].w); }
        s = wave_sum(s);
        GAS v2u* o8 = (GAS v2u*)(XB + (size_t)m * D) + F.lane;
#pragma unroll
        for (int j = 0; j < 4; ++j) { v2u w; w.x = pk2(v[j].x, v[j].y); w.y = pk2(v[j].z, v[j].w); o8[64 * j] = w; }
        if (F.lane == 0) RSTD1[m] = rsqrtf(s * (1.0f / D) + EPS);
    }
}

__device__ __forceinline__ void final_norm(Frame& F) {
    const int gw = F.bx * NWAVES + F.wave, NGW = F.G * NWAVES;
    const float* ssq = (const float*)(F.ctl + CW_SSQ4); const GAS f32x4* nw = (const GAS f32x4*)F.in[IN_NOUT] + F.lane;
    f32x4 g[4];
#pragma unroll
    for (int j = 0; j < 4; ++j) g[j] = nw[64 * j];
    for (int m = gw; m < MT; m += NGW) {
        const float r = rsqrtf(ssq[m] * (1.0f / D) + EPS);
        GAS f32x4* xr = (GAS f32x4*)(F.out + O_Y + (size_t)m * D) + F.lane;
#pragma unroll
        for (int j = 0; j < 4; ++j) { f32x4 v = xr[64 * j]; xr[64 * j] = v * r * g[j]; }
    }
}

constexpr int GP_QR = 0, GP_KR = 17408, GP_KT = 34816, GP_KBG = 53248, GP_BVT = 71680, GP_GKK = 90112, GP_GQK = 106496, GP_TI = 123904, GP_TAB = 133120;
__device__ __forceinline__ float softplusf(float x) { return x > 20.f ? x : log1pf(__expf(x)); }

__device__ __forceinline__ void gdn_prep_unit(Frame& F, int b, int h, int n) {
    LAS unsigned char* L = F.ldv;
    LAS float* TAB = (LAS float*)(L + GP_TAB);
    LAS float* GKK = (LAS float*)(L + GP_GKK);
    LAS float* GQK = (LAS float*)(L + GP_GQK);
    const bf16* U = (const bf16*)(F.ws + WS_U); const float* BA = (const float*)(F.ws + WS_BA);
    const int tid = F.tid, lane = F.lane, wave = F.wave;
    const int uidx = (b * 8 + h) * 64 + n;
    unsigned char* rec = F.ws + WS_REC + (size_t)uidx * REC_BYTES;
    const int row_base = b * SEQ + 64 * n;
    if (wave == 0) {
        const int t = lane; const float bl = BA[(size_t)(row_base + t) * 16 + h], al = BA[(size_t)(row_base + t) * 16 + 8 + h];
        const float beta = sigm(bl); const float g = -__expf(F.in[IN_ALOG][h]) * softplusf(al + F.in[IN_DTB][h]);
        float gc = g;
#pragma unroll
        for (int o = 1; o < 64; o <<= 1) { const float v = __shfl_up(gc, o); if (lane >= o) gc += v; }
        const float gl = __shfl(gc, 63);
        TAB[t] = beta; TAB[64 + t] = gc; TAB[128 + t] = __expf(gc); TAB[192 + t] = __expf(gl - gc);
        if (lane == 0) ((float*)(F.ws + WS_GE))[uidx] = __expf(gl);
    }
    WG_BARRIER();
    for (int idx = tid; idx < 384 * 4; idx += 512) {
        const int ch = idx % 384, quarter = idx / 384, tensor = ch >> 7, c = ch & 127;
        const int col = U_QKVB + tensor * 1024 + h * 128 + c, cw = tensor * 1024 + h * 128 + c;
        const float w0 = F.in[IN_CONVW][cw], w1 = F.in[IN_CONVW][3072 + cw], w2 = F.in[IN_CONVW][2 * 3072 + cw], w3 = F.in[IN_CONVW][3 * 3072 + cw];
        const int t0 = 16 * quarter;
        float x[19];
#pragma unroll
        for (int i = 0; i < 19; ++i) { const int tok = 64 * n + t0 - 3 + i; x[i] = tok >= 0 ? bf2f(U[(size_t)(b * SEQ + tok) * NINP + col]) : 0.f; }
        float y[16];
#pragma unroll
        for (int i = 0; i < 16; ++i) { const float v = w0 * x[i] + w1 * x[i + 1] + w2 * x[i + 2] + w3 * x[i + 3]; y[i] = siluf(v); }
        if (tensor == 0) {
#pragma unroll
            for (int i = 0; i < 16; ++i) *(LAS bf16*)(L + GP_QR + (t0 + i) * 272 + 2 * c) = (bf16)f2bf(y[i]);
        } else if (tensor == 1) {
#pragma unroll
            for (int i = 0; i < 16; ++i) *(LAS bf16*)(L + GP_KR + (t0 + i) * 272 + 2 * c) = (bf16)f2bf(y[i]);
            v4u a, bq; a.x = pk2(y[0], y[1]); a.y = pk2(y[2], y[3]); a.z = pk2(y[4], y[5]); a.w = pk2(y[6], y[7]);
            bq.x = pk2(y[8], y[9]); bq.y = pk2(y[10], y[11]); bq.z = pk2(y[12], y[13]); bq.w = pk2(y[14], y[15]);
            *(LAS v4u*)(L + GP_KT + c * 144 + 2 * t0) = a; *(LAS v4u*)(L + GP_KT + c * 144 + 2 * t0 + 16) = bq;
        } else {
#pragma unroll
            for (int i = 0; i < 16; ++i) y[i] *= TAB[t0 + i];
            v4u a, bq; a.x = pk2(y[0], y[1]); a.y = pk2(y[2], y[3]); a.z = pk2(y[4], y[5]); a.w = pk2(y[6], y[7]);
            bq.x = pk2(y[8], y[9]); bq.y = pk2(y[10], y[11]); bq.z = pk2(y[12], y[13]); bq.w = pk2(y[14], y[15]);
            *(LAS v4u*)(L + GP_BVT + c * 144 + 2 * t0) = a; *(LAS v4u*)(L + GP_BVT + c * 144 + 2 * t0 + 16) = bq;
        }
    }
    WG_BARRIER();
    {
        const int m16 = lane & 15, kg = lane >> 4;
        for (int job = wave; job < 24; job += 8) {
            int kind, it, jt;
            if (job < 20) { kind = job >= 10; int j = job % 10; it = 0; while (j > it) { j -= it + 1; ++it; } jt = j; }
            else { kind = 2; it = jt = job - 20; }
            const int abase = (kind == 2 ? GP_QR : GP_KR) + (16 * (kind == 1 ? jt : it) + m16) * 272 + 16 * kg;
            const int bbase = (kind == 0 ? GP_KR : GP_QR) + (16 * (kind == 0 ? jt : it) + m16) * 272 + 16 * kg;
            f32x4 acc = {0.f, 0.f, 0.f, 0.f};
#pragma unroll
            for (int kb = 0; kb < 4; ++kb) { const bf16x8 a = *(const LAS bf16x8*)(L + abase + 64 * kb), bb = *(const LAS bf16x8*)(L + bbase + 64 * kb); acc = mfma16(a, bb, acc); }
            if (kind == 0) {
#pragma unroll
                for (int jj = 0; jj < 4; ++jj) GKK[(16 * it + 4 * kg + jj) * 64 + 16 * jt + m16] = acc[jj];
            } else if (kind == 1) {
                *(LAS f32x4*)(GQK + (16 * it + m16) * 68 + 16 * jt + 4 * kg) = acc;
            } else {
#pragma unroll
                for (int jj = 0; jj < 4; ++jj) if (4 * kg + jj == m16) TAB[576 + 16 * it + m16] = acc[jj];
            }
        }
    }
    WG_BARRIER();
    if (tid < 64) {
        const int t = tid; const float rk = rsqrtf(GKK[t * 64 + t] + EPS), rq = rsqrtf(TAB[576 + t] + EPS) * 0.08838834764831845f;
        TAB[256 + t] = rk; TAB[320 + t] = rq; TAB[384 + t] = rq * TAB[128 + t]; TAB[448 + t] = rk * TAB[192 + t]; TAB[512 + t] = rk * TAB[t] * TAB[128 + t];
    }
    WG_BARRIER();
    {
        for (int e = tid; e < 4096; e += 512) { const int i = e >> 6, j = e & 63;
            if (j < i) GKK[e] = TAB[i] * TAB[256 + i] * TAB[256 + j] * GKK[e] * __expf(TAB[64 + i] - TAB[64 + j]); }
        const int m16 = lane & 15, kg = lane >> 4;
        { const int it = wave >> 1, kb2 = wave & 1, i = 16 * it + m16; const float sc = TAB[320 + i], gi = TAB[64 + i];
          float o[8];
#pragma unroll
          for (int hlf = 0; hlf < 2; ++hlf) { const int j0 = 32 * kb2 + 16 * hlf + 4 * kg; const f32x4 g = *(const LAS f32x4*)(GQK + i * 68 + j0);
#pragma unroll
              for (int e = 0; e < 4; ++e) { const int j = j0 + e; o[4 * hlf + e] = (j <= i) ? sc * TAB[256 + j] * g[e] * __expf(gi - TAB[64 + j]) : 0.f; } }
          v4u w; w.x = pk2(o[0], o[1]); w.y = pk2(o[2], o[3]); w.z = pk2(o[4], o[5]); w.w = pk2(o[6], o[7]);
          *(GAS v4u*)(rec + 32768 + wave * 1024 + lane * 16) = w; }
#pragma unroll
        for (int r = 0; r < 2; ++r) { const int f = wave * 2 + r, mt = f >> 1, kb2 = f & 1, dk = 16 * mt + m16; float o[8];
#pragma unroll
            for (int hlf = 0; hlf < 2; ++hlf) { const int t0 = 32 * kb2 + 16 * hlf + 4 * kg; const v2u kk = *(const LAS v2u*)(L + GP_KT + dk * 144 + 2 * t0);
                o[4 * hlf + 0] = bflo(kk.x) * TAB[448 + t0]; o[4 * hlf + 1] = bfhi(kk.x) * TAB[448 + t0 + 1]; o[4 * hlf + 2] = bflo(kk.y) * TAB[448 + t0 + 2]; o[4 * hlf + 3] = bfhi(kk.y) * TAB[448 + t0 + 3]; }
            v4u w; w.x = pk2(o[0], o[1]); w.y = pk2(o[2], o[3]); w.z = pk2(o[4], o[5]); w.w = pk2(o[6], o[7]);
            *(GAS v4u*)(rec + 40960 + f * 1024 + lane * 16) = w; }
#pragma unroll
        for (int r = 0; r < 2; ++r) { const int f = wave * 2 + r, mtq = f >> 2, kb = f & 3, t = 16 * mtq + m16; const float sc = TAB[384 + t]; float o[8];
#pragma unroll
            for (int hlf = 0; hlf < 2; ++hlf) { const int d0 = 32 * kb + 16 * hlf + 4 * kg; const v2u qq = *(const LAS v2u*)(L + GP_QR + t * 272 + 2 * d0);
                o[4 * hlf + 0] = bflo(qq.x) * sc; o[4 * hlf + 1] = bfhi(qq.x) * sc; o[4 * hlf + 2] = bflo(qq.y) * sc; o[4 * hlf + 3] = bfhi(qq.y) * sc; }
            v4u w; w.x = pk2(o[0], o[1]); w.y = pk2(o[2], o[3]); w.z = pk2(o[4], o[5]); w.w = pk2(o[6], o[7]);
            *(GAS v4u*)(rec + ((4 + mtq) * 4 + kb) * 1024 + lane * 16) = w; }
        { const int dk = tid >> 2, t0 = (tid & 3) * 16; const v4u a = *(const LAS v4u*)(L + GP_KT + dk * 144 + 2 * t0), bq = *(const LAS v4u*)(L + GP_KT + dk * 144 + 2 * t0 + 16);
          const unsigned wi[8] = {a.x, a.y, a.z, a.w, bq.x, bq.y, bq.z, bq.w}; unsigned wo[8];
#pragma unroll
          for (int i = 0; i < 8; ++i) wo[i] = pk2(bflo(wi[i]) * TAB[512 + t0 + 2 * i], bfhi(wi[i]) * TAB[512 + t0 + 2 * i + 1]);
          *(LAS v4u*)(L + GP_KBG + dk * 144 + 2 * t0) = (v4u){wo[0], wo[1], wo[2], wo[3]}; *(LAS v4u*)(L + GP_KBG + dk * 144 + 2 * t0 + 16) = (v4u){wo[4], wo[5], wo[6], wo[7]}; }
    }
    WG_BARRIER();
    if (wave == 0) {
        float r[64];
#pragma unroll
        for (int i = 0; i < 64; ++i) {
            int lo_ = lane; asm volatile("" : "+v"(lo_));
            float a0 = (lo_ == i) ? 1.f : 0.f, a1 = 0.f;
#pragma unroll
            for (int j4 = 0; j4 < (i + 3) / 4; ++j4) { const f32x4 av = *(const LAS f32x4*)(GKK + i * 64 + 4 * j4);
#pragma unroll
                for (int e = 0; e < 4; ++e) { const int j = 4 * j4 + e; if (j < i) { if (e & 1) a1 -= av[e] * r[j]; else a0 -= av[e] * r[j]; } } }
            r[i] = a0 + a1;
        }
#pragma unroll
        for (int i = 0; i < 64; ++i) *(LAS bf16*)(L + GP_TI + i * 144 + 2 * lane) = (bf16)f2bf(r[i]);
    }
    WG_BARRIER();
    {
        const int m16 = lane & 15, kg = lane >> 4;
#pragma unroll
        for (int it = 0; it < 4; ++it) {
            f32x4 au = {0.f, 0.f, 0.f, 0.f}, aw = {0.f, 0.f, 0.f, 0.f};
#pragma unroll
            for (int jb = 0; jb < 2; ++jb) {
                const bf16x8 ti = *(const LAS bf16x8*)(L + GP_TI + (16 * it + m16) * 144 + 64 * jb + 16 * kg);
                const bf16x8 bv = *(const LAS bf16x8*)(L + GP_BVT + (16 * wave + m16) * 144 + 64 * jb + 16 * kg);
                const bf16x8 kb = *(const LAS bf16x8*)(L + GP_KBG + (16 * wave + m16) * 144 + 64 * jb + 16 * kg);
                au = mfma16(ti, bv, au);
                aw = mfma16(kb, ti, aw);
            }
            v2u w; w.x = pk2(au[0], au[1]); w.y = pk2(au[2], au[3]);
            *(GAS v2u*)(rec + 57344 + ((wave * 4 + it) * 64 + lane) * 8) = w;
            v2u x; x.x = pk2(aw[0], aw[1]); x.y = pk2(aw[2], aw[3]);
            *(GAS v2u*)(rec + (it * 4 + (wave >> 1)) * 1024 + lane * 16 + (wave & 1) * 8) = x;
        }
    }
    WG_BARRIER();
}

constexpr int SC_BUF = 57344, SC_RED = 2 * SC_BUF;
__device__ __forceinline__ void gdn_scan_chain(Frame& F, int bh) {
    LAS unsigned char* L = F.ldv;
    const int tid = F.tid, lane = F.lane, w = F.wave, m16 = lane & 15, kg = lane >> 4;
    const int b = bh >> 3, h = bh & 7;
    const unsigned char* rec0 = F.ws + WS_REC + (size_t)(bh * 64) * REC_BYTES;
    const float* GE = (const float*)(F.ws + WS_GE) + bh * 64;
    const bf16* U = (const bf16*)(F.ws + WS_U); bf16* OB = (bf16*)(F.ws + WS_OB);
    const float nw = F.in[IN_GNORM][16 * w + m16];
    f32x4 S[8];
#pragma unroll
    for (int i = 0; i < 8; ++i) S[i] = (f32x4){0.f, 0.f, 0.f, 0.f};
    { v4u st[7];
#pragma unroll
      for (int i = 0; i < 7; ++i) st[i] = *(const GAS v4u*)(rec0 + (size_t)(i * 512 + tid) * 16);
#pragma unroll
      for (int i = 0; i < 7; ++i) *(LAS v4u*)(L + (i * 512 + tid) * 16) = st[i]; }
    WG_BARRIER();
    for (int n = 0; n < 64; ++n) {
        const unsigned char* rec = rec0 + (size_t)n * REC_BYTES;
        LAS unsigned char* buf = L + (n & 1) * SC_BUF;
        v4u st[7]; const bool more = n + 1 < 64;
        if (more) {
#pragma unroll
            for (int i = 0; i < 7; ++i) st[i] = *(const GAS v4u*)(rec + REC_BYTES + (size_t)(i * 512 + tid) * 16);
        }
        v2u ut[4];
#pragma unroll
        for (int mt = 0; mt < 4; ++mt) ut[mt] = *(const GAS v2u*)(rec + 57344 + ((w * 4 + mt) * 64 + lane) * 8);
        const float ge = GE[n];
        const int row0 = b * SEQ + 64 * n;
        float zz[16];
#pragma unroll
        for (int mt = 0; mt < 4; ++mt)
#pragma unroll
            for (int jj = 0; jj < 4; ++jj) zz[4 * mt + jj] = bf2f(U[(size_t)(row0 + 16 * mt + 4 * kg + jj) * NINP + U_Z + h * 128 + 16 * w + m16]);
        bf16x8 Sb[4];
#pragma unroll
        for (int kb = 0; kb < 4; ++kb) Sb[kb] = pack8(S[2 * kb], S[2 * kb + 1]);
        f32x4 P[8];
#pragma unroll
        for (int mt = 0; mt < 8; ++mt) { P[mt] = (f32x4){0.f, 0.f, 0.f, 0.f};
#pragma unroll
            for (int kb = 0; kb < 4; ++kb) P[mt] = mfma16(*(const LAS bf16x8*)(buf + (mt * 4 + kb) * 1024 + lane * 16), Sb[kb], P[mt]); }
        f32x4 vn[4];
#pragma unroll
        for (int mt = 0; mt < 4; ++mt) { vn[mt][0] = bflo(ut[mt].x) - P[mt][0]; vn[mt][1] = bfhi(ut[mt].x) - P[mt][1]; vn[mt][2] = bflo(ut[mt].y) - P[mt][2]; vn[mt][3] = bfhi(ut[mt].y) - P[mt][3]; }
        bf16x8 vb[2];
        vb[0] = pack8(vn[0], vn[1]); vb[1] = pack8(vn[2], vn[3]);
#pragma unroll
        for (int mt = 0; mt < 4; ++mt)
#pragma unroll
            for (int kb2 = 0; kb2 < 2; ++kb2) P[4 + mt] = mfma16(*(const LAS bf16x8*)(buf + 32768 + (mt * 2 + kb2) * 1024 + lane * 16), vb[kb2], P[4 + mt]);
#pragma unroll
        for (int mt = 0; mt < 8; ++mt) { S[mt] = S[mt] * ge;
#pragma unroll
            for (int kb2 = 0; kb2 < 2; ++kb2) S[mt] = mfma16(*(const LAS bf16x8*)(buf + 40960 + (mt * 2 + kb2) * 1024 + lane * 16), vb[kb2], S[mt]); }
        LAS float* RED = (LAS float*)(L + SC_RED) + (n & 1) * 512;
#pragma unroll
        for (int mt = 0; mt < 4; ++mt)
#pragma unroll
            for (int jj = 0; jj < 4; ++jj) { float q = P[4 + mt][jj] * P[4 + mt][jj];
                q += __shfl_xor(q, 1); q += __shfl_xor(q, 2); q += __shfl_xor(q, 4); q += __shfl_xor(q, 8);
                if (m16 == 0) RED[(16 * mt + 4 * kg + jj) * 8 + w] = q; }
        if (more) {
            LAS unsigned char* nb = L + ((n + 1) & 1) * SC_BUF;
#pragma unroll
            for (int i = 0; i < 7; ++i) *(LAS v4u*)(nb + (i * 512 + tid) * 16) = st[i];
        }
        WG_BARRIER();
#pragma unroll
        for (int mt = 0; mt < 4; ++mt)
#pragma unroll
            for (int jj = 0; jj < 4; ++jj) { const int t = 16 * mt + 4 * kg + jj;
                const f32x4 r0 = *(const LAS f32x4*)(RED + t * 8), r1 = *(const LAS f32x4*)(RED + t * 8 + 4);
                const float ss = ((r0[0] + r0[1]) + (r0[2] + r0[3])) + ((r1[0] + r1[1]) + (r1[2] + r1[3]));
                const float rs = rsqrtf(ss * (1.0f / 128.0f) + EPS); const float z = zz[4 * mt + jj];
                const float o = P[4 + mt][jj] * rs * nw * (z * sigm(z));
                OB[(size_t)(row0 + t) * D + h * 128 + 16 * w + m16] = (bf16)f2bf(o); }
    }
    float* so = F.out + O_SSMP + (size_t)bh * 16384;
#pragma unroll
    for (int mt = 0; mt < 8; ++mt)
#pragma unroll
        for (int jj = 0; jj < 4; ++jj) so[(16 * mt + 4 * kg + jj) * 128 + 16 * w + m16] = S[mt][jj];
    WG_BARRIER();
}

__device__ __forceinline__ void gdn_sample_unit(Frame& F, int b, int h) {
    LAS float* L = (LAS float*)F.ldv;
    const int tid = F.tid, lane = F.lane, wave = F.wave;
    const bf16* U = (const bf16*)(F.ws + WS_U); const float* BA = (const float*)(F.ws + WS_BA);
    const int row0 = MP + 4 * b;
    LAS float* SC = L + 8704;
    if (tid < 4) { const float bl = BA[(size_t)(row0 + tid) * 16 + h], al = BA[(size_t)(row0 + tid) * 16 + 8 + h];
        SC[tid] = sigm(bl); SC[56 + tid] = -__expf(F.in[IN_ALOG][h]) * softplusf(al + F.in[IN_DTB][h]); }
    if (tid < 384) {
        const int tensor = tid >> 7, c = tid & 127, cw = tensor * 1024 + h * 128 + c, col = U_QKVB + cw;
        const float w0 = F.in[IN_CONVW][cw], w1 = F.in[IN_CONVW][3072 + cw], w2 = F.in[IN_CONVW][2 * 3072 + cw], w3 = F.in[IN_CONVW][3 * 3072 + cw];
        float x[7];
#pragma unroll
        for (int i = 0; i < 3; ++i) x[i] = F.in[IN_SCONV][((size_t)b * 3 + i) * 3072 + cw];
#pragma unroll
        for (int i = 0; i < 4; ++i) x[3 + i] = bf2f(U[(size_t)(row0 + i) * NINP + col]);
#pragma unroll
        for (int i = 0; i < 4; ++i) { const float v = w0 * x[i] + w1 * x[i + 1] + w2 * x[i + 2] + w3 * x[i + 3]; L[tensor * 512 + i * 128 + c] = siluf(v); }
    }
    WG_BARRIER();
    if (tid == 0) { float gc = 0.f;
#pragma unroll
        for (int i = 0; i < 4; ++i) { gc += SC[56 + i]; SC[4 + i] = gc; } SC[48] = __expf(gc); }
    { const int tensor = wave >> 2, s = wave & 3; const float a = L[tensor * 512 + s * 128 + lane], c2 = L[tensor * 512 + s * 128 + 64 + lane];
      const float ss = wave_sum(a * a + c2 * c2); if (lane == 0) SC[(tensor ? 8 : 12) + s] = rsqrtf(ss + EPS) * (tensor ? 1.f : 0.08838834764831845f); }
    WG_BARRIER();
#pragma unroll
    for (int r = 0; r < 4; ++r) { const int idx = 4 * wave + r, kind = idx >> 4, i = (idx >> 2) & 3, j = idx & 3;
        const LAS float* a = L + (kind ? 0 : 512) + i * 128; const LAS float* c2 = L + 512 + j * 128;
        const float d = wave_sum(a[lane] * c2[lane] + a[64 + lane] * c2[64 + lane]);
        if (lane == 0) SC[16 + idx] = d * SC[(kind ? 12 : 8) + i] * SC[8 + j]; }
    WG_BARRIER();
    float beta[4], gc[4], Ti[4][4], qkm[4][4];
#pragma unroll
    for (int i = 0; i < 4; ++i) { beta[i] = SC[i]; gc[i] = SC[4 + i]; }
    const float ge = SC[48];
    {
        float A[4][4];
#pragma unroll
        for (int i = 0; i < 4; ++i)
#pragma unroll
            for (int j = 0; j < 4; ++j) { const float dec = __expf(gc[i] - gc[j]); A[i][j] = (j < i) ? beta[i] * SC[16 + 4 * i + j] * dec : 0.f; qkm[i][j] = (j <= i) ? SC[32 + 4 * i + j] * dec : 0.f; }
#pragma unroll
        for (int i = 0; i < 4; ++i)
#pragma unroll
            for (int c = 0; c < 4; ++c) { float v = (i == c) ? 1.f : 0.f;
#pragma unroll
                for (int j = 0; j < 4; ++j) if (j < i) v -= A[i][j] * Ti[j][c];
                Ti[i][c] = v; }
    }
    { const int c = tid & 127, i = tid >> 7; float wv = 0.f, uv = 0.f;
#pragma unroll
      for (int j = 0; j < 4; ++j) { wv += Ti[i][j] * beta[j] * __expf(gc[j]) * SC[8 + j] * L[512 + j * 128 + c]; uv += Ti[i][j] * beta[j] * L[1024 + j * 128 + c]; }
      L[1536 + i * 128 + c] = wv; L[3072 + i * 128 + c] = uv;
      L[2048 + i * 128 + c] = L[i * 128 + c] * SC[12 + i] * __expf(gc[i]);
      L[2560 + i * 128 + c] = L[512 + i * 128 + c] * SC[8 + i] * __expf(gc[3] - gc[i]); }
    WG_BARRIER();
    const int dv = tid & 127, kq = tid >> 7;
    const float* S0 = F.in[IN_SSSM] + ((size_t)(b * 8 + h) * 128 + 32 * kq) * 128 + dv;
    float s[32];
#pragma unroll
    for (int i = 0; i < 32; ++i) s[i] = S0[(size_t)i * 128];
    float pw[4] = {0.f, 0.f, 0.f, 0.f}, pq[4] = {0.f, 0.f, 0.f, 0.f};
#pragma unroll
    for (int i = 0; i < 32; ++i)
#pragma unroll
        for (int c = 0; c < 4; ++c) { pw[c] += L[1536 + c * 128 + 32 * kq + i] * s[i]; pq[c] += L[2048 + c * 128 + 32 * kq + i] * s[i]; }
#pragma unroll
    for (int c = 0; c < 4; ++c) { L[3584 + (c * 4 + kq) * 128 + dv] = pw[c]; L[3584 + ((4 + c) * 4 + kq) * 128 + dv] = pq[c]; }
    WG_BARRIER();
    float vn[4], oo[4];
#pragma unroll
    for (int c = 0; c < 4; ++c) { const float ws_ = (L[3584 + (c * 4 + 0) * 128 + dv] + L[3584 + (c * 4 + 1) * 128 + dv]) + (L[3584 + (c * 4 + 2) * 128 + dv] + L[3584 + (c * 4 + 3) * 128 + dv]);
        vn[c] = L[3072 + c * 128 + dv] - ws_; }
#pragma unroll
    for (int c = 0; c < 4; ++c) { float o = (L[3584 + ((4 + c) * 4 + 0) * 128 + dv] + L[3584 + ((4 + c) * 4 + 1) * 128 + dv]) + (L[3584 + ((4 + c) * 4 + 2) * 128 + dv] + L[3584 + ((4 + c) * 4 + 3) * 128 + dv]);
#pragma unroll
        for (int j = 0; j < 4; ++j) o += qkm[c][j] * vn[j];
        oo[c] = o; }
    float* SO = F.out + O_SSMS + ((size_t)(b * 8 + h) * 128 + 32 * kq) * 128 + dv;
#pragma unroll
    for (int i = 0; i < 32; ++i) { float v = ge * s[i];
#pragma unroll
        for (int c = 0; c < 4; ++c) v += L[2560 + c * 128 + 32 * kq + i] * vn[c];
        SO[(size_t)i * 128] = v; }
    LAS float* RED = L + 8768;
    if (kq == 0) {
#pragma unroll
        for (int c = 0; c < 4; ++c) { const float q = wave_sum(oo[c] * oo[c]); if (lane == 0) RED[c * 2 + wave] = q; }
    }
    WG_BARRIER();
    if (kq == 0) {
        bf16* OB = (bf16*)(F.ws + WS_OB); const float nw = F.in[IN_GNORM][dv];
#pragma unroll
        for (int c = 0; c < 4; ++c) { const float rs = rsqrtf((RED[c * 2] + RED[c * 2 + 1]) * (1.0f / 128.0f) + EPS);
            const float z = bf2f(U[(size_t)(row0 + c) * NINP + U_Z + h * 128 + dv]);
            OB[(size_t)(row0 + c) * D + h * 128 + dv] = (bf16)f2bf(oo[c] * rs * nw * (z * sigm(z))); }
    }
    WG_BARRIER();
}

__device__ __forceinline__ void copy_outputs(Frame& F) {
    const bf16* U = (const bf16*)(F.ws + WS_U);
    const long gt = (long)F.bx * 512 + F.tid, NT = (long)F.G * 512;
    constexpr long C0 = 65536, C1 = 262144, C2 = 1048576, CS = 65536, CCP = 4608, CCS = 147456;
    constexpr long TOT = C0 + C1 + C2 + 3 * CS + CCP + CCS;
    for (long c = gt; c < TOT; c += NT) {
        long r = c; int srow, scol; float* dst;
        if (r < C0 + C1 + C2) {
            int g, keep; if (r < C0) { g = 0; keep = 128; dst = F.out + O_KVP0; } else if (r < C0 + C1) { r -= C0; g = 1; keep = 512; dst = F.out + O_KVP1; } else { r -= C0 + C1; g = 2; keep = 2048; dst = F.out + O_KVP2; }
            const int e8 = r & 15, hh = (r >> 4) & 3, kv = (r >> 6) & 1; const int rr = (int)((r >> 7) % keep), bb = (int)((r >> 7) / keep);
            srow = bb * SEQ + SEQ - keep + rr; scol = (kv ? U_VA : U_KA) + (g * 4 + hh) * 128 + e8 * 8; dst += r * 8;
        } else if ((r -= C0 + C1 + C2) < 3 * CS) {
            const int g = (int)(r / CS); r -= (long)g * CS; dst = F.out + (g == 0 ? O_KVS0 : (g == 1 ? O_KVS1 : O_KVS2)) + r * 8;
            const int e8 = r & 15, hh = (r >> 4) & 3, kv = (r >> 6) & 1, ss = (r >> 7) & 3, bb = (int)(r >> 9);
            srow = MP + 4 * bb + ss; scol = (kv ? U_VA : U_KA) + (g * 4 + hh) * 128 + e8 * 8;
        } else if ((r -= 3 * CS) < CCP) {
            const int ch8 = (int)(r % 384), i = (int)((r / 384) % 3), bb = (int)(r / 1152); dst = F.out + O_CONVP + r * 8;
            srow = bb * SEQ + SEQ - 3 + i; scol = U_QKVB + ch8 * 8;
        } else {
            r -= CCP; const int ch8 = (int)(r % 384), i = (int)((r / 384) % 3), bb = (int)(r / 1152); dst = F.out + O_CONVS + r * 8;
            srow = MP + 4 * bb + 1 + i; scol = U_QKVB + ch8 * 8;
        }
        const v4u v = *(const GAS v4u*)(U + (size_t)srow * NINP + scol);
        *(GAS f32x4*)dst = (f32x4){bflo(v.x), bfhi(v.x), bflo(v.y), bfhi(v.y)};
        *(GAS f32x4*)(dst + 4) = (f32x4){bflo(v.z), bfhi(v.z), bflo(v.w), bfhi(v.w)};
    }
}

constexpr int AT_K = 0, AT_V = 69632;
__device__ __forceinline__ int at_off(int row, int ch) { return 256 * row + 16 * (ch ^ (((row & 3) << 2) | ((row >> 2) & 3))); }
template <int OFF>
__device__ __forceinline__ void tr_read2(unsigned a, bf16x4& lo, bf16x4& hi) {
    asm volatile("ds_read_b64_tr_b16 %0, %2 offset:%3\n\tds_read_b64_tr_b16 %1, %2 offset:%4\n\ts_waitcnt lgkmcnt(0)" : "=&v"(lo), "=&v"(hi) : "v"(a), "i"(OFF), "i"(OFF + 4096) : "memory"); }

__device__ __forceinline__ void attn_prompt_unit(Frame& F, int unit) {
    LAS unsigned char* L = F.ldv;
    const int tid = F.tid, lane = F.lane, w = F.wave, m16 = lane & 15, kg = lane >> 4;
    const bf16* U = (const bf16*)(F.ws + WS_U); bf16* OG = (bf16*)(F.ws + WS_OG); float* LSE = (float*)(F.ws + WS_LSE);
    const int h = unit & 3, rb = (unit >> 2) & 31, b = (unit >> 7) & 3, g = unit >> 9;
    const int dil = g == 0 ? 1 : (g == 1 ? 4 : 16), nb = 32 / dil, r = rb / nb, blk = rb % nb, hh = g * 4 + h;
    const float slope = exp2f(-8.0f * (float)(hh + 1) / 12.0f) * (float)dil;
    for (int i = tid; i < 272 * 16; i += 512) {
        const int row = i >> 4, chp = i & 15, ch = chp ^ (((row & 3) << 2) | ((row >> 2) & 3));
        const int sub = blk * 128 + row - 128; v4u kv = {0u, 0u, 0u, 0u}, vv = {0u, 0u, 0u, 0u};
        if (row < 256 && sub >= 0) { const size_t gr = (size_t)(b * SEQ + sub * dil + r) * NINP;
            kv = *(const GAS v4u*)(U + gr + U_KA + hh * 128 + ch * 8); vv = *(const GAS v4u*)(U + gr + U_VA + hh * 128 + ch * 8); }
        *(LAS v4u*)(L + AT_K + i * 16) = kv; *(LAS v4u*)(L + AT_V + i * 16) = vv;
    }
    const int qi = 16 * w + m16; const size_t qrow = (size_t)(b * SEQ + (blk * 128 + qi) * dil + r);
    bf16x8 qf[4];
#pragma unroll
    for (int kb = 0; kb < 4; ++kb) qf[kb] = *(const GAS bf16x8*)(U + qrow * NINP + U_QA + hh * 128 + 32 * kb + 8 * kg);
    WG_BARRIER();
    f32x4 S[10];
    int kbase[4];
#pragma unroll
    for (int kb = 0; kb < 4; ++kb) kbase[kb] = AT_K + at_off(16 * w + m16, 4 * kb + kg);
#pragma unroll
    for (int kt = 0; kt < 10; ++kt) { S[kt] = (f32x4){0.f, 0.f, 0.f, 0.f};
#pragma unroll
        for (int kb = 0; kb < 4; ++kb) S[kt] = mfma16(*(const LAS bf16x8*)(L + kbase[kb] + kt * 4096), qf[kb], S[kt]); }
    const float sc = 0.08838834764831845f * 1.4426950408889634f, sl2 = slope * 1.4426950408889634f;
    float mx = -INFINITY;
#pragma unroll
    for (int kt = 0; kt < 10; ++kt)
#pragma unroll
        for (int jj = 0; jj < 4; ++jj) { const int kj = 16 * w + 16 * kt + 4 * kg + jj, delta = 128 + qi - kj;
            const bool ok = delta >= 0 && delta <= 128 && (blk > 0 || kj >= 128);
            const float v = ok ? S[kt][jj] * sc - sl2 * (float)delta : -INFINITY; S[kt][jj] = v; mx = fmaxf(mx, v); }
    mx = fmaxf(mx, __shfl_xor(mx, 16)); mx = fmaxf(mx, __shfl_xor(mx, 32));
    float sum = 0.f;
#pragma unroll
    for (int kt = 0; kt < 10; ++kt)
#pragma unroll
        for (int jj = 0; jj < 4; ++jj) { const float p = exp2f(S[kt][jj] - mx); S[kt][jj] = p; sum += p; }
    sum += __shfl_xor(sum, 16); sum += __shfl_xor(sum, 32);
    bf16x8 pb[5];
#pragma unroll
    for (int kb2 = 0; kb2 < 5; ++kb2) pb[kb2] = pack8(S[2 * kb2], S[2 * kb2 + 1]);
    f32x4 O[8];
    const int rq = m16 >> 2, cq = m16 & 3;
    unsigned vbase[8];
#pragma unroll
    for (int dt = 0; dt < 8; ++dt) vbase[dt] = (unsigned)(AT_V + at_off(16 * w + 4 * kg + rq, 2 * dt + (cq >> 1)) + 8 * (cq & 1));
#define AT_PV(KB2) do { bf16x4 lo, hi; tr_read2<8192 * (KB2)>(vbase[dt], lo, hi); \
        bf16x8 vf; vf[0] = lo[0]; vf[1] = lo[1]; vf[2] = lo[2]; vf[3] = lo[3]; vf[4] = hi[0]; vf[5] = hi[1]; vf[6] = hi[2]; vf[7] = hi[3]; \
        O[dt] = mfma16(vf, pb[KB2], O[dt]); } while (0)
#pragma unroll
    for (int dt = 0; dt < 8; ++dt) { O[dt] = (f32x4){0.f, 0.f, 0.f, 0.f}; AT_PV(0); AT_PV(1); AT_PV(2); AT_PV(3); AT_PV(4); }
#undef AT_PV
    const float inv = 1.0f / sum;
#pragma unroll
    for (int dt = 0; dt < 8; ++dt) { v2u o; o.x = pk2(O[dt][0] * inv, O[dt][1] * inv); o.y = pk2(O[dt][2] * inv, O[dt][3] * inv);
        *(GAS v2u*)(OG + qrow * 1536 + hh * 128 + 16 * dt + 4 * kg) = o; }
    if (kg == 0) LSE[qrow * 12 + hh] = (mx + log2f(sum)) * 0.6931471805599453f;
    WG_BARRIER();
}

__device__ __forceinline__ void attn_sample_unit(Frame& F, int unit) {
    const int lane = F.lane, w = F.wave;
    LAS float* QL = (LAS float*)F.ldv + w * 320; LAS float* PL = QL + 128;
    const bf16* U = (const bf16*)(F.ws + WS_U); bf16* OG = (bf16*)(F.ws + WS_OG); float* LSE = (float*)(F.ws + WS_LSE);
    const int hp = unit & 1, g = (unit >> 1) % 3, b = unit / 6;
    const int h = 2 * hp + (w >> 2), s = w & 3, hh = g * 4 + h;
    const int dil = g == 0 ? 1 : (g == 1 ? 4 : 16), wb = g == 0 ? 128 : (g == 1 ? 512 : 2048);
    const float* cache = F.in[g == 0 ? IN_C128 : (g == 1 ? IN_C512 : IN_C2048)] + (size_t)b * wb * 1024 + h * 128;
    const float slope = exp2f(-8.0f * (float)(hh + 1) / 12.0f) * (float)dil;
    const size_t qrow = (size_t)(MP + 4 * b + s);
    { const unsigned qq = *(const GAS unsigned*)(U + qrow * NINP + U_QA + hh * 128 + 2 * lane);
      QL[2 * lane] = bflo(qq) * 0.08838834764831845f; QL[2 * lane + 1] = bfhi(qq) * 0.08838834764831845f; }
    LDS_WAIT(); asm volatile("" ::: "memory");
    float sc[3]; float mx = -INFINITY;
#pragma unroll
    for (int rd = 0; rd < 3; ++rd) { const int j = 64 * rd + lane; float a = -INFINITY;
        if (j <= 128) { const int idx = wb + s - dil * j; float acc = 0.f;
            if (idx >= wb) { const bf16* kr = U + (size_t)(MP + 4 * b + idx - wb) * NINP + U_KA + hh * 128;
#pragma unroll 4
                for (int d = 0; d < 128; d += 8) { const v4u kk = *(const GAS v4u*)(kr + d); const f32x4 q0 = *(const LAS f32x4*)(QL + d), q1 = *(const LAS f32x4*)(QL + d + 4);
                    acc += bflo(kk.x) * q0[0] + bfhi(kk.x) * q0[1] + bflo(kk.y) * q0[2] + bfhi(kk.y) * q0[3] + bflo(kk.z) * q1[0] + bfhi(kk.z) * q1[1] + bflo(kk.w) * q1[2] + bfhi(kk.w) * q1[3]; }
            } else { const float* kr = cache + (size_t)idx * 1024;
#pragma unroll 8
                for (int d = 0; d < 128; d += 4) { const f32x4 kk = *(const GAS f32x4*)(kr + d); const f32x4 q0 = *(const LAS f32x4*)(QL + d);
                    acc += kk[0] * q0[0] + kk[1] * q0[1] + kk[2] * q0[2] + kk[3] * q0[3]; } }
            a = acc - slope * (float)j; }
        sc[rd] = a; mx = fmaxf(mx, a); }
    mx = wave_max(mx);
    float sum = 0.f;
#pragma unroll
    for (int rd = 0; rd < 3; ++rd) { const int j = 64 * rd + lane; const float p = (j <= 128) ? __expf(sc[rd] - mx) : 0.f; sum += p; PL[j] = p; }
    sum = wave_sum(sum);
    LDS_WAIT(); asm volatile("" ::: "memory");
    float o0 = 0.f, o1 = 0.f;
    for (int j = 0; j <= 128; ++j) { const int idx = wb + s - dil * j; const float p = PL[j];
        if (idx >= wb) { const unsigned vv = *(const GAS unsigned*)(U + (size_t)(MP + 4 * b + idx - wb) * NINP + U_VA + hh * 128 + 2 * lane); o0 += p * bflo(vv); o1 += p * bfhi(vv); }
        else { const f32x2 vv = *(const GAS f32x2*)(cache + (size_t)idx * 1024 + 512 + 2 * lane); o0 += p * vv[0]; o1 += p * vv[1]; } }
    const float inv = 1.0f / sum;
    *(GAS unsigned*)(OG + qrow * 1536 + hh * 128 + 2 * lane) = pk2(o0 * inv, o1 * inv);
    if (lane == 0) LSE[qrow * 12 + hh] = mx + __logf(sum);
    asm volatile("" ::: "memory");
}

__device__ __forceinline__ void attn_merge(Frame& F) {
    const bf16* OG = (const bf16*)(F.ws + WS_OG); const float* LSE = (const float*)(F.ws + WS_LSE); bf16* OA = (bf16*)(F.ws + WS_OA);
    const long gt = (long)F.bx * 512 + F.tid, NT = (long)F.G * 512;
    for (long c = gt; c < (long)MT * 64; c += NT) {
        const int row = (int)(c >> 6), hs = (int)(c >> 4) & 3, e8 = (int)c & 15;
        const float l0 = LSE[(size_t)row * 12 + hs], l1 = LSE[(size_t)row * 12 + 4 + hs], l2 = LSE[(size_t)row * 12 + 8 + hs];
        const float m = fmaxf(l0, fmaxf(l1, l2)); float w0 = __expf(l0 - m), w1 = __expf(l1 - m), w2 = __expf(l2 - m); const float inv = 1.0f / (w0 + w1 + w2); w0 *= inv; w1 *= inv; w2 *= inv;
        const v4u a = *(const GAS v4u*)(OG + (size_t)row * 1536 + hs * 128 + e8 * 8), bq = *(const GAS v4u*)(OG + (size_t)row * 1536 + (4 + hs) * 128 + e8 * 8), cq = *(const GAS v4u*)(OG + (size_t)row * 1536 + (8 + hs) * 128 + e8 * 8);
        v4u o;
        o.x = pk2(w0 * bflo(a.x) + w1 * bflo(bq.x) + w2 * bflo(cq.x), w0 * bfhi(a.x) + w1 * bfhi(bq.x) + w2 * bfhi(cq.x));
        o.y = pk2(w0 * bflo(a.y) + w1 * bflo(bq.y) + w2 * bflo(cq.y), w0 * bfhi(a.y) + w1 * bfhi(bq.y) + w2 * bfhi(cq.y));
        o.z = pk2(w0 * bflo(a.z) + w1 * bflo(bq.z) + w2 * bflo(cq.z), w0 * bfhi(a.z) + w1 * bfhi(bq.z) + w2 * bfhi(cq.z));
        o.w = pk2(w0 * bflo(a.w) + w1 * bflo(bq.w) + w2 * bflo(cq.w), w0 * bfhi(a.w) + w1 * bfhi(bq.w) + w2 * bfhi(cq.w));
        *(GAS v4u*)(OA + (size_t)row * 512 + hs * 128 + e8 * 8) = o;
    }
}

#ifndef MK_N_LAUNCHES
#define MK_N_LAUNCHES 1
#endif
constexpr int N_PHASES = 12;
struct Args { const float* in[23]; float* out; unsigned char* ws; int ph_lo, ph_hi; };
static_assert(sizeof(Args) == 23 * 8 + 8 + 8 + 8, "Args has no padding");

__device__ __forceinline__ int q_next(Frame& F, int qi) {
    if (F.tid == 0) F.MISC[16] = __hip_atomic_fetch_add((unsigned*)(F.ctl + CW_Q + 64 * qi), 1u, __ATOMIC_RELAXED, __HIP_MEMORY_SCOPE_AGENT);
    __syncthreads();
    const int v = (int)F.MISC[16];
    __syncthreads();
    return v;
}

__global__ void __launch_bounds__(NWAVES * 64, 2) mk_fwd(Args args) {
    extern __shared__ __attribute__((aligned(16))) unsigned char lds[];
    Frame F;
    F.lds = (LAS unsigned char*)lds;
    { unsigned z = 0u; asm volatile("" : "+v"(z)); F.ldv = (LAS unsigned char*)lds + z; }
    F.MISC = (volatile LAS unsigned*)(F.lds + MISC_OFF);
    F.tid = threadIdx.x; F.lane = F.tid & 63; F.wave = __builtin_amdgcn_readfirstlane(F.tid >> 6);
    F.G = gridDim.x; F.bx = blockIdx.x;
    F.ws = args.ws; F.out = args.out; F.ctl = (gu32*)(args.ws + WS_CTL);
    F.in = args.in;
    for (int u = F.tid; u < (LDS_BYTES - LDSCTL_OFF) / 4; u += NWAVES * 64) ((LAS unsigned*)(F.lds + LDSCTL_OFF))[u] = 0u;
    __syncthreads();
    const bool one = (args.ph_hi - args.ph_lo) > 1;
    XcdBarrier bar; bar.bar = (unsigned*)(F.ctl + CW_BAR); bar.x = 0; bar.st = nullptr;
    if (one) bar = xcd_barrier_post((unsigned*)(F.ctl + CW_BAR), F.MISC + 8);
    const int lo = args.ph_lo, hi = args.ph_hi;
#ifndef PHASE_MASK
#define PHASE_MASK 0xFFF
#endif
#define IN(k) ((((PHASE_MASK) >> (k)) & 1) && lo <= (k) && (k) < hi)
#define SEAM(k) do { if (IN(k) && IN((k) + 1)) xcd_barrier(bar); } while (0)

    bf16* XB = (bf16*)(F.ws + WS_XB); bf16* ACT = (bf16*)(F.ws + WS_ACT); float* X1 = (float*)(F.ws + WS_X1); bf16* X1B = (bf16*)(F.ws + WS_X1B);
    bf16* UU = (bf16*)(F.ws + WS_U); float* BA = (float*)(F.ws + WS_BA); bf16* OB = (bf16*)(F.ws + WS_OB); bf16* OA = (bf16*)(F.ws + WS_OA);
    bf16* M1 = (bf16*)(F.ws + WS_M1); bf16* MG = (bf16*)(F.ws + WS_MG); float* X2 = (float*)(F.ws + WS_X2); bf16* X2B = (bf16*)(F.ws + WS_X2B);
    float* SSQ2 = (float*)(args.ws + WS_CTL) + CW_SSQ2; float* SSQ3 = (float*)(args.ws + WS_CTL) + CW_SSQ3; float* SSQ4 = (float*)(args.ws + WS_CTL) + CW_SSQ4;

    if (IN(0)) { p0_prologue(F); } SEAM(0);
    if (IN(1)) {
        pg8::Gemm g{XB, (const bf16*)(F.ws + WS_W1A), MT, NGU, D}; pg8::StaticOrder S; S.init(MT, NGU, F.G, F.bx);
        pg8::EpiSwiglu E{ACT, (const float*)(F.ws + WS_RSTD1), 0};
        pg8::gemm_phase<pg8::EpiSwiglu, pg8::StaticOrder, true, true>(F.lds + RING_OFF, g, S, E);
    } SEAM(1);
    if (IN(2)) {
        pg8::Gemm g{ACT, (const bf16*)(F.ws + WS_W1B), MT, D, FF}; pg8::StaticOrder S; S.init(MT, D, F.G, F.bx);
        pg8::EpiResid E{F.in[IN_XP], F.in[IN_XS] - (size_t)MP * D, X1, X1B, SSQ2, 0.5f};
        pg8::gemm_phase<pg8::EpiResid, pg8::StaticOrder, true, true>(F.lds + RING_OFF, g, S, E);
    } SEAM(2);
    if (IN(3)) {
        pg8::Gemm g{X1B, (const bf16*)(F.ws + WS_WIN), MT, NINP, D}; pg8::StaticOrder S; S.init(MT, NINP, F.G, F.bx);
        pg8::EpiU E{UU, BA, SSQ2};
        pg8::gemm_phase<pg8::EpiU, pg8::StaticOrder, true, true>(F.lds + RING_OFF, g, S, E);
    } SEAM(3);
    if (IN(4)) {
        for (int i = F.bx; i < NREC + DB * 8; i += F.G) {
#ifndef PH4_MASK
#define PH4_MASK 7
#endif
            if (i < NREC) { if (PH4_MASK & 1) { const int n = i >> 5, bh = i & 31; gdn_prep_unit(F, bh >> 3, bh & 7, n); } }
            else { if (PH4_MASK & 2) { const int j = i - NREC; gdn_sample_unit(F, j >> 3, j & 7); } }
        }
        if (PH4_MASK & 4) copy_outputs(F);
    } SEAM(4);
    if (IN(5)) {
#ifndef PH5_MASK
#define PH5_MASK 7
#endif
        if ((PH5_MASK & 1) && F.bx < NB * 8) gdn_scan_chain(F, F.bx);
        for (;;) { const int u = q_next(F, 0); if (u >= 768 + 1536) break;
            if (u < 768) { if (PH5_MASK & 2) attn_sample_unit(F, u); } else { if (PH5_MASK & 4) attn_prompt_unit(F, u - 768); } }
    } SEAM(5);
    if (IN(6)) { attn_merge(F); } SEAM(6);
    if (IN(7)) {
        { pg8::Gemm g{OA, (const bf16*)(F.ws + WS_WPA), MT, D, 512}; pg8::StaticOrder S; S.init(MT, D, F.G, F.bx);
          pg8::EpiGate<0> E{UU, nullptr, M1};
          pg8::gemm_phase<pg8::EpiGate<0>, pg8::StaticOrder, true, true>(F.lds + RING_OFF, g, S, E); }
        { pg8::Gemm g{OB, (const bf16*)(F.ws + WS_WPB), MT, D, D}; pg8::StaticOrder S; S.init(MT, D, F.G, F.bx);
          pg8::EpiGate<1> E{UU, M1, MG};
          pg8::gemm_phase<pg8::EpiGate<1>, pg8::StaticOrder, true, true>(F.lds + RING_OFF, g, S, E); }
    } SEAM(7);
    if (IN(8)) {
        pg8::Gemm g{MG, (const bf16*)(F.ws + WS_WOUT), MT, D, D}; pg8::StaticOrder S; S.init(MT, D, F.G, F.bx);
        pg8::EpiResid E{X1, X1, X2, X2B, SSQ3, 1.0f};
        pg8::gemm_phase<pg8::EpiResid, pg8::StaticOrder, true, true>(F.lds + RING_OFF, g, S, E);
    } SEAM(8);
    if (IN(9)) {
        pg8::Gemm g{X2B, (const bf16*)(F.ws + WS_W2A), MT, NGU, D}; pg8::StaticOrder S; S.init(MT, NGU, F.G, F.bx);
        pg8::EpiSwiglu E{ACT, SSQ3, 1};
        pg8::gemm_phase<pg8::EpiSwiglu, pg8::StaticOrder, true, true>(F.lds + RING_OFF, g, S, E);
    } SEAM(9);
    if (IN(10)) {
        pg8::Gemm g{ACT, (const bf16*)(F.ws + WS_W2B), MT, D, FF}; pg8::StaticOrder S; S.init(MT, D, F.G, F.bx);
        pg8::EpiResid E{X2, X2, F.out + O_Y, nullptr, SSQ4, 0.5f};
        pg8::gemm_phase<pg8::EpiResid, pg8::StaticOrder, true, true>(F.lds + RING_OFF, g, S, E);
    } SEAM(10);
    if (IN(11)) { final_norm(F); }
#undef IN
#undef SEAM
}

extern "C" void kernel_launch(void* const* d_in, const int* in_sizes, int n_in, void* d_out, int out_size, void* d_ws, size_t ws_size, hipStream_t stream) {
    static int grid = 0;
    if (grid == 0) {
        if (n_in != 23 || out_size != (int)O_END || ws_size < WS_END) { fprintf(stderr, "kernel_launch: unexpected sizes n_in %d out %d ws %zu (need %zu)\n", n_in, out_size, ws_size, (size_t)WS_END); grid = -1; return; }
        int dev = 0, cus = 0, per_cu = 0;
        if (hipGetDevice(&dev) != hipSuccess || hipDeviceGetAttribute(&cus, hipDeviceAttributeMultiprocessorCount, dev) != hipSuccess) { grid = -1; return; }
        if (hipFuncSetAttribute((const void*)mk_fwd, hipFuncAttributeMaxDynamicSharedMemorySize, LDS_BYTES) != hipSuccess) { fprintf(stderr, "kernel_launch: hipFuncSetAttribute failed\n"); grid = -1; return; }
        if (hipOccupancyMaxActiveBlocksPerMultiprocessor(&per_cu, (const void*)mk_fwd, NWAVES * 64, LDS_BYTES) != hipSuccess || per_cu < 1) { fprintf(stderr, "kernel_launch: occupancy query says %d\n", per_cu); per_cu = 1; }
        (void)hipGetLastError();
        grid = cus;
    }
    if (grid < 0) return;
    if (hipMemsetAsync((char*)d_ws + WS_CTL, 0, CTL_ZERO_BYTES, stream) != hipSuccess) return;
    Args a{};
    for (int i = 0; i < 23; ++i) a.in[i] = (const float*)d_in[i];
    a.out = (float*)d_out; a.ws = (unsigned char*)d_ws;
#if MK_N_LAUNCHES == 1
    a.ph_lo = 0; a.ph_hi = N_PHASES;
    hipLaunchKernelGGL(mk_fwd, dim3(grid), dim3(NWAVES * 64), LDS_BYTES, stream, a);
#else
    for (int p = 0; p < N_PHASES; ++p) { a.ph_lo = p; a.ph_hi = p + 1; hipLaunchKernelGGL(mk_fwd, dim3(grid), dim3(NWAVES * 64), LDS_BYTES, stream, a); }
#endif
}
```

```cpp
#include <hip/hip_runtime.h>
#include <cstdio>
#include <cstdint>
#define MK_N_LAUNCHES 1
namespace pg8 {
#define PG8_LAS __attribute__((address_space(3)))
typedef unsigned short bf16_t;
typedef short bf16x8 __attribute__((ext_vector_type(8)));
typedef float f32x4 __attribute__((ext_vector_type(4)));
typedef unsigned u32x4 __attribute__((ext_vector_type(4)));
constexpr int BM = 256, BK = 64, HALF = 128, HTB = HALF * BK * 2  , STAGE_BYTES = 8 * HTB, NXCD = 8, WGM = 8;

__host__ __device__ __forceinline__ int lds_byte(int r, int c) { const int st = (r >> 4) * 2 + (c >> 5), rr = r & 15, cc = c & 31, ob = rr * 64 + cc * 2; return st * 1024 + (ob ^ (((ob >> 9) & 1) << 5)); }
__host__ __device__ __forceinline__ void stage_rc(int b, int& R, int& C) { const int st = b / 1024, sb = b % 1024, swz = sb ^ (((sb >> 9) & 1) << 5); R = (st >> 1) * 16 + swz / 64; C = (st & 1) * 32 + (swz % 64) / 2; }
__host__ __device__ __forceinline__ int perm32(int rho) { const int n = rho >> 4, i = rho & 15; return 8 * (i >> 2) + 4 * n + (i & 3); }

struct Unit { int pm, pn; };
struct Gemm { const bf16_t* A; const bf16_t* Bt; int M, N, K; };
struct StaticOrder {
    int nM, nN, nwg, G, c;
    __host__ __device__ void init(int M, int N, int G_, int c_) { nM = M / BM; nN = N / BM; nwg = nM * nN; G = G_; c = c_; }
    __host__ __device__ bool next(int i, Unit& u) const {
        const long L = (long)i * G + c; if (L >= nwg) return false;
        int wgid = (int)L; { const int q = nwg / NXCD, r = nwg % NXCD, xcd = wgid % NXCD, off = wgid / NXCD; wgid = (xcd < r ? xcd * (q + 1) : r * (q + 1) + (xcd - r) * q) + off; }
        const int nig = WGM * nN, gid = wgid / nig, fm = gid * WGM, gsz = (nM - fm) < WGM ? (nM - fm) : WGM;
        u.pm = fm + ((wgid % nig) % gsz); u.pn = (wgid % nig) / gsz; return true;
    }
    __device__ __forceinline__ void a_ready(const Unit&) const {}
    __device__ __forceinline__ void done(const Unit&) const {}
};
__device__ __forceinline__ unsigned cvt_pk_bf16(float lo, float hi) { unsigned r; asm volatile("v_cvt_pk_bf16_f32 %0, %1, %2" : "=v"(r) : "v"(lo), "v"(hi)); return r; }
typedef float f32x2 __attribute__((ext_vector_type(2)));
template <class Epi, class Sched, bool ALIGN_EPI = false, bool SP2 = false>
__device__ __forceinline__ void gemm_phase(PG8_LAS unsigned char* lds, const Gemm g, const Sched& S, const Epi& E) {
    const int tid = threadIdx.x, wid = __builtin_amdgcn_readfirstlane(tid >> 6), lane = tid & 63, wr = wid >> 2, wc = wid & 3, fr = lane & 15, fq = lane >> 4;
    const int K = g.K, nt = K / BK;
    unsigned voffA[2], voffB[2];
#pragma unroll
    for (int i = 0; i < 2; ++i) { int R, C; stage_rc(tid * 16 + i * 8192, R, C); const int Rb = Epi::PERM ? ((R & ~31) + perm32(R & 31)) : R;
        voffA[i] = (unsigned)(R * K + C) * 2u; voffB[i] = (unsigned)(Rb * K + C) * 2u; }
    const size_t kstep = (size_t)(BK * 2);
    const size_t hstep = (size_t)HALF * K * 2;
    const size_t tstep = 2 * hstep;
    const unsigned ldsw = (unsigned)wid * 1024u;
    const int aoff = lds_byte(wr * 64 + fr, fq * 8), boff = lds_byte(wc * 32 + fr, fq * 8);
#define PG8_SA(b, h) (((b) * 2 + (h)) * HTB)
#define PG8_SB(b, h) ((4 + (b) * 2 + (h)) * HTB)
#define PG8_STAGE(bufoff, gbase, voff) do { _Pragma("unroll") for (int _i = 0; _i < 2; ++_i) \
        __builtin_amdgcn_global_load_lds((const unsigned*)((const char*)(gbase) + (voff)[_i]), (PG8_LAS unsigned*)(lds + (bufoff) + ldsw + _i * 8192), 16, 0, 0); } while (0)
#define PG8_LDA(dst, b, h) do { _Pragma("unroll") for (int m = 0; m < 4; ++m) _Pragma("unroll") for (int k = 0; k < 2; ++k) dst[m][k] = *(const PG8_LAS bf16x8*)(lds + PG8_SA(b, h) + aoff + m * 2048 + k * 1024); } while (0)
#define PG8_LDB(dst, b, h) do { _Pragma("unroll") for (int n = 0; n < 2; ++n) _Pragma("unroll") for (int k = 0; k < 2; ++k) dst[n][k] = *(const PG8_LAS bf16x8*)(lds + PG8_SB(b, h) + boff + n * 2048 + k * 1024); } while (0)
#define PG8_MMA(ai, bj, At, Bt) do { __builtin_amdgcn_s_setprio(1); _Pragma("unroll") for (int m = 0; m < 4; ++m) _Pragma("unroll") for (int n = 0; n < 2; ++n) _Pragma("unroll") for (int k = 0; k < 2; ++k) \
        acc[ai][bj][m][n] = __builtin_amdgcn_mfma_f32_16x16x32_bf16(Bt[n][k], At[m][k], acc[ai][bj][m][n], 0, 0, 0); __builtin_amdgcn_s_setprio(0); } while (0)
#define PG8_WAIT_V(n) asm volatile("s_waitcnt vmcnt(" #n ")" ::: "memory")
#define PG8_WAIT_L(n) asm volatile("s_waitcnt lgkmcnt(" #n ")" ::: "memory")
#define PG8_BAR __builtin_amdgcn_s_barrier()
#define PG8_SCHED __builtin_amdgcn_sched_barrier(0)
    Unit cur, nxt; int ui = 0;
    if (!S.next(0, cur)) return;
    f32x4 acc[2][2][4][2];
#pragma unroll
    for (int a = 0; a < 2; ++a)
#pragma unroll
        for (int b = 0; b < 2; ++b)
#pragma unroll
            for (int m = 0; m < 4; ++m)
#pragma unroll
                for (int n = 0; n < 2; ++n) acc[a][b][m][n] = (f32x4){0.f, 0.f, 0.f, 0.f};
    bf16x8 At[4][2], B0[2][2], B1[2][2];
    const char* cA = (const char*)g.A + (size_t)cur.pm * tstep; const char* cB = (const char*)g.Bt + (size_t)cur.pn * tstep;
    S.a_ready(cur);
    if constexpr (SP2) {
        PG8_STAGE(PG8_SB(0, 0), cB, voffB); PG8_STAGE(PG8_SB(0, 1), cB + hstep, voffB); PG8_STAGE(PG8_SA(0, 0), cA, voffA); PG8_STAGE(PG8_SA(0, 1), cA + hstep, voffA);
        if (wr == 1) PG8_BAR;
        PG8_WAIT_V(2); PG8_BAR;
        PG8_STAGE(PG8_SB(1, 0), cB + kstep, voffB); PG8_STAGE(PG8_SA(1, 0), cA + kstep, voffA); PG8_STAGE(PG8_SB(1, 1), cB + hstep + kstep, voffB);
        PG8_WAIT_V(6); PG8_BAR;
    } else {
        PG8_STAGE(PG8_SB(0, 0), cB, voffB); PG8_STAGE(PG8_SA(0, 0), cA, voffA); PG8_STAGE(PG8_SB(0, 1), cB + hstep, voffB); PG8_STAGE(PG8_SA(0, 1), cA + hstep, voffA);
        if (wr == 1) PG8_BAR;
        PG8_WAIT_V(4); PG8_BAR;
        PG8_STAGE(PG8_SB(1, 0), cB + kstep, voffB); PG8_STAGE(PG8_SA(1, 0), cA + kstep, voffA); PG8_STAGE(PG8_SB(1, 1), cB + hstep + kstep, voffB);
        PG8_WAIT_V(6); PG8_BAR;
    }
    for (;;) {
        const bool has_next = S.next(ui + 1, nxt);
        const char* nA = has_next ? (const char*)g.A + (size_t)nxt.pm * tstep : cA; const char* nB = has_next ? (const char*)g.Bt + (size_t)nxt.pn * tstep : cB;
        for (int t = 0; t < nt; t += 2) {
            const bool last = (t == nt - 2);
            const char* a1 = cA + (size_t)(t + 1) * kstep;
            const char* a2 = last ? nA : cA + (size_t)(t + 2) * kstep; const char* b2 = last ? nB : cB + (size_t)(t + 2) * kstep;
            const char* a3 = a2 + kstep; const char* b3 = b2 + kstep;
            if (last && has_next) S.a_ready(nxt);
            if constexpr (SP2) {
            PG8_LDB(B0, 0, 0); PG8_LDB(B1, 0, 1); PG8_SCHED; PG8_LDA(At, 0, 0); PG8_STAGE(PG8_SA(1, 1), a1 + hstep, voffA);
            PG8_WAIT_V(8); PG8_WAIT_L(0); PG8_BAR; PG8_MMA(0, 0, At, B0); PG8_MMA(0, 1, At, B1); PG8_BAR; PG8_SCHED;
            PG8_LDA(At, 0, 1); PG8_STAGE(PG8_SB(0, 0), b2, voffB); PG8_STAGE(PG8_SB(0, 1), b2 + hstep, voffB); PG8_STAGE(PG8_SA(0, 0), a2, voffA);
            PG8_WAIT_V(8); PG8_WAIT_L(0); PG8_BAR; PG8_MMA(1, 0, At, B0); PG8_MMA(1, 1, At, B1); PG8_BAR; PG8_SCHED;
            PG8_LDB(B0, 1, 0); PG8_LDB(B1, 1, 1); PG8_SCHED; PG8_LDA(At, 1, 0); PG8_STAGE(PG8_SA(0, 1), a2 + hstep, voffA);
            PG8_WAIT_V(8); PG8_WAIT_L(0); PG8_BAR; PG8_MMA(0, 0, At, B0); PG8_MMA(0, 1, At, B1); PG8_BAR; PG8_SCHED;
            PG8_LDA(At, 1, 1); PG8_STAGE(PG8_SB(1, 0), b3, voffB); PG8_STAGE(PG8_SB(1, 1), b3 + hstep, voffB); PG8_STAGE(PG8_SA(1, 0), a3, voffA);
            PG8_WAIT_V(8); PG8_WAIT_L(0); PG8_BAR; PG8_MMA(1, 0, At, B0); PG8_MMA(1, 1, At, B1); PG8_BAR; PG8_SCHED;
            } else {
            PG8_LDB(B0, 0, 0); PG8_SCHED; PG8_LDA(At, 0, 0); PG8_STAGE(PG8_SA(1, 1), a1 + hstep, voffA);
            PG8_WAIT_L(8); PG8_BAR; PG8_WAIT_L(0); PG8_MMA(0, 0, At, B0); PG8_BAR; PG8_SCHED;
            PG8_LDB(B1, 0, 1); PG8_STAGE(PG8_SB(0, 0), b2, voffB);
            PG8_BAR; PG8_WAIT_L(0); PG8_MMA(0, 1, At, B1); PG8_BAR;
            PG8_LDA(At, 0, 1); PG8_STAGE(PG8_SA(0, 0), a2, voffA);
            PG8_BAR; PG8_WAIT_L(0); PG8_MMA(1, 0, At, B0); PG8_BAR; PG8_SCHED;
            PG8_STAGE(PG8_SB(0, 1), b2 + hstep, voffB);
            PG8_WAIT_V(6); PG8_BAR; PG8_MMA(1, 1, At, B1); PG8_BAR;
            PG8_LDB(B0, 1, 0); PG8_SCHED; PG8_LDA(At, 1, 0); PG8_STAGE(PG8_SA(0, 1), a2 + hstep, voffA);
            PG8_WAIT_L(8); PG8_BAR; PG8_WAIT_L(0); PG8_MMA(0, 0, At, B0); PG8_BAR; PG8_SCHED;
            PG8_LDB(B1, 1, 1); PG8_STAGE(PG8_SB(1, 0), b3, voffB);
            PG8_BAR; PG8_WAIT_L(0); PG8_MMA(0, 1, At, B1); PG8_BAR;
            PG8_LDA(At, 1, 1); PG8_STAGE(PG8_SA(1, 0), a3, voffA);
            PG8_BAR; PG8_WAIT_L(0); PG8_MMA(1, 0, At, B0); PG8_BAR; PG8_SCHED;
            PG8_STAGE(PG8_SB(1, 1), b3 + hstep, voffB);
            PG8_WAIT_V(6); PG8_BAR; PG8_MMA(1, 1, At, B1); PG8_BAR;
            }
        }
        if constexpr (ALIGN_EPI) { if (wr == 0) PG8_BAR; }
        if constexpr (!Epi::AFTER_DRAIN) { E(acc, cur, wr, wc, fr, fq); S.done(cur); }
        if (!has_next) break;
#pragma unroll
        for (int a = 0; a < 2; ++a)
#pragma unroll
            for (int b = 0; b < 2; ++b)
#pragma unroll
                for (int m = 0; m < 4; ++m)
#pragma unroll
                    for (int n = 0; n < 2; ++n) acc[a][b][m][n] = (f32x4){0.f, 0.f, 0.f, 0.f};
        cur = nxt; cA = nA; cB = nB; ++ui;
        if constexpr (ALIGN_EPI) { if (wr == 1) PG8_BAR; }
    }
    PG8_WAIT_V(0);
    if constexpr (!ALIGN_EPI) { if (wr == 0) PG8_BAR; }
    PG8_BAR;
    if constexpr (Epi::AFTER_DRAIN) { E.fused(acc, cur, wr, wc, fr, fq, lds, wid, lane); S.done(cur); }
#undef PG8_SA
#undef PG8_SB
#undef PG8_STAGE
#undef PG8_LDA
#undef PG8_LDB
#undef PG8_MMA
#undef PG8_WAIT_V
#undef PG8_WAIT_L
#undef PG8_BAR
#undef PG8_SCHED
}
}

constexpr int D = 1024, MP = 16384, MS = 512, MT = MP + MS, FF = 2816, NGU = 2 * FF;
constexpr int SEQ = 4096, NB = 4, DB = 128, DS = 4;
constexpr int NIN = 10768, NINP = 11008;
constexpr int U_QA = 0, U_KA = 1536, U_VA = 3072, U_QKVB = 4608, U_Z = 7680, U_GATE = 8704, U_BA = 10752;
constexpr float EPS = 1e-6f;

namespace pg8 {
typedef unsigned u32x2 __attribute__((ext_vector_type(2)));
__device__ __forceinline__ float sigm(float x) { return 1.f / (1.f + __expf(-x)); }
__device__ __forceinline__ float bf2f(unsigned short b) { return __uint_as_float(((unsigned)b) << 16); }
__device__ __forceinline__ float bflo(unsigned w) { return __uint_as_float(w << 16); }
__device__ __forceinline__ float bfhi(unsigned w) { return __uint_as_float(w & 0xffff0000u); }

struct EpiSwiglu {
    static constexpr bool PERM = true, AFTER_DRAIN = false;
    bf16_t* O; const float* rs; int mode;
    __device__ __forceinline__ void operator()(const f32x4 (&acc)[2][2][4][2], const Unit& u, int wr, int wc, int fr, int fq) const {
        const int row0 = u.pm * BM + wr * 64 + fr, col0 = u.pn * 128 + wc * 32 + 8 * fq;
#pragma unroll
        for (int ai = 0; ai < 2; ++ai)
#pragma unroll
            for (int m = 0; m < 4; ++m) {
                const int row = row0 + ai * HALF + m * 16;
                float r = rs[row]; if (mode) r = rsqrtf(r * (1.0f / D) + EPS);
                float o[8];
#pragma unroll
                for (int n = 0; n < 2; ++n)
#pragma unroll
                    for (int j = 0; j < 4; ++j) { const float g = acc[ai][0][m][n][j] * r, up = acc[ai][1][m][n][j] * r; o[4 * n + j] = g * sigm(g) * up; }
                u32x4 w; w.x = cvt_pk_bf16(o[0], o[1]); w.y = cvt_pk_bf16(o[2], o[3]); w.z = cvt_pk_bf16(o[4], o[5]); w.w = cvt_pk_bf16(o[6], o[7]);
                *(u32x4*)(O + (size_t)row * FF + col0) = w;
            }
    }
};
struct EpiResid {
    static constexpr bool PERM = false, AFTER_DRAIN = false;
    const float* base; const float* base2; float* out; bf16_t* xb; float* ssq; float scale;
    __device__ __forceinline__ void operator()(const f32x4 (&acc)[2][2][4][2], const Unit& u, int wr, int wc, int fr, int fq) const {
        const int row0 = u.pm * BM + wr * 64 + fr, col0 = u.pn * BM + wc * 32 + 4 * fq;
        const float* base = (u.pm * BM < MP) ? this->base : base2;
#pragma unroll
        for (int ai = 0; ai < 2; ++ai)
#pragma unroll
            for (int m = 0; m < 4; ++m) {
                const int row = row0 + ai * HALF + m * 16; const size_t off = (size_t)row * D + col0; float s = 0.f;
#pragma unroll
                for (int bj = 0; bj < 2; ++bj)
#pragma unroll
                    for (int n = 0; n < 2; ++n) {
                        const f32x4 b = *(const f32x4*)(base + off + bj * HALF + n * 16); const f32x4 v = b + acc[ai][bj][m][n] * scale;
                        *(f32x4*)(out + off + bj * HALF + n * 16) = v;
                        if (xb) { u32x2 w; w.x = cvt_pk_bf16(v[0], v[1]); w.y = cvt_pk_bf16(v[2], v[3]); *(u32x2*)(xb + off + bj * HALF + n * 16) = w; }
                        s += (v[0] * v[0] + v[1] * v[1]) + (v[2] * v[2] + v[3] * v[3]);
                    }
                s += __shfl_xor(s, 16); s += __shfl_xor(s, 32);
                if (fq == 0) atomicAdd(ssq + row, s);
            }
    }
};
struct EpiU {
    static constexpr bool PERM = true, AFTER_DRAIN = false;
    bf16_t* U; float* BA; const float* ssq;
    __device__ __forceinline__ void operator()(const f32x4 (&acc)[2][2][4][2], const Unit& u, int wr, int wc, int fr, int fq) const {
        const int row0 = u.pm * BM + wr * 64 + fr, col0 = u.pn * BM + wc * 32 + 8 * fq;
        const bool ba = (u.pn * BM == U_BA);
#pragma unroll
        for (int ai = 0; ai < 2; ++ai)
#pragma unroll
            for (int m = 0; m < 4; ++m) {
                const int row = row0 + ai * HALF + m * 16; const float r = rsqrtf(ssq[row] * (1.0f / D) + EPS);
                if (!ba) {
#pragma unroll
                    for (int bj = 0; bj < 2; ++bj) { const f32x4 v0 = acc[ai][bj][m][0] * r, v1 = acc[ai][bj][m][1] * r;
                        u32x4 w; w.x = cvt_pk_bf16(v0[0], v0[1]); w.y = cvt_pk_bf16(v0[2], v0[3]); w.z = cvt_pk_bf16(v1[0], v1[1]); w.w = cvt_pk_bf16(v1[2], v1[3]);
                        *(u32x4*)(U + (size_t)row * NINP + col0 + bj * HALF) = w; }
                } else if (wc == 0 && fq < 2) {
                    *(f32x4*)(BA + (size_t)row * 16 + 8 * fq) = acc[ai][0][m][0] * r; *(f32x4*)(BA + (size_t)row * 16 + 8 * fq + 4) = acc[ai][0][m][1] * r;
                }
            }
    }
};
template <int SECOND> struct EpiGate {
    static constexpr bool PERM = true, AFTER_DRAIN = false;
    const bf16_t* U; const bf16_t* M1; bf16_t* O;
    __device__ __forceinline__ void operator()(const f32x4 (&acc)[2][2][4][2], const Unit& u, int wr, int wc, int fr, int fq) const {
        const int row0 = u.pm * BM + wr * 64 + fr, col0 = u.pn * BM + wc * 32 + 8 * fq;
#pragma unroll
        for (int ai = 0; ai < 2; ++ai)
#pragma unroll
            for (int m = 0; m < 4; ++m) {
                const int row = row0 + ai * HALF + m * 16;
#pragma unroll
                for (int bj = 0; bj < 2; ++bj) {
                    const int col = col0 + bj * HALF;
                    const u32x4 g = *(const u32x4*)(U + (size_t)row * NINP + U_GATE + SECOND * D + col);
                    float o[8]; const f32x4 a0 = acc[ai][bj][m][0], a1 = acc[ai][bj][m][1];
                    o[0] = sigm(bflo(g.x)) * a0[0]; o[1] = sigm(bfhi(g.x)) * a0[1]; o[2] = sigm(bflo(g.y)) * a0[2]; o[3] = sigm(bfhi(g.y)) * a0[3];
                    o[4] = sigm(bflo(g.z)) * a1[0]; o[5] = sigm(bfhi(g.z)) * a1[1]; o[6] = sigm(bflo(g.w)) * a1[2]; o[7] = sigm(bfhi(g.w)) * a1[3];
                    if (SECOND) { const u32x4 p = *(const u32x4*)(M1 + (size_t)row * D + col);
                        o[0] += bflo(p.x); o[1] += bfhi(p.x); o[2] += bflo(p.y); o[3] += bfhi(p.y); o[4] += bflo(p.z); o[5] += bfhi(p.z); o[6] += bflo(p.w); o[7] += bfhi(p.w); }
                    u32x4 w; w.x = cvt_pk_bf16(o[0], o[1]); w.y = cvt_pk_bf16(o[2], o[3]); w.z = cvt_pk_bf16(o[4], o[5]); w.w = cvt_pk_bf16(o[6], o[7]);
                    *(u32x4*)(O + (size_t)row * D + col) = w;
                }
            }
    }
};
}

#define GAS __attribute__((address_space(1)))
#define LAS __attribute__((address_space(3)))
typedef unsigned short bf16;
typedef unsigned v4u __attribute__((ext_vector_type(4)));
typedef unsigned v2u __attribute__((ext_vector_type(2)));
typedef float f32x4 __attribute__((ext_vector_type(4)));
typedef float f32x2 __attribute__((ext_vector_type(2)));
typedef short bf16x8 __attribute__((ext_vector_type(8)));
typedef short bf16x4 __attribute__((ext_vector_type(4)));
typedef GAS unsigned gu32;
#define RLX_AGENT __ATOMIC_RELAXED, __HIP_MEMORY_SCOPE_AGENT
#define LDS_WAIT() asm volatile("s_waitcnt lgkmcnt(0)" ::: "memory")
#define VM_WAIT() asm volatile("s_waitcnt vmcnt(0)" ::: "memory")
__device__ __forceinline__ unsigned f2bf(float f) { unsigned u = __builtin_bit_cast(unsigned, f); return (u + 0x7fffu + ((u >> 16) & 1u)) >> 16; }
__device__ __forceinline__ unsigned pk2(float lo, float hi) { return f2bf(lo) | (f2bf(hi) << 16); }
__device__ __forceinline__ float bf2f(unsigned short b) { return __uint_as_float(((unsigned)b) << 16); }
__device__ __forceinline__ float bflo(unsigned w) { return __uint_as_float(w << 16); }
__device__ __forceinline__ float bfhi(unsigned w) { return __uint_as_float(w & 0xffff0000u); }
__device__ __forceinline__ float sigm(float x) { return 1.f / (1.f + __expf(-x)); }
__device__ __forceinline__ float siluf(float x) { return x / (1.f + __expf(-x)); }
__device__ __forceinline__ float wave_sum(float v) {
#pragma unroll
    for (int o = 1; o < 64; o <<= 1) v += __shfl_xor(v, o);
    return v;
}
__device__ __forceinline__ float wave_max(float v) {
#pragma unroll
    for (int o = 1; o < 64; o <<= 1) v = fmaxf(v, __shfl_xor(v, o));
    return v;
}
__device__ __forceinline__ f32x4 mfma16(bf16x8 a, bf16x8 b, f32x4 c) { return __builtin_amdgcn_mfma_f32_16x16x32_bf16(a, b, c, 0, 0, 0); }
__device__ __forceinline__ bf16x8 pack8(f32x4 a, f32x4 b) {
    v4u w; w.x = pk2(a[0], a[1]); w.y = pk2(a[2], a[3]); w.z = pk2(b[0], b[1]); w.w = pk2(b[2], b[3]); return __builtin_bit_cast(bf16x8, w);
}
#define WG_BARRIER() __syncthreads()
#define XB_TMO      128
#define XB_XCNT(j)  (256  + 64 * (j))
#define XB_XSUB(j)  (1280 + 64 * (j))
#define XB_XGEN(j)  (2304 + 64 * (j))
#define XB_TOP      3328
#define XB_TOPGEN   3392
#define XCD_BAR_WORDS 3456
#define XB_SPIN_CAP (1u << 18)

__device__ __forceinline__ unsigned xb_ld(unsigned* p)              { return __hip_atomic_load(p, __ATOMIC_RELAXED, __HIP_MEMORY_SCOPE_AGENT); }
__device__ __forceinline__ unsigned xb_add(unsigned* p, unsigned v) { return __hip_atomic_fetch_add(p, v, __ATOMIC_RELAXED, __HIP_MEMORY_SCOPE_AGENT); }
__device__ __forceinline__ unsigned xb_xcc_id() { return (unsigned)__builtin_amdgcn_s_getreg((3 << 11) | 20) & 0xFu; }
#define XB_SPIN(cond, bar) do { unsigned _sp = 0; while (cond) { __builtin_amdgcn_s_sleep(1); \
    if ((++_sp & 255u) == 0u) { if (xb_ld(&(bar)[XB_TMO])) break; if (_sp > XB_SPIN_CAP) { atomicAdd(&(bar)[XB_TMO], 1u); break; } } } } while (0)

struct XcdBarrier {
    unsigned* bar; unsigned x;
    volatile LAS unsigned* st;
};

__device__ __forceinline__ XcdBarrier xcd_barrier_post(unsigned* bar, volatile LAS unsigned* st) {
    XcdBarrier b; b.bar = bar; b.x = xb_xcc_id(); b.st = st;
    if (threadIdx.x == 0) (void)xb_add(&bar[XB_XCNT(b.x)], 1u);
    return b;
}
__device__ __forceinline__ void xcd_barrier_complete(unsigned* bar, unsigned x, unsigned& nloc, unsigned& nx) {
    const unsigned G = gridDim.x * gridDim.y * gridDim.z;
    unsigned sum, cnt, mine, sp = 0u;
    for (;;) {
        sum = 0u; cnt = 0u; mine = 0u;
#pragma unroll
        for (unsigned j = 0; j < 16; ++j) { const unsigned c = xb_ld(&bar[XB_XCNT(j)]); sum += c; cnt += (c > 0u) ? 1u : 0u; mine = (j == x) ? c : mine; }
        if (sum == G) break;
        __builtin_amdgcn_s_sleep(1);
        if ((++sp & 255u) == 0u) { if (xb_ld(&bar[XB_TMO])) break; if (sp > XB_SPIN_CAP) { atomicAdd(&bar[XB_TMO], 1u); break; } }
    }
    nloc = mine > 0u ? mine : 1u; nx = cnt > 0u ? cnt : 1u;
}

__device__ __forceinline__ void xcd_barrier(const XcdBarrier& b) {
    asm volatile("s_waitcnt vmcnt(0)" ::: "memory");
    __syncthreads();
    if (threadIdx.x == 0) {
        unsigned* bar = b.bar;
        __builtin_amdgcn_s_waitcnt(0);
        unsigned nloc = b.st[0], nx = b.st[1];
        if (nloc == 0u) { xcd_barrier_complete(bar, b.x, nloc, nx); b.st[0] = nloc; b.st[1] = nx; }
        const unsigned old = xb_add(&bar[XB_XSUB(b.x)], 1u);
        const unsigned gen = old / nloc;
        if (old + 1u == (gen + 1u) * nloc) {
            __builtin_amdgcn_fence(__ATOMIC_RELEASE, "agent");
            asm volatile("s_waitcnt vmcnt(0)" ::: "memory");
            const unsigned og = xb_add(&bar[XB_TOP], 1u);
            const unsigned tg = og / nx;
            if (og + 1u == (tg + 1u) * nx) xb_add(&bar[XB_TOPGEN], 1u);
            else XB_SPIN(xb_ld(&bar[XB_TOPGEN]) == tg, bar);
            __builtin_amdgcn_fence(__ATOMIC_ACQUIRE, "agent");
            xb_add(&bar[XB_XGEN(b.x)], 1u);
            asm volatile("s_waitcnt vmcnt(0)" ::: "memory");
        } else {
            XB_SPIN(xb_ld(&bar[XB_XGEN(b.x)]) == gen, bar);
            __builtin_amdgcn_fence(__ATOMIC_ACQUIRE, "agent");
            asm volatile("s_waitcnt vmcnt(0)" ::: "memory");
        }
    }
    __syncthreads();
}


constexpr size_t MiB = 1u << 20;
constexpr size_t al256(size_t x) { return (x + 255) & ~(size_t)255; }
constexpr size_t WS_CTL = 0, CTL_ZERO_BYTES = 1 * MiB;
constexpr size_t WS_W1A = 1 * MiB;
constexpr size_t WS_W1B = WS_W1A + (size_t)NGU * D * 2;
constexpr size_t WS_WIN = WS_W1B + (size_t)D * FF * 2;
constexpr size_t WS_WPA = WS_WIN + (size_t)NINP * D * 2;
constexpr size_t WS_WPB = WS_WPA + (size_t)D * 512 * 2;
constexpr size_t WS_WOUT = WS_WPB + (size_t)D * D * 2;
constexpr size_t WS_W2A = WS_WOUT + (size_t)D * D * 2;
constexpr size_t WS_W2B = WS_W2A + (size_t)NGU * D * 2;
constexpr size_t WS_XB = al256(WS_W2B + (size_t)D * FF * 2);
constexpr size_t WS_RSTD1 = WS_XB + (size_t)MT * D * 2;
constexpr size_t WS_ACT = al256(WS_RSTD1 + (size_t)MT * 4);
constexpr size_t WS_X1 = WS_ACT + (size_t)MT * FF * 2;
constexpr size_t WS_X1B = WS_X1 + (size_t)MT * D * 4;
constexpr size_t WS_U = WS_X1B + (size_t)MT * D * 2;
constexpr size_t WS_BA = WS_U + (size_t)MT * NINP * 2;
constexpr size_t REC_BYTES = 90112;
constexpr int NREC = NB * 8 * 64;
constexpr size_t WS_REC = WS_BA + (size_t)MT * 16 * 4;
constexpr size_t WS_GE = WS_REC + (size_t)NREC * REC_BYTES;
constexpr size_t WS_OB = al256(WS_GE + (size_t)NREC * 4);
constexpr size_t WS_OG = WS_OB + (size_t)MT * D * 2;
constexpr size_t WS_LSE = WS_OG + (size_t)MT * 1536 * 2;
constexpr size_t WS_OA = al256(WS_LSE + (size_t)MT * 12 * 4);
constexpr size_t WS_M1 = WS_OA + (size_t)MT * 512 * 2;
constexpr size_t WS_MG = WS_M1 + (size_t)MT * D * 2;
constexpr size_t WS_X2 = WS_MG + (size_t)MT * D * 2;
constexpr size_t WS_X2B = WS_X2 + (size_t)MT * D * 4;
constexpr size_t WS_END = WS_X2B + (size_t)MT * D * 2;
constexpr int CW_TMO = 0;
constexpr int CW_BAR = 4096;
constexpr int CW_Q = 8192;
constexpr int CW_SSQ2 = 16384, CW_SSQ3 = CW_SSQ2 + 17408, CW_SSQ4 = CW_SSQ3 + 17408;
static_assert((CW_SSQ4 + 17408) * 4 <= (int)CTL_ZERO_BYTES, "CTL words inside the memset region");

constexpr size_t O_Y = 0;
constexpr size_t O_KVP0 = (size_t)MT * D;
constexpr size_t O_KVP1 = O_KVP0 + 524288;
constexpr size_t O_KVP2 = O_KVP1 + 2097152;
constexpr size_t O_CONVP = O_KVP2 + 8388608;
constexpr size_t O_SSMP = O_CONVP + 36864;
constexpr size_t O_KVS0 = O_SSMP + 524288;
constexpr size_t O_KVS1 = O_KVS0 + 524288;
constexpr size_t O_KVS2 = O_KVS1 + 524288;
constexpr size_t O_CONVS = O_KVS2 + 524288;
constexpr size_t O_SSMS = O_CONVS + 1179648;
constexpr size_t O_END = O_SSMS + 16777216;

constexpr int NWAVES = 8;
constexpr int RING_OFF = 0;
constexpr int LDSCTL_OFF = 151552, MISC_OFF = LDSCTL_OFF + 320;
constexpr int LDS_BYTES = 155648;

struct Frame {
    LAS unsigned char* lds;
    LAS unsigned char* ldv;
    volatile LAS unsigned* MISC;
    gu32* ctl;
    int tid, lane, wave, G, bx;
    const float* const* in; float* out; unsigned char* ws;
};
#define IN_XP 0
#define IN_XS 1
#define IN_C128 2
#define IN_C512 3
#define IN_C2048 4
#define IN_SCONV 5
#define IN_SSSM 6
#define IN_NF1 7
#define IN_W1GU 8
#define IN_W1D 9
#define IN_NMIX 10
#define IN_WIN 11
#define IN_CONVW 12
#define IN_ALOG 13
#define IN_DTB 14
#define IN_GNORM 15
#define IN_WPA 16
#define IN_WPB 17
#define IN_WOUT 18
#define IN_NF2 19
#define IN_W2GU 20
#define IN_W2D 21
#define IN_NOUT 22

template <class Map>
__device__ __forceinline__ void p0_transpose_item(const float* W, int K, int N, bf16* WT, const float* gain, LAS float* scr, int item, int lane, Map map) {
    const int nblk = (N + 31) / 32, kb = item / nblk, nb = item % nblk, k0 = 64 * kb, n0 = 32 * nb;
    const int nc = n0 + (lane & 31); const bool okc = nc < N;
#pragma unroll 8
    for (int i = 0; i < 32; ++i) { const int kk = 2 * i + (lane >> 5); float v = okc ? W[(size_t)(k0 + kk) * N + nc] : 0.f; if (gain) v *= gain[k0 + kk]; scr[kk * 33 + (lane & 31)] = v; }
    LDS_WAIT(); asm volatile("" ::: "memory");
    const int c = lane & 7;
#pragma unroll
    for (int j = 0; j < 4; ++j) { const int n = (lane >> 3) + 8 * j; const LAS float* s = scr + (8 * c) * 33 + n;
        v4u o; o.x = pk2(s[0 * 33], s[1 * 33]); o.y = pk2(s[2 * 33], s[3 * 33]); o.z = pk2(s[4 * 33], s[5 * 33]); o.w = pk2(s[6 * 33], s[7 * 33]);
        if (n0 + n < N) *(GAS v4u*)(WT + (size_t)map(n0 + n) * K + k0 + 8 * c) = o; }
    LDS_WAIT(); asm volatile("" ::: "memory");
}
struct MapId { __device__ __forceinline__ int operator()(int c) const { return c; } };
struct MapGU { __device__ __forceinline__ int operator()(int c) const { return c < FF ? 256 * (c >> 7) + (c & 127) : 256 * ((c - FF) >> 7) + 128 + ((c - FF) & 127); } };
struct MapIn { __device__ __forceinline__ int operator()(int c) const { return c < 8704 ? c : (c < 8720 ? U_BA + (c - 8704) : c - 16); } };

__device__ __forceinline__ void p0_prologue(Frame& F) {
    LAS float* scr = (LAS float*)(F.ldv + RING_OFF + F.wave * 16384);
    const int gw = F.bx * NWAVES + F.wave, NGW = F.G * NWAVES;
    bf16* W1A = (bf16*)(F.ws + WS_W1A); bf16* W1B = (bf16*)(F.ws + WS_W1B); bf16* WIN = (bf16*)(F.ws + WS_WIN); bf16* WPA = (bf16*)(F.ws + WS_WPA);
    bf16* WPB = (bf16*)(F.ws + WS_WPB); bf16* WOUT = (bf16*)(F.ws + WS_WOUT); bf16* W2A = (bf16*)(F.ws + WS_W2A); bf16* W2B = (bf16*)(F.ws + WS_W2B);
    constexpr int I_GU = (D / 64) * (NGU / 32), I_DN = (FF / 64) * (D / 32), I_IN = (D / 64) * ((NIN + 31) / 32), I_PA = (512 / 64) * (D / 32), I_DD = (D / 64) * (D / 32);
    constexpr int NITEMS = 2 * I_GU + 2 * I_DN + I_IN + I_PA + 2 * I_DD;
    for (int it = gw; it < NITEMS; it += NGW) {
        int r = it;
        if (r < I_GU) { p0_transpose_item(F.in[IN_W1GU], D, NGU, W1A, F.in[IN_NF1], scr, r, F.lane, MapGU()); continue; } r -= I_GU;
        if (r < I_GU) { p0_transpose_item(F.in[IN_W2GU], D, NGU, W2A, F.in[IN_NF2], scr, r, F.lane, MapGU()); continue; } r -= I_GU;
        if (r < I_DN) { p0_transpose_item(F.in[IN_W1D], FF, D, W1B, nullptr, scr, r, F.lane, MapId()); continue; } r -= I_DN;
        if (r < I_DN) { p0_transpose_item(F.in[IN_W2D], FF, D, W2B, nullptr, scr, r, F.lane, MapId()); continue; } r -= I_DN;
        if (r < I_IN) { p0_transpose_item(F.in[IN_WIN], D, NIN, WIN, F.in[IN_NMIX], scr, r, F.lane, MapIn()); continue; } r -= I_IN;
        if (r < I_PA) { p0_transpose_item(F.in[IN_WPA], 512, D, WPA, nullptr, scr, r, F.lane, MapId()); continue; } r -= I_PA;
        if (r < I_DD) { p0_transpose_item(F.in[IN_WPB], D, D, WPB, nullptr, scr, r, F.lane, MapId()); continue; } r -= I_DD;
        p0_transpose_item(F.in[IN_WOUT], D, D, WOUT, nullptr, scr, r, F.lane, MapId());
    }
    { const int gt = F.bx * 512 + F.tid, NT = F.G * 512; GAS v4u* z = (GAS v4u*)(WIN + (size_t)NIN * D);
      for (int i = gt; i < (NINP - NIN) * D / 8; i += NT) z[i] = (v4u){0u, 0u, 0u, 0u}; }
    bf16* XB = (bf16*)(F.ws + WS_XB); float* RSTD1 = (float*)(F.ws + WS_RSTD1);
    for (int m = gw; m < MT; m += NGW) {
        const float* xrow = (m < MP) ? F.in[IN_XP] + (size_t)m * D : F.in[IN_XS] + (size_t)(m - MP) * D;
        const GAS f32x4* xr = (const GAS f32x4*)xrow + F.lane; f32x4 v[4]; float s = 0.f;
#pragma unroll
        for (int j = 0; j < 4; ++j) { v[j] = xr[64 * j]; s += (v[j].x * v[j].x + v[j].y * v[j].y) + (v[j].z * v[j].z + v[j].w * v[j].w); }
        s = wave_sum(s);
        GAS v2u* o8 = (GAS v2u*)(XB + (size_t)m * D) + F.lane;
#pragma unroll
        for (int j = 0; j < 4; ++j) { v2u w; w.x = pk2(v[j].x, v[j].y); w.y = pk2(v[j].z, v[j].w); o8[64 * j] = w; }
        if (F.lane == 0) RSTD1[m] = rsqrtf(s * (1.0f / D) + EPS);
    }
}

__device__ __forceinline__ void final_norm(Frame& F) {
    const int gw = F.bx * NWAVES + F.wave, NGW = F.G * NWAVES;
    const float* ssq = (const float*)(F.ctl + CW_SSQ4); const GAS f32x4* nw = (const GAS f32x4*)F.in[IN_NOUT] + F.lane;
    f32x4 g[4];
#pragma unroll
    for (int j = 0; j < 4; ++j) g[j] = nw[64 * j];
    for (int m = gw; m < MT; m += NGW) {
        const float r = rsqrtf(ssq[m] * (1.0f / D) + EPS);
        GAS f32x4* xr = (GAS f32x4*)(F.out + O_Y + (size_t)m * D) + F.lane;
#pragma unroll
        for (int j = 0; j < 4; ++j) { f32x4 v = xr[64 * j]; xr[64 * j] = v * r * g[j]; }
    }
}

constexpr int GP_QR = 0, GP_KR = 17408, GP_KT = 34816, GP_KBG = 53248, GP_BVT = 71680, GP_GKK = 90112, GP_GQK = 107520, GP_TI = 124928, GP_TAB = 134144;
constexpr int GKP = 68;
__device__ __forceinline__ f32x4 mfma4(float a, float b, f32x4 c) { return __builtin_amdgcn_mfma_f32_16x16x4f32(a, b, c, 0, 0, 0); }
__device__ __forceinline__ f32x4 prod_ll(const LAS float* A, int ra, int ca, const LAS float* B, int rb, int cb, f32x4 c, int m16, int kg) {
    const f32x4 av = *(const LAS f32x4*)(A + (ra + m16) * GKP + ca + 4 * kg);
#pragma unroll
    for (int t = 0; t < 4; ++t) c = mfma4(av[t], B[(rb + 4 * kg + t) * GKP + cb + m16], c);
    return c;
}
__device__ __forceinline__ f32x4 prod_lr(const LAS float* A, int ra, int ca, f32x4 x, f32x4 c, int m16, int kg) {
    const f32x4 av = *(const LAS f32x4*)(A + (ra + m16) * GKP + ca + 4 * kg);
#pragma unroll
    for (int t = 0; t < 4; ++t) c = mfma4(av[t], x[t], c);
    return c;
}
__device__ __forceinline__ float softplusf(float x) { return x > 20.f ? x : log1pf(__expf(x)); }

__device__ __forceinline__ void gdn_prep_unit(Frame& F, int b, int h, int n) {
    LAS unsigned char* L = F.ldv;
    LAS float* TAB = (LAS float*)(L + GP_TAB);
    LAS float* GKK = (LAS float*)(L + GP_GKK);
    LAS float* GQK = (LAS float*)(L + GP_GQK);
    const bf16* U = (const bf16*)(F.ws + WS_U); const float* BA = (const float*)(F.ws + WS_BA);
    const int tid = F.tid, lane = F.lane, wave = F.wave;
    const int uidx = (b * 8 + h) * 64 + n;
    unsigned char* rec = F.ws + WS_REC + (size_t)uidx * REC_BYTES;
    const int row_base = b * SEQ + 64 * n;
#pragma unroll
    for (int r = 0; r < 4; ++r) { const int q = tid + 512 * r, w_ = q >> 8, mt = (q >> 6) & 3, l_ = q & 63, n_ = l_ & 15, kg_ = l_ >> 4;
        const float nwv = F.in[IN_GNORM][16 * w_ + n_]; float gz[4];
#pragma unroll
        for (int j = 0; j < 4; ++j) { const float z = bf2f(U[(size_t)(row_base + 16 * mt + 4 * kg_ + j) * NINP + U_Z + h * 128 + 16 * w_ + n_]); gz[j] = z * sigm(z) * nwv; }
        v2u pk; pk.x = pk2(gz[0], gz[1]); pk.y = pk2(gz[2], gz[3]); *(GAS v2u*)(rec + 73728 + (size_t)q * 8) = pk; }
    if (wave == 0) {
        const int t = lane; const float bl = BA[(size_t)(row_base + t) * 16 + h], al = BA[(size_t)(row_base + t) * 16 + 8 + h];
        const float beta = sigm(bl); const float g = -__expf(F.in[IN_ALOG][h]) * softplusf(al + F.in[IN_DTB][h]);
        float gc = g;
#pragma unroll
        for (int o = 1; o < 64; o <<= 1) { const float v = __shfl_up(gc, o); if (lane >= o) gc += v; }
        const float gl = __shfl(gc, 63);
        TAB[t] = beta; TAB[64 + t] = gc; TAB[128 + t] = __expf(gc); TAB[192 + t] = __expf(gl - gc);
        if (lane == 0) ((float*)(F.ws + WS_GE))[uidx] = __expf(gl);
    }
    WG_BARRIER();
    if (tid < 384) {
        const int cq = tid & 31, tq = (tid >> 5) & 3, tensor = tid >> 7, c0 = 4 * cq, cw = tensor * 1024 + h * 128 + c0, col = U_QKVB + cw, t0 = 16 * tq;
        const f32x4 w0 = *(const GAS f32x4*)(F.in[IN_CONVW] + cw), w1 = *(const GAS f32x4*)(F.in[IN_CONVW] + 3072 + cw), w2 = *(const GAS f32x4*)(F.in[IN_CONVW] + 2 * 3072 + cw), w3 = *(const GAS f32x4*)(F.in[IN_CONVW] + 3 * 3072 + cw);
        f32x4 x[19];
#pragma unroll
        for (int i = 0; i < 19; ++i) { const int tok = 64 * n + t0 - 3 + i; v2u raw = {0u, 0u}; if (tok >= 0) raw = *(const GAS v2u*)(U + (size_t)(b * SEQ + tok) * NINP + col);
            x[i] = (f32x4){bflo(raw.x), bfhi(raw.x), bflo(raw.y), bfhi(raw.y)}; }
        unsigned tp[4][8];
#pragma unroll
        for (int i = 0; i < 16; ++i) { f32x4 y = w0 * x[i] + w1 * x[i + 1] + w2 * x[i + 2] + w3 * x[i + 3];
#pragma unroll
            for (int e = 0; e < 4; ++e) y[e] = siluf(y[e]);
            if (tensor == 2) y = y * TAB[t0 + i];
            if (tensor < 2) { v2u pk; pk.x = pk2(y[0], y[1]); pk.y = pk2(y[2], y[3]); *(LAS v2u*)(L + (tensor == 0 ? GP_QR : GP_KR) + (t0 + i) * 272 + 2 * c0) = pk; }
            if (tensor > 0) {
#pragma unroll
                for (int e = 0; e < 4; ++e) { const unsigned bq = f2bf(y[e]); if (i & 1) tp[e][i >> 1] |= bq << 16; else tp[e][i >> 1] = bq; } }
        }
        if (tensor > 0) {
#pragma unroll
            for (int e = 0; e < 4; ++e) { LAS unsigned char* dst = L + (tensor == 1 ? GP_KT : GP_BVT) + (c0 + e) * 144 + 2 * t0;
                *(LAS v4u*)dst = (v4u){tp[e][0], tp[e][1], tp[e][2], tp[e][3]}; *(LAS v4u*)(dst + 16) = (v4u){tp[e][4], tp[e][5], tp[e][6], tp[e][7]}; } }
    }
    WG_BARRIER();
    {
        const int m16 = lane & 15, kg = lane >> 4;
        for (int job = wave; job < 24; job += 8) {
            int kind, it, jt;
            if (job < 20) { kind = job >= 10; int j = job % 10; it = 0; while (j > it) { j -= it + 1; ++it; } jt = j; }
            else { kind = 2; it = jt = job - 20; }
            const int abase = (kind == 2 ? GP_QR : GP_KR) + (16 * (kind == 1 ? jt : it) + m16) * 272 + 16 * kg;
            const int bbase = (kind == 0 ? GP_KR : GP_QR) + (16 * (kind == 0 ? jt : it) + m16) * 272 + 16 * kg;
            f32x4 acc = {0.f, 0.f, 0.f, 0.f};
#pragma unroll
            for (int kb = 0; kb < 4; ++kb) { const bf16x8 a = *(const LAS bf16x8*)(L + abase + 64 * kb), bb = *(const LAS bf16x8*)(L + bbase + 64 * kb); acc = mfma16(a, bb, acc); }
            if (kind == 0) {
#pragma unroll
                for (int jj = 0; jj < 4; ++jj) GKK[(16 * it + 4 * kg + jj) * GKP + 16 * jt + m16] = acc[jj];
            } else if (kind == 1) {
                *(LAS f32x4*)(GQK + (16 * it + m16) * 68 + 16 * jt + 4 * kg) = acc;
            } else {
#pragma unroll
                for (int jj = 0; jj < 4; ++jj) if (4 * kg + jj == m16) TAB[576 + 16 * it + m16] = acc[jj];
            }
        }
    }
    WG_BARRIER();
    if (tid < 64) {
        const int t = tid; const float rk = rsqrtf(GKK[t * GKP + t] + EPS), rq = rsqrtf(TAB[576 + t] + EPS) * 0.08838834764831845f;
        TAB[256 + t] = rk; TAB[320 + t] = rq; TAB[384 + t] = rq * TAB[128 + t]; TAB[448 + t] = rk * TAB[192 + t]; TAB[512 + t] = rk * TAB[t] * TAB[128 + t];
    }
    WG_BARRIER();
    {
        for (int e = tid; e < 4096; e += 512) { const int i = e >> 6, j = e & 63;
            if (j < i) GKK[i * GKP + j] = TAB[i] * TAB[256 + i] * TAB[256 + j] * GKK[i * GKP + j] * __expf(TAB[64 + i] - TAB[64 + j]); }
        const int m16 = lane & 15, kg = lane >> 4;
        { const int it = wave >> 1, kb2 = wave & 1, i = 16 * it + m16; const float sc = TAB[320 + i], gi = TAB[64 + i];
          float o[8];
#pragma unroll
          for (int hlf = 0; hlf < 2; ++hlf) { const int j0 = 32 * kb2 + 16 * hlf + 4 * kg; const f32x4 g = *(const LAS f32x4*)(GQK + i * 68 + j0);
#pragma unroll
              for (int e = 0; e < 4; ++e) { const int j = j0 + e; o[4 * hlf + e] = (j <= i) ? sc * TAB[256 + j] * g[e] * __expf(gi - TAB[64 + j]) : 0.f; } }
          v4u w; w.x = pk2(o[0], o[1]); w.y = pk2(o[2], o[3]); w.z = pk2(o[4], o[5]); w.w = pk2(o[6], o[7]);
          *(GAS v4u*)(rec + 32768 + wave * 1024 + lane * 16) = w; }
#pragma unroll
        for (int r = 0; r < 2; ++r) { const int f = wave * 2 + r, mt = f >> 1, kb2 = f & 1, dk = 16 * mt + m16; float o[8];
#pragma unroll
            for (int hlf = 0; hlf < 2; ++hlf) { const int t0 = 32 * kb2 + 16 * hlf + 4 * kg; const v2u kk = *(const LAS v2u*)(L + GP_KT + dk * 144 + 2 * t0);
                o[4 * hlf + 0] = bflo(kk.x) * TAB[448 + t0]; o[4 * hlf + 1] = bfhi(kk.x) * TAB[448 + t0 + 1]; o[4 * hlf + 2] = bflo(kk.y) * TAB[448 + t0 + 2]; o[4 * hlf + 3] = bfhi(kk.y) * TAB[448 + t0 + 3]; }
            v4u w; w.x = pk2(o[0], o[1]); w.y = pk2(o[2], o[3]); w.z = pk2(o[4], o[5]); w.w = pk2(o[6], o[7]);
            *(GAS v4u*)(rec + 40960 + f * 1024 + lane * 16) = w; }
#pragma unroll
        for (int r = 0; r < 2; ++r) { const int f = wave * 2 + r, mtq = f >> 2, kb = f & 3, t = 16 * mtq + m16; const float sc = TAB[384 + t]; float o[8];
#pragma unroll
            for (int hlf = 0; hlf < 2; ++hlf) { const int d0 = 32 * kb + 16 * hlf + 4 * kg; const v2u qq = *(const LAS v2u*)(L + GP_QR + t * 272 + 2 * d0);
                o[4 * hlf + 0] = bflo(qq.x) * sc; o[4 * hlf + 1] = bfhi(qq.x) * sc; o[4 * hlf + 2] = bflo(qq.y) * sc; o[4 * hlf + 3] = bfhi(qq.y) * sc; }
            v4u w; w.x = pk2(o[0], o[1]); w.y = pk2(o[2], o[3]); w.z = pk2(o[4], o[5]); w.w = pk2(o[6], o[7]);
            *(GAS v4u*)(rec + ((4 + mtq) * 4 + kb) * 1024 + lane * 16) = w; }
        { const int dk = tid >> 2, t0 = (tid & 3) * 16; const v4u a = *(const LAS v4u*)(L + GP_KT + dk * 144 + 2 * t0), bq = *(const LAS v4u*)(L + GP_KT + dk * 144 + 2 * t0 + 16);
          const unsigned wi[8] = {a.x, a.y, a.z, a.w, bq.x, bq.y, bq.z, bq.w}; unsigned wo[8];
#pragma unroll
          for (int i = 0; i < 8; ++i) wo[i] = pk2(bflo(wi[i]) * TAB[512 + t0 + 2 * i], bfhi(wi[i]) * TAB[512 + t0 + 2 * i + 1]);
          *(LAS v4u*)(L + GP_KBG + dk * 144 + 2 * t0) = (v4u){wo[0], wo[1], wo[2], wo[3]}; *(LAS v4u*)(L + GP_KBG + dk * 144 + 2 * t0 + 16) = (v4u){wo[4], wo[5], wo[6], wo[7]}; }
    }
    WG_BARRIER();
    LAS float* TIF = GQK;
    {
        const int m16 = lane & 15, kg = lane >> 4;
        if (wave == 0) {
            const LAS float* Ab = GKK + (16 * kg) * GKP + 16 * kg; float r[16];
#pragma unroll
            for (int i = 0; i < 16; ++i) { int lo_ = m16; asm volatile("" : "+v"(lo_)); float a = (lo_ == i) ? 1.f : 0.f;
#pragma unroll
                for (int j4 = 0; j4 < (i + 3) / 4; ++j4) { const f32x4 av = *(const LAS f32x4*)(Ab + i * GKP + 4 * j4);
#pragma unroll
                    for (int e = 0; e < 4; ++e) { const int j = 4 * j4 + e; if (j < i) a -= av[e] * r[j]; } }
                r[i] = a; }
#pragma unroll
            for (int i = 0; i < 16; ++i) TIF[(16 * kg + i) * GKP + 16 * kg + m16] = r[i];
        }
        WG_BARRIER();
        const f32x4 z4 = {0.f, 0.f, 0.f, 0.f};
        if (wave < 3) { const int i = wave + 1, j = wave;
            f32x4 X = prod_ll(GKK, 16 * i, 16 * j, TIF, 16 * j, 16 * j, z4, m16, kg);
            f32x4 T = prod_lr(TIF, 16 * i, 16 * i, X, z4, m16, kg);
#pragma unroll
            for (int jj = 0; jj < 4; ++jj) TIF[(16 * i + 4 * kg + jj) * GKP + 16 * j + m16] = -T[jj]; }
        WG_BARRIER();
        if (wave < 2) { const int i = wave + 2, j = wave;
            f32x4 Y = prod_ll(GKK, 16 * i, 16 * j, TIF, 16 * j, 16 * j, z4, m16, kg);
            Y = prod_ll(GKK, 16 * i, 16 * (j + 1), TIF, 16 * (j + 1), 16 * j, Y, m16, kg);
            f32x4 T = prod_lr(TIF, 16 * i, 16 * i, Y, z4, m16, kg);
#pragma unroll
            for (int jj = 0; jj < 4; ++jj) TIF[(16 * i + 4 * kg + jj) * GKP + 16 * j + m16] = -T[jj]; }
        WG_BARRIER();
        if (wave == 0) {
            f32x4 Y = prod_ll(GKK, 48, 0, TIF, 0, 0, z4, m16, kg);
            Y = prod_ll(GKK, 48, 16, TIF, 16, 0, Y, m16, kg);
            Y = prod_ll(GKK, 48, 32, TIF, 32, 0, Y, m16, kg);
            f32x4 T = prod_lr(TIF, 48, 48, Y, z4, m16, kg);
#pragma unroll
            for (int jj = 0; jj < 4; ++jj) TIF[(48 + 4 * kg + jj) * GKP + m16] = -T[jj]; }
        WG_BARRIER();
        { const int row = tid >> 3, cg = tid & 7; v4u o = {0u, 0u, 0u, 0u};
          if ((cg >> 1) <= (row >> 4)) { const f32x4 a = *(const LAS f32x4*)(TIF + row * GKP + 8 * cg), c = *(const LAS f32x4*)(TIF + row * GKP + 8 * cg + 4);
              o.x = pk2(a[0], a[1]); o.y = pk2(a[2], a[3]); o.z = pk2(c[0], c[1]); o.w = pk2(c[2], c[3]); }
          *(LAS v4u*)(L + GP_TI + row * 144 + 16 * cg) = o; }
    }
    WG_BARRIER();
    {
        const int m16 = lane & 15, kg = lane >> 4;
#pragma unroll
        for (int it = 0; it < 4; ++it) {
            f32x4 au = {0.f, 0.f, 0.f, 0.f}, aw = {0.f, 0.f, 0.f, 0.f};
#pragma unroll
            for (int jb = 0; jb < 2; ++jb) {
                const bf16x8 ti = *(const LAS bf16x8*)(L + GP_TI + (16 * it + m16) * 144 + 64 * jb + 16 * kg);
                const bf16x8 bv = *(const LAS bf16x8*)(L + GP_BVT + (16 * wave + m16) * 144 + 64 * jb + 16 * kg);
                const bf16x8 kb = *(const LAS bf16x8*)(L + GP_KBG + (16 * wave + m16) * 144 + 64 * jb + 16 * kg);
                au = mfma16(ti, bv, au);
                aw = mfma16(kb, ti, aw);
            }
            v2u w; w.x = pk2(au[0], au[1]); w.y = pk2(au[2], au[3]);
            *(GAS v2u*)(rec + 57344 + ((wave * 4 + it) * 64 + lane) * 8) = w;
            v2u x; x.x = pk2(aw[0], aw[1]); x.y = pk2(aw[2], aw[3]);
            *(GAS v2u*)(rec + (it * 4 + (wave >> 1)) * 1024 + lane * 16 + (wave & 1) * 8) = x;
        }
    }
    WG_BARRIER();
}

constexpr int SC_BUF = 57344, SC_RED = 2 * SC_BUF;
struct ScanPre { v2u ut[4]; v2u gz[4]; float ge; };
__device__ __forceinline__ void scan_fetch(const unsigned char* rec, const float* GE, int n, int w, int lane, ScanPre& p) {
#pragma unroll
    for (int mt = 0; mt < 4; ++mt) { p.ut[mt] = *(const GAS v2u*)(rec + 57344 + ((w * 4 + mt) * 64 + lane) * 8); p.gz[mt] = *(const GAS v2u*)(rec + 73728 + ((w * 4 + mt) * 64 + lane) * 8); }
    p.ge = GE[n];
}
__device__ __forceinline__ void scan_step(Frame& F, LAS unsigned char* L, const unsigned char* rec0, const float* GE, int bh, int n, f32x4 (&S)[8], v4u (&stw)[7], v4u (&stl)[7], ScanPre& cur, ScanPre& nxt) {
    const int tid = F.tid, lane = F.lane, w = F.wave, m16 = lane & 15, kg = lane >> 4;
    const int b = bh >> 3, h = bh & 7;
    bf16* OB = (bf16*)(F.ws + WS_OB);
    const unsigned char* rec = rec0 + (size_t)n * REC_BYTES;
    LAS unsigned char* buf = L + (n & 1) * SC_BUF;
    if (n + 1 < 64) { LAS unsigned char* nb = L + ((n + 1) & 1) * SC_BUF;
#pragma unroll
        for (int i = 0; i < 7; ++i) *(LAS v4u*)(nb + (i * 512 + tid) * 16) = stw[i]; }
    if (n + 2 < 64) {
#pragma unroll
        for (int i = 0; i < 7; ++i) stl[i] = *(const GAS v4u*)(rec + 2 * REC_BYTES + (size_t)(i * 512 + tid) * 16); }
    if (n + 1 < 64) scan_fetch(rec + REC_BYTES, GE, n + 1, w, lane, nxt);
    const float ge = cur.ge;
    bf16x8 Sb[4];
#pragma unroll
    for (int kb = 0; kb < 4; ++kb) Sb[kb] = pack8(S[2 * kb], S[2 * kb + 1]);
    f32x4 P[8];
#pragma unroll
    for (int mt = 0; mt < 8; ++mt) { P[mt] = (f32x4){0.f, 0.f, 0.f, 0.f};
#pragma unroll
        for (int kb = 0; kb < 4; ++kb) P[mt] = mfma16(*(const LAS bf16x8*)(buf + (mt * 4 + kb) * 1024 + lane * 16), Sb[kb], P[mt]); }
    f32x4 vn[4];
#pragma unroll
    for (int mt = 0; mt < 4; ++mt) { vn[mt][0] = bflo(cur.ut[mt].x) - P[mt][0]; vn[mt][1] = bfhi(cur.ut[mt].x) - P[mt][1]; vn[mt][2] = bflo(cur.ut[mt].y) - P[mt][2]; vn[mt][3] = bfhi(cur.ut[mt].y) - P[mt][3]; }
    bf16x8 vb[2];
    vb[0] = pack8(vn[0], vn[1]); vb[1] = pack8(vn[2], vn[3]);
#pragma unroll
    for (int mt = 0; mt < 4; ++mt)
#pragma unroll
        for (int kb2 = 0; kb2 < 2; ++kb2) P[4 + mt] = mfma16(*(const LAS bf16x8*)(buf + 32768 + (mt * 2 + kb2) * 1024 + lane * 16), vb[kb2], P[4 + mt]);
#pragma unroll
    for (int mt = 0; mt < 8; ++mt) { S[mt] = S[mt] * ge;
#pragma unroll
        for (int kb2 = 0; kb2 < 2; ++kb2) S[mt] = mfma16(*(const LAS bf16x8*)(buf + 40960 + (mt * 2 + kb2) * 1024 + lane * 16), vb[kb2], S[mt]); }
    LAS float* RED = (LAS float*)(L + SC_RED) + (n & 1) * 512;
#pragma unroll
    for (int mt = 0; mt < 4; ++mt)
#pragma unroll
        for (int jj = 0; jj < 4; ++jj) { float q = P[4 + mt][jj] * P[4 + mt][jj];
            q += __shfl_xor(q, 1); q += __shfl_xor(q, 2); q += __shfl_xor(q, 4); q += __shfl_xor(q, 8);
            if (m16 == 0) RED[(16 * mt + 4 * kg + jj) * 8 + w] = q; }
    WG_BARRIER();
    const int row0 = b * SEQ + 64 * n;
#pragma unroll
    for (int mt = 0; mt < 4; ++mt) { const float g4[4] = {bflo(cur.gz[mt].x), bfhi(cur.gz[mt].x), bflo(cur.gz[mt].y), bfhi(cur.gz[mt].y)};
#pragma unroll
        for (int jj = 0; jj < 4; ++jj) { const int t = 16 * mt + 4 * kg + jj;
            const f32x4 r0 = *(const LAS f32x4*)(RED + t * 8), r1 = *(const LAS f32x4*)(RED + t * 8 + 4);
            const float ss = ((r0[0] + r0[1]) + (r0[2] + r0[3])) + ((r1[0] + r1[1]) + (r1[2] + r1[3]));
            const float rs = rsqrtf(ss * (1.0f / 128.0f) + EPS);
            OB[(size_t)(row0 + t) * D + h * 128 + 16 * w + m16] = (bf16)f2bf(P[4 + mt][jj] * rs * g4[jj]); } }
}
__device__ __forceinline__ void gdn_scan_chain(Frame& F, int bh) {
    LAS unsigned char* L = F.ldv;
    const int tid = F.tid, lane = F.lane, w = F.wave, m16 = lane & 15, kg = lane >> 4;
    const unsigned char* rec0 = F.ws + WS_REC + (size_t)(bh * 64) * REC_BYTES;
    const float* GE = (const float*)(F.ws + WS_GE) + bh * 64;
    f32x4 S[8];
#pragma unroll
    for (int i = 0; i < 8; ++i) S[i] = (f32x4){0.f, 0.f, 0.f, 0.f};
    v4u sa[7], sb[7]; ScanPre pa, pb;
#pragma unroll
    for (int i = 0; i < 7; ++i) sb[i] = *(const GAS v4u*)(rec0 + (size_t)(i * 512 + tid) * 16);
#pragma unroll
    for (int i = 0; i < 7; ++i) sa[i] = *(const GAS v4u*)(rec0 + REC_BYTES + (size_t)(i * 512 + tid) * 16);
    scan_fetch(rec0, GE, 0, w, lane, pa);
#pragma unroll
    for (int i = 0; i < 7; ++i) *(LAS v4u*)(L + (i * 512 + tid) * 16) = sb[i];
    WG_BARRIER();
    for (int n = 0; n < 64; n += 2) {
        scan_step(F, L, rec0, GE, bh, n, S, sa, sb, pa, pb);
        scan_step(F, L, rec0, GE, bh, n + 1, S, sb, sa, pb, pa);
    }
    float* so = F.out + O_SSMP + (size_t)bh * 16384;
#pragma unroll
    for (int mt = 0; mt < 8; ++mt)
#pragma unroll
        for (int jj = 0; jj < 4; ++jj) so[(16 * mt + 4 * kg + jj) * 128 + 16 * w + m16] = S[mt][jj];
    WG_BARRIER();
}

__device__ __forceinline__ void gdn_sample_unit(Frame& F, int b, int h) {
    LAS float* L = (LAS float*)F.ldv;
    const int tid = F.tid, lane = F.lane, wave = F.wave;
    const bf16* U = (const bf16*)(F.ws + WS_U); const float* BA = (const float*)(F.ws + WS_BA);
    const int row0 = MP + 4 * b;
    LAS float* SC = L + 8704;
    if (tid < 4) { const float bl = BA[(size_t)(row0 + tid) * 16 + h], al = BA[(size_t)(row0 + tid) * 16 + 8 + h];
        SC[tid] = sigm(bl); SC[56 + tid] = -__expf(F.in[IN_ALOG][h]) * softplusf(al + F.in[IN_DTB][h]); }
    if (tid < 384) {
        const int tensor = tid >> 7, c = tid & 127, cw = tensor * 1024 + h * 128 + c, col = U_QKVB + cw;
        const float w0 = F.in[IN_CONVW][cw], w1 = F.in[IN_CONVW][3072 + cw], w2 = F.in[IN_CONVW][2 * 3072 + cw], w3 = F.in[IN_CONVW][3 * 3072 + cw];
        float x[7];
#pragma unroll
        for (int i = 0; i < 3; ++i) x[i] = F.in[IN_SCONV][((size_t)b * 3 + i) * 3072 + cw];
#pragma unroll
        for (int i = 0; i < 4; ++i) x[3 + i] = bf2f(U[(size_t)(row0 + i) * NINP + col]);
#pragma unroll
        for (int i = 0; i < 4; ++i) { const float v = w0 * x[i] + w1 * x[i + 1] + w2 * x[i + 2] + w3 * x[i + 3]; L[tensor * 512 + i * 128 + c] = siluf(v); }
    }
    WG_BARRIER();
    if (tid == 0) { float gc = 0.f;
#pragma unroll
        for (int i = 0; i < 4; ++i) { gc += SC[56 + i]; SC[4 + i] = gc; } SC[48] = __expf(gc); }
    { const int tensor = wave >> 2, s = wave & 3; const float a = L[tensor * 512 + s * 128 + lane], c2 = L[tensor * 512 + s * 128 + 64 + lane];
      const float ss = wave_sum(a * a + c2 * c2); if (lane == 0) SC[(tensor ? 8 : 12) + s] = rsqrtf(ss + EPS) * (tensor ? 1.f : 0.08838834764831845f); }
    WG_BARRIER();
#pragma unroll
    for (int r = 0; r < 4; ++r) { const int idx = 4 * wave + r, kind = idx >> 4, i = (idx >> 2) & 3, j = idx & 3;
        const LAS float* a = L + (kind ? 0 : 512) + i * 128; const LAS float* c2 = L + 512 + j * 128;
        const float d = wave_sum(a[lane] * c2[lane] + a[64 + lane] * c2[64 + lane]);
        if (lane == 0) SC[16 + idx] = d * SC[(kind ? 12 : 8) + i] * SC[8 + j]; }
    WG_BARRIER();
    float beta[4], gc[4], Ti[4][4], qkm[4][4];
#pragma unroll
    for (int i = 0; i < 4; ++i) { beta[i] = SC[i]; gc[i] = SC[4 + i]; }
    const float ge = SC[48];
    {
        float A[4][4];
#pragma unroll
        for (int i = 0; i < 4; ++i)
#pragma unroll
            for (int j = 0; j < 4; ++j) { const float dec = __expf(gc[i] - gc[j]); A[i][j] = (j < i) ? beta[i] * SC[16 + 4 * i + j] * dec : 0.f; qkm[i][j] = (j <= i) ? SC[32 + 4 * i + j] * dec : 0.f; }
#pragma unroll
        for (int i = 0; i < 4; ++i)
#pragma unroll
            for (int c = 0; c < 4; ++c) { float v = (i == c) ? 1.f : 0.f;
#pragma unroll
                for (int j = 0; j < 4; ++j) if (j < i) v -= A[i][j] * Ti[j][c];
                Ti[i][c] = v; }
    }
    { const int c = tid & 127, i = tid >> 7; float wv = 0.f, uv = 0.f;
#pragma unroll
      for (int j = 0; j < 4; ++j) { wv += Ti[i][j] * beta[j] * __expf(gc[j]) * SC[8 + j] * L[512 + j * 128 + c]; uv += Ti[i][j] * beta[j] * L[1024 + j * 128 + c]; }
      L[1536 + i * 128 + c] = wv; L[3072 + i * 128 + c] = uv;
      L[2048 + i * 128 + c] = L[i * 128 + c] * SC[12 + i] * __expf(gc[i]);
      L[2560 + i * 128 + c] = L[512 + i * 128 + c] * SC[8 + i] * __expf(gc[3] - gc[i]); }
    WG_BARRIER();
    const int dv = tid & 127, kq = tid >> 7;
    const float* S0 = F.in[IN_SSSM] + ((size_t)(b * 8 + h) * 128 + 32 * kq) * 128 + dv;
    float s[32];
#pragma unroll
    for (int i = 0; i < 32; ++i) s[i] = S0[(size_t)i * 128];
    float pw[4] = {0.f, 0.f, 0.f, 0.f}, pq[4] = {0.f, 0.f, 0.f, 0.f};
#pragma unroll
    for (int i = 0; i < 32; ++i)
#pragma unroll
        for (int c = 0; c < 4; ++c) { pw[c] += L[1536 + c * 128 + 32 * kq + i] * s[i]; pq[c] += L[2048 + c * 128 + 32 * kq + i] * s[i]; }
#pragma unroll
    for (int c = 0; c < 4; ++c) { L[3584 + (c * 4 + kq) * 128 + dv] = pw[c]; L[3584 + ((4 + c) * 4 + kq) * 128 + dv] = pq[c]; }
    WG_BARRIER();
    float vn[4], oo[4];
#pragma unroll
    for (int c = 0; c < 4; ++c) { const float ws_ = (L[3584 + (c * 4 + 0) * 128 + dv] + L[3584 + (c * 4 + 1) * 128 + dv]) + (L[3584 + (c * 4 + 2) * 128 + dv] + L[3584 + (c * 4 + 3) * 128 + dv]);
        vn[c] = L[3072 + c * 128 + dv] - ws_; }
#pragma unroll
    for (int c = 0; c < 4; ++c) { float o = (L[3584 + ((4 + c) * 4 + 0) * 128 + dv] + L[3584 + ((4 + c) * 4 + 1) * 128 + dv]) + (L[3584 + ((4 + c) * 4 + 2) * 128 + dv] + L[3584 + ((4 + c) * 4 + 3) * 128 + dv]);
#pragma unroll
        for (int j = 0; j < 4; ++j) o += qkm[c][j] * vn[j];
        oo[c] = o; }
    float* SO = F.out + O_SSMS + ((size_t)(b * 8 + h) * 128 + 32 * kq) * 128 + dv;
#pragma unroll
    for (int i = 0; i < 32; ++i) { float v = ge * s[i];
#pragma unroll
        for (int c = 0; c < 4; ++c) v += L[2560 + c * 128 + 32 * kq + i] * vn[c];
        SO[(size_t)i * 128] = v; }
    LAS float* RED = L + 8768;
    if (kq == 0) {
#pragma unroll
        for (int c = 0; c < 4; ++c) { const float q = wave_sum(oo[c] * oo[c]); if (lane == 0) RED[c * 2 + wave] = q; }
    }
    WG_BARRIER();
    if (kq == 0) {
        bf16* OB = (bf16*)(F.ws + WS_OB); const float nw = F.in[IN_GNORM][dv];
#pragma unroll
        for (int c = 0; c < 4; ++c) { const float rs = rsqrtf((RED[c * 2] + RED[c * 2 + 1]) * (1.0f / 128.0f) + EPS);
            const float z = bf2f(U[(size_t)(row0 + c) * NINP + U_Z + h * 128 + dv]);
            OB[(size_t)(row0 + c) * D + h * 128 + dv] = (bf16)f2bf(oo[c] * rs * nw * (z * sigm(z))); }
    }
    WG_BARRIER();
}

__device__ __forceinline__ void copy_outputs(Frame& F) {
    const bf16* U = (const bf16*)(F.ws + WS_U);
    const long gt = (long)F.bx * 512 + F.tid, NT = (long)F.G * 512;
    constexpr long C0 = 65536, C1 = 262144, C2 = 1048576, CS = 65536, CCP = 4608, CCS = 147456;
    constexpr long TOT = C0 + C1 + C2 + 3 * CS + CCP + CCS;
    for (long c = gt; c < TOT; c += NT) {
        long r = c; int srow, scol; float* dst;
        if (r < C0 + C1 + C2) {
            int g, keep; if (r < C0) { g = 0; keep = 128; dst = F.out + O_KVP0; } else if (r < C0 + C1) { r -= C0; g = 1; keep = 512; dst = F.out + O_KVP1; } else { r -= C0 + C1; g = 2; keep = 2048; dst = F.out + O_KVP2; }
            const int e8 = r & 15, hh = (r >> 4) & 3, kv = (r >> 6) & 1; const int rr = (int)((r >> 7) % keep), bb = (int)((r >> 7) / keep);
            srow = bb * SEQ + SEQ - keep + rr; scol = (kv ? U_VA : U_KA) + (g * 4 + hh) * 128 + e8 * 8; dst += r * 8;
        } else if ((r -= C0 + C1 + C2) < 3 * CS) {
            const int g = (int)(r / CS); r -= (long)g * CS; dst = F.out + (g == 0 ? O_KVS0 : (g == 1 ? O_KVS1 : O_KVS2)) + r * 8;
            const int e8 = r & 15, hh = (r >> 4) & 3, kv = (r >> 6) & 1, ss = (r >> 7) & 3, bb = (int)(r >> 9);
            srow = MP + 4 * bb + ss; scol = (kv ? U_VA : U_KA) + (g * 4 + hh) * 128 + e8 * 8;
        } else if ((r -= 3 * CS) < CCP) {
            const int ch8 = (int)(r % 384), i = (int)((r / 384) % 3), bb = (int)(r / 1152); dst = F.out + O_CONVP + r * 8;
            srow = bb * SEQ + SEQ - 3 + i; scol = U_QKVB + ch8 * 8;
        } else {
            r -= CCP; const int ch8 = (int)(r % 384), i = (int)((r / 384) % 3), bb = (int)(r / 1152); dst = F.out + O_CONVS + r * 8;
            srow = MP + 4 * bb + 1 + i; scol = U_QKVB + ch8 * 8;
        }
        const v4u v = *(const GAS v4u*)(U + (size_t)srow * NINP + scol);
        *(GAS f32x4*)dst = (f32x4){bflo(v.x), bfhi(v.x), bflo(v.y), bfhi(v.y)};
        *(GAS f32x4*)(dst + 4) = (f32x4){bflo(v.z), bfhi(v.z), bflo(v.w), bfhi(v.w)};
    }
}

constexpr int AT_K = 0, AT_V = 69632;
__device__ __forceinline__ int at_off(int row, int ch) { return 256 * row + 16 * (ch ^ (((row & 3) << 2) | ((row >> 2) & 3))); }
template <int OFF>
__device__ __forceinline__ void tr_read2(unsigned a, bf16x4& lo, bf16x4& hi) {
    asm volatile("ds_read_b64_tr_b16 %0, %2 offset:%3\n\tds_read_b64_tr_b16 %1, %2 offset:%4\n\ts_waitcnt lgkmcnt(0)" : "=&v"(lo), "=&v"(hi) : "v"(a), "i"(OFF), "i"(OFF + 4096) : "memory"); }

__device__ __forceinline__ void attn_prompt_unit(Frame& F, int unit) {
    LAS unsigned char* L = F.ldv;
    const int tid = F.tid, lane = F.lane, w = F.wave, m16 = lane & 15, kg = lane >> 4;
    const bf16* U = (const bf16*)(F.ws + WS_U); bf16* OG = (bf16*)(F.ws + WS_OG); float* LSE = (float*)(F.ws + WS_LSE);
    const int h = unit & 3, rb = (unit >> 2) & 31, b = (unit >> 7) & 3, g = unit >> 9;
    const int dil = g == 0 ? 1 : (g == 1 ? 4 : 16), nb = 32 / dil, r = rb / nb, blk = rb % nb, hh = g * 4 + h;
    const float slope = exp2f(-8.0f * (float)(hh + 1) / 12.0f) * (float)dil;
    for (int i = tid; i < 272 * 16; i += 512) {
        const int row = i >> 4, chp = i & 15, ch = chp ^ (((row & 3) << 2) | ((row >> 2) & 3));
        const int sub = blk * 128 + row - 128; v4u kv = {0u, 0u, 0u, 0u}, vv = {0u, 0u, 0u, 0u};
        if (row < 256 && sub >= 0) { const size_t gr = (size_t)(b * SEQ + sub * dil + r) * NINP;
            kv = *(const GAS v4u*)(U + gr + U_KA + hh * 128 + ch * 8); vv = *(const GAS v4u*)(U + gr + U_VA + hh * 128 + ch * 8); }
        *(LAS v4u*)(L + AT_K + i * 16) = kv; *(LAS v4u*)(L + AT_V + i * 16) = vv;
    }
    const int qi = 16 * w + m16; const size_t qrow = (size_t)(b * SEQ + (blk * 128 + qi) * dil + r);
    bf16x8 qf[4];
#pragma unroll
    for (int kb = 0; kb < 4; ++kb) qf[kb] = *(const GAS bf16x8*)(U + qrow * NINP + U_QA + hh * 128 + 32 * kb + 8 * kg);
    WG_BARRIER();
    f32x4 S[10];
    int kbase[4];
#pragma unroll
    for (int kb = 0; kb < 4; ++kb) kbase[kb] = AT_K + at_off(16 * w + m16, 4 * kb + kg);
#pragma unroll
    for (int kt = 0; kt < 10; ++kt) { S[kt] = (f32x4){0.f, 0.f, 0.f, 0.f};
#pragma unroll
        for (int kb = 0; kb < 4; ++kb) S[kt] = mfma16(*(const LAS bf16x8*)(L + kbase[kb] + kt * 4096), qf[kb], S[kt]); }
    const float sc = 0.08838834764831845f * 1.4426950408889634f, sl2 = slope * 1.4426950408889634f;
    float mx = -INFINITY;
#pragma unroll
    for (int kt = 0; kt < 10; ++kt)
#pragma unroll
        for (int jj = 0; jj < 4; ++jj) { const int kj = 16 * w + 16 * kt + 4 * kg + jj, delta = 128 + qi - kj;
            const bool ok = delta >= 0 && delta <= 128 && (blk > 0 || kj >= 128);
            const float v = ok ? S[kt][jj] * sc - sl2 * (float)delta : -INFINITY; S[kt][jj] = v; mx = fmaxf(mx, v); }
    mx = fmaxf(mx, __shfl_xor(mx, 16)); mx = fmaxf(mx, __shfl_xor(mx, 32));
    float sum = 0.f;
#pragma unroll
    for (int kt = 0; kt < 10; ++kt)
#pragma unroll
        for (int jj = 0; jj < 4; ++jj) { const float p = exp2f(S[kt][jj] - mx); S[kt][jj] = p; sum += p; }
    sum += __shfl_xor(sum, 16); sum += __shfl_xor(sum, 32);
    bf16x8 pb[5];
#pragma unroll
    for (int kb2 = 0; kb2 < 5; ++kb2) pb[kb2] = pack8(S[2 * kb2], S[2 * kb2 + 1]);
    f32x4 O[8];
    const int rq = m16 >> 2, cq = m16 & 3;
    unsigned vbase[8];
#pragma unroll
    for (int dt = 0; dt < 8; ++dt) vbase[dt] = (unsigned)(AT_V + at_off(16 * w + 4 * kg + rq, 2 * dt + (cq >> 1)) + 8 * (cq & 1));
#define AT_PV(KB2) do { bf16x4 lo, hi; tr_read2<8192 * (KB2)>(vbase[dt], lo, hi); \
        bf16x8 vf; vf[0] = lo[0]; vf[1] = lo[1]; vf[2] = lo[2]; vf[3] = lo[3]; vf[4] = hi[0]; vf[5] = hi[1]; vf[6] = hi[2]; vf[7] = hi[3]; \
        O[dt] = mfma16(vf, pb[KB2], O[dt]); } while (0)
#pragma unroll
    for (int dt = 0; dt < 8; ++dt) { O[dt] = (f32x4){0.f, 0.f, 0.f, 0.f}; AT_PV(0); AT_PV(1); AT_PV(2); AT_PV(3); AT_PV(4); }
#undef AT_PV
    const float inv = 1.0f / sum;
#pragma unroll
    for (int dt = 0; dt < 8; ++dt) { v2u o; o.x = pk2(O[dt][0] * inv, O[dt][1] * inv); o.y = pk2(O[dt][2] * inv, O[dt][3] * inv);
        *(GAS v2u*)(OG + qrow * 1536 + hh * 128 + 16 * dt + 4 * kg) = o; }
    if (kg == 0) LSE[qrow * 12 + hh] = (mx + log2f(sum)) * 0.6931471805599453f;
    WG_BARRIER();
}

__device__ __forceinline__ float half_sum(float v) { v += __shfl_xor(v, 1); v += __shfl_xor(v, 2); v += __shfl_xor(v, 4); v += __shfl_xor(v, 8); v += __shfl_xor(v, 16); return v; }
__device__ __forceinline__ void attn_sample_unit(Frame& F, int unit) {
    const int lane = F.lane, w = F.wave;
    const bf16* U = (const bf16*)(F.ws + WS_U); bf16* OG = (bf16*)(F.ws + WS_OG); float* LSE = (float*)(F.ws + WS_LSE);
    int b, g; if (unit < 256) { b = unit >> 1; g = 1 + (unit & 1); } else { b = unit - 256; g = 0; }
    const int s = w & 3, h = 2 * (w >> 2) + (lane >> 5), dl = lane & 31, hh = g * 4 + h;
    const int dil = g == 0 ? 1 : (g == 1 ? 4 : 16), wb = g == 0 ? 128 : (g == 1 ? 512 : 2048);
    const float* cache = F.in[g == 0 ? IN_C128 : (g == 1 ? IN_C512 : IN_C2048)] + (size_t)b * wb * 1024 + h * 128 + 4 * dl;
    const float L2E = 1.4426950408889634f;
    const float sl2 = exp2f(-8.0f * (float)(hh + 1) / 12.0f) * (float)dil * L2E;
    const size_t qrow = (size_t)(MP + 4 * b + s);
    f32x4 q; { const v2u qq = *(const GAS v2u*)(U + qrow * NINP + U_QA + hh * 128 + 4 * dl); const float sc = 0.08838834764831845f * L2E;
        q = (f32x4){bflo(qq.x) * sc, bfhi(qq.x) * sc, bflo(qq.y) * sc, bfhi(qq.y) * sc}; }
    float m = -INFINITY, l = 0.f; f32x4 o = {0.f, 0.f, 0.f, 0.f};
    const int jn = (g == 0) ? s : 0;
    for (int j = 0; j <= jn; ++j) { const size_t kr = (size_t)(MP + 4 * b + s - dil * j) * NINP + hh * 128 + 4 * dl;
        const v2u kk = *(const GAS v2u*)(U + kr + U_KA), vv = *(const GAS v2u*)(U + kr + U_VA);
        const float sc = half_sum(bflo(kk.x) * q[0] + bfhi(kk.x) * q[1] + bflo(kk.y) * q[2] + bfhi(kk.y) * q[3]) - sl2 * (float)j;
        const float mn = fmaxf(m, sc), al = exp2f(m - mn), p = exp2f(sc - mn); m = mn; l = l * al + p;
        o = o * al + (f32x4){bflo(vv.x), bfhi(vv.x), bflo(vv.y), bfhi(vv.y)} * p; }
    for (int blk = 0; blk < 16; ++blk) {
        f32x4 kf[8], vf[8]; float sc[8];
#pragma unroll
        for (int i = 0; i < 8; ++i) { const int j = jn + 1 + 8 * blk + i; int idx = wb + s - dil * j; idx = idx < 0 ? 0 : idx;
            kf[i] = *(const GAS f32x4*)(cache + (size_t)idx * 1024); vf[i] = *(const GAS f32x4*)(cache + (size_t)idx * 1024 + 512); }
        float mb = -INFINITY;
#pragma unroll
        for (int i = 0; i < 8; ++i) { const int j = jn + 1 + 8 * blk + i;
            float d = half_sum(kf[i][0] * q[0] + kf[i][1] * q[1] + kf[i][2] * q[2] + kf[i][3] * q[3]) - sl2 * (float)j;
            d = (j <= 128) ? d : -INFINITY; sc[i] = d; mb = fmaxf(mb, d); }
        const float mn = fmaxf(m, mb), al = exp2f(m - mn); m = mn; l *= al; o = o * al;
#pragma unroll
        for (int i = 0; i < 8; ++i) { const float p = exp2f(sc[i] - mn); l += p; o = o + vf[i] * p; }
    }
    const float inv = 1.0f / l;
    v2u ov; ov.x = pk2(o[0] * inv, o[1] * inv); ov.y = pk2(o[2] * inv, o[3] * inv);
    *(GAS v2u*)(OG + qrow * 1536 + hh * 128 + 4 * dl) = ov;
    if (dl == 0) LSE[qrow * 12 + hh] = (m + log2f(l)) * 0.6931471805599453f;
}

__device__ __forceinline__ void attn_merge(Frame& F) {
    const bf16* OG = (const bf16*)(F.ws + WS_OG); const float* LSE = (const float*)(F.ws + WS_LSE); bf16* OA = (bf16*)(F.ws + WS_OA);
    const long gt = (long)F.bx * 512 + F.tid, NT = (long)F.G * 512;
    for (long c = gt; c < (long)MT * 64; c += NT) {
        const int row = (int)(c >> 6), hs = (int)(c >> 4) & 3, e8 = (int)c & 15;
        const float l0 = LSE[(size_t)row * 12 + hs], l1 = LSE[(size_t)row * 12 + 4 + hs], l2 = LSE[(size_t)row * 12 + 8 + hs];
        const float m = fmaxf(l0, fmaxf(l1, l2)); float w0 = __expf(l0 - m), w1 = __expf(l1 - m), w2 = __expf(l2 - m); const float inv = 1.0f / (w0 + w1 + w2); w0 *= inv; w1 *= inv; w2 *= inv;
        const v4u a = *(const GAS v4u*)(OG + (size_t)row * 1536 + hs * 128 + e8 * 8), bq = *(const GAS v4u*)(OG + (size_t)row * 1536 + (4 + hs) * 128 + e8 * 8), cq = *(const GAS v4u*)(OG + (size_t)row * 1536 + (8 + hs) * 128 + e8 * 8);
        v4u o;
        o.x = pk2(w0 * bflo(a.x) + w1 * bflo(bq.x) + w2 * bflo(cq.x), w0 * bfhi(a.x) + w1 * bfhi(bq.x) + w2 * bfhi(cq.x));
        o.y = pk2(w0 * bflo(a.y) + w1 * bflo(bq.y) + w2 * bflo(cq.y), w0 * bfhi(a.y) + w1 * bfhi(bq.y) + w2 * bfhi(cq.y));
        o.z = pk2(w0 * bflo(a.z) + w1 * bflo(bq.z) + w2 * bflo(cq.z), w0 * bfhi(a.z) + w1 * bfhi(bq.z) + w2 * bfhi(cq.z));
        o.w = pk2(w0 * bflo(a.w) + w1 * bflo(bq.w) + w2 * bflo(cq.w), w0 * bfhi(a.w) + w1 * bfhi(bq.w) + w2 * bfhi(cq.w));
        *(GAS v4u*)(OA + (size_t)row * 512 + hs * 128 + e8 * 8) = o;
    }
}

#ifndef MK_N_LAUNCHES
#define MK_N_LAUNCHES 1
#endif
constexpr int N_PHASES = 12;
struct Args { const float* in[23]; float* out; unsigned char* ws; int ph_lo, ph_hi, sub, qi; };
static_assert(sizeof(Args) == 23 * 8 + 8 + 8 + 16, "Args has no padding");

__device__ __forceinline__ int q_next(Frame& F, int qi) {
    if (F.tid == 0) F.MISC[16] = __hip_atomic_fetch_add((unsigned*)(F.ctl + CW_Q + 64 * qi), 1u, __ATOMIC_RELAXED, __HIP_MEMORY_SCOPE_AGENT);
    __syncthreads();
    const int v = (int)F.MISC[16];
    __syncthreads();
    return v;
}

#ifndef PH5_MASK
#define PH5_MASK 7
#endif
__device__ __forceinline__ void phase5(Frame& F, int qi, int sub) {
    if ((sub & 1) && F.bx < NB * 8) gdn_scan_chain(F, F.bx);
    for (;;) { const int u = q_next(F, qi); if (u >= 384 + 1536) break;
        if (u < 384) { if (sub & 2) attn_sample_unit(F, u); } else { if (sub & 4) attn_prompt_unit(F, u - 384); } }
}
__global__ void __launch_bounds__(NWAVES * 64, 2) mk_fwd(Args args) {
    extern __shared__ __attribute__((aligned(16))) unsigned char lds[];
    Frame F;
    F.lds = (LAS unsigned char*)lds;
    { unsigned z = 0u; asm volatile("" : "+v"(z)); F.ldv = (LAS unsigned char*)lds + z; }
    F.MISC = (volatile LAS unsigned*)(F.lds + MISC_OFF);
    F.tid = threadIdx.x; F.lane = F.tid & 63; F.wave = __builtin_amdgcn_readfirstlane(F.tid >> 6);
    F.G = gridDim.x; F.bx = blockIdx.x;
    F.ws = args.ws; F.out = args.out; F.ctl = (gu32*)(args.ws + WS_CTL);
    F.in = args.in;
    for (int u = F.tid; u < (LDS_BYTES - LDSCTL_OFF) / 4; u += NWAVES * 64) ((LAS unsigned*)(F.lds + LDSCTL_OFF))[u] = 0u;
    __syncthreads();
    const bool one = (args.ph_hi - args.ph_lo) > 1;
    XcdBarrier bar; bar.bar = (unsigned*)(F.ctl + CW_BAR); bar.x = 0; bar.st = nullptr;
    if (one) bar = xcd_barrier_post((unsigned*)(F.ctl + CW_BAR), F.MISC + 8);
    const int lo = args.ph_lo, hi = args.ph_hi;
#ifndef PHASE_MASK
#define PHASE_MASK 0xFFF
#endif
#define IN(k) ((((PHASE_MASK) >> (k)) & 1) && lo <= (k) && (k) < hi)
#define SEAM(k) do { if (IN(k) && IN((k) + 1)) xcd_barrier(bar); } while (0)

    bf16* XB = (bf16*)(F.ws + WS_XB); bf16* ACT = (bf16*)(F.ws + WS_ACT); float* X1 = (float*)(F.ws + WS_X1); bf16* X1B = (bf16*)(F.ws + WS_X1B);
    bf16* UU = (bf16*)(F.ws + WS_U); float* BA = (float*)(F.ws + WS_BA); bf16* OB = (bf16*)(F.ws + WS_OB); bf16* OA = (bf16*)(F.ws + WS_OA);
    bf16* M1 = (bf16*)(F.ws + WS_M1); bf16* MG = (bf16*)(F.ws + WS_MG); float* X2 = (float*)(F.ws + WS_X2); bf16* X2B = (bf16*)(F.ws + WS_X2B);
    float* SSQ2 = (float*)(args.ws + WS_CTL) + CW_SSQ2; float* SSQ3 = (float*)(args.ws + WS_CTL) + CW_SSQ3; float* SSQ4 = (float*)(args.ws + WS_CTL) + CW_SSQ4;

#ifndef DUP_MASK
#define DUP_MASK 0
#endif
#define DUP(k) (((DUP_MASK) >> (k)) & 1)
    if (IN(0)) { p0_prologue(F); } SEAM(0);
    if (IN(1)) {
        pg8::Gemm g{XB, (const bf16*)(F.ws + WS_W1A), MT, NGU, D}; pg8::StaticOrder S; S.init(MT, NGU, F.G, F.bx);
        pg8::EpiSwiglu E{ACT, (const float*)(F.ws + WS_RSTD1), 0};
        pg8::gemm_phase<pg8::EpiSwiglu, pg8::StaticOrder, true, true>(F.lds + RING_OFF, g, S, E);
    } SEAM(1);
    if (IN(2)) {
        pg8::Gemm g{ACT, (const bf16*)(F.ws + WS_W1B), MT, D, FF}; pg8::StaticOrder S; S.init(MT, D, F.G, F.bx);
        pg8::EpiResid E{F.in[IN_XP], F.in[IN_XS] - (size_t)MP * D, X1, X1B, SSQ2, 0.5f};
        pg8::gemm_phase<pg8::EpiResid, pg8::StaticOrder, true, true>(F.lds + RING_OFF, g, S, E);
    } SEAM(2);
    if (IN(3)) {
        pg8::Gemm g{X1B, (const bf16*)(F.ws + WS_WIN), MT, NINP, D}; pg8::StaticOrder S; S.init(MT, NINP, F.G, F.bx);
        pg8::EpiU E{UU, BA, SSQ2};
        pg8::gemm_phase<pg8::EpiU, pg8::StaticOrder, true, true>(F.lds + RING_OFF, g, S, E);
    } SEAM(3);
    if (IN(4)) {
        for (int i = F.bx; i < NREC + DB * 8; i += F.G) {
#ifndef PH4_MASK
#define PH4_MASK 7
#endif
            if (i < NREC) { if (args.sub & 1) { const int n = i >> 5, bh = i & 31; gdn_prep_unit(F, bh >> 3, bh & 7, n); } }
            else { if (args.sub & 2) { const int j = i - NREC; gdn_sample_unit(F, j >> 3, j & 7); } }
        }
        if (args.sub & 4) copy_outputs(F);
    } SEAM(4);
    if (IN(5)) {
        phase5(F, args.qi, args.sub);
    } SEAM(5);
    if (IN(6)) { attn_merge(F); } SEAM(6);
    if (IN(7)) {
        { pg8::Gemm g{OA, (const bf16*)(F.ws + WS_WPA), MT, D, 512}; pg8::StaticOrder S; S.init(MT, D, F.G, F.bx);
          pg8::EpiGate<0> E{UU, nullptr, M1};
          pg8::gemm_phase<pg8::EpiGate<0>, pg8::StaticOrder, true, true>(F.lds + RING_OFF, g, S, E); }
        { pg8::Gemm g{OB, (const bf16*)(F.ws + WS_WPB), MT, D, D}; pg8::StaticOrder S; S.init(MT, D, F.G, F.bx);
          pg8::EpiGate<1> E{UU, M1, MG};
          pg8::gemm_phase<pg8::EpiGate<1>, pg8::StaticOrder, true, true>(F.lds + RING_OFF, g, S, E); }
    } SEAM(7);
    if (IN(8)) {
        pg8::Gemm g{MG, (const bf16*)(F.ws + WS_WOUT), MT, D, D}; pg8::StaticOrder S; S.init(MT, D, F.G, F.bx);
        pg8::EpiResid E{X1, X1, X2, X2B, SSQ3, 1.0f};
        pg8::gemm_phase<pg8::EpiResid, pg8::StaticOrder, true, true>(F.lds + RING_OFF, g, S, E);
    } SEAM(8);
    if (IN(9)) {
        pg8::Gemm g{X2B, (const bf16*)(F.ws + WS_W2A), MT, NGU, D}; pg8::StaticOrder S; S.init(MT, NGU, F.G, F.bx);
        pg8::EpiSwiglu E{ACT, SSQ3, 1};
        pg8::gemm_phase<pg8::EpiSwiglu, pg8::StaticOrder, true, true>(F.lds + RING_OFF, g, S, E);
    } SEAM(9);
    if (IN(10)) {
        pg8::Gemm g{ACT, (const bf16*)(F.ws + WS_W2B), MT, D, FF}; pg8::StaticOrder S; S.init(MT, D, F.G, F.bx);
        pg8::EpiResid E{X2, X2, F.out + O_Y, nullptr, SSQ4, 0.5f};
        pg8::gemm_phase<pg8::EpiResid, pg8::StaticOrder, true, true>(F.lds + RING_OFF, g, S, E);
    } SEAM(10);
    if (IN(11)) { final_norm(F); }
#undef IN
#undef SEAM
}

extern "C" void kernel_launch(void* const* d_in, const int* in_sizes, int n_in, void* d_out, int out_size, void* d_ws, size_t ws_size, hipStream_t stream) {
    static int grid = 0;
    if (grid == 0) {
        if (n_in != 23 || out_size != (int)O_END || ws_size < WS_END) { fprintf(stderr, "kernel_launch: unexpected sizes n_in %d out %d ws %zu (need %zu)\n", n_in, out_size, ws_size, (size_t)WS_END); grid = -1; return; }
        int dev = 0, cus = 0, per_cu = 0;
        if (hipGetDevice(&dev) != hipSuccess || hipDeviceGetAttribute(&cus, hipDeviceAttributeMultiprocessorCount, dev) != hipSuccess) { grid = -1; return; }
        if (hipFuncSetAttribute((const void*)mk_fwd, hipFuncAttributeMaxDynamicSharedMemorySize, LDS_BYTES) != hipSuccess) { fprintf(stderr, "kernel_launch: hipFuncSetAttribute failed\n"); grid = -1; return; }
        if (hipOccupancyMaxActiveBlocksPerMultiprocessor(&per_cu, (const void*)mk_fwd, NWAVES * 64, LDS_BYTES) != hipSuccess || per_cu < 1) { fprintf(stderr, "kernel_launch: occupancy query says %d\n", per_cu); per_cu = 1; }
        (void)hipGetLastError();
        grid = cus;
    }
    if (grid < 0) return;
    if (hipMemsetAsync((char*)d_ws + WS_CTL, 0, CTL_ZERO_BYTES, stream) != hipSuccess) return;
    Args a{};
    for (int i = 0; i < 23; ++i) a.in[i] = (const float*)d_in[i];
    a.out = (float*)d_out; a.ws = (unsigned char*)d_ws;
#if MK_N_LAUNCHES == 1
    a.ph_lo = 0; a.ph_hi = N_PHASES; a.sub = 7; a.qi = 0;
    hipLaunchKernelGGL(mk_fwd, dim3(grid), dim3(NWAVES * 64), LDS_BYTES, stream, a);
#ifdef EXTRA_MASK
    for (int p = 0; p < N_PHASES; ++p) if ((EXTRA_MASK >> p) & 1) { a.ph_lo = p; a.ph_hi = p + 1; a.sub = EXTRA_SUB; a.qi = 1; hipLaunchKernelGGL(mk_fwd, dim3(grid), dim3(NWAVES * 64), LDS_BYTES, stream, a); }
#endif
#else
    a.sub = 7; a.qi = 0;
    for (int p = 0; p < N_PHASES; ++p) { a.ph_lo = p; a.ph_hi = p + 1; hipLaunchKernelGGL(mk_fwd, dim3(grid), dim3(NWAVES * 64), LDS_BYTES, stream, a); }
#endif
}
```

```cpp
#include <hip/hip_runtime.h>
#include <cstdio>
#include <cstdint>
#define MK_N_LAUNCHES 1
namespace pg8 {
#define PG8_LAS __attribute__((address_space(3)))
typedef unsigned short bf16_t;
typedef short bf16x8 __attribute__((ext_vector_type(8)));
typedef float f32x4 __attribute__((ext_vector_type(4)));
typedef unsigned u32x4 __attribute__((ext_vector_type(4)));
constexpr int BM = 256, BK = 64, HALF = 128, HTB = HALF * BK * 2  , STAGE_BYTES = 8 * HTB, NXCD = 8, WGM = 8;

__host__ __device__ __forceinline__ int lds_byte(int r, int c) { const int st = (r >> 4) * 2 + (c >> 5), rr = r & 15, cc = c & 31, ob = rr * 64 + cc * 2; return st * 1024 + (ob ^ (((ob >> 9) & 1) << 5)); }
__host__ __device__ __forceinline__ void stage_rc(int b, int& R, int& C) { const int st = b / 1024, sb = b % 1024, swz = sb ^ (((sb >> 9) & 1) << 5); R = (st >> 1) * 16 + swz / 64; C = (st & 1) * 32 + (swz % 64) / 2; }
__host__ __device__ __forceinline__ int perm32(int rho) { const int n = rho >> 4, i = rho & 15; return 8 * (i >> 2) + 4 * n + (i & 3); }

struct Unit { int pm, pn; };
struct Gemm { const bf16_t* A; const bf16_t* Bt; int M, N, K; };
struct StaticOrder {
    int nM, nN, nwg, G, c;
    __host__ __device__ void init(int M, int N, int G_, int c_) { nM = M / BM; nN = N / BM; nwg = nM * nN; G = G_; c = c_; }
    __host__ __device__ bool next(int i, Unit& u) const {
        const long L = (long)i * G + c; if (L >= nwg) return false;
        int wgid = (int)L; { const int q = nwg / NXCD, r = nwg % NXCD, xcd = wgid % NXCD, off = wgid / NXCD; wgid = (xcd < r ? xcd * (q + 1) : r * (q + 1) + (xcd - r) * q) + off; }
        const int nig = WGM * nN, gid = wgid / nig, fm = gid * WGM, gsz = (nM - fm) < WGM ? (nM - fm) : WGM;
        u.pm = fm + ((wgid % nig) % gsz); u.pn = (wgid % nig) / gsz; return true;
    }
    __device__ __forceinline__ void a_ready(const Unit&) const {}
    __device__ __forceinline__ void done(const Unit&) const {}
};
__device__ __forceinline__ unsigned cvt_pk_bf16(float lo, float hi) { unsigned r; asm volatile("v_cvt_pk_bf16_f32 %0, %1, %2" : "=v"(r) : "v"(lo), "v"(hi)); return r; }
typedef float f32x2 __attribute__((ext_vector_type(2)));
template <class Epi, class Sched, bool ALIGN_EPI = false, bool SP2 = false>
__device__ __forceinline__ void gemm_phase(PG8_LAS unsigned char* lds, const Gemm g, const Sched& S, const Epi& E) {
    const int tid = threadIdx.x, wid = __builtin_amdgcn_readfirstlane(tid >> 6), lane = tid & 63, wr = wid >> 2, wc = wid & 3, fr = lane & 15, fq = lane >> 4;
    const int K = g.K, nt = K / BK;
    unsigned voffA[2], voffB[2];
#pragma unroll
    for (int i = 0; i < 2; ++i) { int R, C; stage_rc(tid * 16 + i * 8192, R, C); const int Rb = Epi::PERM ? ((R & ~31) + perm32(R & 31)) : R;
        voffA[i] = (unsigned)(R * K + C) * 2u; voffB[i] = (unsigned)(Rb * K + C) * 2u; }
    const size_t kstep = (size_t)(BK * 2);
    const size_t hstep = (size_t)HALF * K * 2;
    const size_t tstep = 2 * hstep;
    const unsigned ldsw = (unsigned)wid * 1024u;
    const int aoff = lds_byte(wr * 64 + fr, fq * 8), boff = lds_byte(wc * 32 + fr, fq * 8);
#define PG8_SA(b, h) (((b) * 2 + (h)) * HTB)
#define PG8_SB(b, h) ((4 + (b) * 2 + (h)) * HTB)
#define PG8_STAGE(bufoff, gbase, voff) do { _Pragma("unroll") for (int _i = 0; _i < 2; ++_i) \
        __builtin_amdgcn_global_load_lds((const unsigned*)((const char*)(gbase) + (voff)[_i]), (PG8_LAS unsigned*)(lds + (bufoff) + ldsw + _i * 8192), 16, 0, 0); } while (0)
#define PG8_LDA(dst, b, h) do { _Pragma("unroll") for (int m = 0; m < 4; ++m) _Pragma("unroll") for (int k = 0; k < 2; ++k) dst[m][k] = *(const PG8_LAS bf16x8*)(lds + PG8_SA(b, h) + aoff + m * 2048 + k * 1024); } while (0)
#define PG8_LDB(dst, b, h) do { _Pragma("unroll") for (int n = 0; n < 2; ++n) _Pragma("unroll") for (int k = 0; k < 2; ++k) dst[n][k] = *(const PG8_LAS bf16x8*)(lds + PG8_SB(b, h) + boff + n * 2048 + k * 1024); } while (0)
#define PG8_MMA(ai, bj, At, Bt) do { __builtin_amdgcn_s_setprio(1); _Pragma("unroll") for (int m = 0; m < 4; ++m) _Pragma("unroll") for (int n = 0; n < 2; ++n) _Pragma("unroll") for (int k = 0; k < 2; ++k) \
        acc[ai][bj][m][n] = __builtin_amdgcn_mfma_f32_16x16x32_bf16(Bt[n][k], At[m][k], acc[ai][bj][m][n], 0, 0, 0); __builtin_amdgcn_s_setprio(0); } while (0)
#define PG8_WAIT_V(n) asm volatile("s_waitcnt vmcnt(" #n ")" ::: "memory")
#define PG8_WAIT_L(n) asm volatile("s_waitcnt lgkmcnt(" #n ")" ::: "memory")
#define PG8_BAR __builtin_amdgcn_s_barrier()
#define PG8_SCHED __builtin_amdgcn_sched_barrier(0)
    Unit cur, nxt; int ui = 0;
    if (!S.next(0, cur)) return;
    f32x4 acc[2][2][4][2];
#pragma unroll
    for (int a = 0; a < 2; ++a)
#pragma unroll
        for (int b = 0; b < 2; ++b)
#pragma unroll
            for (int m = 0; m < 4; ++m)
#pragma unroll
                for (int n = 0; n < 2; ++n) acc[a][b][m][n] = (f32x4){0.f, 0.f, 0.f, 0.f};
    bf16x8 At[4][2], B0[2][2], B1[2][2];
    const char* cA = (const char*)g.A + (size_t)cur.pm * tstep; const char* cB = (const char*)g.Bt + (size_t)cur.pn * tstep;
    S.a_ready(cur);
    if constexpr (SP2) {
        PG8_STAGE(PG8_SB(0, 0), cB, voffB); PG8_STAGE(PG8_SB(0, 1), cB + hstep, voffB); PG8_STAGE(PG8_SA(0, 0), cA, voffA); PG8_STAGE(PG8_SA(0, 1), cA + hstep, voffA);
        if (wr == 1) PG8_BAR;
        PG8_WAIT_V(2); PG8_BAR;
        PG8_STAGE(PG8_SB(1, 0), cB + kstep, voffB); PG8_STAGE(PG8_SA(1, 0), cA + kstep, voffA); PG8_STAGE(PG8_SB(1, 1), cB + hstep + kstep, voffB);
        PG8_WAIT_V(6); PG8_BAR;
    } else {
        PG8_STAGE(PG8_SB(0, 0), cB, voffB); PG8_STAGE(PG8_SA(0, 0), cA, voffA); PG8_STAGE(PG8_SB(0, 1), cB + hstep, voffB); PG8_STAGE(PG8_SA(0, 1), cA + hstep, voffA);
        if (wr == 1) PG8_BAR;
        PG8_WAIT_V(4); PG8_BAR;
        PG8_STAGE(PG8_SB(1, 0), cB + kstep, voffB); PG8_STAGE(PG8_SA(1, 0), cA + kstep, voffA); PG8_STAGE(PG8_SB(1, 1), cB + hstep + kstep, voffB);
        PG8_WAIT_V(6); PG8_BAR;
    }
    for (;;) {
        const bool has_next = S.next(ui + 1, nxt);
        const char* nA = has_next ? (const char*)g.A + (size_t)nxt.pm * tstep : cA; const char* nB = has_next ? (const char*)g.Bt + (size_t)nxt.pn * tstep : cB;
        for (int t = 0; t < nt; t += 2) {
            const bool last = (t == nt - 2);
            const char* a1 = cA + (size_t)(t + 1) * kstep;
            const char* a2 = last ? nA : cA + (size_t)(t + 2) * kstep; const char* b2 = last ? nB : cB + (size_t)(t + 2) * kstep;
            const char* a3 = a2 + kstep; const char* b3 = b2 + kstep;
            if (last && has_next) S.a_ready(nxt);
            if constexpr (SP2) {
            PG8_LDB(B0, 0, 0); PG8_LDB(B1, 0, 1); PG8_SCHED; PG8_LDA(At, 0, 0); PG8_STAGE(PG8_SA(1, 1), a1 + hstep, voffA);
            PG8_WAIT_V(8); PG8_WAIT_L(0); PG8_BAR; PG8_MMA(0, 0, At, B0); PG8_MMA(0, 1, At, B1); PG8_BAR; PG8_SCHED;
            PG8_LDA(At, 0, 1); PG8_STAGE(PG8_SB(0, 0), b2, voffB); PG8_STAGE(PG8_SB(0, 1), b2 + hstep, voffB); PG8_STAGE(PG8_SA(0, 0), a2, voffA);
            PG8_WAIT_V(8); PG8_WAIT_L(0); PG8_BAR; PG8_MMA(1, 0, At, B0); PG8_MMA(1, 1, At, B1); PG8_BAR; PG8_SCHED;
            PG8_LDB(B0, 1, 0); PG8_LDB(B1, 1, 1); PG8_SCHED; PG8_LDA(At, 1, 0); PG8_STAGE(PG8_SA(0, 1), a2 + hstep, voffA);
            PG8_WAIT_V(8); PG8_WAIT_L(0); PG8_BAR; PG8_MMA(0, 0, At, B0); PG8_MMA(0, 1, At, B1); PG8_BAR; PG8_SCHED;
            PG8_LDA(At, 1, 1); PG8_STAGE(PG8_SB(1, 0), b3, voffB); PG8_STAGE(PG8_SB(1, 1), b3 + hstep, voffB); PG8_STAGE(PG8_SA(1, 0), a3, voffA);
            PG8_WAIT_V(8); PG8_WAIT_L(0); PG8_BAR; PG8_MMA(1, 0, At, B0); PG8_MMA(1, 1, At, B1); PG8_BAR; PG8_SCHED;
            } else {
            PG8_LDB(B0, 0, 0); PG8_SCHED; PG8_LDA(At, 0, 0); PG8_STAGE(PG8_SA(1, 1), a1 + hstep, voffA);
            PG8_WAIT_L(8); PG8_BAR; PG8_WAIT_L(0); PG8_MMA(0, 0, At, B0); PG8_BAR; PG8_SCHED;
            PG8_LDB(B1, 0, 1); PG8_STAGE(PG8_SB(0, 0), b2, voffB);
            PG8_BAR; PG8_WAIT_L(0); PG8_MMA(0, 1, At, B1); PG8_BAR;
            PG8_LDA(At, 0, 1); PG8_STAGE(PG8_SA(0, 0), a2, voffA);
            PG8_BAR; PG8_WAIT_L(0); PG8_MMA(1, 0, At, B0); PG8_BAR; PG8_SCHED;
            PG8_STAGE(PG8_SB(0, 1), b2 + hstep, voffB);
            PG8_WAIT_V(6); PG8_BAR; PG8_MMA(1, 1, At, B1); PG8_BAR;
            PG8_LDB(B0, 1, 0); PG8_SCHED; PG8_LDA(At, 1, 0); PG8_STAGE(PG8_SA(0, 1), a2 + hstep, voffA);
            PG8_WAIT_L(8); PG8_BAR; PG8_WAIT_L(0); PG8_MMA(0, 0, At, B0); PG8_BAR; PG8_SCHED;
            PG8_LDB(B1, 1, 1); PG8_STAGE(PG8_SB(1, 0), b3, voffB);
            PG8_BAR; PG8_WAIT_L(0); PG8_MMA(0, 1, At, B1); PG8_BAR;
            PG8_LDA(At, 1, 1); PG8_STAGE(PG8_SA(1, 0), a3, voffA);
            PG8_BAR; PG8_WAIT_L(0); PG8_MMA(1, 0, At, B0); PG8_BAR; PG8_SCHED;
            PG8_STAGE(PG8_SB(1, 1), b3 + hstep, voffB);
            PG8_WAIT_V(6); PG8_BAR; PG8_MMA(1, 1, At, B1); PG8_BAR;
            }
        }
        if constexpr (ALIGN_EPI) { if (wr == 0) PG8_BAR; }
        if constexpr (!Epi::AFTER_DRAIN) { E(acc, cur, wr, wc, fr, fq); S.done(cur); }
        if (!has_next) break;
#pragma unroll
        for (int a = 0; a < 2; ++a)
#pragma unroll
            for (int b = 0; b < 2; ++b)
#pragma unroll
                for (int m = 0; m < 4; ++m)
#pragma unroll
                    for (int n = 0; n < 2; ++n) acc[a][b][m][n] = (f32x4){0.f, 0.f, 0.f, 0.f};
        cur = nxt; cA = nA; cB = nB; ++ui;
        if constexpr (ALIGN_EPI) { if (wr == 1) PG8_BAR; }
    }
    PG8_WAIT_V(0);
    if constexpr (!ALIGN_EPI) { if (wr == 0) PG8_BAR; }
    PG8_BAR;
    if constexpr (Epi::AFTER_DRAIN) { E.fused(acc, cur, wr, wc, fr, fq, lds, wid, lane); S.done(cur); }
#undef PG8_SA
#undef PG8_SB
#undef PG8_STAGE
#undef PG8_LDA
#undef PG8_LDB
#undef PG8_MMA
#undef PG8_WAIT_V
#undef PG8_WAIT_L
#undef PG8_BAR
#undef PG8_SCHED
}
}

constexpr int D = 1024, MP = 16384, MS = 512, MT = MP + MS, FF = 2816, NGU = 2 * FF;
constexpr int SEQ = 4096, NB = 4, DB = 128, DS = 4;
constexpr int NIN = 10768, NINP = 11008;
constexpr int U_QA = 0, U_KA = 1536, U_VA = 3072, U_QKVB = 4608, U_Z = 7680, U_GATE = 8704, U_BA = 10752;
constexpr float EPS = 1e-6f;

namespace pg8 {
typedef unsigned u32x2 __attribute__((ext_vector_type(2)));
__device__ __forceinline__ float sigm(float x) { return 1.f / (1.f + __expf(-x)); }
__device__ __forceinline__ float bf2f(unsigned short b) { return __uint_as_float(((unsigned)b) << 16); }
__device__ __forceinline__ float bflo(unsigned w) { return __uint_as_float(w << 16); }
__device__ __forceinline__ float bfhi(unsigned w) { return __uint_as_float(w & 0xffff0000u); }

struct EpiSwiglu {
    static constexpr bool PERM = true, AFTER_DRAIN = false;
    bf16_t* O; const float* rs; int mode;
    __device__ __forceinline__ void operator()(const f32x4 (&acc)[2][2][4][2], const Unit& u, int wr, int wc, int fr, int fq) const {
        const int row0 = u.pm * BM + wr * 64 + fr, col0 = u.pn * 128 + wc * 32 + 8 * fq;
#pragma unroll
        for (int ai = 0; ai < 2; ++ai)
#pragma unroll
            for (int m = 0; m < 4; ++m) {
                const int row = row0 + ai * HALF + m * 16;
                float r = rs[row]; if (mode) r = rsqrtf(r * (1.0f / D) + EPS);
                float o[8];
#pragma unroll
                for (int n = 0; n < 2; ++n)
#pragma unroll
                    for (int j = 0; j < 4; ++j) { const float g = acc[ai][0][m][n][j] * r, up = acc[ai][1][m][n][j] * r; o[4 * n + j] = g * sigm(g) * up; }
                u32x4 w; w.x = cvt_pk_bf16(o[0], o[1]); w.y = cvt_pk_bf16(o[2], o[3]); w.z = cvt_pk_bf16(o[4], o[5]); w.w = cvt_pk_bf16(o[6], o[7]);
                *(u32x4*)(O + (size_t)row * FF + col0) = w;
            }
    }
};
struct EpiResid {
    static constexpr bool PERM = false, AFTER_DRAIN = false;
    const float* base; const float* base2; float* out; bf16_t* xb; float* ssq; float scale;
    __device__ __forceinline__ void operator()(const f32x4 (&acc)[2][2][4][2], const Unit& u, int wr, int wc, int fr, int fq) const {
        const int row0 = u.pm * BM + wr * 64 + fr, col0 = u.pn * BM + wc * 32 + 4 * fq;
        const float* base = (u.pm * BM < MP) ? this->base : base2;
#pragma unroll
        for (int ai = 0; ai < 2; ++ai)
#pragma unroll
            for (int m = 0; m < 4; ++m) {
                const int row = row0 + ai * HALF + m * 16; const size_t off = (size_t)row * D + col0; float s = 0.f;
#pragma unroll
                for (int bj = 0; bj < 2; ++bj)
#pragma unroll
                    for (int n = 0; n < 2; ++n) {
                        const f32x4 b = *(const f32x4*)(base + off + bj * HALF + n * 16); const f32x4 v = b + acc[ai][bj][m][n] * scale;
                        *(f32x4*)(out + off + bj * HALF + n * 16) = v;
                        if (xb) { u32x2 w; w.x = cvt_pk_bf16(v[0], v[1]); w.y = cvt_pk_bf16(v[2], v[3]); *(u32x2*)(xb + off + bj * HALF + n * 16) = w; }
                        s += (v[0] * v[0] + v[1] * v[1]) + (v[2] * v[2] + v[3] * v[3]);
                    }
                s += __shfl_xor(s, 16); s += __shfl_xor(s, 32);
                if (fq == 0) atomicAdd(ssq + row, s);
            }
    }
};
struct EpiU {
    static constexpr bool PERM = true, AFTER_DRAIN = false;
    bf16_t* U; float* BA; const float* ssq;
    __device__ __forceinline__ void operator()(const f32x4 (&acc)[2][2][4][2], const Unit& u, int wr, int wc, int fr, int fq) const {
        const int row0 = u.pm * BM + wr * 64 + fr, col0 = u.pn * BM + wc * 32 + 8 * fq;
        const bool ba = (u.pn * BM == U_BA);
#pragma unroll
        for (int ai = 0; ai < 2; ++ai)
#pragma unroll
            for (int m = 0; m < 4; ++m) {
                const int row = row0 + ai * HALF + m * 16; const float r = rsqrtf(ssq[row] * (1.0f / D) + EPS);
                if (!ba) {
#pragma unroll
                    for (int bj = 0; bj < 2; ++bj) { const f32x4 v0 = acc[ai][bj][m][0] * r, v1 = acc[ai][bj][m][1] * r;
                        u32x4 w; w.x = cvt_pk_bf16(v0[0], v0[1]); w.y = cvt_pk_bf16(v0[2], v0[3]); w.z = cvt_pk_bf16(v1[0], v1[1]); w.w = cvt_pk_bf16(v1[2], v1[3]);
                        *(u32x4*)(U + (size_t)row * NINP + col0 + bj * HALF) = w; }
                } else if (wc == 0 && fq < 2) {
                    *(f32x4*)(BA + (size_t)row * 16 + 8 * fq) = acc[ai][0][m][0] * r; *(f32x4*)(BA + (size_t)row * 16 + 8 * fq + 4) = acc[ai][0][m][1] * r;
                }
            }
    }
};
template <int SECOND> struct EpiGate {
    static constexpr bool PERM = true, AFTER_DRAIN = false;
    const bf16_t* U; const bf16_t* M1; bf16_t* O;
    __device__ __forceinline__ void operator()(const f32x4 (&acc)[2][2][4][2], const Unit& u, int wr, int wc, int fr, int fq) const {
        const int row0 = u.pm * BM + wr * 64 + fr, col0 = u.pn * BM + wc * 32 + 8 * fq;
#pragma unroll
        for (int ai = 0; ai < 2; ++ai)
#pragma unroll
            for (int m = 0; m < 4; ++m) {
                const int row = row0 + ai * HALF + m * 16;
#pragma unroll
                for (int bj = 0; bj < 2; ++bj) {
                    const int col = col0 + bj * HALF;
                    const u32x4 g = *(const u32x4*)(U + (size_t)row * NINP + U_GATE + SECOND * D + col);
                    float o[8]; const f32x4 a0 = acc[ai][bj][m][0], a1 = acc[ai][bj][m][1];
                    o[0] = sigm(bflo(g.x)) * a0[0]; o[1] = sigm(bfhi(g.x)) * a0[1]; o[2] = sigm(bflo(g.y)) * a0[2]; o[3] = sigm(bfhi(g.y)) * a0[3];
                    o[4] = sigm(bflo(g.z)) * a1[0]; o[5] = sigm(bfhi(g.z)) * a1[1]; o[6] = sigm(bflo(g.w)) * a1[2]; o[7] = sigm(bfhi(g.w)) * a1[3];
                    if (SECOND) { const u32x4 p = *(const u32x4*)(M1 + (size_t)row * D + col);
                        o[0] += bflo(p.x); o[1] += bfhi(p.x); o[2] += bflo(p.y); o[3] += bfhi(p.y); o[4] += bflo(p.z); o[5] += bfhi(p.z); o[6] += bflo(p.w); o[7] += bfhi(p.w); }
                    u32x4 w; w.x = cvt_pk_bf16(o[0], o[1]); w.y = cvt_pk_bf16(o[2], o[3]); w.z = cvt_pk_bf16(o[4], o[5]); w.w = cvt_pk_bf16(o[6], o[7]);
                    *(u32x4*)(O + (size_t)row * D + col) = w;
                }
            }
    }
};
}

#define GAS __attribute__((address_space(1)))
#define LAS __attribute__((address_space(3)))
typedef unsigned short bf16;
typedef unsigned v4u __attribute__((ext_vector_type(4)));
typedef unsigned v2u __attribute__((ext_vector_type(2)));
typedef float f32x4 __attribute__((ext_vector_type(4)));
typedef float f32x2 __attribute__((ext_vector_type(2)));
typedef short bf16x8 __attribute__((ext_vector_type(8)));
typedef short bf16x4 __attribute__((ext_vector_type(4)));
typedef GAS unsigned gu32;
#define RLX_AGENT __ATOMIC_RELAXED, __HIP_MEMORY_SCOPE_AGENT
#define LDS_WAIT() asm volatile("s_waitcnt lgkmcnt(0)" ::: "memory")
#define VM_WAIT() asm volatile("s_waitcnt vmcnt(0)" ::: "memory")
__device__ __forceinline__ unsigned f2bf(float f) { unsigned u = __builtin_bit_cast(unsigned, f); return (u + 0x7fffu + ((u >> 16) & 1u)) >> 16; }
typedef __bf16 bf16x2_t __attribute__((ext_vector_type(2)));
__device__ __forceinline__ unsigned pk2(float lo, float hi) { const bf16x2_t v = __builtin_convertvector((f32x2){lo, hi}, bf16x2_t); return __builtin_bit_cast(unsigned, v); }
__device__ __forceinline__ float bf2f(unsigned short b) { return __uint_as_float(((unsigned)b) << 16); }
__device__ __forceinline__ float bflo(unsigned w) { return __uint_as_float(w << 16); }
__device__ __forceinline__ float bfhi(unsigned w) { return __uint_as_float(w & 0xffff0000u); }
__device__ __forceinline__ float sigm(float x) { return 1.f / (1.f + __expf(-x)); }
__device__ __forceinline__ float siluf(float x) { return x / (1.f + __expf(-x)); }
__device__ __forceinline__ float wave_sum(float v) {
#pragma unroll
    for (int o = 1; o < 64; o <<= 1) v += __shfl_xor(v, o);
    return v;
}
__device__ __forceinline__ float wave_max(float v) {
#pragma unroll
    for (int o = 1; o < 64; o <<= 1) v = fmaxf(v, __shfl_xor(v, o));
    return v;
}
template <int CTRL> __device__ __forceinline__ float dpp_f(float v) { return __builtin_bit_cast(float, __builtin_amdgcn_update_dpp(0, __builtin_bit_cast(int, v), CTRL, 0xf, 0xf, true)); }
__device__ __forceinline__ float row_sum16(float v) { v += dpp_f<0xB1>(v); v += dpp_f<0x4E>(v); v += dpp_f<0x141>(v); v += dpp_f<0x140>(v); return v; }
__device__ __forceinline__ f32x4 mfma16(bf16x8 a, bf16x8 b, f32x4 c) { return __builtin_amdgcn_mfma_f32_16x16x32_bf16(a, b, c, 0, 0, 0); }
__device__ __forceinline__ bf16x8 pack8(f32x4 a, f32x4 b) {
    v4u w; w.x = pk2(a[0], a[1]); w.y = pk2(a[2], a[3]); w.z = pk2(b[0], b[1]); w.w = pk2(b[2], b[3]); return __builtin_bit_cast(bf16x8, w);
}
#define WG_BARRIER() do { asm volatile("s_waitcnt lgkmcnt(0)" ::: "memory"); __builtin_amdgcn_s_barrier(); asm volatile("" ::: "memory"); } while (0)
#define XB_TMO      128
#define XB_XCNT(j)  (256  + 64 * (j))
#define XB_XSUB(j)  (1280 + 64 * (j))
#define XB_XGEN(j)  (2304 + 64 * (j))
#define XB_TOP      3328
#define XB_TOPGEN   3392
#define XCD_BAR_WORDS 3456
#define XB_SPIN_CAP (1u << 18)

__device__ __forceinline__ unsigned xb_ld(unsigned* p)              { return __hip_atomic_load(p, __ATOMIC_RELAXED, __HIP_MEMORY_SCOPE_AGENT); }
__device__ __forceinline__ unsigned xb_add(unsigned* p, unsigned v) { return __hip_atomic_fetch_add(p, v, __ATOMIC_RELAXED, __HIP_MEMORY_SCOPE_AGENT); }
__device__ __forceinline__ unsigned xb_xcc_id() { return (unsigned)__builtin_amdgcn_s_getreg((3 << 11) | 20) & 0xFu; }
#define XB_SPIN(cond, bar) do { unsigned _sp = 0; while (cond) { __builtin_amdgcn_s_sleep(1); \
    if ((++_sp & 255u) == 0u) { if (xb_ld(&(bar)[XB_TMO])) break; if (_sp > XB_SPIN_CAP) { atomicAdd(&(bar)[XB_TMO], 1u); break; } } } } while (0)

struct XcdBarrier {
    unsigned* bar; unsigned x;
    volatile LAS unsigned* st;
};

__device__ __forceinline__ XcdBarrier xcd_barrier_post(unsigned* bar, volatile LAS unsigned* st) {
    XcdBarrier b; b.bar = bar; b.x = xb_xcc_id(); b.st = st;
    if (threadIdx.x == 0) (void)xb_add(&bar[XB_XCNT(b.x)], 1u);
    return b;
}
__device__ __forceinline__ void xcd_barrier_complete(unsigned* bar, unsigned x, unsigned& nloc, unsigned& nx) {
    const unsigned G = gridDim.x * gridDim.y * gridDim.z;
    unsigned sum, cnt, mine, sp = 0u;
    for (;;) {
        sum = 0u; cnt = 0u; mine = 0u;
#pragma unroll
        for (unsigned j = 0; j < 16; ++j) { const unsigned c = xb_ld(&bar[XB_XCNT(j)]); sum += c; cnt += (c > 0u) ? 1u : 0u; mine = (j == x) ? c : mine; }
        if (sum == G) break;
        __builtin_amdgcn_s_sleep(1);
        if ((++sp & 255u) == 0u) { if (xb_ld(&bar[XB_TMO])) break; if (sp > XB_SPIN_CAP) { atomicAdd(&bar[XB_TMO], 1u); break; } }
    }
    nloc = mine > 0u ? mine : 1u; nx = cnt > 0u ? cnt : 1u;
}

__device__ __forceinline__ void xcd_barrier(const XcdBarrier& b) {
    asm volatile("s_waitcnt vmcnt(0)" ::: "memory");
    __syncthreads();
    if (threadIdx.x == 0) {
        unsigned* bar = b.bar;
        __builtin_amdgcn_s_waitcnt(0);
        unsigned nloc = b.st[0], nx = b.st[1];
        if (nloc == 0u) { xcd_barrier_complete(bar, b.x, nloc, nx); b.st[0] = nloc; b.st[1] = nx; }
        const unsigned old = xb_add(&bar[XB_XSUB(b.x)], 1u);
        const unsigned gen = old / nloc;
        if (old + 1u == (gen + 1u) * nloc) {
            __builtin_amdgcn_fence(__ATOMIC_RELEASE, "agent");
            asm volatile("s_waitcnt vmcnt(0)" ::: "memory");
            const unsigned og = xb_add(&bar[XB_TOP], 1u);
            const unsigned tg = og / nx;
            if (og + 1u == (tg + 1u) * nx) xb_add(&bar[XB_TOPGEN], 1u);
            else XB_SPIN(xb_ld(&bar[XB_TOPGEN]) == tg, bar);
            __builtin_amdgcn_fence(__ATOMIC_ACQUIRE, "agent");
            xb_add(&bar[XB_XGEN(b.x)], 1u);
            asm volatile("s_waitcnt vmcnt(0)" ::: "memory");
        } else {
            XB_SPIN(xb_ld(&bar[XB_XGEN(b.x)]) == gen, bar);
            __builtin_amdgcn_fence(__ATOMIC_ACQUIRE, "agent");
            asm volatile("s_waitcnt vmcnt(0)" ::: "memory");
        }
    }
    __syncthreads();
}


constexpr size_t MiB = 1u << 20;
constexpr size_t al256(size_t x) { return (x + 255) & ~(size_t)255; }
constexpr size_t WS_CTL = 0, CTL_ZERO_BYTES = 1 * MiB;
constexpr size_t WS_W1A = 1 * MiB;
constexpr size_t WS_W1B = WS_W1A + (size_t)NGU * D * 2;
constexpr size_t WS_WIN = WS_W1B + (size_t)D * FF * 2;
constexpr size_t WS_WPA = WS_WIN + (size_t)NINP * D * 2;
constexpr size_t WS_WPB = WS_WPA + (size_t)D * 512 * 2;
constexpr size_t WS_WOUT = WS_WPB + (size_t)D * D * 2;
constexpr size_t WS_W2A = WS_WOUT + (size_t)D * D * 2;
constexpr size_t WS_W2B = WS_W2A + (size_t)NGU * D * 2;
constexpr size_t WS_XB = al256(WS_W2B + (size_t)D * FF * 2);
constexpr size_t WS_RSTD1 = WS_XB + (size_t)MT * D * 2;
constexpr size_t WS_ACT = al256(WS_RSTD1 + (size_t)MT * 4);
constexpr size_t WS_X1 = WS_ACT + (size_t)MT * FF * 2;
constexpr size_t WS_X1B = WS_X1 + (size_t)MT * D * 4;
constexpr size_t WS_U = WS_X1B + (size_t)MT * D * 2;
constexpr size_t WS_BA = WS_U + (size_t)MT * NINP * 2;
constexpr size_t REC_BYTES = 90112;
constexpr int NREC = NB * 8 * 64;
constexpr size_t WS_REC = WS_BA + (size_t)MT * 16 * 4;
constexpr size_t WS_GE = WS_REC + (size_t)NREC * REC_BYTES;
constexpr size_t WS_OB = al256(WS_GE + (size_t)NREC * 4);
constexpr size_t WS_OG = WS_OB + (size_t)MT * D * 2;
constexpr size_t WS_LSE = WS_OG + (size_t)MT * 1536 * 2;
constexpr size_t WS_OA = al256(WS_LSE + (size_t)MT * 12 * 4);
constexpr size_t WS_M1 = WS_OA + (size_t)MT * 512 * 2;
constexpr size_t WS_MG = WS_M1 + (size_t)MT * D * 2;
constexpr size_t WS_X2 = WS_MG + (size_t)MT * D * 2;
constexpr size_t WS_X2B = WS_X2 + (size_t)MT * D * 4;
constexpr size_t WS_END = WS_X2B + (size_t)MT * D * 2;
constexpr int CW_TMO = 0;
constexpr int CW_BAR = 4096;
constexpr int CW_Q = 8192;
constexpr int CW_SSQ2 = 16384, CW_SSQ3 = CW_SSQ2 + 17408, CW_SSQ4 = CW_SSQ3 + 17408;
static_assert((CW_SSQ4 + 17408) * 4 <= (int)CTL_ZERO_BYTES, "CTL words inside the memset region");

constexpr size_t O_Y = 0;
constexpr size_t O_KVP0 = (size_t)MT * D;
constexpr size_t O_KVP1 = O_KVP0 + 524288;
constexpr size_t O_KVP2 = O_KVP1 + 2097152;
constexpr size_t O_CONVP = O_KVP2 + 8388608;
constexpr size_t O_SSMP = O_CONVP + 36864;
constexpr size_t O_KVS0 = O_SSMP + 524288;
constexpr size_t O_KVS1 = O_KVS0 + 524288;
constexpr size_t O_KVS2 = O_KVS1 + 524288;
constexpr size_t O_CONVS = O_KVS2 + 524288;
constexpr size_t O_SSMS = O_CONVS + 1179648;
constexpr size_t O_END = O_SSMS + 16777216;

constexpr int NWAVES = 8;
constexpr int RING_OFF = 0;
constexpr int LDSCTL_OFF = 151552, MISC_OFF = LDSCTL_OFF + 320;
constexpr int LDS_BYTES = 155648;

struct Frame {
    LAS unsigned char* lds;
    LAS unsigned char* ldv;
    volatile LAS unsigned* MISC;
    gu32* ctl;
    int tid, lane, wave, G, bx;
    const float* const* in; float* out; unsigned char* ws;
};
#define IN_XP 0
#define IN_XS 1
#define IN_C128 2
#define IN_C512 3
#define IN_C2048 4
#define IN_SCONV 5
#define IN_SSSM 6
#define IN_NF1 7
#define IN_W1GU 8
#define IN_W1D 9
#define IN_NMIX 10
#define IN_WIN 11
#define IN_CONVW 12
#define IN_ALOG 13
#define IN_DTB 14
#define IN_GNORM 15
#define IN_WPA 16
#define IN_WPB 17
#define IN_WOUT 18
#define IN_NF2 19
#define IN_W2GU 20
#define IN_W2D 21
#define IN_NOUT 22

template <class Map>
__device__ __forceinline__ void p0_transpose_item(const float* W, int K, int N, bf16* WT, const float* gain, LAS float* scr, int item, int lane, Map map) {
    const int nblk = (N + 31) / 32, kb = item / nblk, nb = item % nblk, k0 = 64 * kb, n0 = 32 * nb;
    const int nc = n0 + (lane & 31); const bool okc = nc < N;
#pragma unroll 8
    for (int i = 0; i < 32; ++i) { const int kk = 2 * i + (lane >> 5); float v = okc ? W[(size_t)(k0 + kk) * N + nc] : 0.f; if (gain) v *= gain[k0 + kk]; scr[kk * 33 + (lane & 31)] = v; }
    LDS_WAIT(); asm volatile("" ::: "memory");
    const int c = lane & 7;
#pragma unroll
    for (int j = 0; j < 4; ++j) { const int n = (lane >> 3) + 8 * j; const LAS float* s = scr + (8 * c) * 33 + n;
        v4u o; o.x = pk2(s[0 * 33], s[1 * 33]); o.y = pk2(s[2 * 33], s[3 * 33]); o.z = pk2(s[4 * 33], s[5 * 33]); o.w = pk2(s[6 * 33], s[7 * 33]);
        if (n0 + n < N) *(GAS v4u*)(WT + (size_t)map(n0 + n) * K + k0 + 8 * c) = o; }
    LDS_WAIT(); asm volatile("" ::: "memory");
}
struct MapId { __device__ __forceinline__ int operator()(int c) const { return c; } };
struct MapGU { __device__ __forceinline__ int operator()(int c) const { return c < FF ? 256 * (c >> 7) + (c & 127) : 256 * ((c - FF) >> 7) + 128 + ((c - FF) & 127); } };
struct MapIn { __device__ __forceinline__ int operator()(int c) const { return c < 8704 ? c : (c < 8720 ? U_BA + (c - 8704) : c - 16); } };

__device__ __forceinline__ void p0_prologue(Frame& F) {
    LAS float* scr = (LAS float*)(F.ldv + RING_OFF + F.wave * 16384);
    const int gw = F.bx * NWAVES + F.wave, NGW = F.G * NWAVES;
    bf16* W1A = (bf16*)(F.ws + WS_W1A); bf16* W1B = (bf16*)(F.ws + WS_W1B); bf16* WIN = (bf16*)(F.ws + WS_WIN); bf16* WPA = (bf16*)(F.ws + WS_WPA);
    bf16* WPB = (bf16*)(F.ws + WS_WPB); bf16* WOUT = (bf16*)(F.ws + WS_WOUT); bf16* W2A = (bf16*)(F.ws + WS_W2A); bf16* W2B = (bf16*)(F.ws + WS_W2B);
    constexpr int I_GU = (D / 64) * (NGU / 32), I_DN = (FF / 64) * (D / 32), I_IN = (D / 64) * ((NIN + 31) / 32), I_PA = (512 / 64) * (D / 32), I_DD = (D / 64) * (D / 32);
    constexpr int NITEMS = 2 * I_GU + 2 * I_DN + I_IN + I_PA + 2 * I_DD;
    for (int it = gw; it < NITEMS; it += NGW) {
        int r = it;
        if (r < I_GU) { p0_transpose_item(F.in[IN_W1GU], D, NGU, W1A, F.in[IN_NF1], scr, r, F.lane, MapGU()); continue; } r -= I_GU;
        if (r < I_GU) { p0_transpose_item(F.in[IN_W2GU], D, NGU, W2A, F.in[IN_NF2], scr, r, F.lane, MapGU()); continue; } r -= I_GU;
        if (r < I_DN) { p0_transpose_item(F.in[IN_W1D], FF, D, W1B, nullptr, scr, r, F.lane, MapId()); continue; } r -= I_DN;
        if (r < I_DN) { p0_transpose_item(F.in[IN_W2D], FF, D, W2B, nullptr, scr, r, F.lane, MapId()); continue; } r -= I_DN;
        if (r < I_IN) { p0_transpose_item(F.in[IN_WIN], D, NIN, WIN, F.in[IN_NMIX], scr, r, F.lane, MapIn()); continue; } r -= I_IN;
        if (r < I_PA) { p0_transpose_item(F.in[IN_WPA], 512, D, WPA, nullptr, scr, r, F.lane, MapId()); continue; } r -= I_PA;
        if (r < I_DD) { p0_transpose_item(F.in[IN_WPB], D, D, WPB, nullptr, scr, r, F.lane, MapId()); continue; } r -= I_DD;
        p0_transpose_item(F.in[IN_WOUT], D, D, WOUT, nullptr, scr, r, F.lane, MapId());
    }
    { const int gt = F.bx * 512 + F.tid, NT = F.G * 512; GAS v4u* z = (GAS v4u*)(WIN + (size_t)NIN * D);
      for (int i = gt; i < (NINP - NIN) * D / 8; i += NT) z[i] = (v4u){0u, 0u, 0u, 0u}; }
    bf16* XB = (bf16*)(F.ws + WS_XB); float* RSTD1 = (float*)(F.ws + WS_RSTD1);
    for (int m = gw; m < MT; m += NGW) {
        const float* xrow = (m < MP) ? F.in[IN_XP] + (size_t)m * D : F.in[IN_XS] + (size_t)(m - MP) * D;
        const GAS f32x4* xr = (const GAS f32x4*)xrow + F.lane; f32x4 v[4]; float s = 0.f;
#pragma unroll
        for (int j = 0; j < 4; ++j) { v[j] = xr[64 * j]; s += (v[j].x * v[j].x + v[j].y * v[j].y) + (v[j].z * v[j].z + v[j].w * v[j].w); }
        s = wave_sum(s);
        GAS v2u* o8 = (GAS v2u*)(XB + (size_t)m * D) + F.lane;
#pragma unroll
        for (int j = 0; j < 4; ++j) { v2u w; w.x = pk2(v[j].x, v[j].y); w.y = pk2(v[j].z, v[j].w); o8[64 * j] = w; }
        if (F.lane == 0) RSTD1[m] = rsqrtf(s * (1.0f / D) + EPS);
    }
}

__device__ __forceinline__ void final_norm(Frame& F) {
    const int gw = F.bx * NWAVES + F.wave, NGW = F.G * NWAVES;
    const float* ssq = (const float*)(F.ctl + CW_SSQ4); const GAS f32x4* nw = (const GAS f32x4*)F.in[IN_NOUT] + F.lane;
    f32x4 g[4];
#pragma unroll
    for (int j = 0; j < 4; ++j) g[j] = nw[64 * j];
    for (int m = gw; m < MT; m += NGW) {
        const float r = rsqrtf(ssq[m] * (1.0f / D) + EPS);
        GAS f32x4* xr = (GAS f32x4*)(F.out + O_Y + (size_t)m * D) + F.lane;
#pragma unroll
        for (int j = 0; j < 4; ++j) { f32x4 v = xr[64 * j]; xr[64 * j] = v * r * g[j]; }
    }
}

constexpr int GP_QR = 0, GP_KR = 17408, GP_KT = 34816, GP_KBG = 53248, GP_BVT = 71680, GP_GKK = 90112, GP_GQK = 107520, GP_TI = 124928, GP_TAB = 134144;
constexpr int GKP = 68;
__device__ __forceinline__ f32x4 mfma4(float a, float b, f32x4 c) { return __builtin_amdgcn_mfma_f32_16x16x4f32(a, b, c, 0, 0, 0); }
__device__ __forceinline__ f32x4 prod_ll(const LAS float* A, int ra, int ca, const LAS float* B, int rb, int cb, f32x4 c, int m16, int kg) {
    const f32x4 av = *(const LAS f32x4*)(A + (ra + m16) * GKP + ca + 4 * kg);
#pragma unroll
    for (int t = 0; t < 4; ++t) c = mfma4(av[t], B[(rb + 4 * kg + t) * GKP + cb + m16], c);
    return c;
}
__device__ __forceinline__ f32x4 prod_lr(const LAS float* A, int ra, int ca, f32x4 x, f32x4 c, int m16, int kg) {
    const f32x4 av = *(const LAS f32x4*)(A + (ra + m16) * GKP + ca + 4 * kg);
#pragma unroll
    for (int t = 0; t < 4; ++t) c = mfma4(av[t], x[t], c);
    return c;
}
__device__ __forceinline__ float softplusf(float x) { return x > 20.f ? x : log1pf(__expf(x)); }

__device__ __forceinline__ void gdn_prep_unit(Frame& F, int b, int h, int n) {
    LAS unsigned char* L = F.ldv;
    LAS float* TAB = (LAS float*)(L + GP_TAB);
    LAS float* GKK = (LAS float*)(L + GP_GKK);
    LAS float* GQK = (LAS float*)(L + GP_GQK);
    const bf16* U = (const bf16*)(F.ws + WS_U); const float* BA = (const float*)(F.ws + WS_BA);
    const int tid = F.tid, lane = F.lane, wave = F.wave;
    const int uidx = (b * 8 + h) * 64 + n;
    unsigned char* rec = F.ws + WS_REC + (size_t)uidx * REC_BYTES;
    const int row_base = b * SEQ + 64 * n;
    const int gz_t = tid >> 3, gz_c = (tid & 7) * 16;
    const v4u zr0 = *(const GAS v4u*)(U + (size_t)(row_base + gz_t) * NINP + U_Z + h * 128 + gz_c), zr1 = *(const GAS v4u*)(U + (size_t)(row_base + gz_t) * NINP + U_Z + h * 128 + gz_c + 8);
    const int cv_cq = tid & 31, cv_tq = (tid >> 5) & 3, cv_tensor = tid >> 7, cv_c0 = 4 * cv_cq, cv_cw = cv_tensor * 1024 + h * 128 + cv_c0, cv_t0 = 16 * cv_tq;
    v2u raw[19]; f32x4 w0 = {0.f, 0.f, 0.f, 0.f}, w1 = w0, w2 = w0, w3 = w0;
    if (tid < 384) {
        w0 = *(const GAS f32x4*)(F.in[IN_CONVW] + cv_cw); w1 = *(const GAS f32x4*)(F.in[IN_CONVW] + 3072 + cv_cw); w2 = *(const GAS f32x4*)(F.in[IN_CONVW] + 2 * 3072 + cv_cw); w3 = *(const GAS f32x4*)(F.in[IN_CONVW] + 3 * 3072 + cv_cw);
#pragma unroll
        for (int i = 0; i < 19; ++i) { const int tok = 64 * n + cv_t0 - 3 + i; raw[i] = (v2u){0u, 0u}; if (tok >= 0) raw[i] = *(const GAS v2u*)(U + (size_t)(b * SEQ + tok) * NINP + U_QKVB + cv_cw); }
    }
    if (wave == 0) {
        const int t = lane; const float bl = BA[(size_t)(row_base + t) * 16 + h], al = BA[(size_t)(row_base + t) * 16 + 8 + h];
        const float beta = sigm(bl); const float g = -__expf(F.in[IN_ALOG][h]) * softplusf(al + F.in[IN_DTB][h]);
        float gc = g;
#pragma unroll
        for (int o = 1; o < 64; o <<= 1) { const float v = __shfl_up(gc, o); if (lane >= o) gc += v; }
        const float gl = __shfl(gc, 63);
        TAB[t] = beta; TAB[64 + t] = gc; TAB[128 + t] = __expf(gc); TAB[192 + t] = __expf(gl - gc);
        if (lane == 0) ((float*)(F.ws + WS_GE))[uidx] = __expf(gl);
    }
    WG_BARRIER();
    if (tid < 384) {
        const int tensor = cv_tensor, c0 = cv_c0, t0 = cv_t0;
        f32x4 x[19];
#pragma unroll
        for (int i = 0; i < 19; ++i) x[i] = (f32x4){bflo(raw[i].x), bfhi(raw[i].x), bflo(raw[i].y), bfhi(raw[i].y)};
        unsigned tp[4][8];
#pragma unroll
        for (int i = 0; i < 16; ++i) { f32x4 y = w0 * x[i] + w1 * x[i + 1] + w2 * x[i + 2] + w3 * x[i + 3];
#pragma unroll
            for (int e = 0; e < 4; ++e) y[e] = siluf(y[e]);
            if (tensor == 2) y = y * TAB[t0 + i];
            if (tensor < 2) { v2u pk; pk.x = pk2(y[0], y[1]); pk.y = pk2(y[2], y[3]); *(LAS v2u*)(L + (tensor == 0 ? GP_QR : GP_KR) + (t0 + i) * 272 + 2 * c0) = pk; }
            if (tensor > 0) {
#pragma unroll
                for (int e = 0; e < 4; ++e) { const unsigned bq = f2bf(y[e]); if (i & 1) tp[e][i >> 1] |= bq << 16; else tp[e][i >> 1] = bq; } }
        }
        if (tensor > 0) {
#pragma unroll
            for (int e = 0; e < 4; ++e) { LAS unsigned char* dst = L + (tensor == 1 ? GP_KT : GP_BVT) + (c0 + e) * 144 + 2 * t0;
                *(LAS v4u*)dst = (v4u){tp[e][0], tp[e][1], tp[e][2], tp[e][3]}; *(LAS v4u*)(dst + 16) = (v4u){tp[e][4], tp[e][5], tp[e][6], tp[e][7]}; } }
    }
    WG_BARRIER();
    {
        const int m16 = lane & 15, kg = lane >> 4;
        for (int job = wave; job < 24; job += 8) {
            int kind, it, jt;
            if (job < 20) { kind = job >= 10; int j = job % 10; it = 0; while (j > it) { j -= it + 1; ++it; } jt = j; }
            else { kind = 2; it = jt = job - 20; }
            const int abase = (kind == 2 ? GP_QR : GP_KR) + (16 * (kind == 1 ? jt : it) + m16) * 272 + 16 * kg;
            const int bbase = (kind == 0 ? GP_KR : GP_QR) + (16 * (kind == 0 ? jt : it) + m16) * 272 + 16 * kg;
            f32x4 acc = {0.f, 0.f, 0.f, 0.f};
#pragma unroll
            for (int kb = 0; kb < 4; ++kb) { const bf16x8 a = *(const LAS bf16x8*)(L + abase + 64 * kb), bb = *(const LAS bf16x8*)(L + bbase + 64 * kb); acc = mfma16(a, bb, acc); }
            if (kind == 0) {
#pragma unroll
                for (int jj = 0; jj < 4; ++jj) GKK[(16 * it + 4 * kg + jj) * GKP + 16 * jt + m16] = acc[jj];
            } else if (kind == 1) {
                *(LAS f32x4*)(GQK + (16 * it + m16) * 68 + 16 * jt + 4 * kg) = acc;
            } else {
#pragma unroll
                for (int jj = 0; jj < 4; ++jj) if (4 * kg + jj == m16) TAB[576 + 16 * it + m16] = acc[jj];
            }
        }
    }
    WG_BARRIER();
    if (tid < 64) {
        const int t = tid; const float rk = rsqrtf(GKK[t * GKP + t] + EPS), rq = rsqrtf(TAB[576 + t] + EPS) * 0.08838834764831845f;
        TAB[256 + t] = rk; TAB[320 + t] = rq; TAB[384 + t] = rq * TAB[128 + t]; TAB[448 + t] = rk * TAB[192 + t]; TAB[512 + t] = rk * TAB[t] * TAB[128 + t];
    }
    WG_BARRIER();
    {
        for (int e = tid; e < 4096; e += 512) { const int i = e >> 6, j = e & 63;
            if (j < i) GKK[i * GKP + j] = TAB[i] * TAB[256 + i] * TAB[256 + j] * GKK[i * GKP + j] * __expf(TAB[64 + i] - TAB[64 + j]); }
        const int m16 = lane & 15, kg = lane >> 4;
        { const int it = wave >> 1, kb2 = wave & 1, i = 16 * it + m16; const float sc = TAB[320 + i], gi = TAB[64 + i];
          float o[8];
#pragma unroll
          for (int hlf = 0; hlf < 2; ++hlf) { const int j0 = 32 * kb2 + 16 * hlf + 4 * kg; const f32x4 g = *(const LAS f32x4*)(GQK + i * 68 + j0);
#pragma unroll
              for (int e = 0; e < 4; ++e) { const int j = j0 + e; o[4 * hlf + e] = (j <= i) ? sc * TAB[256 + j] * g[e] * __expf(gi - TAB[64 + j]) : 0.f; } }
          v4u w; w.x = pk2(o[0], o[1]); w.y = pk2(o[2], o[3]); w.z = pk2(o[4], o[5]); w.w = pk2(o[6], o[7]);
          *(GAS v4u*)(rec + 32768 + wave * 1024 + lane * 16) = w; }
#pragma unroll
        for (int r = 0; r < 2; ++r) { const int f = wave * 2 + r, mt = f >> 1, kb2 = f & 1, dk = 16 * mt + m16; float o[8];
#pragma unroll
            for (int hlf = 0; hlf < 2; ++hlf) { const int t0 = 32 * kb2 + 16 * hlf + 4 * kg; const v2u kk = *(const LAS v2u*)(L + GP_KT + dk * 144 + 2 * t0);
                o[4 * hlf + 0] = bflo(kk.x) * TAB[448 + t0]; o[4 * hlf + 1] = bfhi(kk.x) * TAB[448 + t0 + 1]; o[4 * hlf + 2] = bflo(kk.y) * TAB[448 + t0 + 2]; o[4 * hlf + 3] = bfhi(kk.y) * TAB[448 + t0 + 3]; }
            v4u w; w.x = pk2(o[0], o[1]); w.y = pk2(o[2], o[3]); w.z = pk2(o[4], o[5]); w.w = pk2(o[6], o[7]);
            *(GAS v4u*)(rec + 40960 + f * 1024 + lane * 16) = w; }
#pragma unroll
        for (int r = 0; r < 2; ++r) { const int f = wave * 2 + r, mtq = f >> 2, kb = f & 3, t = 16 * mtq + m16; const float sc = TAB[384 + t]; float o[8];
#pragma unroll
            for (int hlf = 0; hlf < 2; ++hlf) { const int d0 = 32 * kb + 16 * hlf + 4 * kg; const v2u qq = *(const LAS v2u*)(L + GP_QR + t * 272 + 2 * d0);
                o[4 * hlf + 0] = bflo(qq.x) * sc; o[4 * hlf + 1] = bfhi(qq.x) * sc; o[4 * hlf + 2] = bflo(qq.y) * sc; o[4 * hlf + 3] = bfhi(qq.y) * sc; }
            v4u w; w.x = pk2(o[0], o[1]); w.y = pk2(o[2], o[3]); w.z = pk2(o[4], o[5]); w.w = pk2(o[6], o[7]);
            *(GAS v4u*)(rec + ((4 + mtq) * 4 + kb) * 1024 + lane * 16) = w; }
        { const int dk = tid >> 2, t0 = (tid & 3) * 16; const v4u a = *(const LAS v4u*)(L + GP_KT + dk * 144 + 2 * t0), bq = *(const LAS v4u*)(L + GP_KT + dk * 144 + 2 * t0 + 16);
          const unsigned wi[8] = {a.x, a.y, a.z, a.w, bq.x, bq.y, bq.z, bq.w}; unsigned wo[8];
#pragma unroll
          for (int i = 0; i < 8; ++i) wo[i] = pk2(bflo(wi[i]) * TAB[512 + t0 + 2 * i], bfhi(wi[i]) * TAB[512 + t0 + 2 * i + 1]);
          *(LAS v4u*)(L + GP_KBG + dk * 144 + 2 * t0) = (v4u){wo[0], wo[1], wo[2], wo[3]}; *(LAS v4u*)(L + GP_KBG + dk * 144 + 2 * t0 + 16) = (v4u){wo[4], wo[5], wo[6], wo[7]}; }
    }
    WG_BARRIER();
    LAS float* TIF = GQK;
    {
        const int m16 = lane & 15, kg = lane >> 4;
        if (wave == 0) {
            const LAS float* Ab = GKK + (16 * kg) * GKP + 16 * kg; float r[16];
#pragma unroll
            for (int i = 0; i < 16; ++i) { int lo_ = m16; asm volatile("" : "+v"(lo_)); float a = (lo_ == i) ? 1.f : 0.f;
#pragma unroll
                for (int j4 = 0; j4 < (i + 3) / 4; ++j4) { const f32x4 av = *(const LAS f32x4*)(Ab + i * GKP + 4 * j4);
#pragma unroll
                    for (int e = 0; e < 4; ++e) { const int j = 4 * j4 + e; if (j < i) a -= av[e] * r[j]; } }
                r[i] = a; }
#pragma unroll
            for (int i = 0; i < 16; ++i) TIF[(16 * kg + i) * GKP + 16 * kg + m16] = r[i];
        }
        WG_BARRIER();
        const f32x4 z4 = {0.f, 0.f, 0.f, 0.f};
        if (wave < 3) { const int i = wave + 1, j = wave;
            f32x4 X = prod_ll(GKK, 16 * i, 16 * j, TIF, 16 * j, 16 * j, z4, m16, kg);
            f32x4 T = prod_lr(TIF, 16 * i, 16 * i, X, z4, m16, kg);
#pragma unroll
            for (int jj = 0; jj < 4; ++jj) TIF[(16 * i + 4 * kg + jj) * GKP + 16 * j + m16] = -T[jj]; }
        WG_BARRIER();
        if (wave < 2) { const int i = wave + 2, j = wave;
            f32x4 Y = prod_ll(GKK, 16 * i, 16 * j, TIF, 16 * j, 16 * j, z4, m16, kg);
            Y = prod_ll(GKK, 16 * i, 16 * (j + 1), TIF, 16 * (j + 1), 16 * j, Y, m16, kg);
            f32x4 T = prod_lr(TIF, 16 * i, 16 * i, Y, z4, m16, kg);
#pragma unroll
            for (int jj = 0; jj < 4; ++jj) TIF[(16 * i + 4 * kg + jj) * GKP + 16 * j + m16] = -T[jj]; }
        WG_BARRIER();
        if (wave == 0) {
            f32x4 Y = prod_ll(GKK, 48, 0, TIF, 0, 0, z4, m16, kg);
            Y = prod_ll(GKK, 48, 16, TIF, 16, 0, Y, m16, kg);
            Y = prod_ll(GKK, 48, 32, TIF, 32, 0, Y, m16, kg);
            f32x4 T = prod_lr(TIF, 48, 48, Y, z4, m16, kg);
#pragma unroll
            for (int jj = 0; jj < 4; ++jj) TIF[(48 + 4 * kg + jj) * GKP + m16] = -T[jj]; }
        WG_BARRIER();
        { const int row = tid >> 3, cg = tid & 7; v4u o = {0u, 0u, 0u, 0u};
          if ((cg >> 1) <= (row >> 4)) { const f32x4 a = *(const LAS f32x4*)(TIF + row * GKP + 8 * cg), c = *(const LAS f32x4*)(TIF + row * GKP + 8 * cg + 4);
              o.x = pk2(a[0], a[1]); o.y = pk2(a[2], a[3]); o.z = pk2(c[0], c[1]); o.w = pk2(c[2], c[3]); }
          *(LAS v4u*)(L + GP_TI + row * 144 + 16 * cg) = o; }
    }
    WG_BARRIER();
    {
        const int m16 = lane & 15, kg = lane >> 4;
#pragma unroll
        for (int it = 0; it < 4; ++it) {
            f32x4 au = {0.f, 0.f, 0.f, 0.f}, aw = {0.f, 0.f, 0.f, 0.f};
#pragma unroll
            for (int jb = 0; jb < 2; ++jb) {
                const bf16x8 ti = *(const LAS bf16x8*)(L + GP_TI + (16 * it + m16) * 144 + 64 * jb + 16 * kg);
                const bf16x8 bv = *(const LAS bf16x8*)(L + GP_BVT + (16 * wave + m16) * 144 + 64 * jb + 16 * kg);
                const bf16x8 kb = *(const LAS bf16x8*)(L + GP_KBG + (16 * wave + m16) * 144 + 64 * jb + 16 * kg);
                au = mfma16(ti, bv, au);
                aw = mfma16(kb, ti, aw);
            }
            v2u w; w.x = pk2(au[0], au[1]); w.y = pk2(au[2], au[3]);
            *(GAS v2u*)(rec + 57344 + ((wave * 4 + it) * 64 + lane) * 8) = w;
            v2u x; x.x = pk2(aw[0], aw[1]); x.y = pk2(aw[2], aw[3]);
            *(GAS v2u*)(rec + (it * 4 + (wave >> 1)) * 1024 + lane * 16 + (wave & 1) * 8) = x;
        }
    }
    { const unsigned zi[8] = {zr0.x, zr0.y, zr0.z, zr0.w, zr1.x, zr1.y, zr1.z, zr1.w}; unsigned zo[8];
#pragma unroll
      for (int i = 0; i < 8; ++i) { const float za = bflo(zi[i]), zb = bfhi(zi[i]); const f32x2 nw2 = *(const GAS f32x2*)(F.in[IN_GNORM] + gz_c + 2 * i);
          zo[i] = pk2(za * sigm(za) * nw2[0], zb * sigm(zb) * nw2[1]); }
      *(GAS v4u*)(rec + 73728 + (gz_t * 128 + gz_c) * 2) = (v4u){zo[0], zo[1], zo[2], zo[3]}; *(GAS v4u*)(rec + 73728 + (gz_t * 128 + gz_c + 8) * 2) = (v4u){zo[4], zo[5], zo[6], zo[7]}; }
    WG_BARRIER();
}

constexpr int SC_BUF = 57344, SC_OT = 2 * SC_BUF, SC_OTB = 17408, SC_RED = SC_OT + 2 * SC_OTB;
static_assert(SC_RED + 2048 <= LDSCTL_OFF, "scan LDS map");
__device__ __forceinline__ void gdn_scan_chain(Frame& F, int bh) {
    LAS unsigned char* L = F.ldv;
    const int tid = F.tid, lane = F.lane, w = F.wave, m16 = lane & 15, kg = lane >> 4;
    const int b = bh >> 3, h = bh & 7;
    const unsigned char* rec0 = F.ws + WS_REC + (size_t)(bh * 64) * REC_BYTES;
    if (w >= 4) {
        const int ht = tid - 256; bf16* OB = (bf16*)(F.ws + WS_OB);
        v4u st[14];
#pragma unroll
        for (int i = 0; i < 14; ++i) st[i] = *(const GAS v4u*)(rec0 + (size_t)(i * 256 + ht) * 16);
#pragma unroll
        for (int i = 0; i < 14; ++i) *(LAS v4u*)(L + (i * 256 + ht) * 16) = st[i];
#pragma unroll
        for (int i = 0; i < 14; ++i) st[i] = *(const GAS v4u*)(rec0 + REC_BYTES + (size_t)(i * 256 + ht) * 16);
        WG_BARRIER();
        for (int m = 0; m < 65; ++m) {
            if (m + 1 <= 63) { LAS unsigned char* nb = L + ((m + 1) & 1) * SC_BUF;
#pragma unroll
                for (int i = 0; i < 14; ++i) *(LAS v4u*)(nb + (i * 256 + ht) * 16) = st[i]; }
            if (m + 2 <= 63) { const unsigned char* rec = rec0 + (size_t)(m + 2) * REC_BYTES;
#pragma unroll
                for (int i = 0; i < 14; ++i) st[i] = *(const GAS v4u*)(rec + (size_t)(i * 256 + ht) * 16); }
            if (m >= 1) {
                const LAS unsigned char* ot = L + SC_OT + ((m - 1) & 1) * SC_OTB; const LAS float* RED = (const LAS float*)(L + SC_RED) + ((m - 1) & 1) * 256;
                const int row0 = b * SEQ + 64 * (m - 1); const unsigned char* gzt = rec0 + (size_t)(m - 1) * REC_BYTES + 73728;
                v4u gv[4];
#pragma unroll
                for (int r = 0; r < 4; ++r) gv[r] = *(const GAS v4u*)(gzt + (size_t)(ht + 256 * r) * 16);
#pragma unroll
                for (int r = 0; r < 4; ++r) { const int idx = ht + 256 * r, row = idx >> 4, ch = idx & 15;
                    const v4u ov = *(const LAS v4u*)(ot + row * 272 + ch * 16); const f32x4 r4 = *(const LAS f32x4*)(RED + row * 4);
                    const float rs = rsqrtf(((r4[0] + r4[1]) + (r4[2] + r4[3])) * (1.0f / 128.0f) + EPS);
                    v4u o; o.x = pk2(bflo(ov.x) * rs * bflo(gv[r].x), bfhi(ov.x) * rs * bfhi(gv[r].x)); o.y = pk2(bflo(ov.y) * rs * bflo(gv[r].y), bfhi(ov.y) * rs * bfhi(gv[r].y));
                    o.z = pk2(bflo(ov.z) * rs * bflo(gv[r].z), bfhi(ov.z) * rs * bfhi(gv[r].z)); o.w = pk2(bflo(ov.w) * rs * bflo(gv[r].w), bfhi(ov.w) * rs * bfhi(gv[r].w));
                    *(GAS v4u*)(OB + (size_t)(row0 + row) * D + h * 128 + ch * 8) = o; } }
            WG_BARRIER();
        }
    } else {
        const float* GE = (const float*)(F.ws + WS_GE) + bh * 64;
        f32x4 S[2][8], P[2][8];
#pragma unroll
        for (int hf = 0; hf < 2; ++hf)
#pragma unroll
            for (int i = 0; i < 8; ++i) { S[hf][i] = (f32x4){0.f, 0.f, 0.f, 0.f}; P[hf][i] = (f32x4){0.f, 0.f, 0.f, 0.f}; }
        WG_BARRIER();
        for (int m = 0; m < 65; ++m) {
            if (m <= 63) {
                const unsigned char* rec = rec0 + (size_t)m * REC_BYTES; const LAS unsigned char* buf = L + (m & 1) * SC_BUF;
                v2u ut[2][4];
#pragma unroll
                for (int hf = 0; hf < 2; ++hf)
#pragma unroll
                    for (int mt = 0; mt < 4; ++mt) ut[hf][mt] = *(const GAS v2u*)(rec + 57344 + (((2 * w + hf) * 4 + mt) * 64 + lane) * 8);
                const float ge = GE[m];
                bf16x8 Sb[2][4];
#pragma unroll
                for (int hf = 0; hf < 2; ++hf)
#pragma unroll
                    for (int kb = 0; kb < 4; ++kb) Sb[hf][kb] = pack8(S[hf][2 * kb], S[hf][2 * kb + 1]);
#pragma unroll
                for (int mt = 0; mt < 8; ++mt) { P[0][mt] = (f32x4){0.f, 0.f, 0.f, 0.f}; P[1][mt] = (f32x4){0.f, 0.f, 0.f, 0.f};
#pragma unroll
                    for (int kb = 0; kb < 4; ++kb) { const bf16x8 a = *(const LAS bf16x8*)(buf + (mt * 4 + kb) * 1024 + lane * 16); P[0][mt] = mfma16(a, Sb[0][kb], P[0][mt]); P[1][mt] = mfma16(a, Sb[1][kb], P[1][mt]); } }
                bf16x8 vb[2][2];
#pragma unroll
                for (int hf = 0; hf < 2; ++hf) { f32x4 vn[4];
#pragma unroll
                    for (int mt = 0; mt < 4; ++mt) { vn[mt][0] = bflo(ut[hf][mt].x) - P[hf][mt][0]; vn[mt][1] = bfhi(ut[hf][mt].x) - P[hf][mt][1]; vn[mt][2] = bflo(ut[hf][mt].y) - P[hf][mt][2]; vn[mt][3] = bfhi(ut[hf][mt].y) - P[hf][mt][3]; }
                    vb[hf][0] = pack8(vn[0], vn[1]); vb[hf][1] = pack8(vn[2], vn[3]); }
#pragma unroll
                for (int mt = 0; mt < 4; ++mt)
#pragma unroll
                    for (int kb2 = 0; kb2 < 2; ++kb2) { const bf16x8 a = *(const LAS bf16x8*)(buf + 32768 + (mt * 2 + kb2) * 1024 + lane * 16); P[0][4 + mt] = mfma16(a, vb[0][kb2], P[0][4 + mt]); P[1][4 + mt] = mfma16(a, vb[1][kb2], P[1][4 + mt]); }
#pragma unroll
                for (int mt = 0; mt < 8; ++mt) { S[0][mt] = S[0][mt] * ge; S[1][mt] = S[1][mt] * ge;
#pragma unroll
                    for (int kb2 = 0; kb2 < 2; ++kb2) { const bf16x8 a = *(const LAS bf16x8*)(buf + 40960 + (mt * 2 + kb2) * 1024 + lane * 16); S[0][mt] = mfma16(a, vb[0][kb2], S[0][mt]); S[1][mt] = mfma16(a, vb[1][kb2], S[1][mt]); } }
                LAS float* RED = (LAS float*)(L + SC_RED) + (m & 1) * 256; LAS unsigned char* ot = L + SC_OT + (m & 1) * SC_OTB;
#pragma unroll
                for (int mt = 0; mt < 4; ++mt)
#pragma unroll
                    for (int jj = 0; jj < 4; jj += 2) { const int t = 16 * mt + 4 * kg + jj;
#pragma unroll
                        for (int hf = 0; hf < 2; ++hf) { const unsigned pr = pk2(P[hf][4 + mt][jj], P[hf][4 + mt][jj + 1]);
                            *(LAS bf16*)(ot + t * 272 + (32 * w + 16 * hf + m16) * 2) = (bf16)(pr & 0xffffu); *(LAS bf16*)(ot + (t + 1) * 272 + (32 * w + 16 * hf + m16) * 2) = (bf16)(pr >> 16); } }
                float mine = 0.f;
#pragma unroll
                for (int mt = 0; mt < 4; ++mt)
#pragma unroll
                    for (int jj = 0; jj < 4; ++jj) { const float q = row_sum16(P[0][4 + mt][jj] * P[0][4 + mt][jj] + P[1][4 + mt][jj] * P[1][4 + mt][jj]); mine = (m16 == 4 * mt + jj) ? q : mine; }
                RED[(16 * (m16 >> 2) + 4 * kg + (m16 & 3)) * 4 + w] = mine;
            }
            WG_BARRIER();
        }
        float* so = F.out + O_SSMP + (size_t)bh * 16384;
#pragma unroll
        for (int hf = 0; hf < 2; ++hf)
#pragma unroll
            for (int mt = 0; mt < 8; ++mt)
#pragma unroll
                for (int jj = 0; jj < 4; ++jj) so[(16 * mt + 4 * kg + jj) * 128 + 32 * w + 16 * hf + m16] = S[hf][mt][jj];
    }
    WG_BARRIER();
}

__device__ __forceinline__ void gdn_sample_unit(Frame& F, int b, int h) {
    LAS float* L = (LAS float*)F.ldv;
    const int tid = F.tid, lane = F.lane, wave = F.wave;
    const bf16* U = (const bf16*)(F.ws + WS_U); const float* BA = (const float*)(F.ws + WS_BA);
    const int row0 = MP + 4 * b;
    LAS float* SC = L + 8704;
    if (tid < 4) { const float bl = BA[(size_t)(row0 + tid) * 16 + h], al = BA[(size_t)(row0 + tid) * 16 + 8 + h];
        SC[tid] = sigm(bl); SC[56 + tid] = -__expf(F.in[IN_ALOG][h]) * softplusf(al + F.in[IN_DTB][h]); }
    if (tid < 384) {
        const int tensor = tid >> 7, c = tid & 127, cw = tensor * 1024 + h * 128 + c, col = U_QKVB + cw;
        const float w0 = F.in[IN_CONVW][cw], w1 = F.in[IN_CONVW][3072 + cw], w2 = F.in[IN_CONVW][2 * 3072 + cw], w3 = F.in[IN_CONVW][3 * 3072 + cw];
        float x[7];
#pragma unroll
        for (int i = 0; i < 3; ++i) x[i] = F.in[IN_SCONV][((size_t)b * 3 + i) * 3072 + cw];
#pragma unroll
        for (int i = 0; i < 4; ++i) x[3 + i] = bf2f(U[(size_t)(row0 + i) * NINP + col]);
#pragma unroll
        for (int i = 0; i < 4; ++i) { const float v = w0 * x[i] + w1 * x[i + 1] + w2 * x[i + 2] + w3 * x[i + 3]; L[tensor * 512 + i * 128 + c] = siluf(v); }
    }
    WG_BARRIER();
    if (tid == 0) { float gc = 0.f;
#pragma unroll
        for (int i = 0; i < 4; ++i) { gc += SC[56 + i]; SC[4 + i] = gc; } SC[48] = __expf(gc); }
    { const int tensor = wave >> 2, s = wave & 3; const float a = L[tensor * 512 + s * 128 + lane], c2 = L[tensor * 512 + s * 128 + 64 + lane];
      const float ss = wave_sum(a * a + c2 * c2); if (lane == 0) SC[(tensor ? 8 : 12) + s] = rsqrtf(ss + EPS) * (tensor ? 1.f : 0.08838834764831845f); }
    WG_BARRIER();
#pragma unroll
    for (int r = 0; r < 4; ++r) { const int idx = 4 * wave + r, kind = idx >> 4, i = (idx >> 2) & 3, j = idx & 3;
        const LAS float* a = L + (kind ? 0 : 512) + i * 128; const LAS float* c2 = L + 512 + j * 128;
        const float d = wave_sum(a[lane] * c2[lane] + a[64 + lane] * c2[64 + lane]);
        if (lane == 0) SC[16 + idx] = d * SC[(kind ? 12 : 8) + i] * SC[8 + j]; }
    WG_BARRIER();
    float beta[4], gc[4], Ti[4][4], qkm[4][4];
#pragma unroll
    for (int i = 0; i < 4; ++i) { beta[i] = SC[i]; gc[i] = SC[4 + i]; }
    const float ge = SC[48];
    {
        float A[4][4];
#pragma unroll
        for (int i = 0; i < 4; ++i)
#pragma unroll
            for (int j = 0; j < 4; ++j) { const float dec = __expf(gc[i] - gc[j]); A[i][j] = (j < i) ? beta[i] * SC[16 + 4 * i + j] * dec : 0.f; qkm[i][j] = (j <= i) ? SC[32 + 4 * i + j] * dec : 0.f; }
#pragma unroll
        for (int i = 0; i < 4; ++i)
#pragma unroll
            for (int c = 0; c < 4; ++c) { float v = (i == c) ? 1.f : 0.f;
#pragma unroll
                for (int j = 0; j < 4; ++j) if (j < i) v -= A[i][j] * Ti[j][c];
                Ti[i][c] = v; }
    }
    { const int c = tid & 127, i = tid >> 7; float wv = 0.f, uv = 0.f;
#pragma unroll
      for (int j = 0; j < 4; ++j) { wv += Ti[i][j] * beta[j] * __expf(gc[j]) * SC[8 + j] * L[512 + j * 128 + c]; uv += Ti[i][j] * beta[j] * L[1024 + j * 128 + c]; }
      L[1536 + i * 128 + c] = wv; L[3072 + i * 128 + c] = uv;
      L[2048 + i * 128 + c] = L[i * 128 + c] * SC[12 + i] * __expf(gc[i]);
      L[2560 + i * 128 + c] = L[512 + i * 128 + c] * SC[8 + i] * __expf(gc[3] - gc[i]); }
    WG_BARRIER();
    const int dv = tid & 127, kq = tid >> 7;
    const float* S0 = F.in[IN_SSSM] + ((size_t)(b * 8 + h) * 128 + 32 * kq) * 128 + dv;
    float s[32];
#pragma unroll
    for (int i = 0; i < 32; ++i) s[i] = S0[(size_t)i * 128];
    float pw[4] = {0.f, 0.f, 0.f, 0.f}, pq[4] = {0.f, 0.f, 0.f, 0.f};
#pragma unroll
    for (int i = 0; i < 32; ++i)
#pragma unroll
        for (int c = 0; c < 4; ++c) { pw[c] += L[1536 + c * 128 + 32 * kq + i] * s[i]; pq[c] += L[2048 + c * 128 + 32 * kq + i] * s[i]; }
#pragma unroll
    for (int c = 0; c < 4; ++c) { L[3584 + (c * 4 + kq) * 128 + dv] = pw[c]; L[3584 + ((4 + c) * 4 + kq) * 128 + dv] = pq[c]; }
    WG_BARRIER();
    float vn[4], oo[4];
#pragma unroll
    for (int c = 0; c < 4; ++c) { const float ws_ = (L[3584 + (c * 4 + 0) * 128 + dv] + L[3584 + (c * 4 + 1) * 128 + dv]) + (L[3584 + (c * 4 + 2) * 128 + dv] + L[3584 + (c * 4 + 3) * 128 + dv]);
        vn[c] = L[3072 + c * 128 + dv] - ws_; }
#pragma unroll
    for (int c = 0; c < 4; ++c) { float o = (L[3584 + ((4 + c) * 4 + 0) * 128 + dv] + L[3584 + ((4 + c) * 4 + 1) * 128 + dv]) + (L[3584 + ((4 + c) * 4 + 2) * 128 + dv] + L[3584 + ((4 + c) * 4 + 3) * 128 + dv]);
#pragma unroll
        for (int j = 0; j < 4; ++j) o += qkm[c][j] * vn[j];
        oo[c] = o; }
    float* SO = F.out + O_SSMS + ((size_t)(b * 8 + h) * 128 + 32 * kq) * 128 + dv;
#pragma unroll
    for (int i = 0; i < 32; ++i) { float v = ge * s[i];
#pragma unroll
        for (int c = 0; c < 4; ++c) v += L[2560 + c * 128 + 32 * kq + i] * vn[c];
        SO[(size_t)i * 128] = v; }
    LAS float* RED = L + 8768;
    if (kq == 0) {
#pragma unroll
        for (int c = 0; c < 4; ++c) { const float q = wave_sum(oo[c] * oo[c]); if (lane == 0) RED[c * 2 + wave] = q; }
    }
    WG_BARRIER();
    if (kq == 0) {
        bf16* OB = (bf16*)(F.ws + WS_OB); const float nw = F.in[IN_GNORM][dv];
#pragma unroll
        for (int c = 0; c < 4; ++c) { const float rs = rsqrtf((RED[c * 2] + RED[c * 2 + 1]) * (1.0f / 128.0f) + EPS);
            const float z = bf2f(U[(size_t)(row0 + c) * NINP + U_Z + h * 128 + dv]);
            OB[(size_t)(row0 + c) * D + h * 128 + dv] = (bf16)f2bf(oo[c] * rs * nw * (z * sigm(z))); }
    }
    WG_BARRIER();
}

__device__ __forceinline__ void copy_outputs(Frame& F) {
    const bf16* U = (const bf16*)(F.ws + WS_U);
    const long gt = (long)F.bx * 512 + F.tid, NT = (long)F.G * 512;
    constexpr long C0 = 65536, C1 = 262144, C2 = 1048576, CS = 65536, CCP = 4608, CCS = 147456;
    constexpr long TOT = C0 + C1 + C2 + 3 * CS + CCP + CCS;
    for (long c = gt; c < TOT; c += NT) {
        long r = c; int srow, scol; float* dst;
        if (r < C0 + C1 + C2) {
            int g, keep; if (r < C0) { g = 0; keep = 128; dst = F.out + O_KVP0; } else if (r < C0 + C1) { r -= C0; g = 1; keep = 512; dst = F.out + O_KVP1; } else { r -= C0 + C1; g = 2; keep = 2048; dst = F.out + O_KVP2; }
            const int e8 = r & 15, hh = (r >> 4) & 3, kv = (r >> 6) & 1; const int rr = (int)((r >> 7) % keep), bb = (int)((r >> 7) / keep);
            srow = bb * SEQ + SEQ - keep + rr; scol = (kv ? U_VA : U_KA) + (g * 4 + hh) * 128 + e8 * 8; dst += r * 8;
        } else if ((r -= C0 + C1 + C2) < 3 * CS) {
            const int g = (int)(r / CS); r -= (long)g * CS; dst = F.out + (g == 0 ? O_KVS0 : (g == 1 ? O_KVS1 : O_KVS2)) + r * 8;
            const int e8 = r & 15, hh = (r >> 4) & 3, kv = (r >> 6) & 1, ss = (r >> 7) & 3, bb = (int)(r >> 9);
            srow = MP + 4 * bb + ss; scol = (kv ? U_VA : U_KA) + (g * 4 + hh) * 128 + e8 * 8;
        } else if ((r -= 3 * CS) < CCP) {
            const int ch8 = (int)(r % 384), i = (int)((r / 384) % 3), bb = (int)(r / 1152); dst = F.out + O_CONVP + r * 8;
            srow = bb * SEQ + SEQ - 3 + i; scol = U_QKVB + ch8 * 8;
        } else {
            r -= CCP; const int ch8 = (int)(r % 384), i = (int)((r / 384) % 3), bb = (int)(r / 1152); dst = F.out + O_CONVS + r * 8;
            srow = MP + 4 * bb + 1 + i; scol = U_QKVB + ch8 * 8;
        }
        const v4u v = *(const GAS v4u*)(U + (size_t)srow * NINP + scol);
        *(GAS f32x4*)dst = (f32x4){bflo(v.x), bfhi(v.x), bflo(v.y), bfhi(v.y)};
        *(GAS f32x4*)(dst + 4) = (f32x4){bflo(v.z), bfhi(v.z), bflo(v.w), bfhi(v.w)};
    }
}

constexpr int AT_K = 0, AT_V = 69632;
__device__ __forceinline__ int at_off(int row, int ch) { return 256 * row + 16 * (ch ^ (((row & 3) << 2) | ((row >> 2) & 3))); }
template <int OFF>
__device__ __forceinline__ void tr_read2(unsigned a, bf16x4& lo, bf16x4& hi) {
    asm volatile("ds_read_b64_tr_b16 %0, %2 offset:%3\n\tds_read_b64_tr_b16 %1, %2 offset:%4\n\ts_waitcnt lgkmcnt(0)" : "=&v"(lo), "=&v"(hi) : "v"(a), "i"(OFF), "i"(OFF + 4096) : "memory"); }

__device__ __forceinline__ void attn_prompt_unit(Frame& F, int unit) {
    LAS unsigned char* L = F.ldv;
    const int tid = F.tid, lane = F.lane, w = F.wave, m16 = lane & 15, kg = lane >> 4;
    const bf16* U = (const bf16*)(F.ws + WS_U); bf16* OG = (bf16*)(F.ws + WS_OG); float* LSE = (float*)(F.ws + WS_LSE);
    const int h = unit & 3, rb = (unit >> 2) & 31, b = (unit >> 7) & 3, g = unit >> 9;
    const int dil = g == 0 ? 1 : (g == 1 ? 4 : 16), nb = 32 / dil, r = rb / nb, blk = rb % nb, hh = g * 4 + h;
    const float slope = exp2f(-8.0f * (float)(hh + 1) / 12.0f) * (float)dil;
    for (int i = tid; i < 272 * 16; i += 512) {
        const int row = i >> 4, chp = i & 15, ch = chp ^ (((row & 3) << 2) | ((row >> 2) & 3));
        const int sub = blk * 128 + row - 128; v4u kv = {0u, 0u, 0u, 0u}, vv = {0u, 0u, 0u, 0u};
        if (row < 256 && sub >= 0) { const size_t gr = (size_t)(b * SEQ + sub * dil + r) * NINP;
            kv = *(const GAS v4u*)(U + gr + U_KA + hh * 128 + ch * 8); vv = *(const GAS v4u*)(U + gr + U_VA + hh * 128 + ch * 8); }
        *(LAS v4u*)(L + AT_K + i * 16) = kv; *(LAS v4u*)(L + AT_V + i * 16) = vv;
    }
    const int qi = 16 * w + m16; const size_t qrow = (size_t)(b * SEQ + (blk * 128 + qi) * dil + r);
    bf16x8 qf[4];
#pragma unroll
    for (int kb = 0; kb < 4; ++kb) qf[kb] = *(const GAS bf16x8*)(U + qrow * NINP + U_QA + hh * 128 + 32 * kb + 8 * kg);
    WG_BARRIER();
    f32x4 S[10];
    int kbase[4];
#pragma unroll
    for (int kb = 0; kb < 4; ++kb) kbase[kb] = AT_K + at_off(16 * w + m16, 4 * kb + kg);
#pragma unroll
    for (int kt = 0; kt < 10; ++kt) { S[kt] = (f32x4){0.f, 0.f, 0.f, 0.f};
#pragma unroll
        for (int kb = 0; kb < 4; ++kb) S[kt] = mfma16(*(const LAS bf16x8*)(L + kbase[kb] + kt * 4096), qf[kb], S[kt]); }
    const float sc = 0.08838834764831845f * 1.4426950408889634f, sl2 = slope * 1.4426950408889634f;
    float mx = -INFINITY;
#pragma unroll
    for (int kt = 0; kt < 10; ++kt)
#pragma unroll
        for (int jj = 0; jj < 4; ++jj) { const int kj = 16 * w + 16 * kt + 4 * kg + jj, delta = 128 + qi - kj;
            const bool ok = delta >= 0 && delta <= 128 && (blk > 0 || kj >= 128);
            const float v = ok ? S[kt][jj] * sc - sl2 * (float)delta : -INFINITY; S[kt][jj] = v; mx = fmaxf(mx, v); }
    mx = fmaxf(mx, __shfl_xor(mx, 16)); mx = fmaxf(mx, __shfl_xor(mx, 32));
    float sum = 0.f;
#pragma unroll
    for (int kt = 0; kt < 10; ++kt)
#pragma unroll
        for (int jj = 0; jj < 4; ++jj) { const float p = exp2f(S[kt][jj] - mx); S[kt][jj] = p; sum += p; }
    sum += __shfl_xor(sum, 16); sum += __shfl_xor(sum, 32);
    bf16x8 pb[5];
#pragma unroll
    for (int kb2 = 0; kb2 < 5; ++kb2) pb[kb2] = pack8(S[2 * kb2], S[2 * kb2 + 1]);
    f32x4 O[8];
    const int rq = m16 >> 2, cq = m16 & 3;
    unsigned vbase[8];
#pragma unroll
    for (int dt = 0; dt < 8; ++dt) vbase[dt] = (unsigned)(AT_V + at_off(16 * w + 4 * kg + rq, 2 * dt + (cq >> 1)) + 8 * (cq & 1));
#define AT_PV(KB2) do { bf16x4 lo, hi; tr_read2<8192 * (KB2)>(vbase[dt], lo, hi); \
        bf16x8 vf; vf[0] = lo[0]; vf[1] = lo[1]; vf[2] = lo[2]; vf[3] = lo[3]; vf[4] = hi[0]; vf[5] = hi[1]; vf[6] = hi[2]; vf[7] = hi[3]; \
        O[dt] = mfma16(vf, pb[KB2], O[dt]); } while (0)
#pragma unroll
    for (int dt = 0; dt < 8; ++dt) { O[dt] = (f32x4){0.f, 0.f, 0.f, 0.f}; AT_PV(0); AT_PV(1); AT_PV(2); AT_PV(3); AT_PV(4); }
#undef AT_PV
    const float inv = 1.0f / sum;
#pragma unroll
    for (int dt = 0; dt < 8; ++dt) { v2u o; o.x = pk2(O[dt][0] * inv, O[dt][1] * inv); o.y = pk2(O[dt][2] * inv, O[dt][3] * inv);
        *(GAS v2u*)(OG + qrow * 1536 + hh * 128 + 16 * dt + 4 * kg) = o; }
    if (kg == 0) LSE[qrow * 12 + hh] = (mx + log2f(sum)) * 0.6931471805599453f;
    WG_BARRIER();
}

__device__ __forceinline__ float half_sum(float v) { v = row_sum16(v); v += __shfl_xor(v, 16); return v; }
__device__ __forceinline__ void attn_sample_unit(Frame& F, int unit) {
    const int lane = F.lane, w = F.wave;
    const bf16* U = (const bf16*)(F.ws + WS_U); bf16* OG = (bf16*)(F.ws + WS_OG); float* LSE = (float*)(F.ws + WS_LSE);
    int b, g; if (unit < 256) { b = unit >> 1; g = 1 + (unit & 1); } else { b = unit - 256; g = 0; }
    const int s = w & 3, h = 2 * (w >> 2) + (lane >> 5), dl = lane & 31, hh = g * 4 + h;
    const int dil = g == 0 ? 1 : (g == 1 ? 4 : 16), wb = g == 0 ? 128 : (g == 1 ? 512 : 2048);
    const float* cache = F.in[g == 0 ? IN_C128 : (g == 1 ? IN_C512 : IN_C2048)] + (size_t)b * wb * 1024 + h * 128 + 4 * dl;
    const float L2E = 1.4426950408889634f;
    const float sl2 = exp2f(-8.0f * (float)(hh + 1) / 12.0f) * (float)dil * L2E;
    const size_t qrow = (size_t)(MP + 4 * b + s);
    f32x4 q; { const v2u qq = *(const GAS v2u*)(U + qrow * NINP + U_QA + hh * 128 + 4 * dl); const float sc = 0.08838834764831845f * L2E;
        q = (f32x4){bflo(qq.x) * sc, bfhi(qq.x) * sc, bflo(qq.y) * sc, bfhi(qq.y) * sc}; }
    float m = -INFINITY, l = 0.f; f32x4 o = {0.f, 0.f, 0.f, 0.f};
    const int jn = (g == 0) ? s : 0;
    for (int j = 0; j <= jn; ++j) { const size_t kr = (size_t)(MP + 4 * b + s - dil * j) * NINP + hh * 128 + 4 * dl;
        const v2u kk = *(const GAS v2u*)(U + kr + U_KA), vv = *(const GAS v2u*)(U + kr + U_VA);
        const float sc = half_sum(bflo(kk.x) * q[0] + bfhi(kk.x) * q[1] + bflo(kk.y) * q[2] + bfhi(kk.y) * q[3]) - sl2 * (float)j;
        const float mn = fmaxf(m, sc), al = exp2f(m - mn), p = exp2f(sc - mn); m = mn; l = l * al + p;
        o = o * al + (f32x4){bflo(vv.x), bfhi(vv.x), bflo(vv.y), bfhi(vv.y)} * p; }
    for (int blk = 0; blk < 16; ++blk) {
        f32x4 kf[8], vf[8]; float sc[8];
#pragma unroll
        for (int i = 0; i < 8; ++i) { const int j = jn + 1 + 8 * blk + i; int idx = wb + s - dil * j; idx = idx < 0 ? 0 : idx;
            kf[i] = *(const GAS f32x4*)(cache + (size_t)idx * 1024); vf[i] = *(const GAS f32x4*)(cache + (size_t)idx * 1024 + 512); }
        float mb = -INFINITY;
#pragma unroll
        for (int i = 0; i < 8; ++i) { const int j = jn + 1 + 8 * blk + i;
            float d = half_sum(kf[i][0] * q[0] + kf[i][1] * q[1] + kf[i][2] * q[2] + kf[i][3] * q[3]) - sl2 * (float)j;
            d = (j <= 128) ? d : -INFINITY; sc[i] = d; mb = fmaxf(mb, d); }
        const float mn = fmaxf(m, mb), al = exp2f(m - mn); m = mn; l *= al; o = o * al;
#pragma unroll
        for (int i = 0; i < 8; ++i) { const float p = exp2f(sc[i] - mn); l += p; o = o + vf[i] * p; }
    }
    const float inv = 1.0f / l;
    v2u ov; ov.x = pk2(o[0] * inv, o[1] * inv); ov.y = pk2(o[2] * inv, o[3] * inv);
    *(GAS v2u*)(OG + qrow * 1536 + hh * 128 + 4 * dl) = ov;
    if (dl == 0) LSE[qrow * 12 + hh] = (m + log2f(l)) * 0.6931471805599453f;
}

__device__ __forceinline__ void attn_merge(Frame& F) {
    const bf16* OG = (const bf16*)(F.ws + WS_OG); const float* LSE = (const float*)(F.ws + WS_LSE); bf16* OA = (bf16*)(F.ws + WS_OA);
    const long gt = (long)F.bx * 512 + F.tid, NT = (long)F.G * 512;
    for (long c = gt; c < (long)MT * 64; c += NT) {
        const int row = (int)(c >> 6), hs = (int)(c >> 4) & 3, e8 = (int)c & 15;
        const float l0 = LSE[(size_t)row * 12 + hs], l1 = LSE[(size_t)row * 12 + 4 + hs], l2 = LSE[(size_t)row * 12 + 8 + hs];
        const float m = fmaxf(l0, fmaxf(l1, l2)); float w0 = __expf(l0 - m), w1 = __expf(l1 - m), w2 = __expf(l2 - m); const float inv = 1.0f / (w0 + w1 + w2); w0 *= inv; w1 *= inv; w2 *= inv;
        const v4u a = *(const GAS v4u*)(OG + (size_t)row * 1536 + hs * 128 + e8 * 8), bq = *(const GAS v4u*)(OG + (size_t)row * 1536 + (4 + hs) * 128 + e8 * 8), cq = *(const GAS v4u*)(OG + (size_t)row * 1536 + (8 + hs) * 128 + e8 * 8);
        v4u o;
        o.x = pk2(w0 * bflo(a.x) + w1 * bflo(bq.x) + w2 * bflo(cq.x), w0 * bfhi(a.x) + w1 * bfhi(bq.x) + w2 * bfhi(cq.x));
        o.y = pk2(w0 * bflo(a.y) + w1 * bflo(bq.y) + w2 * bflo(cq.y), w0 * bfhi(a.y) + w1 * bfhi(bq.y) + w2 * bfhi(cq.y));
        o.z = pk2(w0 * bflo(a.z) + w1 * bflo(bq.z) + w2 * bflo(cq.z), w0 * bfhi(a.z) + w1 * bfhi(bq.z) + w2 * bfhi(cq.z));
        o.w = pk2(w0 * bflo(a.w) + w1 * bflo(bq.w) + w2 * bflo(cq.w), w0 * bfhi(a.w) + w1 * bfhi(bq.w) + w2 * bfhi(cq.w));
        *(GAS v4u*)(OA + (size_t)row * 512 + hs * 128 + e8 * 8) = o;
    }
}

#ifndef MK_N_LAUNCHES
#define MK_N_LAUNCHES 1
#endif
constexpr int N_PHASES = 12;
struct Args { const float* in[23]; float* out; unsigned char* ws; int ph_lo, ph_hi, sub, qi; };
static_assert(sizeof(Args) == 23 * 8 + 8 + 8 + 16, "Args has no padding");

__device__ __forceinline__ int q_next(Frame& F, int qi) {
    if (F.tid == 0) F.MISC[16] = __hip_atomic_fetch_add((unsigned*)(F.ctl + CW_Q + 64 * qi), 1u, __ATOMIC_RELAXED, __HIP_MEMORY_SCOPE_AGENT);
    __syncthreads();
    const int v = (int)F.MISC[16];
    __syncthreads();
    return v;
}

#ifndef PH5_MASK
#define PH5_MASK 7
#endif
__device__ __forceinline__ void phase5(Frame& F, int qi, int sub) {
    if ((sub & 1) && F.bx < NB * 8) gdn_scan_chain(F, F.bx);
    for (;;) { const int u = q_next(F, qi); if (u >= 384 + 1536) break;
        if (u < 384) { if (sub & 2) attn_sample_unit(F, u); } else { if (sub & 4) attn_prompt_unit(F, u - 384); } }
}
__global__ void __launch_bounds__(NWAVES * 64, 2) mk_fwd(Args args) {
    extern __shared__ __attribute__((aligned(16))) unsigned char lds[];
    Frame F;
    F.lds = (LAS unsigned char*)lds;
    { unsigned z = 0u; asm volatile("" : "+v"(z)); F.ldv = (LAS unsigned char*)lds + z; }
    F.MISC = (volatile LAS unsigned*)(F.lds + MISC_OFF);
    F.tid = threadIdx.x; F.lane = F.tid & 63; F.wave = __builtin_amdgcn_readfirstlane(F.tid >> 6);
    F.G = gridDim.x; F.bx = blockIdx.x;
    F.ws = args.ws; F.out = args.out; F.ctl = (gu32*)(args.ws + WS_CTL);
    F.in = args.in;
    for (int u = F.tid; u < (LDS_BYTES - LDSCTL_OFF) / 4; u += NWAVES * 64) ((LAS unsigned*)(F.lds + LDSCTL_OFF))[u] = 0u;
    __syncthreads();
    const bool one = (args.ph_hi - args.ph_lo) > 1;
    XcdBarrier bar; bar.bar = (unsigned*)(F.ctl + CW_BAR); bar.x = 0; bar.st = nullptr;
    if (one) bar = xcd_barrier_post((unsigned*)(F.ctl + CW_BAR), F.MISC + 8);
    const int lo = args.ph_lo, hi = args.ph_hi;
#ifndef PHASE_MASK
#define PHASE_MASK 0xFFF
#endif
#define IN(k) ((((PHASE_MASK) >> (k)) & 1) && lo <= (k) && (k) < hi)
#define SEAM(k) do { if (IN(k) && IN((k) + 1)) xcd_barrier(bar); } while (0)

    bf16* XB = (bf16*)(F.ws + WS_XB); bf16* ACT = (bf16*)(F.ws + WS_ACT); float* X1 = (float*)(F.ws + WS_X1); bf16* X1B = (bf16*)(F.ws + WS_X1B);
    bf16* UU = (bf16*)(F.ws + WS_U); float* BA = (float*)(F.ws + WS_BA); bf16* OB = (bf16*)(F.ws + WS_OB); bf16* OA = (bf16*)(F.ws + WS_OA);
    bf16* M1 = (bf16*)(F.ws + WS_M1); bf16* MG = (bf16*)(F.ws + WS_MG); float* X2 = (float*)(F.ws + WS_X2); bf16* X2B = (bf16*)(F.ws + WS_X2B);
    float* SSQ2 = (float*)(args.ws + WS_CTL) + CW_SSQ2; float* SSQ3 = (float*)(args.ws + WS_CTL) + CW_SSQ3; float* SSQ4 = (float*)(args.ws + WS_CTL) + CW_SSQ4;

#ifndef DUP_MASK
#define DUP_MASK 0
#endif
#define DUP(k) (((DUP_MASK) >> (k)) & 1)
    if (IN(0)) { p0_prologue(F); } SEAM(0);
    if (IN(1)) {
        pg8::Gemm g{XB, (const bf16*)(F.ws + WS_W1A), MT, NGU, D}; pg8::StaticOrder S; S.init(MT, NGU, F.G, F.bx);
        pg8::EpiSwiglu E{ACT, (const float*)(F.ws + WS_RSTD1), 0};
        pg8::gemm_phase<pg8::EpiSwiglu, pg8::StaticOrder, true, true>(F.lds + RING_OFF, g, S, E);
    } SEAM(1);
    if (IN(2)) {
        pg8::Gemm g{ACT, (const bf16*)(F.ws + WS_W1B), MT, D, FF}; pg8::StaticOrder S; S.init(MT, D, F.G, F.bx);
        pg8::EpiResid E{F.in[IN_XP], F.in[IN_XS] - (size_t)MP * D, X1, X1B, SSQ2, 0.5f};
        pg8::gemm_phase<pg8::EpiResid, pg8::StaticOrder, true, true>(F.lds + RING_OFF, g, S, E);
    } SEAM(2);
    if (IN(3)) {
        pg8::Gemm g{X1B, (const bf16*)(F.ws + WS_WIN), MT, NINP, D}; pg8::StaticOrder S; S.init(MT, NINP, F.G, F.bx);
        pg8::EpiU E{UU, BA, SSQ2};
        pg8::gemm_phase<pg8::EpiU, pg8::StaticOrder, true, true>(F.lds + RING_OFF, g, S, E);
    } SEAM(3);
    if (IN(4)) {
        for (int i = F.bx; i < NREC + DB * 8; i += F.G) {
#ifndef PH4_MASK
#define PH4_MASK 7
#endif
            if (i < NREC) { if (args.sub & 1) { const int n = i >> 5, bh = i & 31; gdn_prep_unit(F, bh >> 3, bh & 7, n); } }
            else { if (args.sub & 2) { const int j = i - NREC; gdn_sample_unit(F, j >> 3, j & 7); } }
        }
        if (args.sub & 4) copy_outputs(F);
    } SEAM(4);
    if (IN(5)) {
        phase5(F, args.qi, args.sub);
    } SEAM(5);
    if (IN(6)) { attn_merge(F); } SEAM(6);
    if (IN(7)) {
        { pg8::Gemm g{OA, (const bf16*)(F.ws + WS_WPA), MT, D, 512}; pg8::StaticOrder S; S.init(MT, D, F.G, F.bx);
          pg8::EpiGate<0> E{UU, nullptr, M1};
          pg8::gemm_phase<pg8::EpiGate<0>, pg8::StaticOrder, true, true>(F.lds + RING_OFF, g, S, E); }
        { pg8::Gemm g{OB, (const bf16*)(F.ws + WS_WPB), MT, D, D}; pg8::StaticOrder S; S.init(MT, D, F.G, F.bx);
          pg8::EpiGate<1> E{UU, M1, MG};
          pg8::gemm_phase<pg8::EpiGate<1>, pg8::StaticOrder, true, true>(F.lds + RING_OFF, g, S, E); }
    } SEAM(7);
    if (IN(8)) {
        pg8::Gemm g{MG, (const bf16*)(F.ws + WS_WOUT), MT, D, D}; pg8::StaticOrder S; S.init(MT, D, F.G, F.bx);
        pg8::EpiResid E{X1, X1, X2, X2B, SSQ3, 1.0f};
        pg8::gemm_phase<pg8::EpiResid, pg8::StaticOrder, true, true>(F.lds + RING_OFF, g, S, E);
    } SEAM(8);
    if (IN(9)) {
        pg8::Gemm g{X2B, (const bf16*)(F.ws + WS_W2A), MT, NGU, D}; pg8::StaticOrder S; S.init(MT, NGU, F.G, F.bx);
        pg8::EpiSwiglu E{ACT, SSQ3, 1};
        pg8::gemm_phase<pg8::EpiSwiglu, pg8::StaticOrder, true, true>(F.lds + RING_OFF, g, S, E);
    } SEAM(9);
    if (IN(10)) {
        pg8::Gemm g{ACT, (const bf16*)(F.ws + WS_W2B), MT, D, FF}; pg8::StaticOrder S; S.init(MT, D, F.G, F.bx);
        pg8::EpiResid E{X2, X2, F.out + O_Y, nullptr, SSQ4, 0.5f};
        pg8::gemm_phase<pg8::EpiResid, pg8::StaticOrder, true, true>(F.lds + RING_OFF, g, S, E);
    } SEAM(10);
    if (IN(11)) { final_norm(F); }
#undef IN
#undef SEAM
}

extern "C" void kernel_launch(void* const* d_in, const int* in_sizes, int n_in, void* d_out, int out_size, void* d_ws, size_t ws_size, hipStream_t stream) {
    static int grid = 0;
    if (grid == 0) {
        if (n_in != 23 || out_size != (int)O_END || ws_size < WS_END) { fprintf(stderr, "kernel_launch: unexpected sizes n_in %d out %d ws %zu (need %zu)\n", n_in, out_size, ws_size, (size_t)WS_END); grid = -1; return; }
        int dev = 0, cus = 0, per_cu = 0;
        if (hipGetDevice(&dev) != hipSuccess || hipDeviceGetAttribute(&cus, hipDeviceAttributeMultiprocessorCount, dev) != hipSuccess) { grid = -1; return; }
        if (hipFuncSetAttribute((const void*)mk_fwd, hipFuncAttributeMaxDynamicSharedMemorySize, LDS_BYTES) != hipSuccess) { fprintf(stderr, "kernel_launch: hipFuncSetAttribute failed\n"); grid = -1; return; }
        if (hipOccupancyMaxActiveBlocksPerMultiprocessor(&per_cu, (const void*)mk_fwd, NWAVES * 64, LDS_BYTES) != hipSuccess || per_cu < 1) { fprintf(stderr, "kernel_launch: occupancy query says %d\n", per_cu); per_cu = 1; }
        (void)hipGetLastError();
        grid = cus;
    }
    if (grid < 0) return;
    if (hipMemsetAsync((char*)d_ws + WS_CTL, 0, CTL_ZERO_BYTES, stream) != hipSuccess) return;
    Args a{};
    for (int i = 0; i < 23; ++i) a.in[i] = (const float*)d_in[i];
    a.out = (float*)d_out; a.ws = (unsigned char*)d_ws;
#if MK_N_LAUNCHES == 1
    a.ph_lo = 0; a.ph_hi = N_PHASES; a.sub = 7; a.qi = 0;
    hipLaunchKernelGGL(mk_fwd, dim3(grid), dim3(NWAVES * 64), LDS_BYTES, stream, a);
#ifdef EXTRA_MASK
    for (int p = 0; p < N_PHASES; ++p) if ((EXTRA_MASK >> p) & 1) { a.ph_lo = p; a.ph_hi = p + 1; a.sub = EXTRA_SUB; a.qi = 1; hipLaunchKernelGGL(mk_fwd, dim3(grid), dim3(NWAVES * 64), LDS_BYTES, stream, a); }
#endif
#else
    a.sub = 7; a.qi = 0;
    for (int p = 0; p < N_PHASES; ++p) { a.ph_lo = p; a.ph_hi = p + 1; hipLaunchKernelGGL(mk_fwd, dim3(grid), dim3(NWAVES * 64), LDS_BYTES, stream, a); }
#endif
}
```

```cpp
#include <hip/hip_runtime.h>
#include <cstdio>
#include <cstdint>
#define MK_N_LAUNCHES 1
namespace pg8 {
#define PG8_LAS __attribute__((address_space(3)))
typedef unsigned short bf16_t;
typedef short bf16x8 __attribute__((ext_vector_type(8)));
typedef float f32x4 __attribute__((ext_vector_type(4)));
typedef unsigned u32x4 __attribute__((ext_vector_type(4)));
constexpr int BM = 256, BK = 64, HALF = 128, HTB = HALF * BK * 2  , STAGE_BYTES = 8 * HTB, NXCD = 8, WGM = 8;

__host__ __device__ __forceinline__ int lds_byte(int r, int c) { const int st = (r >> 4) * 2 + (c >> 5), rr = r & 15, cc = c & 31, ob = rr * 64 + cc * 2; return st * 1024 + (ob ^ (((ob >> 9) & 1) << 5)); }
__host__ __device__ __forceinline__ void stage_rc(int b, int& R, int& C) { const int st = b / 1024, sb = b % 1024, swz = sb ^ (((sb >> 9) & 1) << 5); R = (st >> 1) * 16 + swz / 64; C = (st & 1) * 32 + (swz % 64) / 2; }
__host__ __device__ __forceinline__ int perm32(int rho) { const int n = rho >> 4, i = rho & 15; return 8 * (i >> 2) + 4 * n + (i & 3); }

struct Unit { int pm, pn; };
struct Gemm { const bf16_t* A; const bf16_t* Bt; int M, N, K; };
struct StaticOrder {
    int nM, nN, nwg, G, c;
    __host__ __device__ void init(int M, int N, int G_, int c_) { nM = M / BM; nN = N / BM; nwg = nM * nN; G = G_; c = c_; }
    __host__ __device__ bool next(int i, Unit& u) const {
        const long L = (long)i * G + c; if (L >= nwg) return false;
        int wgid = (int)L; { const int q = nwg / NXCD, r = nwg % NXCD, xcd = wgid % NXCD, off = wgid / NXCD; wgid = (xcd < r ? xcd * (q + 1) : r * (q + 1) + (xcd - r) * q) + off; }
        const int nig = WGM * nN, gid = wgid / nig, fm = gid * WGM, gsz = (nM - fm) < WGM ? (nM - fm) : WGM;
        u.pm = fm + ((wgid % nig) % gsz); u.pn = (wgid % nig) / gsz; return true;
    }
    __device__ __forceinline__ void a_ready(const Unit&) const {}
    __device__ __forceinline__ void done(const Unit&) const {}
};
__device__ __forceinline__ unsigned cvt_pk_bf16(float lo, float hi) { unsigned r; asm volatile("v_cvt_pk_bf16_f32 %0, %1, %2" : "=v"(r) : "v"(lo), "v"(hi)); return r; }
typedef float f32x2 __attribute__((ext_vector_type(2)));
template <class Epi, class Sched, bool ALIGN_EPI = false, bool SP2 = false>
__device__ __forceinline__ void gemm_phase(PG8_LAS unsigned char* lds, const Gemm g, const Sched& S, const Epi& E) {
    const int tid = threadIdx.x, wid = __builtin_amdgcn_readfirstlane(tid >> 6), lane = tid & 63, wr = wid >> 2, wc = wid & 3, fr = lane & 15, fq = lane >> 4;
    const int K = g.K, nt = K / BK;
    unsigned voffA[2], voffB[2];
#pragma unroll
    for (int i = 0; i < 2; ++i) { int R, C; stage_rc(tid * 16 + i * 8192, R, C); const int Rb = Epi::PERM ? ((R & ~31) + perm32(R & 31)) : R;
        voffA[i] = (unsigned)(R * K + C) * 2u; voffB[i] = (unsigned)(Rb * K + C) * 2u; }
    const size_t kstep = (size_t)(BK * 2);
    const size_t hstep = (size_t)HALF * K * 2;
    const size_t tstep = 2 * hstep;
    const unsigned ldsw = (unsigned)wid * 1024u;
    const int aoff = lds_byte(wr * 64 + fr, fq * 8), boff = lds_byte(wc * 32 + fr, fq * 8);
#define PG8_SA(b, h) (((b) * 2 + (h)) * HTB)
#define PG8_SB(b, h) ((4 + (b) * 2 + (h)) * HTB)
#define PG8_STAGE(bufoff, gbase, voff) do { _Pragma("unroll") for (int _i = 0; _i < 2; ++_i) \
        __builtin_amdgcn_global_load_lds((const unsigned*)((const char*)(gbase) + (voff)[_i]), (PG8_LAS unsigned*)(lds + (bufoff) + ldsw + _i * 8192), 16, 0, 0); } while (0)
#define PG8_LDA(dst, b, h) do { _Pragma("unroll") for (int m = 0; m < 4; ++m) _Pragma("unroll") for (int k = 0; k < 2; ++k) dst[m][k] = *(const PG8_LAS bf16x8*)(lds + PG8_SA(b, h) + aoff + m * 2048 + k * 1024); } while (0)
#define PG8_LDB(dst, b, h) do { _Pragma("unroll") for (int n = 0; n < 2; ++n) _Pragma("unroll") for (int k = 0; k < 2; ++k) dst[n][k] = *(const PG8_LAS bf16x8*)(lds + PG8_SB(b, h) + boff + n * 2048 + k * 1024); } while (0)
#define PG8_MMA(ai, bj, At, Bt) do { __builtin_amdgcn_s_setprio(1); _Pragma("unroll") for (int m = 0; m < 4; ++m) _Pragma("unroll") for (int n = 0; n < 2; ++n) _Pragma("unroll") for (int k = 0; k < 2; ++k) \
        acc[ai][bj][m][n] = __builtin_amdgcn_mfma_f32_16x16x32_bf16(Bt[n][k], At[m][k], acc[ai][bj][m][n], 0, 0, 0); __builtin_amdgcn_s_setprio(0); } while (0)
#define PG8_WAIT_V(n) asm volatile("s_waitcnt vmcnt(" #n ")" ::: "memory")
#define PG8_WAIT_L(n) asm volatile("s_waitcnt lgkmcnt(" #n ")" ::: "memory")
#define PG8_BAR __builtin_amdgcn_s_barrier()
#define PG8_SCHED __builtin_amdgcn_sched_barrier(0)
    Unit cur, nxt; int ui = 0;
    if (!S.next(0, cur)) return;
    f32x4 acc[2][2][4][2];
#pragma unroll
    for (int a = 0; a < 2; ++a)
#pragma unroll
        for (int b = 0; b < 2; ++b)
#pragma unroll
            for (int m = 0; m < 4; ++m)
#pragma unroll
                for (int n = 0; n < 2; ++n) acc[a][b][m][n] = (f32x4){0.f, 0.f, 0.f, 0.f};
    bf16x8 At[4][2], B0[2][2], B1[2][2];
    const char* cA = (const char*)g.A + (size_t)cur.pm * tstep; const char* cB = (const char*)g.Bt + (size_t)cur.pn * tstep;
    S.a_ready(cur);
    if constexpr (SP2) {
        PG8_STAGE(PG8_SB(0, 0), cB, voffB); PG8_STAGE(PG8_SB(0, 1), cB + hstep, voffB); PG8_STAGE(PG8_SA(0, 0), cA, voffA); PG8_STAGE(PG8_SA(0, 1), cA + hstep, voffA);
        if (wr == 1) PG8_BAR;
        PG8_WAIT_V(2); PG8_BAR;
        PG8_STAGE(PG8_SB(1, 0), cB + kstep, voffB); PG8_STAGE(PG8_SA(1, 0), cA + kstep, voffA); PG8_STAGE(PG8_SB(1, 1), cB + hstep + kstep, voffB);
        PG8_WAIT_V(6); PG8_BAR;
    } else {
        PG8_STAGE(PG8_SB(0, 0), cB, voffB); PG8_STAGE(PG8_SA(0, 0), cA, voffA); PG8_STAGE(PG8_SB(0, 1), cB + hstep, voffB); PG8_STAGE(PG8_SA(0, 1), cA + hstep, voffA);
        if (wr == 1) PG8_BAR;
        PG8_WAIT_V(4); PG8_BAR;
        PG8_STAGE(PG8_SB(1, 0), cB + kstep, voffB); PG8_STAGE(PG8_SA(1, 0), cA + kstep, voffA); PG8_STAGE(PG8_SB(1, 1), cB + hstep + kstep, voffB);
        PG8_WAIT_V(6); PG8_BAR;
    }
    for (;;) {
        const bool has_next = S.next(ui + 1, nxt);
        const char* nA = has_next ? (const char*)g.A + (size_t)nxt.pm * tstep : cA; const char* nB = has_next ? (const char*)g.Bt + (size_t)nxt.pn * tstep : cB;
        for (int t = 0; t < nt; t += 2) {
            const bool last = (t == nt - 2);
            const char* a1 = cA + (size_t)(t + 1) * kstep;
            const char* a2 = last ? nA : cA + (size_t)(t + 2) * kstep; const char* b2 = last ? nB : cB + (size_t)(t + 2) * kstep;
            const char* a3 = a2 + kstep; const char* b3 = b2 + kstep;
            if (last && has_next) S.a_ready(nxt);
            if constexpr (SP2) {
            PG8_LDB(B0, 0, 0); PG8_LDB(B1, 0, 1); PG8_SCHED; PG8_LDA(At, 0, 0); PG8_STAGE(PG8_SA(1, 1), a1 + hstep, voffA);
            PG8_WAIT_V(8); PG8_WAIT_L(0); PG8_BAR; PG8_MMA(0, 0, At, B0); PG8_MMA(0, 1, At, B1); PG8_BAR; PG8_SCHED;
            PG8_LDA(At, 0, 1); PG8_STAGE(PG8_SB(0, 0), b2, voffB); PG8_STAGE(PG8_SB(0, 1), b2 + hstep, voffB); PG8_STAGE(PG8_SA(0, 0), a2, voffA);
            PG8_WAIT_V(8); PG8_WAIT_L(0); PG8_BAR; PG8_MMA(1, 0, At, B0); PG8_MMA(1, 1, At, B1); PG8_BAR; PG8_SCHED;
            PG8_LDB(B0, 1, 0); PG8_LDB(B1, 1, 1); PG8_SCHED; PG8_LDA(At, 1, 0); PG8_STAGE(PG8_SA(0, 1), a2 + hstep, voffA);
            PG8_WAIT_V(8); PG8_WAIT_L(0); PG8_BAR; PG8_MMA(0, 0, At, B0); PG8_MMA(0, 1, At, B1); PG8_BAR; PG8_SCHED;
            PG8_LDA(At, 1, 1); PG8_STAGE(PG8_SB(1, 0), b3, voffB); PG8_STAGE(PG8_SB(1, 1), b3 + hstep, voffB); PG8_STAGE(PG8_SA(1, 0), a3, voffA);
            PG8_WAIT_V(8); PG8_WAIT_L(0); PG8_BAR; PG8_MMA(1, 0, At, B0); PG8_MMA(1, 1, At, B1); PG8_BAR; PG8_SCHED;
            } else {
            PG8_LDB(B0, 0, 0); PG8_SCHED; PG8_LDA(At, 0, 0); PG8_STAGE(PG8_SA(1, 1), a1 + hstep, voffA);
            PG8_WAIT_L(8); PG8_BAR; PG8_WAIT_L(0); PG8_MMA(0, 0, At, B0); PG8_BAR; PG8_SCHED;
            PG8_LDB(B1, 0, 1); PG8_STAGE(PG8_SB(0, 0), b2, voffB);
            PG8_BAR; PG8_WAIT_L(0); PG8_MMA(0, 1, At, B1); PG8_BAR;
            PG8_LDA(At, 0, 1); PG8_STAGE(PG8_SA(0, 0), a2, voffA);
            PG8_BAR; PG8_WAIT_L(0); PG8_MMA(1, 0, At, B0); PG8_BAR; PG8_SCHED;
            PG8_STAGE(PG8_SB(0, 1), b2 + hstep, voffB);
            PG8_WAIT_V(6); PG8_BAR; PG8_MMA(1, 1, At, B1); PG8_BAR;
            PG8_LDB(B0, 1, 0); PG8_SCHED; PG8_LDA(At, 1, 0); PG8_STAGE(PG8_SA(0, 1), a2 + hstep, voffA);
            PG8_WAIT_L(8); PG8_BAR; PG8_WAIT_L(0); PG8_MMA(0, 0, At, B0); PG8_BAR; PG8_SCHED;
            PG8_LDB(B1, 1, 1); PG8_STAGE(PG8_SB(1, 0), b3, voffB);
            PG8_BAR; PG8_WAIT_L(0); PG8_MMA(0, 1, At, B1); PG8_BAR;
            PG8_LDA(At, 1, 1); PG8_STAGE(PG8_SA(1, 0), a3, voffA);
            PG8_BAR; PG8_WAIT_L(0); PG8_MMA(1, 0, At, B0); PG8_BAR; PG8_SCHED;
            PG8_STAGE(PG8_SB(1, 1), b3 + hstep, voffB);
            PG8_WAIT_V(6); PG8_BAR; PG8_MMA(1, 1, At, B1); PG8_BAR;
            }
        }
        if constexpr (ALIGN_EPI) { if (wr == 0) PG8_BAR; }
        if constexpr (!Epi::AFTER_DRAIN) { E(acc, cur, wr, wc, fr, fq); S.done(cur); }
        if (!has_next) break;
#pragma unroll
        for (int a = 0; a < 2; ++a)
#pragma unroll
            for (int b = 0; b < 2; ++b)
#pragma unroll
                for (int m = 0; m < 4; ++m)
#pragma unroll
                    for (int n = 0; n < 2; ++n) acc[a][b][m][n] = (f32x4){0.f, 0.f, 0.f, 0.f};
        cur = nxt; cA = nA; cB = nB; ++ui;
        if constexpr (ALIGN_EPI) { if (wr == 1) PG8_BAR; }
    }
    PG8_WAIT_V(0);
    if constexpr (!ALIGN_EPI) { if (wr == 0) PG8_BAR; }
    PG8_BAR;
    if constexpr (Epi::AFTER_DRAIN) { E.fused(acc, cur, wr, wc, fr, fq, lds, wid, lane); S.done(cur); }
#undef PG8_SA
#undef PG8_SB
#undef PG8_STAGE
#undef PG8_LDA
#undef PG8_LDB
#undef PG8_MMA
#undef PG8_WAIT_V
#undef PG8_WAIT_L
#undef PG8_BAR
#undef PG8_SCHED
}
}

constexpr int D = 1024, MP = 16384, MS = 512, MT = MP + MS, FF = 2816, NGU = 2 * FF;
constexpr int SEQ = 4096, NB = 4, DB = 128, DS = 4;
constexpr int NIN = 10768, NINP = 11008;
constexpr int U_QA = 0, U_KA = 1536, U_VA = 3072, U_QKVB = 4608, U_Z = 7680, U_GATE = 8704, U_BA = 10752;
constexpr float EPS = 1e-6f;

namespace pg8 {
typedef unsigned u32x2 __attribute__((ext_vector_type(2)));
__device__ __forceinline__ float sigm(float x) { return 1.f / (1.f + __expf(-x)); }
__device__ __forceinline__ float bf2f(unsigned short b) { return __uint_as_float(((unsigned)b) << 16); }
__device__ __forceinline__ float bflo(unsigned w) { return __uint_as_float(w << 16); }
__device__ __forceinline__ float bfhi(unsigned w) { return __uint_as_float(w & 0xffff0000u); }

struct EpiSwiglu {
    static constexpr bool PERM = true, AFTER_DRAIN = false;
    bf16_t* O; const float* rs; int mode;
    __device__ __forceinline__ void operator()(const f32x4 (&acc)[2][2][4][2], const Unit& u, int wr, int wc, int fr, int fq) const {
        const int row0 = u.pm * BM + wr * 64 + fr, col0 = u.pn * 128 + wc * 32 + 8 * fq;
#pragma unroll
        for (int ai = 0; ai < 2; ++ai)
#pragma unroll
            for (int m = 0; m < 4; ++m) {
                const int row = row0 + ai * HALF + m * 16;
                float r = rs[row]; if (mode) r = rsqrtf(r * (1.0f / D) + EPS);
                float o[8];
#pragma unroll
                for (int n = 0; n < 2; ++n)
#pragma unroll
                    for (int j = 0; j < 4; ++j) { const float g = acc[ai][0][m][n][j] * r, up = acc[ai][1][m][n][j] * r; o[4 * n + j] = g * sigm(g) * up; }
                u32x4 w; w.x = cvt_pk_bf16(o[0], o[1]); w.y = cvt_pk_bf16(o[2], o[3]); w.z = cvt_pk_bf16(o[4], o[5]); w.w = cvt_pk_bf16(o[6], o[7]);
                *(u32x4*)(O + (size_t)row * FF + col0) = w;
            }
    }
};
struct EpiResid {
    static constexpr bool PERM = false, AFTER_DRAIN = false;
    const float* base; const float* base2; float* out; bf16_t* xb; float* ssq; float scale;
    __device__ __forceinline__ void operator()(const f32x4 (&acc)[2][2][4][2], const Unit& u, int wr, int wc, int fr, int fq) const {
        const int row0 = u.pm * BM + wr * 64 + fr, col0 = u.pn * BM + wc * 32 + 4 * fq;
        const float* base = (u.pm * BM < MP) ? this->base : base2;
#pragma unroll
        for (int ai = 0; ai < 2; ++ai)
#pragma unroll
            for (int m = 0; m < 4; ++m) {
                const int row = row0 + ai * HALF + m * 16; const size_t off = (size_t)row * D + col0; float s = 0.f;
#pragma unroll
                for (int bj = 0; bj < 2; ++bj)
#pragma unroll
                    for (int n = 0; n < 2; ++n) {
                        const f32x4 b = *(const f32x4*)(base + off + bj * HALF + n * 16); const f32x4 v = b + acc[ai][bj][m][n] * scale;
                        *(f32x4*)(out + off + bj * HALF + n * 16) = v;
                        if (xb) { u32x2 w; w.x = cvt_pk_bf16(v[0], v[1]); w.y = cvt_pk_bf16(v[2], v[3]); *(u32x2*)(xb + off + bj * HALF + n * 16) = w; }
                        s += (v[0] * v[0] + v[1] * v[1]) + (v[2] * v[2] + v[3] * v[3]);
                    }
                s += __shfl_xor(s, 16); s += __shfl_xor(s, 32);
                if (fq == 0) atomicAdd(ssq + row, s);
            }
    }
};
struct EpiU {
    static constexpr bool PERM = true, AFTER_DRAIN = false;
    bf16_t* U; float* BA; const float* ssq;
    __device__ __forceinline__ void operator()(const f32x4 (&acc)[2][2][4][2], const Unit& u, int wr, int wc, int fr, int fq) const {
        const int row0 = u.pm * BM + wr * 64 + fr, col0 = u.pn * BM + wc * 32 + 8 * fq;
        const bool ba = (u.pn * BM == U_BA);
#pragma unroll
        for (int ai = 0; ai < 2; ++ai)
#pragma unroll
            for (int m = 0; m < 4; ++m) {
                const int row = row0 + ai * HALF + m * 16; const float r = rsqrtf(ssq[row] * (1.0f / D) + EPS);
                if (!ba) {
#pragma unroll
                    for (int bj = 0; bj < 2; ++bj) { const f32x4 v0 = acc[ai][bj][m][0] * r, v1 = acc[ai][bj][m][1] * r;
                        u32x4 w; w.x = cvt_pk_bf16(v0[0], v0[1]); w.y = cvt_pk_bf16(v0[2], v0[3]); w.z = cvt_pk_bf16(v1[0], v1[1]); w.w = cvt_pk_bf16(v1[2], v1[3]);
                        *(u32x4*)(U + (size_t)row * NINP + col0 + bj * HALF) = w; }
                } else if (wc == 0 && fq < 2) {
                    *(f32x4*)(BA + (size_t)row * 16 + 8 * fq) = acc[ai][0][m][0] * r; *(f32x4*)(BA + (size_t)row * 16 + 8 * fq + 4) = acc[ai][0][m][1] * r;
                }
            }
    }
};
template <int SECOND> struct EpiGate {
    static constexpr bool PERM = true, AFTER_DRAIN = false;
    const bf16_t* U; const bf16_t* M1; bf16_t* O;
    __device__ __forceinline__ void operator()(const f32x4 (&acc)[2][2][4][2], const Unit& u, int wr, int wc, int fr, int fq) const {
        const int row0 = u.pm * BM + wr * 64 + fr, col0 = u.pn * BM + wc * 32 + 8 * fq;
#pragma unroll
        for (int ai = 0; ai < 2; ++ai)
#pragma unroll
            for (int m = 0; m < 4; ++m) {
                const int row = row0 + ai * HALF + m * 16;
#pragma unroll
                for (int bj = 0; bj < 2; ++bj) {
                    const int col = col0 + bj * HALF;
                    const u32x4 g = *(const u32x4*)(U + (size_t)row * NINP + U_GATE + SECOND * D + col);
                    float o[8]; const f32x4 a0 = acc[ai][bj][m][0], a1 = acc[ai][bj][m][1];
                    o[0] = sigm(bflo(g.x)) * a0[0]; o[1] = sigm(bfhi(g.x)) * a0[1]; o[2] = sigm(bflo(g.y)) * a0[2]; o[3] = sigm(bfhi(g.y)) * a0[3];
                    o[4] = sigm(bflo(g.z)) * a1[0]; o[5] = sigm(bfhi(g.z)) * a1[1]; o[6] = sigm(bflo(g.w)) * a1[2]; o[7] = sigm(bfhi(g.w)) * a1[3];
                    if (SECOND) { const u32x4 p = *(const u32x4*)(M1 + (size_t)row * D + col);
                        o[0] += bflo(p.x); o[1] += bfhi(p.x); o[2] += bflo(p.y); o[3] += bfhi(p.y); o[4] += bflo(p.z); o[5] += bfhi(p.z); o[6] += bflo(p.w); o[7] += bfhi(p.w); }
                    u32x4 w; w.x = cvt_pk_bf16(o[0], o[1]); w.y = cvt_pk_bf16(o[2], o[3]); w.z = cvt_pk_bf16(o[4], o[5]); w.w = cvt_pk_bf16(o[6], o[7]);
                    *(u32x4*)(O + (size_t)row * D + col) = w;
                }
            }
    }
};
}

#define GAS __attribute__((address_space(1)))
#define LAS __attribute__((address_space(3)))
typedef unsigned short bf16;
typedef unsigned v4u __attribute__((ext_vector_type(4)));
typedef unsigned v2u __attribute__((ext_vector_type(2)));
typedef float f32x4 __attribute__((ext_vector_type(4)));
typedef float f32x2 __attribute__((ext_vector_type(2)));
typedef short bf16x8 __attribute__((ext_vector_type(8)));
typedef short bf16x4 __attribute__((ext_vector_type(4)));
typedef GAS unsigned gu32;
#define RLX_AGENT __ATOMIC_RELAXED, __HIP_MEMORY_SCOPE_AGENT
#define LDS_WAIT() asm volatile("s_waitcnt lgkmcnt(0)" ::: "memory")
#define VM_WAIT() asm volatile("s_waitcnt vmcnt(0)" ::: "memory")
__device__ __forceinline__ unsigned f2bf(float f) { unsigned u = __builtin_bit_cast(unsigned, f); return (u + 0x7fffu + ((u >> 16) & 1u)) >> 16; }
typedef __bf16 bf16x2_t __attribute__((ext_vector_type(2)));
__device__ __forceinline__ unsigned pk2(float lo, float hi) { const bf16x2_t v = __builtin_convertvector((f32x2){lo, hi}, bf16x2_t); return __builtin_bit_cast(unsigned, v); }
__device__ __forceinline__ float bf2f(unsigned short b) { return __uint_as_float(((unsigned)b) << 16); }
__device__ __forceinline__ float bflo(unsigned w) { return __uint_as_float(w << 16); }
__device__ __forceinline__ float bfhi(unsigned w) { return __uint_as_float(w & 0xffff0000u); }
__device__ __forceinline__ float sigm(float x) { return 1.f / (1.f + __expf(-x)); }
__device__ __forceinline__ float siluf(float x) { return x / (1.f + __expf(-x)); }
__device__ __forceinline__ float wave_sum(float v) {
#pragma unroll
    for (int o = 1; o < 64; o <<= 1) v += __shfl_xor(v, o);
    return v;
}
__device__ __forceinline__ float wave_max(float v) {
#pragma unroll
    for (int o = 1; o < 64; o <<= 1) v = fmaxf(v, __shfl_xor(v, o));
    return v;
}
template <int CTRL> __device__ __forceinline__ float dpp_f(float v) { return __builtin_bit_cast(float, __builtin_amdgcn_update_dpp(0, __builtin_bit_cast(int, v), CTRL, 0xf, 0xf, true)); }
__device__ __forceinline__ float row_sum16(float v) { v += dpp_f<0xB1>(v); v += dpp_f<0x4E>(v); v += dpp_f<0x141>(v); v += dpp_f<0x140>(v); return v; }
__device__ __forceinline__ f32x4 mfma16(bf16x8 a, bf16x8 b, f32x4 c) { return __builtin_amdgcn_mfma_f32_16x16x32_bf16(a, b, c, 0, 0, 0); }
__device__ __forceinline__ bf16x8 pack8(f32x4 a, f32x4 b) {
    v4u w; w.x = pk2(a[0], a[1]); w.y = pk2(a[2], a[3]); w.z = pk2(b[0], b[1]); w.w = pk2(b[2], b[3]); return __builtin_bit_cast(bf16x8, w);
}
#define WG_BARRIER() do { asm volatile("s_waitcnt lgkmcnt(0)" ::: "memory"); __builtin_amdgcn_s_barrier(); asm volatile("" ::: "memory"); } while (0)
#define XB_TMO      128
#define XB_XCNT(j)  (256  + 64 * (j))
#define XB_XSUB(j)  (1280 + 64 * (j))
#define XB_XGEN(j)  (2304 + 64 * (j))
#define XB_TOP      3328
#define XB_TOPGEN   3392
#define XCD_BAR_WORDS 3456
#define XB_SPIN_CAP (1u << 18)

__device__ __forceinline__ unsigned xb_ld(unsigned* p)              { return __hip_atomic_load(p, __ATOMIC_RELAXED, __HIP_MEMORY_SCOPE_AGENT); }
__device__ __forceinline__ unsigned xb_add(unsigned* p, unsigned v) { return __hip_atomic_fetch_add(p, v, __ATOMIC_RELAXED, __HIP_MEMORY_SCOPE_AGENT); }
__device__ __forceinline__ unsigned xb_xcc_id() { return (unsigned)__builtin_amdgcn_s_getreg((3 << 11) | 20) & 0xFu; }
#define XB_SPIN(cond, bar) do { unsigned _sp = 0; while (cond) { __builtin_amdgcn_s_sleep(1); \
    if ((++_sp & 255u) == 0u) { if (xb_ld(&(bar)[XB_TMO])) break; if (_sp > XB_SPIN_CAP) { atomicAdd(&(bar)[XB_TMO], 1u); break; } } } } while (0)

struct XcdBarrier {
    unsigned* bar; unsigned x;
    volatile LAS unsigned* st;
};

__device__ __forceinline__ XcdBarrier xcd_barrier_post(unsigned* bar, volatile LAS unsigned* st) {
    XcdBarrier b; b.bar = bar; b.x = xb_xcc_id(); b.st = st;
    if (threadIdx.x == 0) (void)xb_add(&bar[XB_XCNT(b.x)], 1u);
    return b;
}
__device__ __forceinline__ void xcd_barrier_complete(unsigned* bar, unsigned x, unsigned& nloc, unsigned& nx) {
    const unsigned G = gridDim.x * gridDim.y * gridDim.z;
    unsigned sum, cnt, mine, sp = 0u;
    for (;;) {
        sum = 0u; cnt = 0u; mine = 0u;
#pragma unroll
        for (unsigned j = 0; j < 16; ++j) { const unsigned c = xb_ld(&bar[XB_XCNT(j)]); sum += c; cnt += (c > 0u) ? 1u : 0u; mine = (j == x) ? c : mine; }
        if (sum == G) break;
        __builtin_amdgcn_s_sleep(1);
        if ((++sp & 255u) == 0u) { if (xb_ld(&bar[XB_TMO])) break; if (sp > XB_SPIN_CAP) { atomicAdd(&bar[XB_TMO], 1u); break; } }
    }
    nloc = mine > 0u ? mine : 1u; nx = cnt > 0u ? cnt : 1u;
}

__device__ __forceinline__ void xcd_barrier(const XcdBarrier& b) {
    asm volatile("s_waitcnt vmcnt(0)" ::: "memory");
    __syncthreads();
    if (threadIdx.x == 0) {
        unsigned* bar = b.bar;
        __builtin_amdgcn_s_waitcnt(0);
        unsigned nloc = b.st[0], nx = b.st[1];
        if (nloc == 0u) { xcd_barrier_complete(bar, b.x, nloc, nx); b.st[0] = nloc; b.st[1] = nx; }
        const unsigned old = xb_add(&bar[XB_XSUB(b.x)], 1u);
        const unsigned gen = old / nloc;
        if (old + 1u == (gen + 1u) * nloc) {
            __builtin_amdgcn_fence(__ATOMIC_RELEASE, "agent");
            asm volatile("s_waitcnt vmcnt(0)" ::: "memory");
            const unsigned og = xb_add(&bar[XB_TOP], 1u);
            const unsigned tg = og / nx;
            if (og + 1u == (tg + 1u) * nx) xb_add(&bar[XB_TOPGEN], 1u);
            else XB_SPIN(xb_ld(&bar[XB_TOPGEN]) == tg, bar);
            __builtin_amdgcn_fence(__ATOMIC_ACQUIRE, "agent");
            xb_add(&bar[XB_XGEN(b.x)], 1u);
            asm volatile("s_waitcnt vmcnt(0)" ::: "memory");
        } else {
            XB_SPIN(xb_ld(&bar[XB_XGEN(b.x)]) == gen, bar);
            __builtin_amdgcn_fence(__ATOMIC_ACQUIRE, "agent");
            asm volatile("s_waitcnt vmcnt(0)" ::: "memory");
        }
    }
    __syncthreads();
}


constexpr size_t MiB = 1u << 20;
constexpr size_t al256(size_t x) { return (x + 255) & ~(size_t)255; }
constexpr size_t WS_CTL = 0, CTL_ZERO_BYTES = 1 * MiB;
constexpr size_t WS_W1A = 1 * MiB;
constexpr size_t WS_W1B = WS_W1A + (size_t)NGU * D * 2;
constexpr size_t WS_WIN = WS_W1B + (size_t)D * FF * 2;
constexpr size_t WS_WPA = WS_WIN + (size_t)NINP * D * 2;
constexpr size_t WS_WPB = WS_WPA + (size_t)D * 512 * 2;
constexpr size_t WS_WOUT = WS_WPB + (size_t)D * D * 2;
constexpr size_t WS_W2A = WS_WOUT + (size_t)D * D * 2;
constexpr size_t WS_W2B = WS_W2A + (size_t)NGU * D * 2;
constexpr size_t WS_XB = al256(WS_W2B + (size_t)D * FF * 2);
constexpr size_t WS_RSTD1 = WS_XB + (size_t)MT * D * 2;
constexpr size_t WS_ACT = al256(WS_RSTD1 + (size_t)MT * 4);
constexpr size_t WS_X1 = WS_ACT + (size_t)MT * FF * 2;
constexpr size_t WS_X1B = WS_X1 + (size_t)MT * D * 4;
constexpr size_t WS_U = WS_X1B + (size_t)MT * D * 2;
constexpr size_t WS_BA = WS_U + (size_t)MT * NINP * 2;
constexpr size_t REC_BYTES = 90112;
constexpr int NREC = NB * 8 * 64;
constexpr size_t WS_REC = WS_BA + (size_t)MT * 16 * 4;
constexpr size_t WS_GE = WS_REC + (size_t)NREC * REC_BYTES;
constexpr size_t WS_OB = al256(WS_GE + (size_t)NREC * 4);
constexpr size_t WS_OG = WS_OB + (size_t)MT * D * 2;
constexpr size_t WS_LSE = WS_OG + (size_t)MT * 1536 * 2;
constexpr size_t WS_OA = al256(WS_LSE + (size_t)MT * 12 * 4);
constexpr size_t WS_M1 = WS_OA + (size_t)MT * 512 * 2;
constexpr size_t WS_MG = WS_M1 + (size_t)MT * D * 2;
constexpr size_t WS_X2 = WS_MG + (size_t)MT * D * 2;
constexpr size_t WS_X2B = WS_X2 + (size_t)MT * D * 4;
constexpr size_t WS_END = WS_X2B + (size_t)MT * D * 2;
constexpr int CW_TMO = 0;
constexpr int CW_BAR = 4096;
constexpr int CW_Q = 8192;
constexpr int CW_SSQ2 = 16384, CW_SSQ3 = CW_SSQ2 + 17408, CW_SSQ4 = CW_SSQ3 + 17408;
static_assert((CW_SSQ4 + 17408) * 4 <= (int)CTL_ZERO_BYTES, "CTL words inside the memset region");

constexpr size_t O_Y = 0;
constexpr size_t O_KVP0 = (size_t)MT * D;
constexpr size_t O_KVP1 = O_KVP0 + 524288;
constexpr size_t O_KVP2 = O_KVP1 + 2097152;
constexpr size_t O_CONVP = O_KVP2 + 8388608;
constexpr size_t O_SSMP = O_CONVP + 36864;
constexpr size_t O_KVS0 = O_SSMP + 524288;
constexpr size_t O_KVS1 = O_KVS0 + 524288;
constexpr size_t O_KVS2 = O_KVS1 + 524288;
constexpr size_t O_CONVS = O_KVS2 + 524288;
constexpr size_t O_SSMS = O_CONVS + 1179648;
constexpr size_t O_END = O_SSMS + 16777216;

constexpr int NWAVES = 8;
constexpr int RING_OFF = 0;
constexpr int LDSCTL_OFF = 151552, MISC_OFF = LDSCTL_OFF + 320;
constexpr int LDS_BYTES = 155648;

struct Frame {
    LAS unsigned char* lds;
    LAS unsigned char* ldv;
    volatile LAS unsigned* MISC;
    gu32* ctl;
    int tid, lane, wave, G, bx;
    const float* const* in; float* out; unsigned char* ws;
};
#define IN_XP 0
#define IN_XS 1
#define IN_C128 2
#define IN_C512 3
#define IN_C2048 4
#define IN_SCONV 5
#define IN_SSSM 6
#define IN_NF1 7
#define IN_W1GU 8
#define IN_W1D 9
#define IN_NMIX 10
#define IN_WIN 11
#define IN_CONVW 12
#define IN_ALOG 13
#define IN_DTB 14
#define IN_GNORM 15
#define IN_WPA 16
#define IN_WPB 17
#define IN_WOUT 18
#define IN_NF2 19
#define IN_W2GU 20
#define IN_W2D 21
#define IN_NOUT 22

template <class Map>
__device__ __forceinline__ void p0_transpose_item(const float* W, int K, int N, bf16* WT, const float* gain, LAS float* scr, int item, int lane, Map map) {
    const int nblk = (N + 31) / 32, kb = item / nblk, nb = item % nblk, k0 = 64 * kb, n0 = 32 * nb;
    const int nc = n0 + (lane & 31); const bool okc = nc < N;
#pragma unroll 8
    for (int i = 0; i < 32; ++i) { const int kk = 2 * i + (lane >> 5); float v = okc ? W[(size_t)(k0 + kk) * N + nc] : 0.f; if (gain) v *= gain[k0 + kk]; scr[kk * 33 + (lane & 31)] = v; }
    LDS_WAIT(); asm volatile("" ::: "memory");
    const int c = lane & 7;
#pragma unroll
    for (int j = 0; j < 4; ++j) { const int n = (lane >> 3) + 8 * j; const LAS float* s = scr + (8 * c) * 33 + n;
        v4u o; o.x = pk2(s[0 * 33], s[1 * 33]); o.y = pk2(s[2 * 33], s[3 * 33]); o.z = pk2(s[4 * 33], s[5 * 33]); o.w = pk2(s[6 * 33], s[7 * 33]);
        if (n0 + n < N) *(GAS v4u*)(WT + (size_t)map(n0 + n) * K + k0 + 8 * c) = o; }
    LDS_WAIT(); asm volatile("" ::: "memory");
}
struct MapId { __device__ __forceinline__ int operator()(int c) const { return c; } };
struct MapGU { __device__ __forceinline__ int operator()(int c) const { return c < FF ? 256 * (c >> 7) + (c & 127) : 256 * ((c - FF) >> 7) + 128 + ((c - FF) & 127); } };
struct MapIn { __device__ __forceinline__ int operator()(int c) const { return c < 8704 ? c : (c < 8720 ? U_BA + (c - 8704) : c - 16); } };

__device__ __forceinline__ void p0_prologue(Frame& F) {
    LAS float* scr = (LAS float*)(F.ldv + RING_OFF + F.wave * 16384);
    const int gw = F.bx * NWAVES + F.wave, NGW = F.G * NWAVES;
    bf16* W1A = (bf16*)(F.ws + WS_W1A); bf16* W1B = (bf16*)(F.ws + WS_W1B); bf16* WIN = (bf16*)(F.ws + WS_WIN); bf16* WPA = (bf16*)(F.ws + WS_WPA);
    bf16* WPB = (bf16*)(F.ws + WS_WPB); bf16* WOUT = (bf16*)(F.ws + WS_WOUT); bf16* W2A = (bf16*)(F.ws + WS_W2A); bf16* W2B = (bf16*)(F.ws + WS_W2B);
    constexpr int I_GU = (D / 64) * (NGU / 32), I_DN = (FF / 64) * (D / 32), I_IN = (D / 64) * ((NIN + 31) / 32), I_PA = (512 / 64) * (D / 32), I_DD = (D / 64) * (D / 32);
    constexpr int NITEMS = 2 * I_GU + 2 * I_DN + I_IN + I_PA + 2 * I_DD;
    for (int it = gw; it < NITEMS; it += NGW) {
        int r = it;
        if (r < I_GU) { p0_transpose_item(F.in[IN_W1GU], D, NGU, W1A, F.in[IN_NF1], scr, r, F.lane, MapGU()); continue; } r -= I_GU;
        if (r < I_GU) { p0_transpose_item(F.in[IN_W2GU], D, NGU, W2A, F.in[IN_NF2], scr, r, F.lane, MapGU()); continue; } r -= I_GU;
        if (r < I_DN) { p0_transpose_item(F.in[IN_W1D], FF, D, W1B, nullptr, scr, r, F.lane, MapId()); continue; } r -= I_DN;
        if (r < I_DN) { p0_transpose_item(F.in[IN_W2D], FF, D, W2B, nullptr, scr, r, F.lane, MapId()); continue; } r -= I_DN;
        if (r < I_IN) { p0_transpose_item(F.in[IN_WIN], D, NIN, WIN, F.in[IN_NMIX], scr, r, F.lane, MapIn()); continue; } r -= I_IN;
        if (r < I_PA) { p0_transpose_item(F.in[IN_WPA], 512, D, WPA, nullptr, scr, r, F.lane, MapId()); continue; } r -= I_PA;
        if (r < I_DD) { p0_transpose_item(F.in[IN_WPB], D, D, WPB, nullptr, scr, r, F.lane, MapId()); continue; } r -= I_DD;
        p0_transpose_item(F.in[IN_WOUT], D, D, WOUT, nullptr, scr, r, F.lane, MapId());
    }
    { const int gt = F.bx * 512 + F.tid, NT = F.G * 512; GAS v4u* z = (GAS v4u*)(WIN + (size_t)NIN * D);
      for (int i = gt; i < (NINP - NIN) * D / 8; i += NT) z[i] = (v4u){0u, 0u, 0u, 0u}; }
    bf16* XB = (bf16*)(F.ws + WS_XB); float* RSTD1 = (float*)(F.ws + WS_RSTD1);
    for (int m = gw; m < MT; m += NGW) {
        const float* xrow = (m < MP) ? F.in[IN_XP] + (size_t)m * D : F.in[IN_XS] + (size_t)(m - MP) * D;
        const GAS f32x4* xr = (const GAS f32x4*)xrow + F.lane; f32x4 v[4]; float s = 0.f;
#pragma unroll
        for (int j = 0; j < 4; ++j) { v[j] = xr[64 * j]; s += (v[j].x * v[j].x + v[j].y * v[j].y) + (v[j].z * v[j].z + v[j].w * v[j].w); }
        s = wave_sum(s);
        GAS v2u* o8 = (GAS v2u*)(XB + (size_t)m * D) + F.lane;
#pragma unroll
        for (int j = 0; j < 4; ++j) { v2u w; w.x = pk2(v[j].x, v[j].y); w.y = pk2(v[j].z, v[j].w); o8[64 * j] = w; }
        if (F.lane == 0) RSTD1[m] = rsqrtf(s * (1.0f / D) + EPS);
    }
}

__device__ __forceinline__ void final_norm(Frame& F) {
    const int gw = F.bx * NWAVES + F.wave, NGW = F.G * NWAVES;
    const float* ssq = (const float*)(F.ctl + CW_SSQ4); const GAS f32x4* nw = (const GAS f32x4*)F.in[IN_NOUT] + F.lane;
    f32x4 g[4];
#pragma unroll
    for (int j = 0; j < 4; ++j) g[j] = nw[64 * j];
    for (int m = gw; m < MT; m += NGW) {
        const float r = rsqrtf(ssq[m] * (1.0f / D) + EPS);
        GAS f32x4* xr = (GAS f32x4*)(F.out + O_Y + (size_t)m * D) + F.lane;
#pragma unroll
        for (int j = 0; j < 4; ++j) { f32x4 v = xr[64 * j]; xr[64 * j] = v * r * g[j]; }
    }
}

template <int K>
__device__ __forceinline__ void skinny_partial(const bf16* A, const bf16* Bt, int r0, int c0, int w, int lane, LAS unsigned char* part) {
    const int m16 = lane & 15, kg = lane >> 4;
    f32x4 acc[2][4];
#pragma unroll
    for (int i = 0; i < 2; ++i)
#pragma unroll
        for (int j = 0; j < 4; ++j) acc[i][j] = (f32x4){0.f, 0.f, 0.f, 0.f};
    const bf16* ap = A + (size_t)(r0 + m16) * K + w * (K / 8) + 8 * kg; const bf16* bp = Bt + (size_t)(c0 + m16) * K + w * (K / 8) + 8 * kg;
#pragma unroll 4
    for (int kb = 0; kb < K / 256; ++kb) {
        bf16x8 a[2], bq[4];
#pragma unroll
        for (int i = 0; i < 2; ++i) a[i] = *(const GAS bf16x8*)(ap + (size_t)16 * i * K + 32 * kb);
#pragma unroll
        for (int j = 0; j < 4; ++j) bq[j] = *(const GAS bf16x8*)(bp + (size_t)16 * j * K + 32 * kb);
#pragma unroll
        for (int i = 0; i < 2; ++i)
#pragma unroll
            for (int j = 0; j < 4; ++j) acc[i][j] = mfma16(bq[j], a[i], acc[i][j]);
    }
#pragma unroll
    for (int i = 0; i < 2; ++i)
#pragma unroll
        for (int j = 0; j < 4; ++j) *(LAS f32x4*)(part + ((w * 8 + i * 4 + j) * 64 + lane) * 16) = acc[i][j];
}
__device__ __forceinline__ f32x4 skinny_reduce(const LAS unsigned char* part, int w, int lane) {
    f32x4 s = {0.f, 0.f, 0.f, 0.f};
#pragma unroll
    for (int p = 0; p < 8; ++p) s = s + *(const LAS f32x4*)(part + ((p * 8 + w) * 64 + lane) * 16);
    return s;
}
template <int K>
__device__ __forceinline__ void skinny_resid(Frame& F, const bf16* A, const bf16* Bt, const float* base, float* out, bf16* xb, float* ssq, float scale) {
    const int lane = F.lane, w = F.wave, m16 = lane & 15, kg = lane >> 4, wr = w >> 2, wc = w & 3;
    for (int t = F.bx; t < 256; t += F.G) {
        const int r0 = MP + 32 * (t >> 4), c0 = 64 * (t & 15);
        skinny_partial<K>(A, Bt, r0, c0, w, lane, F.ldv);
        WG_BARRIER();
        const f32x4 acc = skinny_reduce(F.ldv, w, lane);
        const int row = r0 + 16 * wr + m16;
        const size_t off = (size_t)row * D + c0 + 16 * wc + 4 * kg;
        const f32x4 v = *(const GAS f32x4*)(base + off) + acc * scale;
        *(GAS f32x4*)(out + off) = v;
        if (xb) { v2u pk; pk.x = pk2(v[0], v[1]); pk.y = pk2(v[2], v[3]); *(GAS v2u*)(xb + off) = pk; }
        float s = (v[0] * v[0] + v[1] * v[1]) + (v[2] * v[2] + v[3] * v[3]);
        s += __shfl_xor(s, 16); s += __shfl_xor(s, 32);
        if (kg == 0) atomicAdd(ssq + row, s);
        WG_BARRIER();
    }
}
__device__ __forceinline__ void skinny_merge(Frame& F, const bf16* OA, const bf16* WPA, const bf16* OB, const bf16* WPB, const bf16* U, bf16* MG) {
    const int lane = F.lane, w = F.wave, m16 = lane & 15, kg = lane >> 4, wr = w >> 2, wc = w & 3;
    for (int t = F.bx; t < 256; t += F.G) {
        const int r0 = MP + 32 * (t >> 4), c0 = 64 * (t & 15);
        skinny_partial<512>(OA, WPA, r0, c0, w, lane, F.ldv);
        skinny_partial<D>(OB, WPB, r0, c0, w, lane, F.ldv + 65536);
        WG_BARRIER();
        const f32x4 aa = skinny_reduce(F.ldv, w, lane), ab = skinny_reduce(F.ldv + 65536, w, lane);
        const int row = r0 + 16 * wr + m16, col = c0 + 16 * wc + 4 * kg;
        const v2u ga = *(const GAS v2u*)(U + (size_t)row * NINP + U_GATE + col), gb = *(const GAS v2u*)(U + (size_t)row * NINP + U_GATE + D + col);
        v2u o; o.x = pk2(sigm(bflo(ga.x)) * aa[0] + sigm(bflo(gb.x)) * ab[0], sigm(bfhi(ga.x)) * aa[1] + sigm(bfhi(gb.x)) * ab[1]);
        o.y = pk2(sigm(bflo(ga.y)) * aa[2] + sigm(bflo(gb.y)) * ab[2], sigm(bfhi(ga.y)) * aa[3] + sigm(bfhi(gb.y)) * ab[3]);
        *(GAS v2u*)(MG + (size_t)row * D + col) = o;
        WG_BARRIER();
    }
}
__device__ __forceinline__ void skinny_ba(Frame& F, const bf16* X1B, const bf16* WIN, const float* ssq, float* BA) {
    const int lane = F.lane, m16 = lane & 15, kg = lane >> 4;
    for (int t = F.bx * NWAVES + F.wave; t < MT / 16; t += F.G * NWAVES) {
        const int row = 16 * t + m16;
        f32x4 acc = {0.f, 0.f, 0.f, 0.f}; { const bf16* ap = X1B + (size_t)row * D + 8 * kg; const bf16* bp = WIN + (size_t)(U_BA + m16) * D + 8 * kg;
#pragma unroll 16
            for (int kb = 0; kb < D / 32; ++kb) acc = mfma16(*(const GAS bf16x8*)(bp + 32 * kb), *(const GAS bf16x8*)(ap + 32 * kb), acc); }
        *(GAS f32x4*)(BA + (size_t)row * 16 + 4 * kg) = acc * rsqrtf(ssq[row] * (1.0f / D) + EPS);
    }
}

constexpr int GP_QR = 0, GP_KR = 17408, GP_KT = 34816, GP_KBG = 53248, GP_BVT = 71680, GP_GKK = 90112, GP_GQK = 107520, GP_TI = 124928, GP_TAB = 134144;
constexpr int GKP = 68;
__device__ __forceinline__ f32x4 mfma4(float a, float b, f32x4 c) { return __builtin_amdgcn_mfma_f32_16x16x4f32(a, b, c, 0, 0, 0); }
__device__ __forceinline__ f32x4 prod_ll(const LAS float* A, int ra, int ca, const LAS float* B, int rb, int cb, f32x4 c, int m16, int kg) {
    const f32x4 av = *(const LAS f32x4*)(A + (ra + m16) * GKP + ca + 4 * kg);
#pragma unroll
    for (int t = 0; t < 4; ++t) c = mfma4(av[t], B[(rb + 4 * kg + t) * GKP + cb + m16], c);
    return c;
}
__device__ __forceinline__ f32x4 prod_lr(const LAS float* A, int ra, int ca, f32x4 x, f32x4 c, int m16, int kg) {
    const f32x4 av = *(const LAS f32x4*)(A + (ra + m16) * GKP + ca + 4 * kg);
#pragma unroll
    for (int t = 0; t < 4; ++t) c = mfma4(av[t], x[t], c);
    return c;
}
__device__ __forceinline__ float softplusf(float x) { return x > 20.f ? x : log1pf(__expf(x)); }

__device__ __forceinline__ void gdn_prep_unit(Frame& F, int b, int h, int n) {
    LAS unsigned char* L = F.ldv;
    LAS float* TAB = (LAS float*)(L + GP_TAB);
    LAS float* GKK = (LAS float*)(L + GP_GKK);
    LAS float* GQK = (LAS float*)(L + GP_GQK);
    const bf16* U = (const bf16*)(F.ws + WS_U); const float* BA = (const float*)(F.ws + WS_BA);
    const int tid = F.tid, lane = F.lane, wave = F.wave;
    const int uidx = (b * 8 + h) * 64 + n;
    unsigned char* rec = F.ws + WS_REC + (size_t)uidx * REC_BYTES;
    const int row_base = b * SEQ + 64 * n;
    const int gz_t = tid >> 3, gz_c = (tid & 7) * 16;
    const v4u zr0 = *(const GAS v4u*)(U + (size_t)(row_base + gz_t) * NINP + U_Z + h * 128 + gz_c), zr1 = *(const GAS v4u*)(U + (size_t)(row_base + gz_t) * NINP + U_Z + h * 128 + gz_c + 8);
    const int cv_cq = tid & 31, cv_tq = (tid >> 5) & 3, cv_tensor = tid >> 7, cv_c0 = 4 * cv_cq, cv_cw = cv_tensor * 1024 + h * 128 + cv_c0, cv_t0 = 16 * cv_tq;
    v2u raw[19]; f32x4 w0 = {0.f, 0.f, 0.f, 0.f}, w1 = w0, w2 = w0, w3 = w0;
    if (tid < 384) {
        w0 = *(const GAS f32x4*)(F.in[IN_CONVW] + cv_cw); w1 = *(const GAS f32x4*)(F.in[IN_CONVW] + 3072 + cv_cw); w2 = *(const GAS f32x4*)(F.in[IN_CONVW] + 2 * 3072 + cv_cw); w3 = *(const GAS f32x4*)(F.in[IN_CONVW] + 3 * 3072 + cv_cw);
#pragma unroll
        for (int i = 0; i < 19; ++i) { const int tok = 64 * n + cv_t0 - 3 + i; raw[i] = (v2u){0u, 0u}; if (tok >= 0) raw[i] = *(const GAS v2u*)(U + (size_t)(b * SEQ + tok) * NINP + U_QKVB + cv_cw); }
    }
    if (wave == 0) {
        const int t = lane; const float bl = BA[(size_t)(row_base + t) * 16 + h], al = BA[(size_t)(row_base + t) * 16 + 8 + h];
        const float beta = sigm(bl); const float g = -__expf(F.in[IN_ALOG][h]) * softplusf(al + F.in[IN_DTB][h]);
        float gc = g;
#pragma unroll
        for (int o = 1; o < 64; o <<= 1) { const float v = __shfl_up(gc, o); if (lane >= o) gc += v; }
        const float gl = __shfl(gc, 63);
        TAB[t] = beta; TAB[64 + t] = gc; TAB[128 + t] = __expf(gc); TAB[192 + t] = __expf(gl - gc);
        if (lane == 0) ((float*)(F.ws + WS_GE))[uidx] = __expf(gl);
    }
    WG_BARRIER();
    if (tid < 384) {
        const int tensor = cv_tensor, c0 = cv_c0, t0 = cv_t0;
        f32x4 x[19];
#pragma unroll
        for (int i = 0; i < 19; ++i) x[i] = (f32x4){bflo(raw[i].x), bfhi(raw[i].x), bflo(raw[i].y), bfhi(raw[i].y)};
        unsigned tp[4][8];
#pragma unroll
        for (int i = 0; i < 16; ++i) { f32x4 y = w0 * x[i] + w1 * x[i + 1] + w2 * x[i + 2] + w3 * x[i + 3];
#pragma unroll
            for (int e = 0; e < 4; ++e) y[e] = siluf(y[e]);
            if (tensor == 2) y = y * TAB[t0 + i];
            if (tensor < 2) { v2u pk; pk.x = pk2(y[0], y[1]); pk.y = pk2(y[2], y[3]); *(LAS v2u*)(L + (tensor == 0 ? GP_QR : GP_KR) + (t0 + i) * 272 + 2 * c0) = pk; }
            if (tensor > 0) {
#pragma unroll
                for (int e = 0; e < 4; ++e) { const unsigned bq = f2bf(y[e]); if (i & 1) tp[e][i >> 1] |= bq << 16; else tp[e][i >> 1] = bq; } }
        }
        if (tensor > 0) {
#pragma unroll
            for (int e = 0; e < 4; ++e) { LAS unsigned char* dst = L + (tensor == 1 ? GP_KT : GP_BVT) + (c0 + e) * 144 + 2 * t0;
                *(LAS v4u*)dst = (v4u){tp[e][0], tp[e][1], tp[e][2], tp[e][3]}; *(LAS v4u*)(dst + 16) = (v4u){tp[e][4], tp[e][5], tp[e][6], tp[e][7]}; } }
    }
    WG_BARRIER();
    {
        const int m16 = lane & 15, kg = lane >> 4;
        for (int job = wave; job < 24; job += 8) {
            int kind, it, jt;
            if (job < 20) { kind = job >= 10; int j = job % 10; it = 0; while (j > it) { j -= it + 1; ++it; } jt = j; }
            else { kind = 2; it = jt = job - 20; }
            const int abase = (kind == 2 ? GP_QR : GP_KR) + (16 * (kind == 1 ? jt : it) + m16) * 272 + 16 * kg;
            const int bbase = (kind == 0 ? GP_KR : GP_QR) + (16 * (kind == 0 ? jt : it) + m16) * 272 + 16 * kg;
            f32x4 acc = {0.f, 0.f, 0.f, 0.f};
#pragma unroll
            for (int kb = 0; kb < 4; ++kb) { const bf16x8 a = *(const LAS bf16x8*)(L + abase + 64 * kb), bb = *(const LAS bf16x8*)(L + bbase + 64 * kb); acc = mfma16(a, bb, acc); }
            if (kind == 0) {
#pragma unroll
                for (int jj = 0; jj < 4; ++jj) GKK[(16 * it + 4 * kg + jj) * GKP + 16 * jt + m16] = acc[jj];
            } else if (kind == 1) {
                *(LAS f32x4*)(GQK + (16 * it + m16) * 68 + 16 * jt + 4 * kg) = acc;
            } else {
#pragma unroll
                for (int jj = 0; jj < 4; ++jj) if (4 * kg + jj == m16) TAB[576 + 16 * it + m16] = acc[jj];
            }
        }
    }
    WG_BARRIER();
    if (tid < 64) {
        const int t = tid; const float rk = rsqrtf(GKK[t * GKP + t] + EPS), rq = rsqrtf(TAB[576 + t] + EPS) * 0.08838834764831845f;
        TAB[256 + t] = rk; TAB[320 + t] = rq; TAB[384 + t] = rq * TAB[128 + t]; TAB[448 + t] = rk * TAB[192 + t]; TAB[512 + t] = rk * TAB[t] * TAB[128 + t];
    }
    WG_BARRIER();
    {
        for (int e = tid; e < 4096; e += 512) { const int i = e >> 6, j = e & 63;
            if (j < i) GKK[i * GKP + j] = TAB[i] * TAB[256 + i] * TAB[256 + j] * GKK[i * GKP + j] * __expf(TAB[64 + i] - TAB[64 + j]); }
        const int m16 = lane & 15, kg = lane >> 4;
        { const int it = wave >> 1, kb2 = wave & 1, i = 16 * it + m16; const float sc = TAB[320 + i], gi = TAB[64 + i];
          float o[8];
#pragma unroll
          for (int hlf = 0; hlf < 2; ++hlf) { const int j0 = 32 * kb2 + 16 * hlf + 4 * kg; const f32x4 g = *(const LAS f32x4*)(GQK + i * 68 + j0);
#pragma unroll
              for (int e = 0; e < 4; ++e) { const int j = j0 + e; o[4 * hlf + e] = (j <= i) ? sc * TAB[256 + j] * g[e] * __expf(gi - TAB[64 + j]) : 0.f; } }
          v4u w; w.x = pk2(o[0], o[1]); w.y = pk2(o[2], o[3]); w.z = pk2(o[4], o[5]); w.w = pk2(o[6], o[7]);
          *(GAS v4u*)(rec + 32768 + wave * 1024 + lane * 16) = w; }
#pragma unroll
        for (int r = 0; r < 2; ++r) { const int f = wave * 2 + r, mt = f >> 1, kb2 = f & 1, dk = 16 * mt + m16; float o[8];
#pragma unroll
            for (int hlf = 0; hlf < 2; ++hlf) { const int t0 = 32 * kb2 + 16 * hlf + 4 * kg; const v2u kk = *(const LAS v2u*)(L + GP_KT + dk * 144 + 2 * t0);
                o[4 * hlf + 0] = bflo(kk.x) * TAB[448 + t0]; o[4 * hlf + 1] = bfhi(kk.x) * TAB[448 + t0 + 1]; o[4 * hlf + 2] = bflo(kk.y) * TAB[448 + t0 + 2]; o[4 * hlf + 3] = bfhi(kk.y) * TAB[448 + t0 + 3]; }
            v4u w; w.x = pk2(o[0], o[1]); w.y = pk2(o[2], o[3]); w.z = pk2(o[4], o[5]); w.w = pk2(o[6], o[7]);
            *(GAS v4u*)(rec + 40960 + f * 1024 + lane * 16) = w; }
#pragma unroll
        for (int r = 0; r < 2; ++r) { const int f = wave * 2 + r, mtq = f >> 2, kb = f & 3, t = 16 * mtq + m16; const float sc = TAB[384 + t]; float o[8];
#pragma unroll
            for (int hlf = 0; hlf < 2; ++hlf) { const int d0 = 32 * kb + 16 * hlf + 4 * kg; const v2u qq = *(const LAS v2u*)(L + GP_QR + t * 272 + 2 * d0);
                o[4 * hlf + 0] = bflo(qq.x) * sc; o[4 * hlf + 1] = bfhi(qq.x) * sc; o[4 * hlf + 2] = bflo(qq.y) * sc; o[4 * hlf + 3] = bfhi(qq.y) * sc; }
            v4u w; w.x = pk2(o[0], o[1]); w.y = pk2(o[2], o[3]); w.z = pk2(o[4], o[5]); w.w = pk2(o[6], o[7]);
            *(GAS v4u*)(rec + ((4 + mtq) * 4 + kb) * 1024 + lane * 16) = w; }
        { const int dk = tid >> 2, t0 = (tid & 3) * 16; const v4u a = *(const LAS v4u*)(L + GP_KT + dk * 144 + 2 * t0), bq = *(const LAS v4u*)(L + GP_KT + dk * 144 + 2 * t0 + 16);
          const unsigned wi[8] = {a.x, a.y, a.z, a.w, bq.x, bq.y, bq.z, bq.w}; unsigned wo[8];
#pragma unroll
          for (int i = 0; i < 8; ++i) wo[i] = pk2(bflo(wi[i]) * TAB[512 + t0 + 2 * i], bfhi(wi[i]) * TAB[512 + t0 + 2 * i + 1]);
          *(LAS v4u*)(L + GP_KBG + dk * 144 + 2 * t0) = (v4u){wo[0], wo[1], wo[2], wo[3]}; *(LAS v4u*)(L + GP_KBG + dk * 144 + 2 * t0 + 16) = (v4u){wo[4], wo[5], wo[6], wo[7]}; }
    }
    WG_BARRIER();
    LAS float* TIF = GQK;
    {
        const int m16 = lane & 15, kg = lane >> 4;
        if (wave == 0) {
            const LAS float* Ab = GKK + (16 * kg) * GKP + 16 * kg; float r[16];
#pragma unroll
            for (int i = 0; i < 16; ++i) { int lo_ = m16; asm volatile("" : "+v"(lo_)); float a = (lo_ == i) ? 1.f : 0.f;
#pragma unroll
                for (int j4 = 0; j4 < (i + 3) / 4; ++j4) { const f32x4 av = *(const LAS f32x4*)(Ab + i * GKP + 4 * j4);
#pragma unroll
                    for (int e = 0; e < 4; ++e) { const int j = 4 * j4 + e; if (j < i) a -= av[e] * r[j]; } }
                r[i] = a; }
#pragma unroll
            for (int i = 0; i < 16; ++i) TIF[(16 * kg + i) * GKP + 16 * kg + m16] = r[i];
        }
        WG_BARRIER();
        const f32x4 z4 = {0.f, 0.f, 0.f, 0.f};
        if (wave < 3) { const int i = wave + 1, j = wave;
            f32x4 X = prod_ll(GKK, 16 * i, 16 * j, TIF, 16 * j, 16 * j, z4, m16, kg);
            f32x4 T = prod_lr(TIF, 16 * i, 16 * i, X, z4, m16, kg);
#pragma unroll
            for (int jj = 0; jj < 4; ++jj) TIF[(16 * i + 4 * kg + jj) * GKP + 16 * j + m16] = -T[jj]; }
        WG_BARRIER();
        if (wave < 2) { const int i = wave + 2, j = wave;
            f32x4 Y = prod_ll(GKK, 16 * i, 16 * j, TIF, 16 * j, 16 * j, z4, m16, kg);
            Y = prod_ll(GKK, 16 * i, 16 * (j + 1), TIF, 16 * (j + 1), 16 * j, Y, m16, kg);
            f32x4 T = prod_lr(TIF, 16 * i, 16 * i, Y, z4, m16, kg);
#pragma unroll
            for (int jj = 0; jj < 4; ++jj) TIF[(16 * i + 4 * kg + jj) * GKP + 16 * j + m16] = -T[jj]; }
        WG_BARRIER();
        if (wave == 0) {
            f32x4 Y = prod_ll(GKK, 48, 0, TIF, 0, 0, z4, m16, kg);
            Y = prod_ll(GKK, 48, 16, TIF, 16, 0, Y, m16, kg);
            Y = prod_ll(GKK, 48, 32, TIF, 32, 0, Y, m16, kg);
            f32x4 T = prod_lr(TIF, 48, 48, Y, z4, m16, kg);
#pragma unroll
            for (int jj = 0; jj < 4; ++jj) TIF[(48 + 4 * kg + jj) * GKP + m16] = -T[jj]; }
        WG_BARRIER();
        { const int row = tid >> 3, cg = tid & 7; v4u o = {0u, 0u, 0u, 0u};
          if ((cg >> 1) <= (row >> 4)) { const f32x4 a = *(const LAS f32x4*)(TIF + row * GKP + 8 * cg), c = *(const LAS f32x4*)(TIF + row * GKP + 8 * cg + 4);
              o.x = pk2(a[0], a[1]); o.y = pk2(a[2], a[3]); o.z = pk2(c[0], c[1]); o.w = pk2(c[2], c[3]); }
          *(LAS v4u*)(L + GP_TI + row * 144 + 16 * cg) = o; }
    }
    WG_BARRIER();
    {
        const int m16 = lane & 15, kg = lane >> 4;
#pragma unroll
        for (int it = 0; it < 4; ++it) {
            f32x4 au = {0.f, 0.f, 0.f, 0.f}, aw = {0.f, 0.f, 0.f, 0.f};
#pragma unroll
            for (int jb = 0; jb < 2; ++jb) {
                const bf16x8 ti = *(const LAS bf16x8*)(L + GP_TI + (16 * it + m16) * 144 + 64 * jb + 16 * kg);
                const bf16x8 bv = *(const LAS bf16x8*)(L + GP_BVT + (16 * wave + m16) * 144 + 64 * jb + 16 * kg);
                const bf16x8 kb = *(const LAS bf16x8*)(L + GP_KBG + (16 * wave + m16) * 144 + 64 * jb + 16 * kg);
                au = mfma16(ti, bv, au);
                aw = mfma16(kb, ti, aw);
            }
            v2u w; w.x = pk2(au[0], au[1]); w.y = pk2(au[2], au[3]);
            *(GAS v2u*)(rec + 57344 + ((wave * 4 + it) * 64 + lane) * 8) = w;
            v2u x; x.x = pk2(aw[0], aw[1]); x.y = pk2(aw[2], aw[3]);
            *(GAS v2u*)(rec + (it * 4 + (wave >> 1)) * 1024 + lane * 16 + (wave & 1) * 8) = x;
        }
    }
    { const unsigned zi[8] = {zr0.x, zr0.y, zr0.z, zr0.w, zr1.x, zr1.y, zr1.z, zr1.w}; unsigned zo[8];
#pragma unroll
      for (int i = 0; i < 8; ++i) { const float za = bflo(zi[i]), zb = bfhi(zi[i]); const f32x2 nw2 = *(const GAS f32x2*)(F.in[IN_GNORM] + gz_c + 2 * i);
          zo[i] = pk2(za * sigm(za) * nw2[0], zb * sigm(zb) * nw2[1]); }
      *(GAS v4u*)(rec + 73728 + (gz_t * 128 + gz_c) * 2) = (v4u){zo[0], zo[1], zo[2], zo[3]}; *(GAS v4u*)(rec + 73728 + (gz_t * 128 + gz_c + 8) * 2) = (v4u){zo[4], zo[5], zo[6], zo[7]}; }
    WG_BARRIER();
}

constexpr int SC_BUF = 57344, SC_OT = 2 * SC_BUF, SC_OTB = 17408, SC_RED = SC_OT + 2 * SC_OTB;
static_assert(SC_RED + 2048 <= LDSCTL_OFF, "scan LDS map");
__device__ __forceinline__ void gdn_scan_chain(Frame& F, int bh) {
#ifdef NO_SCAN
    return;
#endif
    LAS unsigned char* L = F.ldv;
    const int tid = F.tid, lane = F.lane, w = F.wave, m16 = lane & 15, kg = lane >> 4;
    const int b = bh >> 3, h = bh & 7;
    const unsigned char* rec0 = F.ws + WS_REC + (size_t)(bh * 64) * REC_BYTES;
    if (w >= 4) {
        const int ht = tid - 256; bf16* OB = (bf16*)(F.ws + WS_OB);
        v4u st[14];
#pragma unroll
        for (int i = 0; i < 14; ++i) st[i] = *(const GAS v4u*)(rec0 + (size_t)(i * 256 + ht) * 16);
#pragma unroll
        for (int i = 0; i < 14; ++i) *(LAS v4u*)(L + (i * 256 + ht) * 16) = st[i];
#pragma unroll
        for (int i = 0; i < 14; ++i) st[i] = *(const GAS v4u*)(rec0 + REC_BYTES + (size_t)(i * 256 + ht) * 16);
        WG_BARRIER();
        for (int m = 0; m < 65; ++m) {
            if (m + 1 <= 63) { LAS unsigned char* nb = L + ((m + 1) & 1) * SC_BUF;
#pragma unroll
                for (int i = 0; i < 14; ++i) *(LAS v4u*)(nb + (i * 256 + ht) * 16) = st[i]; }
            if (m + 2 <= 63) { const unsigned char* rec = rec0 + (size_t)(m + 2) * REC_BYTES;
#pragma unroll
                for (int i = 0; i < 14; ++i) st[i] = *(const GAS v4u*)(rec + (size_t)(i * 256 + ht) * 16); }
            if (m >= 1) {
                const LAS unsigned char* ot = L + SC_OT + ((m - 1) & 1) * SC_OTB; const LAS float* RED = (const LAS float*)(L + SC_RED) + ((m - 1) & 1) * 256;
                const int row0 = b * SEQ + 64 * (m - 1); const unsigned char* gzt = rec0 + (size_t)(m - 1) * REC_BYTES + 73728;
                v4u gv[4];
#pragma unroll
                for (int r = 0; r < 4; ++r) gv[r] = *(const GAS v4u*)(gzt + (size_t)(ht + 256 * r) * 16);
#pragma unroll
                for (int r = 0; r < 4; ++r) { const int idx = ht + 256 * r, row = idx >> 4, ch = idx & 15;
                    const v4u ov = *(const LAS v4u*)(ot + row * 272 + ch * 16); const f32x4 r4 = *(const LAS f32x4*)(RED + row * 4);
                    const float rs = rsqrtf(((r4[0] + r4[1]) + (r4[2] + r4[3])) * (1.0f / 128.0f) + EPS);
                    v4u o; o.x = pk2(bflo(ov.x) * rs * bflo(gv[r].x), bfhi(ov.x) * rs * bfhi(gv[r].x)); o.y = pk2(bflo(ov.y) * rs * bflo(gv[r].y), bfhi(ov.y) * rs * bfhi(gv[r].y));
                    o.z = pk2(bflo(ov.z) * rs * bflo(gv[r].z), bfhi(ov.z) * rs * bfhi(gv[r].z)); o.w = pk2(bflo(ov.w) * rs * bflo(gv[r].w), bfhi(ov.w) * rs * bfhi(gv[r].w));
                    *(GAS v4u*)(OB + (size_t)(row0 + row) * D + h * 128 + ch * 8) = o; } }
            WG_BARRIER();
        }
    } else {
        const float* GE = (const float*)(F.ws + WS_GE) + bh * 64;
        f32x4 S[2][8], P[2][8];
#pragma unroll
        for (int hf = 0; hf < 2; ++hf)
#pragma unroll
            for (int i = 0; i < 8; ++i) { S[hf][i] = (f32x4){0.f, 0.f, 0.f, 0.f}; P[hf][i] = (f32x4){0.f, 0.f, 0.f, 0.f}; }
        WG_BARRIER();
        for (int m = 0; m < 65; ++m) {
            if (m <= 63) {
                const unsigned char* rec = rec0 + (size_t)m * REC_BYTES; const LAS unsigned char* buf = L + (m & 1) * SC_BUF;
                v2u ut[2][4];
#pragma unroll
                for (int hf = 0; hf < 2; ++hf)
#pragma unroll
                    for (int mt = 0; mt < 4; ++mt) ut[hf][mt] = *(const GAS v2u*)(rec + 57344 + (((2 * w + hf) * 4 + mt) * 64 + lane) * 8);
                const float ge = GE[m];
                bf16x8 Sb[2][4];
#pragma unroll
                for (int hf = 0; hf < 2; ++hf)
#pragma unroll
                    for (int kb = 0; kb < 4; ++kb) Sb[hf][kb] = pack8(S[hf][2 * kb], S[hf][2 * kb + 1]);
#pragma unroll
                for (int mt = 0; mt < 8; ++mt) { P[0][mt] = (f32x4){0.f, 0.f, 0.f, 0.f}; P[1][mt] = (f32x4){0.f, 0.f, 0.f, 0.f};
#pragma unroll
                    for (int kb = 0; kb < 4; ++kb) { const bf16x8 a = *(const LAS bf16x8*)(buf + (mt * 4 + kb) * 1024 + lane * 16); P[0][mt] = mfma16(a, Sb[0][kb], P[0][mt]); P[1][mt] = mfma16(a, Sb[1][kb], P[1][mt]); } }
                bf16x8 vb[2][2];
#pragma unroll
                for (int hf = 0; hf < 2; ++hf) { f32x4 vn[4];
#pragma unroll
                    for (int mt = 0; mt < 4; ++mt) { vn[mt][0] = bflo(ut[hf][mt].x) - P[hf][mt][0]; vn[mt][1] = bfhi(ut[hf][mt].x) - P[hf][mt][1]; vn[mt][2] = bflo(ut[hf][mt].y) - P[hf][mt][2]; vn[mt][3] = bfhi(ut[hf][mt].y) - P[hf][mt][3]; }
                    vb[hf][0] = pack8(vn[0], vn[1]); vb[hf][1] = pack8(vn[2], vn[3]); }
#pragma unroll
                for (int mt = 0; mt < 4; ++mt)
#pragma unroll
                    for (int kb2 = 0; kb2 < 2; ++kb2) { const bf16x8 a = *(const LAS bf16x8*)(buf + 32768 + (mt * 2 + kb2) * 1024 + lane * 16); P[0][4 + mt] = mfma16(a, vb[0][kb2], P[0][4 + mt]); P[1][4 + mt] = mfma16(a, vb[1][kb2], P[1][4 + mt]); }
#pragma unroll
                for (int mt = 0; mt < 8; ++mt) { S[0][mt] = S[0][mt] * ge; S[1][mt] = S[1][mt] * ge;
#pragma unroll
                    for (int kb2 = 0; kb2 < 2; ++kb2) { const bf16x8 a = *(const LAS bf16x8*)(buf + 40960 + (mt * 2 + kb2) * 1024 + lane * 16); S[0][mt] = mfma16(a, vb[0][kb2], S[0][mt]); S[1][mt] = mfma16(a, vb[1][kb2], S[1][mt]); } }
                LAS float* RED = (LAS float*)(L + SC_RED) + (m & 1) * 256; LAS unsigned char* ot = L + SC_OT + (m & 1) * SC_OTB;
#pragma unroll
                for (int mt = 0; mt < 4; ++mt)
#pragma unroll
                    for (int jj = 0; jj < 4; jj += 2) { const int t = 16 * mt + 4 * kg + jj;
#pragma unroll
                        for (int hf = 0; hf < 2; ++hf) { const unsigned pr = pk2(P[hf][4 + mt][jj], P[hf][4 + mt][jj + 1]);
                            *(LAS bf16*)(ot + t * 272 + (32 * w + 16 * hf + m16) * 2) = (bf16)(pr & 0xffffu); *(LAS bf16*)(ot + (t + 1) * 272 + (32 * w + 16 * hf + m16) * 2) = (bf16)(pr >> 16); } }
                float mine = 0.f;
#pragma unroll
                for (int mt = 0; mt < 4; ++mt)
#pragma unroll
                    for (int jj = 0; jj < 4; ++jj) { const float q = row_sum16(P[0][4 + mt][jj] * P[0][4 + mt][jj] + P[1][4 + mt][jj] * P[1][4 + mt][jj]); mine = (m16 == 4 * mt + jj) ? q : mine; }
                RED[(16 * (m16 >> 2) + 4 * kg + (m16 & 3)) * 4 + w] = mine;
            }
            WG_BARRIER();
        }
        float* so = F.out + O_SSMP + (size_t)bh * 16384;
#pragma unroll
        for (int hf = 0; hf < 2; ++hf)
#pragma unroll
            for (int mt = 0; mt < 8; ++mt)
#pragma unroll
                for (int jj = 0; jj < 4; ++jj) so[(16 * mt + 4 * kg + jj) * 128 + 32 * w + 16 * hf + m16] = S[hf][mt][jj];
    }
    WG_BARRIER();
}

__device__ __forceinline__ void gdn_sample_unit(Frame& F, int b, int h) {
    LAS float* L = (LAS float*)F.ldv;
    const int tid = F.tid, lane = F.lane, wave = F.wave;
    const bf16* U = (const bf16*)(F.ws + WS_U); const float* BA = (const float*)(F.ws + WS_BA);
    const int row0 = MP + 4 * b;
    LAS float* SC = L + 8704;
    if (tid < 4) { const float bl = BA[(size_t)(row0 + tid) * 16 + h], al = BA[(size_t)(row0 + tid) * 16 + 8 + h];
        SC[tid] = sigm(bl); SC[56 + tid] = -__expf(F.in[IN_ALOG][h]) * softplusf(al + F.in[IN_DTB][h]); }
    if (tid < 384) {
        const int tensor = tid >> 7, c = tid & 127, cw = tensor * 1024 + h * 128 + c, col = U_QKVB + cw;
        const float w0 = F.in[IN_CONVW][cw], w1 = F.in[IN_CONVW][3072 + cw], w2 = F.in[IN_CONVW][2 * 3072 + cw], w3 = F.in[IN_CONVW][3 * 3072 + cw];
        float x[7];
#pragma unroll
        for (int i = 0; i < 3; ++i) x[i] = F.in[IN_SCONV][((size_t)b * 3 + i) * 3072 + cw];
#pragma unroll
        for (int i = 0; i < 4; ++i) x[3 + i] = bf2f(U[(size_t)(row0 + i) * NINP + col]);
#pragma unroll
        for (int i = 0; i < 4; ++i) { const float v = w0 * x[i] + w1 * x[i + 1] + w2 * x[i + 2] + w3 * x[i + 3]; L[tensor * 512 + i * 128 + c] = siluf(v); }
    }
    WG_BARRIER();
    if (tid == 0) { float gc = 0.f;
#pragma unroll
        for (int i = 0; i < 4; ++i) { gc += SC[56 + i]; SC[4 + i] = gc; } SC[48] = __expf(gc); }
    { const int tensor = wave >> 2, s = wave & 3; const float a = L[tensor * 512 + s * 128 + lane], c2 = L[tensor * 512 + s * 128 + 64 + lane];
      const float ss = wave_sum(a * a + c2 * c2); if (lane == 0) SC[(tensor ? 8 : 12) + s] = rsqrtf(ss + EPS) * (tensor ? 1.f : 0.08838834764831845f); }
    WG_BARRIER();
#pragma unroll
    for (int r = 0; r < 4; ++r) { const int idx = 4 * wave + r, kind = idx >> 4, i = (idx >> 2) & 3, j = idx & 3;
        const LAS float* a = L + (kind ? 0 : 512) + i * 128; const LAS float* c2 = L + 512 + j * 128;
        const float d = wave_sum(a[lane] * c2[lane] + a[64 + lane] * c2[64 + lane]);
        if (lane == 0) SC[16 + idx] = d * SC[(kind ? 12 : 8) + i] * SC[8 + j]; }
    WG_BARRIER();
    float beta[4], gc[4], Ti[4][4], qkm[4][4];
#pragma unroll
    for (int i = 0; i < 4; ++i) { beta[i] = SC[i]; gc[i] = SC[4 + i]; }
    const float ge = SC[48];
    {
        float A[4][4];
#pragma unroll
        for (int i = 0; i < 4; ++i)
#pragma unroll
            for (int j = 0; j < 4; ++j) { const float dec = __expf(gc[i] - gc[j]); A[i][j] = (j < i) ? beta[i] * SC[16 + 4 * i + j] * dec : 0.f; qkm[i][j] = (j <= i) ? SC[32 + 4 * i + j] * dec : 0.f; }
#pragma unroll
        for (int i = 0; i < 4; ++i)
#pragma unroll
            for (int c = 0; c < 4; ++c) { float v = (i == c) ? 1.f : 0.f;
#pragma unroll
                for (int j = 0; j < 4; ++j) if (j < i) v -= A[i][j] * Ti[j][c];
                Ti[i][c] = v; }
    }
    { const int c = tid & 127, i = tid >> 7; float wv = 0.f, uv = 0.f;
#pragma unroll
      for (int j = 0; j < 4; ++j) { wv += Ti[i][j] * beta[j] * __expf(gc[j]) * SC[8 + j] * L[512 + j * 128 + c]; uv += Ti[i][j] * beta[j] * L[1024 + j * 128 + c]; }
      L[1536 + i * 128 + c] = wv; L[3072 + i * 128 + c] = uv;
      L[2048 + i * 128 + c] = L[i * 128 + c] * SC[12 + i] * __expf(gc[i]);
      L[2560 + i * 128 + c] = L[512 + i * 128 + c] * SC[8 + i] * __expf(gc[3] - gc[i]); }
    WG_BARRIER();
    const int dv = tid & 127, kq = tid >> 7;
    const float* S0 = F.in[IN_SSSM] + ((size_t)(b * 8 + h) * 128 + 32 * kq) * 128 + dv;
    float s[32];
#pragma unroll
    for (int i = 0; i < 32; ++i) s[i] = S0[(size_t)i * 128];
    float pw[4] = {0.f, 0.f, 0.f, 0.f}, pq[4] = {0.f, 0.f, 0.f, 0.f};
#pragma unroll
    for (int i = 0; i < 32; ++i)
#pragma unroll
        for (int c = 0; c < 4; ++c) { pw[c] += L[1536 + c * 128 + 32 * kq + i] * s[i]; pq[c] += L[2048 + c * 128 + 32 * kq + i] * s[i]; }
#pragma unroll
    for (int c = 0; c < 4; ++c) { L[3584 + (c * 4 + kq) * 128 + dv] = pw[c]; L[3584 + ((4 + c) * 4 + kq) * 128 + dv] = pq[c]; }
    WG_BARRIER();
    float vn[4], oo[4];
#pragma unroll
    for (int c = 0; c < 4; ++c) { const float ws_ = (L[3584 + (c * 4 + 0) * 128 + dv] + L[3584 + (c * 4 + 1) * 128 + dv]) + (L[3584 + (c * 4 + 2) * 128 + dv] + L[3584 + (c * 4 + 3) * 128 + dv]);
        vn[c] = L[3072 + c * 128 + dv] - ws_; }
#pragma unroll
    for (int c = 0; c < 4; ++c) { float o = (L[3584 + ((4 + c) * 4 + 0) * 128 + dv] + L[3584 + ((4 + c) * 4 + 1) * 128 + dv]) + (L[3584 + ((4 + c) * 4 + 2) * 128 + dv] + L[3584 + ((4 + c) * 4 + 3) * 128 + dv]);
#pragma unroll
        for (int j = 0; j < 4; ++j) o += qkm[c][j] * vn[j];
        oo[c] = o; }
    float* SO = F.out + O_SSMS + ((size_t)(b * 8 + h) * 128 + 32 * kq) * 128 + dv;
#pragma unroll
    for (int i = 0; i < 32; ++i) { float v = ge * s[i];
#pragma unroll
        for (int c = 0; c < 4; ++c) v += L[2560 + c * 128 + 32 * kq + i] * vn[c];
        SO[(size_t)i * 128] = v; }
    LAS float* RED = L + 8768;
    if (kq == 0) {
#pragma unroll
        for (int c = 0; c < 4; ++c) { const float q = wave_sum(oo[c] * oo[c]); if (lane == 0) RED[c * 2 + wave] = q; }
    }
    WG_BARRIER();
    if (kq == 0) {
        bf16* OB = (bf16*)(F.ws + WS_OB); const float nw = F.in[IN_GNORM][dv];
#pragma unroll
        for (int c = 0; c < 4; ++c) { const float rs = rsqrtf((RED[c * 2] + RED[c * 2 + 1]) * (1.0f / 128.0f) + EPS);
            const float z = bf2f(U[(size_t)(row0 + c) * NINP + U_Z + h * 128 + dv]);
            OB[(size_t)(row0 + c) * D + h * 128 + dv] = (bf16)f2bf(oo[c] * rs * nw * (z * sigm(z))); }
    }
    WG_BARRIER();
}

__device__ __forceinline__ void copy_outputs(Frame& F) {
    const bf16* U = (const bf16*)(F.ws + WS_U);
    const long gt = (long)F.bx * 512 + F.tid, NT = (long)F.G * 512;
    constexpr long C0 = 65536, C1 = 262144, C2 = 1048576, CS = 65536, CCP = 4608, CCS = 147456;
    constexpr long TOT = C0 + C1 + C2 + 3 * CS + CCP + CCS;
    for (long c = gt; c < TOT; c += NT) {
        long r = c; int srow, scol; float* dst;
        if (r < C0 + C1 + C2) {
            int g, keep; if (r < C0) { g = 0; keep = 128; dst = F.out + O_KVP0; } else if (r < C0 + C1) { r -= C0; g = 1; keep = 512; dst = F.out + O_KVP1; } else { r -= C0 + C1; g = 2; keep = 2048; dst = F.out + O_KVP2; }
            const int e8 = r & 15, hh = (r >> 4) & 3, kv = (r >> 6) & 1; const int rr = (int)((r >> 7) % keep), bb = (int)((r >> 7) / keep);
            srow = bb * SEQ + SEQ - keep + rr; scol = (kv ? U_VA : U_KA) + (g * 4 + hh) * 128 + e8 * 8; dst += r * 8;
        } else if ((r -= C0 + C1 + C2) < 3 * CS) {
            const int g = (int)(r / CS); r -= (long)g * CS; dst = F.out + (g == 0 ? O_KVS0 : (g == 1 ? O_KVS1 : O_KVS2)) + r * 8;
            const int e8 = r & 15, hh = (r >> 4) & 3, kv = (r >> 6) & 1, ss = (r >> 7) & 3, bb = (int)(r >> 9);
            srow = MP + 4 * bb + ss; scol = (kv ? U_VA : U_KA) + (g * 4 + hh) * 128 + e8 * 8;
        } else if ((r -= 3 * CS) < CCP) {
            const int ch8 = (int)(r % 384), i = (int)((r / 384) % 3), bb = (int)(r / 1152); dst = F.out + O_CONVP + r * 8;
            srow = bb * SEQ + SEQ - 3 + i; scol = U_QKVB + ch8 * 8;
        } else {
            r -= CCP; const int ch8 = (int)(r % 384), i = (int)((r / 384) % 3), bb = (int)(r / 1152); dst = F.out + O_CONVS + r * 8;
            srow = MP + 4 * bb + 1 + i; scol = U_QKVB + ch8 * 8;
        }
        const v4u v = *(const GAS v4u*)(U + (size_t)srow * NINP + scol);
        *(GAS f32x4*)dst = (f32x4){bflo(v.x), bfhi(v.x), bflo(v.y), bfhi(v.y)};
        *(GAS f32x4*)(dst + 4) = (f32x4){bflo(v.z), bfhi(v.z), bflo(v.w), bfhi(v.w)};
    }
}

constexpr int AT_K = 0, AT_V = 69632;
__device__ __forceinline__ int at_off(int row, int ch) { return 256 * row + 16 * (ch ^ (((row & 3) << 2) | ((row >> 2) & 3))); }
__device__ __forceinline__ void tr_read10(unsigned a, bf16x4 (&lo)[5], bf16x4 (&hi)[5]) {
    asm volatile("ds_read_b64_tr_b16 %0, %10\n\tds_read_b64_tr_b16 %1, %10 offset:4096\n\tds_read_b64_tr_b16 %2, %10 offset:8192\n\tds_read_b64_tr_b16 %3, %10 offset:12288\n\t"
                 "ds_read_b64_tr_b16 %4, %10 offset:16384\n\tds_read_b64_tr_b16 %5, %10 offset:20480\n\tds_read_b64_tr_b16 %6, %10 offset:24576\n\tds_read_b64_tr_b16 %7, %10 offset:28672\n\t"
                 "ds_read_b64_tr_b16 %8, %10 offset:32768\n\tds_read_b64_tr_b16 %9, %10 offset:36864\n\ts_waitcnt lgkmcnt(0)"
                 : "=&v"(lo[0]), "=&v"(hi[0]), "=&v"(lo[1]), "=&v"(hi[1]), "=&v"(lo[2]), "=&v"(hi[2]), "=&v"(lo[3]), "=&v"(hi[3]), "=&v"(lo[4]), "=&v"(hi[4]) : "v"(a) : "memory"); }

__device__ __forceinline__ void attn_prompt_unit(Frame& F, int unit) {
#ifdef NO_PATTN
    return;
#endif
    LAS unsigned char* L = F.ldv;
    const int tid = F.tid, lane = F.lane, w = F.wave, m16 = lane & 15, kg = lane >> 4;
    const bf16* U = (const bf16*)(F.ws + WS_U); bf16* OG = (bf16*)(F.ws + WS_OG); float* LSE = (float*)(F.ws + WS_LSE);
    const int h = unit & 3, rb = (unit >> 2) & 31, b = (unit >> 7) & 3, g = unit >> 9;
    const int dil = g == 0 ? 1 : (g == 1 ? 4 : 16), nb = 32 / dil, r = rb / nb, blk = rb % nb, hh = g * 4 + h;
    const float slope = exp2f(-8.0f * (float)(hh + 1) / 12.0f) * (float)dil;
#pragma unroll 1
    for (int hv = 0; hv < 3; ++hv) { v4u kreg[3], vreg[3];
#pragma unroll
      for (int it = 0; it < 3; ++it) { const int i = tid + 512 * (3 * hv + it), row = i >> 4, chp = i & 15, ch = chp ^ (((row & 3) << 2) | ((row >> 2) & 3));
          const int sub = blk * 128 + row - 128; kreg[it] = (v4u){0u, 0u, 0u, 0u}; vreg[it] = (v4u){0u, 0u, 0u, 0u};
          if (row < 256 && sub >= 0) { const size_t gr = (size_t)(b * SEQ + sub * dil + r) * NINP;
              kreg[it] = *(const GAS v4u*)(U + gr + U_KA + hh * 128 + ch * 8); vreg[it] = *(const GAS v4u*)(U + gr + U_VA + hh * 128 + ch * 8); } }
#pragma unroll
      for (int it = 0; it < 3; ++it) { const int i = tid + 512 * (3 * hv + it); if (i < 272 * 16) { *(LAS v4u*)(L + AT_K + i * 16) = kreg[it]; *(LAS v4u*)(L + AT_V + i * 16) = vreg[it]; } } }
    const int qi = 16 * w + m16; const size_t qrow = (size_t)(b * SEQ + (blk * 128 + qi) * dil + r);
    bf16x8 qf[4];
#pragma unroll
    for (int kb = 0; kb < 4; ++kb) qf[kb] = *(const GAS bf16x8*)(U + qrow * NINP + U_QA + hh * 128 + 32 * kb + 8 * kg);
    WG_BARRIER();
    f32x4 S[10];
    int kbase[4];
#pragma unroll
    for (int kb = 0; kb < 4; ++kb) kbase[kb] = AT_K + at_off(16 * w + m16, 4 * kb + kg);
#pragma unroll
    for (int kt = 0; kt < 10; ++kt) { S[kt] = (f32x4){0.f, 0.f, 0.f, 0.f};
#pragma unroll
        for (int kb = 0; kb < 4; ++kb) S[kt] = mfma16(*(const LAS bf16x8*)(L + kbase[kb] + kt * 4096), qf[kb], S[kt]); }
    const float sc = 0.08838834764831845f * 1.4426950408889634f, sl2 = slope * 1.4426950408889634f;
    float mx = -INFINITY;
#pragma unroll
    for (int kt = 0; kt < 10; ++kt)
#pragma unroll
        for (int jj = 0; jj < 4; ++jj) { const int kj = 16 * w + 16 * kt + 4 * kg + jj, delta = 128 + qi - kj;
            const bool ok = delta >= 0 && delta <= 128 && (blk > 0 || kj >= 128);
            const float v = ok ? S[kt][jj] * sc - sl2 * (float)delta : -INFINITY; S[kt][jj] = v; mx = fmaxf(mx, v); }
    mx = fmaxf(mx, __shfl_xor(mx, 16)); mx = fmaxf(mx, __shfl_xor(mx, 32));
    float sum = 0.f;
#pragma unroll
    for (int kt = 0; kt < 10; ++kt)
#pragma unroll
        for (int jj = 0; jj < 4; ++jj) { const float p = exp2f(S[kt][jj] - mx); S[kt][jj] = p; sum += p; }
    sum += __shfl_xor(sum, 16); sum += __shfl_xor(sum, 32);
    bf16x8 pb[5];
#pragma unroll
    for (int kb2 = 0; kb2 < 5; ++kb2) pb[kb2] = pack8(S[2 * kb2], S[2 * kb2 + 1]);
    f32x4 O[8];
    const int rq = m16 >> 2, cq = m16 & 3;
    unsigned vbase[8];
#pragma unroll
    for (int dt = 0; dt < 8; ++dt) vbase[dt] = (unsigned)(AT_V + at_off(16 * w + 4 * kg + rq, 2 * dt + (cq >> 1)) + 8 * (cq & 1));
#pragma unroll
    for (int dt = 0; dt < 8; ++dt) { O[dt] = (f32x4){0.f, 0.f, 0.f, 0.f}; bf16x4 lo[5], hi[5]; tr_read10(vbase[dt], lo, hi);
#pragma unroll
        for (int kb2 = 0; kb2 < 5; ++kb2) { bf16x8 vf; vf[0] = lo[kb2][0]; vf[1] = lo[kb2][1]; vf[2] = lo[kb2][2]; vf[3] = lo[kb2][3]; vf[4] = hi[kb2][0]; vf[5] = hi[kb2][1]; vf[6] = hi[kb2][2]; vf[7] = hi[kb2][3];
            O[dt] = mfma16(vf, pb[kb2], O[dt]); } }
    const float inv = 1.0f / sum;
#pragma unroll
    for (int dt = 0; dt < 8; ++dt) { v2u o; o.x = pk2(O[dt][0] * inv, O[dt][1] * inv); o.y = pk2(O[dt][2] * inv, O[dt][3] * inv);
        *(GAS v2u*)(OG + qrow * 1536 + hh * 128 + 16 * dt + 4 * kg) = o; }
    if (kg == 0) LSE[qrow * 12 + hh] = (mx + log2f(sum)) * 0.6931471805599453f;
    WG_BARRIER();
}

__device__ __forceinline__ float half_sum(float v) { v = row_sum16(v); v += __shfl_xor(v, 16); return v; }
__device__ __forceinline__ void attn_sample_unit(Frame& F, int unit) {
#ifdef NO_SATTN
    return;
#endif
    const int lane = F.lane, w = F.wave;
    const bf16* U = (const bf16*)(F.ws + WS_U); bf16* OG = (bf16*)(F.ws + WS_OG); float* LSE = (float*)(F.ws + WS_LSE);
    const int b = unit & 127, g = unit >> 7;
    const int s = w & 3, h = 2 * (w >> 2) + (lane >> 5), dl = lane & 31, hh = g * 4 + h;
    const int dil = g == 0 ? 1 : (g == 1 ? 4 : 16), wb = g == 0 ? 128 : (g == 1 ? 512 : 2048);
    const float* cache = F.in[g == 0 ? IN_C128 : (g == 1 ? IN_C512 : IN_C2048)] + (size_t)b * wb * 1024 + h * 128 + 4 * dl;
    const float L2E = 1.4426950408889634f;
    const float sl2 = exp2f(-8.0f * (float)(hh + 1) / 12.0f) * (float)dil * L2E;
    const size_t qrow = (size_t)(MP + 4 * b + s);
    f32x4 q; { const v2u qq = *(const GAS v2u*)(U + qrow * NINP + U_QA + hh * 128 + 4 * dl); const float sc = 0.08838834764831845f * L2E;
        q = (f32x4){bflo(qq.x) * sc, bfhi(qq.x) * sc, bflo(qq.y) * sc, bfhi(qq.y) * sc}; }
    float m = -INFINITY, l = 0.f; f32x4 o = {0.f, 0.f, 0.f, 0.f};
    const int jn = (g == 0) ? s : 0;
    for (int j = 0; j <= jn; ++j) { const size_t kr = (size_t)(MP + 4 * b + s - dil * j) * NINP + hh * 128 + 4 * dl;
        const v2u kk = *(const GAS v2u*)(U + kr + U_KA), vv = *(const GAS v2u*)(U + kr + U_VA);
        const float sc = half_sum(bflo(kk.x) * q[0] + bfhi(kk.x) * q[1] + bflo(kk.y) * q[2] + bfhi(kk.y) * q[3]) - sl2 * (float)j;
        const float mn = fmaxf(m, sc), al = exp2f(m - mn), p = exp2f(sc - mn); m = mn; l = l * al + p;
        o = o * al + (f32x4){bflo(vv.x), bfhi(vv.x), bflo(vv.y), bfhi(vv.y)} * p; }
    f32x4 kA[8], vA[8], kB[8], vB[8];
#define SA_LOAD(KF, VF, BLK) do { _Pragma("unroll") for (int i = 0; i < 8; ++i) { const int j = jn + 1 + 8 * (BLK) + i; int idx = wb + s - dil * j; idx = idx < 0 ? 0 : idx; \
        KF[i] = *(const GAS f32x4*)(cache + (size_t)idx * 1024); VF[i] = *(const GAS f32x4*)(cache + (size_t)idx * 1024 + 512); } } while (0)
#define SA_COMP(KF, VF, BLK) do { float sc[8]; float mb = -INFINITY; \
        _Pragma("unroll") for (int i = 0; i < 8; ++i) { const int j = jn + 1 + 8 * (BLK) + i; \
            float d = half_sum(KF[i][0] * q[0] + KF[i][1] * q[1] + KF[i][2] * q[2] + KF[i][3] * q[3]) - sl2 * (float)j; \
            d = (j <= 128) ? d : -INFINITY; sc[i] = d; mb = fmaxf(mb, d); } \
        const float mn = fmaxf(m, mb), al = exp2f(m - mn); m = mn; l *= al; o = o * al; \
        _Pragma("unroll") for (int i = 0; i < 8; ++i) { const float p = exp2f(sc[i] - mn); l += p; o = o + VF[i] * p; } } while (0)
    SA_LOAD(kA, vA, 0);
    for (int blk = 0; blk < 16; blk += 2) {
        SA_LOAD(kB, vB, blk + 1);
        SA_COMP(kA, vA, blk);
        if (blk + 2 < 16) SA_LOAD(kA, vA, blk + 2);
        SA_COMP(kB, vB, blk + 1);
    }
#undef SA_LOAD
#undef SA_COMP
    const float inv = 1.0f / l;
    v2u ov; ov.x = pk2(o[0] * inv, o[1] * inv); ov.y = pk2(o[2] * inv, o[3] * inv);
    *(GAS v2u*)(OG + qrow * 1536 + hh * 128 + 4 * dl) = ov;
    if (dl == 0) LSE[qrow * 12 + hh] = (m + log2f(l)) * 0.6931471805599453f;
}

__device__ __forceinline__ void attn_merge(Frame& F) {
    const bf16* OG = (const bf16*)(F.ws + WS_OG); const float* LSE = (const float*)(F.ws + WS_LSE); bf16* OA = (bf16*)(F.ws + WS_OA);
    const long gt = (long)F.bx * 512 + F.tid, NT = (long)F.G * 512;
    for (long c = gt; c < (long)MT * 64; c += NT) {
        const int row = (int)(c >> 6), hs = (int)(c >> 4) & 3, e8 = (int)c & 15;
        const float l0 = LSE[(size_t)row * 12 + hs], l1 = LSE[(size_t)row * 12 + 4 + hs], l2 = LSE[(size_t)row * 12 + 8 + hs];
        const float m = fmaxf(l0, fmaxf(l1, l2)); float w0 = __expf(l0 - m), w1 = __expf(l1 - m), w2 = __expf(l2 - m); const float inv = 1.0f / (w0 + w1 + w2); w0 *= inv; w1 *= inv; w2 *= inv;
        const v4u a = *(const GAS v4u*)(OG + (size_t)row * 1536 + hs * 128 + e8 * 8), bq = *(const GAS v4u*)(OG + (size_t)row * 1536 + (4 + hs) * 128 + e8 * 8), cq = *(const GAS v4u*)(OG + (size_t)row * 1536 + (8 + hs) * 128 + e8 * 8);
        v4u o;
        o.x = pk2(w0 * bflo(a.x) + w1 * bflo(bq.x) + w2 * bflo(cq.x), w0 * bfhi(a.x) + w1 * bfhi(bq.x) + w2 * bfhi(cq.x));
        o.y = pk2(w0 * bflo(a.y) + w1 * bflo(bq.y) + w2 * bflo(cq.y), w0 * bfhi(a.y) + w1 * bfhi(bq.y) + w2 * bfhi(cq.y));
        o.z = pk2(w0 * bflo(a.z) + w1 * bflo(bq.z) + w2 * bflo(cq.z), w0 * bfhi(a.z) + w1 * bfhi(bq.z) + w2 * bfhi(cq.z));
        o.w = pk2(w0 * bflo(a.w) + w1 * bflo(bq.w) + w2 * bflo(cq.w), w0 * bfhi(a.w) + w1 * bfhi(bq.w) + w2 * bfhi(cq.w));
        *(GAS v4u*)(OA + (size_t)row * 512 + hs * 128 + e8 * 8) = o;
    }
}

#ifndef MK_N_LAUNCHES
#define MK_N_LAUNCHES 1
#endif
constexpr int N_PHASES = 12;
struct Args { const float* in[23]; float* out; unsigned char* ws; int ph_lo, ph_hi, sub, qi; };
static_assert(sizeof(Args) == 23 * 8 + 8 + 8 + 16, "Args has no padding");

__device__ __forceinline__ int q_next(Frame& F, int qi) {
    if (F.tid == 0) F.MISC[16] = __hip_atomic_fetch_add((unsigned*)(F.ctl + CW_Q + 64 * qi), 1u, __ATOMIC_RELAXED, __HIP_MEMORY_SCOPE_AGENT);
    __syncthreads();
    const int v = (int)F.MISC[16];
    __syncthreads();
    return v;
}

#ifndef PH5_MASK
#define PH5_MASK 7
#endif
__device__ __forceinline__ void phase5(Frame& F, int qi, int sub) {
    if ((sub & 1) && F.bx < NB * 8) gdn_scan_chain(F, F.bx);
    if (F.bx >= 32 && F.bx < 96) for (;;) { const int u = q_next(F, 3 * qi); if (u >= 128) break; if (sub & 2) attn_sample_unit(F, 256 + u); }
    for (;;) { const int u = q_next(F, 3 * qi + 1); if (u >= 256) break; if (sub & 2) attn_sample_unit(F, (u < 128) ? 128 + u : u - 128); }
    for (;;) { const int u = q_next(F, 3 * qi + 2); if (u >= 1536) break; if (sub & 4) attn_prompt_unit(F, u); }
}
__global__ void __launch_bounds__(NWAVES * 64, 2) mk_fwd(Args args) {
    extern __shared__ __attribute__((aligned(16))) unsigned char lds[];
    Frame F;
    F.lds = (LAS unsigned char*)lds;
    { unsigned z = 0u; asm volatile("" : "+v"(z)); F.ldv = (LAS unsigned char*)lds + z; }
    F.MISC = (volatile LAS unsigned*)(F.lds + MISC_OFF);
    F.tid = threadIdx.x; F.lane = F.tid & 63; F.wave = __builtin_amdgcn_readfirstlane(F.tid >> 6);
    F.G = gridDim.x; F.bx = blockIdx.x;
    F.ws = args.ws; F.out = args.out; F.ctl = (gu32*)(args.ws + WS_CTL);
    F.in = args.in;
    for (int u = F.tid; u < (LDS_BYTES - LDSCTL_OFF) / 4; u += NWAVES * 64) ((LAS unsigned*)(F.lds + LDSCTL_OFF))[u] = 0u;
    __syncthreads();
    const bool one = (args.ph_hi - args.ph_lo) > 1;
    XcdBarrier bar; bar.bar = (unsigned*)(F.ctl + CW_BAR); bar.x = 0; bar.st = nullptr;
    if (one) bar = xcd_barrier_post((unsigned*)(F.ctl + CW_BAR), F.MISC + 8);
    const int lo = args.ph_lo, hi = args.ph_hi;
#ifndef PHASE_MASK
#define PHASE_MASK 0xFFF
#endif
#define IN(k) ((((PHASE_MASK) >> (k)) & 1) && lo <= (k) && (k) < hi)
#define SEAM(k) do { if (IN(k) && IN((k) + 1)) xcd_barrier(bar); } while (0)

    bf16* XB = (bf16*)(F.ws + WS_XB); bf16* ACT = (bf16*)(F.ws + WS_ACT); float* X1 = (float*)(F.ws + WS_X1); bf16* X1B = (bf16*)(F.ws + WS_X1B);
    bf16* UU = (bf16*)(F.ws + WS_U); float* BA = (float*)(F.ws + WS_BA); bf16* OB = (bf16*)(F.ws + WS_OB); bf16* OA = (bf16*)(F.ws + WS_OA);
    bf16* M1 = (bf16*)(F.ws + WS_M1); bf16* MG = (bf16*)(F.ws + WS_MG); float* X2 = (float*)(F.ws + WS_X2); bf16* X2B = (bf16*)(F.ws + WS_X2B);
    float* SSQ2 = (float*)(args.ws + WS_CTL) + CW_SSQ2; float* SSQ3 = (float*)(args.ws + WS_CTL) + CW_SSQ3; float* SSQ4 = (float*)(args.ws + WS_CTL) + CW_SSQ4;

#ifndef DUP_MASK
#define DUP_MASK 0
#endif
#define DUP(k) (((DUP_MASK) >> (k)) & 1)
    if (IN(0)) { p0_prologue(F); } SEAM(0);
    if (IN(1)) {
        pg8::Gemm g{XB, (const bf16*)(F.ws + WS_W1A), MT, NGU, D}; pg8::StaticOrder S; S.init(MT, NGU, F.G, F.bx);
        pg8::EpiSwiglu E{ACT, (const float*)(F.ws + WS_RSTD1), 0};
        pg8::gemm_phase<pg8::EpiSwiglu, pg8::StaticOrder, true, true>(F.lds + RING_OFF, g, S, E);
    } SEAM(1);
    if (IN(2)) {
        pg8::Gemm g{ACT, (const bf16*)(F.ws + WS_W1B), MP, D, FF}; pg8::StaticOrder S; S.init(MP, D, F.G, F.bx);
        pg8::EpiResid E{F.in[IN_XP], F.in[IN_XS] - (size_t)MP * D, X1, X1B, SSQ2, 0.5f};
        pg8::gemm_phase<pg8::EpiResid, pg8::StaticOrder, true, true>(F.lds + RING_OFF, g, S, E);
        if (args.sub & 8) skinny_resid<FF>(F, ACT, (const bf16*)(F.ws + WS_W1B), F.in[IN_XS] - (size_t)MP * D, X1, X1B, SSQ2, 0.5f);
    } SEAM(2);
    if (IN(3)) {
        pg8::Gemm g{X1B, (const bf16*)(F.ws + WS_WIN), MT, U_BA, D}; pg8::StaticOrder S; S.init(MT, U_BA, F.G, F.bx);
        pg8::EpiU E{UU, BA, SSQ2};
        pg8::gemm_phase<pg8::EpiU, pg8::StaticOrder, true, true>(F.lds + RING_OFF, g, S, E);
        skinny_ba(F, X1B, (const bf16*)(F.ws + WS_WIN), SSQ2, BA);
    } SEAM(3);
    if (IN(4)) {
        for (int i = F.bx; i < NREC + DB * 8; i += F.G) {
#ifndef PH4_MASK
#define PH4_MASK 7
#endif
            if (i < NREC) { if (args.sub & 1) { const int n = i >> 5, bh = i & 31; gdn_prep_unit(F, bh >> 3, bh & 7, n); } }
            else { if (args.sub & 2) { const int j = i - NREC; gdn_sample_unit(F, j >> 3, j & 7); } }
        }
        if (args.sub & 4) copy_outputs(F);
    } SEAM(4);
    if (IN(5)) {
        phase5(F, args.qi, args.sub);
    } SEAM(5);
    if (IN(6)) { attn_merge(F); } SEAM(6);
    if (IN(7)) {
        { pg8::Gemm g{OA, (const bf16*)(F.ws + WS_WPA), MP, D, 512}; pg8::StaticOrder S; S.init(MP, D, F.G, F.bx);
          pg8::EpiGate<0> E{UU, nullptr, M1};
          pg8::gemm_phase<pg8::EpiGate<0>, pg8::StaticOrder, true, true>(F.lds + RING_OFF, g, S, E); }
        { pg8::Gemm g{OB, (const bf16*)(F.ws + WS_WPB), MP, D, D}; pg8::StaticOrder S; S.init(MP, D, F.G, F.bx);
          pg8::EpiGate<1> E{UU, M1, MG};
          pg8::gemm_phase<pg8::EpiGate<1>, pg8::StaticOrder, true, true>(F.lds + RING_OFF, g, S, E); }
        if (args.sub & 8) skinny_merge(F, OA, (const bf16*)(F.ws + WS_WPA), OB, (const bf16*)(F.ws + WS_WPB), UU, MG);
    } SEAM(7);
    if (IN(8)) {
        pg8::Gemm g{MG, (const bf16*)(F.ws + WS_WOUT), MP, D, D}; pg8::StaticOrder S; S.init(MP, D, F.G, F.bx);
        pg8::EpiResid E{X1, X1, X2, X2B, SSQ3, 1.0f};
        pg8::gemm_phase<pg8::EpiResid, pg8::StaticOrder, true, true>(F.lds + RING_OFF, g, S, E);
        skinny_resid<D>(F, MG, (const bf16*)(F.ws + WS_WOUT), X1, X2, X2B, SSQ3, 1.0f);
    } SEAM(8);
    if (IN(9)) {
        pg8::Gemm g{X2B, (const bf16*)(F.ws + WS_W2A), MT, NGU, D}; pg8::StaticOrder S; S.init(MT, NGU, F.G, F.bx);
        pg8::EpiSwiglu E{ACT, SSQ3, 1};
        pg8::gemm_phase<pg8::EpiSwiglu, pg8::StaticOrder, true, true>(F.lds + RING_OFF, g, S, E);
    } SEAM(9);
    if (IN(10)) {
        pg8::Gemm g{ACT, (const bf16*)(F.ws + WS_W2B), MP, D, FF}; pg8::StaticOrder S; S.init(MP, D, F.G, F.bx);
        pg8::EpiResid E{X2, X2, F.out + O_Y, nullptr, SSQ4, 0.5f};
        pg8::gemm_phase<pg8::EpiResid, pg8::StaticOrder, true, true>(F.lds + RING_OFF, g, S, E);
        skinny_resid<FF>(F, ACT, (const bf16*)(F.ws + WS_W2B), X2, F.out + O_Y, nullptr, SSQ4, 0.5f);
    } SEAM(10);
    if (IN(11)) { final_norm(F); }
#undef IN
#undef SEAM
}

extern "C" void kernel_launch(void* const* d_in, const int* in_sizes, int n_in, void* d_out, int out_size, void* d_ws, size_t ws_size, hipStream_t stream) {
    static int grid = 0;
    if (grid == 0) {
        if (n_in != 23 || out_size != (int)O_END || ws_size < WS_END) { fprintf(stderr, "kernel_launch: unexpected sizes n_in %d out %d ws %zu (need %zu)\n", n_in, out_size, ws_size, (size_t)WS_END); grid = -1; return; }
        int dev = 0, cus = 0, per_cu = 0;
        if (hipGetDevice(&dev) != hipSuccess || hipDeviceGetAttribute(&cus, hipDeviceAttributeMultiprocessorCount, dev) != hipSuccess) { grid = -1; return; }
        if (hipFuncSetAttribute((const void*)mk_fwd, hipFuncAttributeMaxDynamicSharedMemorySize, LDS_BYTES) != hipSuccess) { fprintf(stderr, "kernel_launch: hipFuncSetAttribute failed\n"); grid = -1; return; }
        if (hipOccupancyMaxActiveBlocksPerMultiprocessor(&per_cu, (const void*)mk_fwd, NWAVES * 64, LDS_BYTES) != hipSuccess || per_cu < 1) { fprintf(stderr, "kernel_launch: occupancy query says %d\n", per_cu); per_cu = 1; }
        (void)hipGetLastError();
        grid = cus;
    }
    if (grid < 0) return;
    if (hipMemsetAsync((char*)d_ws + WS_CTL, 0, CTL_ZERO_BYTES, stream) != hipSuccess) return;
    Args a{};
    for (int i = 0; i < 23; ++i) a.in[i] = (const float*)d_in[i];
    a.out = (float*)d_out; a.ws = (unsigned char*)d_ws;
#if MK_N_LAUNCHES == 1
    a.ph_lo = 0; a.ph_hi = N_PHASES; a.sub = 15; a.qi = 0;
    hipLaunchKernelGGL(mk_fwd, dim3(grid), dim3(NWAVES * 64), LDS_BYTES, stream, a);
#ifdef EXTRA_MASK
    for (int p = 0; p < N_PHASES; ++p) if ((EXTRA_MASK >> p) & 1) { a.ph_lo = p; a.ph_hi = p + 1; a.sub = EXTRA_SUB; a.qi = 1; hipLaunchKernelGGL(mk_fwd, dim3(grid), dim3(NWAVES * 64), LDS_BYTES, stream, a); }
#endif
#else
    a.sub = 15; a.qi = 0;
    for (int p = 0; p < N_PHASES; ++p) { a.ph_lo = p; a.ph_hi = p + 1; hipLaunchKernelGGL(mk_fwd, dim3(grid), dim3(NWAVES * 64), LDS_BYTES, stream, a); }
#endif
}
```

```cpp
#include <hip/hip_runtime.h>
#include <cstdio>
#include <cstdint>
#define MK_N_LAUNCHES 1
namespace pg8 {
#define PG8_LAS __attribute__((address_space(3)))
typedef unsigned short bf16_t;
typedef short bf16x8 __attribute__((ext_vector_type(8)));
typedef float f32x4 __attribute__((ext_vector_type(4)));
typedef unsigned u32x4 __attribute__((ext_vector_type(4)));
constexpr int BM = 256, BK = 64, HALF = 128, HTB = HALF * BK * 2  , STAGE_BYTES = 8 * HTB, NXCD = 8, WGM = 8;

__host__ __device__ __forceinline__ int lds_byte(int r, int c) { const int st = (r >> 4) * 2 + (c >> 5), rr = r & 15, cc = c & 31, ob = rr * 64 + cc * 2; return st * 1024 + (ob ^ (((ob >> 9) & 1) << 5)); }
__host__ __device__ __forceinline__ void stage_rc(int b, int& R, int& C) { const int st = b / 1024, sb = b % 1024, swz = sb ^ (((sb >> 9) & 1) << 5); R = (st >> 1) * 16 + swz / 64; C = (st & 1) * 32 + (swz % 64) / 2; }
__host__ __device__ __forceinline__ int perm32(int rho) { const int n = rho >> 4, i = rho & 15; return 8 * (i >> 2) + 4 * n + (i & 3); }

struct Unit { int pm, pn; };
struct Gemm { const bf16_t* A; const bf16_t* Bt; int M, N, K; };
struct StaticOrder {
    int nM, nN, nwg, G, c;
    __host__ __device__ void init(int M, int N, int G_, int c_) { nM = M / BM; nN = N / BM; nwg = nM * nN; G = G_; c = c_; }
    __host__ __device__ bool next(int i, Unit& u) const {
        const long L = (long)i * G + c; if (L >= nwg) return false;
        int wgid = (int)L; { const int q = nwg / NXCD, r = nwg % NXCD, xcd = wgid % NXCD, off = wgid / NXCD; wgid = (xcd < r ? xcd * (q + 1) : r * (q + 1) + (xcd - r) * q) + off; }
        const int nig = WGM * nN, gid = wgid / nig, fm = gid * WGM, gsz = (nM - fm) < WGM ? (nM - fm) : WGM;
        u.pm = fm + ((wgid % nig) % gsz); u.pn = (wgid % nig) / gsz; return true;
    }
    __device__ __forceinline__ void a_ready(const Unit&) const {}
    __device__ __forceinline__ void done(const Unit&) const {}
};
__device__ __forceinline__ unsigned cvt_pk_bf16(float lo, float hi) { unsigned r; asm volatile("v_cvt_pk_bf16_f32 %0, %1, %2" : "=v"(r) : "v"(lo), "v"(hi)); return r; }
typedef float f32x2 __attribute__((ext_vector_type(2)));
template <class Epi, class Sched, bool ALIGN_EPI = false, bool SP2 = false>
__device__ __forceinline__ void gemm_phase(PG8_LAS unsigned char* lds, const Gemm g, const Sched& S, const Epi& E) {
    const int tid = threadIdx.x, wid = __builtin_amdgcn_readfirstlane(tid >> 6), lane = tid & 63, wr = wid >> 2, wc = wid & 3, fr = lane & 15, fq = lane >> 4;
    const int K = g.K, nt = K / BK;
    unsigned voffA[2], voffB[2];
#pragma unroll
    for (int i = 0; i < 2; ++i) { int R, C; stage_rc(tid * 16 + i * 8192, R, C); const int Rb = Epi::PERM ? ((R & ~31) + perm32(R & 31)) : R;
        voffA[i] = (unsigned)(R * K + C) * 2u; voffB[i] = (unsigned)(Rb * K + C) * 2u; }
    const size_t kstep = (size_t)(BK * 2);
    const size_t hstep = (size_t)HALF * K * 2;
    const size_t tstep = 2 * hstep;
    const unsigned ldsw = (unsigned)wid * 1024u;
    const int aoff = lds_byte(wr * 64 + fr, fq * 8), boff = lds_byte(wc * 32 + fr, fq * 8);
#define PG8_SA(b, h) (((b) * 2 + (h)) * HTB)
#define PG8_SB(b, h) ((4 + (b) * 2 + (h)) * HTB)
#define PG8_STAGE(bufoff, gbase, voff) do { _Pragma("unroll") for (int _i = 0; _i < 2; ++_i) \
        __builtin_amdgcn_global_load_lds((const unsigned*)((const char*)(gbase) + (voff)[_i]), (PG8_LAS unsigned*)(lds + (bufoff) + ldsw + _i * 8192), 16, 0, 0); } while (0)
#define PG8_LDA(dst, b, h) do { _Pragma("unroll") for (int m = 0; m < 4; ++m) _Pragma("unroll") for (int k = 0; k < 2; ++k) dst[m][k] = *(const PG8_LAS bf16x8*)(lds + PG8_SA(b, h) + aoff + m * 2048 + k * 1024); } while (0)
#define PG8_LDB(dst, b, h) do { _Pragma("unroll") for (int n = 0; n < 2; ++n) _Pragma("unroll") for (int k = 0; k < 2; ++k) dst[n][k] = *(const PG8_LAS bf16x8*)(lds + PG8_SB(b, h) + boff + n * 2048 + k * 1024); } while (0)
#define PG8_MMA(ai, bj, At, Bt) do { __builtin_amdgcn_s_setprio(1); _Pragma("unroll") for (int m = 0; m < 4; ++m) _Pragma("unroll") for (int n = 0; n < 2; ++n) _Pragma("unroll") for (int k = 0; k < 2; ++k) \
        acc[ai][bj][m][n] = __builtin_amdgcn_mfma_f32_16x16x32_bf16(Bt[n][k], At[m][k], acc[ai][bj][m][n], 0, 0, 0); __builtin_amdgcn_s_setprio(0); } while (0)
#define PG8_WAIT_V(n) asm volatile("s_waitcnt vmcnt(" #n ")" ::: "memory")
#define PG8_WAIT_L(n) asm volatile("s_waitcnt lgkmcnt(" #n ")" ::: "memory")
#define PG8_BAR __builtin_amdgcn_s_barrier()
#define PG8_SCHED __builtin_amdgcn_sched_barrier(0)
    Unit cur, nxt; int ui = 0;
    if (!S.next(0, cur)) return;
    f32x4 acc[2][2][4][2];
#pragma unroll
    for (int a = 0; a < 2; ++a)
#pragma unroll
        for (int b = 0; b < 2; ++b)
#pragma unroll
            for (int m = 0; m < 4; ++m)
#pragma unroll
                for (int n = 0; n < 2; ++n) acc[a][b][m][n] = (f32x4){0.f, 0.f, 0.f, 0.f};
    bf16x8 At[4][2], B0[2][2], B1[2][2];
    const char* cA = (const char*)g.A + (size_t)cur.pm * tstep; const char* cB = (const char*)g.Bt + (size_t)cur.pn * tstep;
    S.a_ready(cur);
    if constexpr (SP2) {
        PG8_STAGE(PG8_SB(0, 0), cB, voffB); PG8_STAGE(PG8_SB(0, 1), cB + hstep, voffB); PG8_STAGE(PG8_SA(0, 0), cA, voffA); PG8_STAGE(PG8_SA(0, 1), cA + hstep, voffA);
        if (wr == 1) PG8_BAR;
        PG8_WAIT_V(2); PG8_BAR;
        PG8_STAGE(PG8_SB(1, 0), cB + kstep, voffB); PG8_STAGE(PG8_SA(1, 0), cA + kstep, voffA); PG8_STAGE(PG8_SB(1, 1), cB + hstep + kstep, voffB);
        PG8_WAIT_V(6); PG8_BAR;
    } else {
        PG8_STAGE(PG8_SB(0, 0), cB, voffB); PG8_STAGE(PG8_SA(0, 0), cA, voffA); PG8_STAGE(PG8_SB(0, 1), cB + hstep, voffB); PG8_STAGE(PG8_SA(0, 1), cA + hstep, voffA);
        if (wr == 1) PG8_BAR;
        PG8_WAIT_V(4); PG8_BAR;
        PG8_STAGE(PG8_SB(1, 0), cB + kstep, voffB); PG8_STAGE(PG8_SA(1, 0), cA + kstep, voffA); PG8_STAGE(PG8_SB(1, 1), cB + hstep + kstep, voffB);
        PG8_WAIT_V(6); PG8_BAR;
    }
    for (;;) {
        const bool has_next = S.next(ui + 1, nxt);
        const char* nA = has_next ? (const char*)g.A + (size_t)nxt.pm * tstep : cA; const char* nB = has_next ? (const char*)g.Bt + (size_t)nxt.pn * tstep : cB;
        for (int t = 0; t < nt; t += 2) {
            const bool last = (t == nt - 2);
            const char* a1 = cA + (size_t)(t + 1) * kstep;
            const char* a2 = last ? nA : cA + (size_t)(t + 2) * kstep; const char* b2 = last ? nB : cB + (size_t)(t + 2) * kstep;
            const char* a3 = a2 + kstep; const char* b3 = b2 + kstep;
            if (last && has_next) S.a_ready(nxt);
            if constexpr (SP2) {
            PG8_LDB(B0, 0, 0); PG8_LDB(B1, 0, 1); PG8_SCHED; PG8_LDA(At, 0, 0); PG8_STAGE(PG8_SA(1, 1), a1 + hstep, voffA);
            PG8_WAIT_V(8); PG8_WAIT_L(0); PG8_BAR; PG8_MMA(0, 0, At, B0); PG8_MMA(0, 1, At, B1); PG8_BAR; PG8_SCHED;
            PG8_LDA(At, 0, 1); PG8_STAGE(PG8_SB(0, 0), b2, voffB); PG8_STAGE(PG8_SB(0, 1), b2 + hstep, voffB); PG8_STAGE(PG8_SA(0, 0), a2, voffA);
            PG8_WAIT_V(8); PG8_WAIT_L(0); PG8_BAR; PG8_MMA(1, 0, At, B0); PG8_MMA(1, 1, At, B1); PG8_BAR; PG8_SCHED;
            PG8_LDB(B0, 1, 0); PG8_LDB(B1, 1, 1); PG8_SCHED; PG8_LDA(At, 1, 0); PG8_STAGE(PG8_SA(0, 1), a2 + hstep, voffA);
            PG8_WAIT_V(8); PG8_WAIT_L(0); PG8_BAR; PG8_MMA(0, 0, At, B0); PG8_MMA(0, 1, At, B1); PG8_BAR; PG8_SCHED;
            PG8_LDA(At, 1, 1); PG8_STAGE(PG8_SB(1, 0), b3, voffB); PG8_STAGE(PG8_SB(1, 1), b3 + hstep, voffB); PG8_STAGE(PG8_SA(1, 0), a3, voffA);
            PG8_WAIT_V(8); PG8_WAIT_L(0); PG8_BAR; PG8_MMA(1, 0, At, B0); PG8_MMA(1, 1, At, B1); PG8_BAR; PG8_SCHED;
            } else {
            PG8_LDB(B0, 0, 0); PG8_SCHED; PG8_LDA(At, 0, 0); PG8_STAGE(PG8_SA(1, 1), a1 + hstep, voffA);
            PG8_WAIT_L(8); PG8_BAR; PG8_WAIT_L(0); PG8_MMA(0, 0, At, B0); PG8_BAR; PG8_SCHED;
            PG8_LDB(B1, 0, 1); PG8_STAGE(PG8_SB(0, 0), b2, voffB);
            PG8_BAR; PG8_WAIT_L(0); PG8_MMA(0, 1, At, B1); PG8_BAR;
            PG8_LDA(At, 0, 1); PG8_STAGE(PG8_SA(0, 0), a2, voffA);
            PG8_BAR; PG8_WAIT_L(0); PG8_MMA(1, 0, At, B0); PG8_BAR; PG8_SCHED;
            PG8_STAGE(PG8_SB(0, 1), b2 + hstep, voffB);
            PG8_WAIT_V(6); PG8_BAR; PG8_MMA(1, 1, At, B1); PG8_BAR;
            PG8_LDB(B0, 1, 0); PG8_SCHED; PG8_LDA(At, 1, 0); PG8_STAGE(PG8_SA(0, 1), a2 + hstep, voffA);
            PG8_WAIT_L(8); PG8_BAR; PG8_WAIT_L(0); PG8_MMA(0, 0, At, B0); PG8_BAR; PG8_SCHED;
            PG8_LDB(B1, 1, 1); PG8_STAGE(PG8_SB(1, 0), b3, voffB);
            PG8_BAR; PG8_WAIT_L(0); PG8_MMA(0, 1, At, B1); PG8_BAR;
            PG8_LDA(At, 1, 1); PG8_STAGE(PG8_SA(1, 0), a3, voffA);
            PG8_BAR; PG8_WAIT_L(0); PG8_MMA(1, 0, At, B0); PG8_BAR; PG8_SCHED;
            PG8_STAGE(PG8_SB(1, 1), b3 + hstep, voffB);
            PG8_WAIT_V(6); PG8_BAR; PG8_MMA(1, 1, At, B1); PG8_BAR;
            }
        }
        if constexpr (ALIGN_EPI) { if (wr == 0) PG8_BAR; }
        if constexpr (!Epi::AFTER_DRAIN) { E(acc, cur, wr, wc, fr, fq); S.done(cur); }
        if (!has_next) break;
#pragma unroll
        for (int a = 0; a < 2; ++a)
#pragma unroll
            for (int b = 0; b < 2; ++b)
#pragma unroll
                for (int m = 0; m < 4; ++m)
#pragma unroll
                    for (int n = 0; n < 2; ++n) acc[a][b][m][n] = (f32x4){0.f, 0.f, 0.f, 0.f};
        cur = nxt; cA = nA; cB = nB; ++ui;
        if constexpr (ALIGN_EPI) { if (wr == 1) PG8_BAR; }
    }
    PG8_WAIT_V(0);
    if constexpr (!ALIGN_EPI) { if (wr == 0) PG8_BAR; }
    PG8_BAR;
    if constexpr (Epi::AFTER_DRAIN) { E.fused(acc, cur, wr, wc, fr, fq, lds, wid, lane); S.done(cur); }
#undef PG8_SA
#undef PG8_SB
#undef PG8_STAGE
#undef PG8_LDA
#undef PG8_LDB
#undef PG8_MMA
#undef PG8_WAIT_V
#undef PG8_WAIT_L
#undef PG8_BAR
#undef PG8_SCHED
}
}

constexpr int D = 1024, MP = 16384, MS = 512, MT = MP + MS, FF = 2816, NGU = 2 * FF;
constexpr int SEQ = 4096, NB = 4, DB = 128, DS = 4;
constexpr int NIN = 10768, NINP = 11008;
constexpr int U_QA = 0, U_KA = 1536, U_VA = 3072, U_QKVB = 4608, U_Z = 7680, U_GATE = 8704, U_BA = 10752;
constexpr float EPS = 1e-6f;

namespace pg8 {
typedef unsigned u32x2 __attribute__((ext_vector_type(2)));
__device__ __forceinline__ float sigm(float x) { return 1.f / (1.f + __expf(-x)); }
__device__ __forceinline__ float bf2f(unsigned short b) { return __uint_as_float(((unsigned)b) << 16); }
__device__ __forceinline__ float bflo(unsigned w) { return __uint_as_float(w << 16); }
__device__ __forceinline__ float bfhi(unsigned w) { return __uint_as_float(w & 0xffff0000u); }

struct EpiSwiglu {
    static constexpr bool PERM = true, AFTER_DRAIN = false;
    bf16_t* O; const float* rs; int mode;
    __device__ __forceinline__ void operator()(const f32x4 (&acc)[2][2][4][2], const Unit& u, int wr, int wc, int fr, int fq) const {
        const int row0 = u.pm * BM + wr * 64 + fr, col0 = u.pn * 128 + wc * 32 + 8 * fq;
#pragma unroll
        for (int ai = 0; ai < 2; ++ai)
#pragma unroll
            for (int m = 0; m < 4; ++m) {
                const int row = row0 + ai * HALF + m * 16;
                float r = rs[row]; if (mode) r = rsqrtf(r * (1.0f / D) + EPS);
                float o[8];
#pragma unroll
                for (int n = 0; n < 2; ++n)
#pragma unroll
                    for (int j = 0; j < 4; ++j) { const float g = acc[ai][0][m][n][j] * r, up = acc[ai][1][m][n][j] * r; o[4 * n + j] = g * sigm(g) * up; }
                u32x4 w; w.x = cvt_pk_bf16(o[0], o[1]); w.y = cvt_pk_bf16(o[2], o[3]); w.z = cvt_pk_bf16(o[4], o[5]); w.w = cvt_pk_bf16(o[6], o[7]);
                *(u32x4*)(O + (size_t)row * FF + col0) = w;
            }
    }
};
struct EpiResid {
    static constexpr bool PERM = false, AFTER_DRAIN = false;
    const float* base; const float* base2; float* out; bf16_t* xb; float* ssq; float scale;
    __device__ __forceinline__ void operator()(const f32x4 (&acc)[2][2][4][2], const Unit& u, int wr, int wc, int fr, int fq) const {
        const int row0 = u.pm * BM + wr * 64 + fr, col0 = u.pn * BM + wc * 32 + 4 * fq;
        const float* base = (u.pm * BM < MP) ? this->base : base2;
#pragma unroll
        for (int ai = 0; ai < 2; ++ai)
#pragma unroll
            for (int m = 0; m < 4; ++m) {
                const int row = row0 + ai * HALF + m * 16; const size_t off = (size_t)row * D + col0; float s = 0.f;
#pragma unroll
                for (int bj = 0; bj < 2; ++bj)
#pragma unroll
                    for (int n = 0; n < 2; ++n) {
                        const f32x4 b = *(const f32x4*)(base + off + bj * HALF + n * 16); const f32x4 v = b + acc[ai][bj][m][n] * scale;
                        *(f32x4*)(out + off + bj * HALF + n * 16) = v;
                        if (xb) { u32x2 w; w.x = cvt_pk_bf16(v[0], v[1]); w.y = cvt_pk_bf16(v[2], v[3]); *(u32x2*)(xb + off + bj * HALF + n * 16) = w; }
                        s += (v[0] * v[0] + v[1] * v[1]) + (v[2] * v[2] + v[3] * v[3]);
                    }
                s += __shfl_xor(s, 16); s += __shfl_xor(s, 32);
                if (fq == 0) atomicAdd(ssq + row, s);
            }
    }
};
struct EpiU {
    static constexpr bool PERM = true, AFTER_DRAIN = false;
    bf16_t* U; float* BA; const float* ssq;
    __device__ __forceinline__ void operator()(const f32x4 (&acc)[2][2][4][2], const Unit& u, int wr, int wc, int fr, int fq) const {
        const int row0 = u.pm * BM + wr * 64 + fr, col0 = u.pn * BM + wc * 32 + 8 * fq;
        const bool ba = (u.pn * BM == U_BA);
#pragma unroll
        for (int ai = 0; ai < 2; ++ai)
#pragma unroll
            for (int m = 0; m < 4; ++m) {
                const int row = row0 + ai * HALF + m * 16; const float r = rsqrtf(ssq[row] * (1.0f / D) + EPS);
                if (!ba) {
#pragma unroll
                    for (int bj = 0; bj < 2; ++bj) { const f32x4 v0 = acc[ai][bj][m][0] * r, v1 = acc[ai][bj][m][1] * r;
                        u32x4 w; w.x = cvt_pk_bf16(v0[0], v0[1]); w.y = cvt_pk_bf16(v0[2], v0[3]); w.z = cvt_pk_bf16(v1[0], v1[1]); w.w = cvt_pk_bf16(v1[2], v1[3]);
                        *(u32x4*)(U + (size_t)row * NINP + col0 + bj * HALF) = w; }
                } else if (wc == 0 && fq < 2) {
                    *(f32x4*)(BA + (size_t)row * 16 + 8 * fq) = acc[ai][0][m][0] * r; *(f32x4*)(BA + (size_t)row * 16 + 8 * fq + 4) = acc[ai][0][m][1] * r;
                }
            }
    }
};
template <int SECOND> struct EpiGate {
    static constexpr bool PERM = true, AFTER_DRAIN = false;
    const bf16_t* U; const bf16_t* M1; bf16_t* O;
    __device__ __forceinline__ void operator()(const f32x4 (&acc)[2][2][4][2], const Unit& u, int wr, int wc, int fr, int fq) const {
        const int row0 = u.pm * BM + wr * 64 + fr, col0 = u.pn * BM + wc * 32 + 8 * fq;
#pragma unroll
        for (int ai = 0; ai < 2; ++ai)
#pragma unroll
            for (int m = 0; m < 4; ++m) {
                const int row = row0 + ai * HALF + m * 16;
#pragma unroll
                for (int bj = 0; bj < 2; ++bj) {
                    const int col = col0 + bj * HALF;
                    const u32x4 g = *(const u32x4*)(U + (size_t)row * NINP + U_GATE + SECOND * D + col);
                    float o[8]; const f32x4 a0 = acc[ai][bj][m][0], a1 = acc[ai][bj][m][1];
                    o[0] = sigm(bflo(g.x)) * a0[0]; o[1] = sigm(bfhi(g.x)) * a0[1]; o[2] = sigm(bflo(g.y)) * a0[2]; o[3] = sigm(bfhi(g.y)) * a0[3];
                    o[4] = sigm(bflo(g.z)) * a1[0]; o[5] = sigm(bfhi(g.z)) * a1[1]; o[6] = sigm(bflo(g.w)) * a1[2]; o[7] = sigm(bfhi(g.w)) * a1[3];
                    if (SECOND) { const u32x4 p = *(const u32x4*)(M1 + (size_t)row * D + col);
                        o[0] += bflo(p.x); o[1] += bfhi(p.x); o[2] += bflo(p.y); o[3] += bfhi(p.y); o[4] += bflo(p.z); o[5] += bfhi(p.z); o[6] += bflo(p.w); o[7] += bfhi(p.w); }
                    u32x4 w; w.x = cvt_pk_bf16(o[0], o[1]); w.y = cvt_pk_bf16(o[2], o[3]); w.z = cvt_pk_bf16(o[4], o[5]); w.w = cvt_pk_bf16(o[6], o[7]);
                    *(u32x4*)(O + (size_t)row * D + col) = w;
                }
            }
    }
};
}

#define GAS __attribute__((address_space(1)))
#define LAS __attribute__((address_space(3)))
typedef unsigned short bf16;
typedef unsigned v4u __attribute__((ext_vector_type(4)));
typedef unsigned v2u __attribute__((ext_vector_type(2)));
typedef float f32x4 __attribute__((ext_vector_type(4)));
typedef float f32x2 __attribute__((ext_vector_type(2)));
typedef short bf16x8 __attribute__((ext_vector_type(8)));
typedef short bf16x4 __attribute__((ext_vector_type(4)));
typedef GAS unsigned gu32;
#define RLX_AGENT __ATOMIC_RELAXED, __HIP_MEMORY_SCOPE_AGENT
#define LDS_WAIT() asm volatile("s_waitcnt lgkmcnt(0)" ::: "memory")
#define VM_WAIT() asm volatile("s_waitcnt vmcnt(0)" ::: "memory")
__device__ __forceinline__ unsigned f2bf(float f) { unsigned u = __builtin_bit_cast(unsigned, f); return (u + 0x7fffu + ((u >> 16) & 1u)) >> 16; }
typedef __bf16 bf16x2_t __attribute__((ext_vector_type(2)));
__device__ __forceinline__ unsigned pk2(float lo, float hi) { const bf16x2_t v = __builtin_convertvector((f32x2){lo, hi}, bf16x2_t); return __builtin_bit_cast(unsigned, v); }
__device__ __forceinline__ float bf2f(unsigned short b) { return __uint_as_float(((unsigned)b) << 16); }
__device__ __forceinline__ float bflo(unsigned w) { return __uint_as_float(w << 16); }
__device__ __forceinline__ float bfhi(unsigned w) { return __uint_as_float(w & 0xffff0000u); }
__device__ __forceinline__ float sigm(float x) { return 1.f / (1.f + __expf(-x)); }
__device__ __forceinline__ float siluf(float x) { return x / (1.f + __expf(-x)); }
__device__ __forceinline__ float wave_sum(float v) {
#pragma unroll
    for (int o = 1; o < 64; o <<= 1) v += __shfl_xor(v, o);
    return v;
}
__device__ __forceinline__ float wave_max(float v) {
#pragma unroll
    for (int o = 1; o < 64; o <<= 1) v = fmaxf(v, __shfl_xor(v, o));
    return v;
}
template <int CTRL> __device__ __forceinline__ float dpp_f(float v) { return __builtin_bit_cast(float, __builtin_amdgcn_update_dpp(0, __builtin_bit_cast(int, v), CTRL, 0xf, 0xf, true)); }
__device__ __forceinline__ float row_sum16(float v) { v += dpp_f<0xB1>(v); v += dpp_f<0x4E>(v); v += dpp_f<0x141>(v); v += dpp_f<0x140>(v); return v; }
__device__ __forceinline__ f32x4 mfma16(bf16x8 a, bf16x8 b, f32x4 c) { return __builtin_amdgcn_mfma_f32_16x16x32_bf16(a, b, c, 0, 0, 0); }
__device__ __forceinline__ bf16x8 pack8(f32x4 a, f32x4 b) {
    v4u w; w.x = pk2(a[0], a[1]); w.y = pk2(a[2], a[3]); w.z = pk2(b[0], b[1]); w.w = pk2(b[2], b[3]); return __builtin_bit_cast(bf16x8, w);
}
#define WG_BARRIER() do { asm volatile("s_waitcnt lgkmcnt(0)" ::: "memory"); __builtin_amdgcn_s_barrier(); asm volatile("" ::: "memory"); } while (0)
#define XB_TMO      128
#define XB_XCNT(j)  (256  + 64 * (j))
#define XB_XSUB(j)  (1280 + 64 * (j))
#define XB_XGEN(j)  (2304 + 64 * (j))
#define XB_TOP      3328
#define XB_TOPGEN   3392
#define XCD_BAR_WORDS 3456
#define XB_SPIN_CAP (1u << 18)

__device__ __forceinline__ unsigned xb_ld(unsigned* p)              { return __hip_atomic_load(p, __ATOMIC_RELAXED, __HIP_MEMORY_SCOPE_AGENT); }
__device__ __forceinline__ unsigned xb_add(unsigned* p, unsigned v) { return __hip_atomic_fetch_add(p, v, __ATOMIC_RELAXED, __HIP_MEMORY_SCOPE_AGENT); }
__device__ __forceinline__ unsigned xb_xcc_id() { return (unsigned)__builtin_amdgcn_s_getreg((3 << 11) | 20) & 0xFu; }
#define XB_SPIN(cond, bar) do { unsigned _sp = 0; while (cond) { __builtin_amdgcn_s_sleep(1); \
    if ((++_sp & 255u) == 0u) { if (xb_ld(&(bar)[XB_TMO])) break; if (_sp > XB_SPIN_CAP) { atomicAdd(&(bar)[XB_TMO], 1u); break; } } } } while (0)

struct XcdBarrier {
    unsigned* bar; unsigned x;
    volatile LAS unsigned* st;
};

__device__ __forceinline__ XcdBarrier xcd_barrier_post(unsigned* bar, volatile LAS unsigned* st) {
    XcdBarrier b; b.bar = bar; b.x = xb_xcc_id(); b.st = st;
    if (threadIdx.x == 0) (void)xb_add(&bar[XB_XCNT(b.x)], 1u);
    return b;
}
__device__ __forceinline__ void xcd_barrier_complete(unsigned* bar, unsigned x, unsigned& nloc, unsigned& nx) {
    const unsigned G = gridDim.x * gridDim.y * gridDim.z;
    unsigned sum, cnt, mine, sp = 0u;
    for (;;) {
        sum = 0u; cnt = 0u; mine = 0u;
#pragma unroll
        for (unsigned j = 0; j < 16; ++j) { const unsigned c = xb_ld(&bar[XB_XCNT(j)]); sum += c; cnt += (c > 0u) ? 1u : 0u; mine = (j == x) ? c : mine; }
        if (sum == G) break;
        __builtin_amdgcn_s_sleep(1);
        if ((++sp & 255u) == 0u) { if (xb_ld(&bar[XB_TMO])) break; if (sp > XB_SPIN_CAP) { atomicAdd(&bar[XB_TMO], 1u); break; } }
    }
    nloc = mine > 0u ? mine : 1u; nx = cnt > 0u ? cnt : 1u;
}

__device__ __forceinline__ void xcd_barrier(const XcdBarrier& b) {
    asm volatile("s_waitcnt vmcnt(0)" ::: "memory");
    __syncthreads();
    if (threadIdx.x == 0) {
        unsigned* bar = b.bar;
        __builtin_amdgcn_s_waitcnt(0);
        unsigned nloc = b.st[0], nx = b.st[1];
        if (nloc == 0u) { xcd_barrier_complete(bar, b.x, nloc, nx); b.st[0] = nloc; b.st[1] = nx; }
        const unsigned old = xb_add(&bar[XB_XSUB(b.x)], 1u);
        const unsigned gen = old / nloc;
        if (old + 1u == (gen + 1u) * nloc) {
            __builtin_amdgcn_fence(__ATOMIC_RELEASE, "agent");
            asm volatile("s_waitcnt vmcnt(0)" ::: "memory");
            const unsigned og = xb_add(&bar[XB_TOP], 1u);
            const unsigned tg = og / nx;
            if (og + 1u == (tg + 1u) * nx) xb_add(&bar[XB_TOPGEN], 1u);
            else XB_SPIN(xb_ld(&bar[XB_TOPGEN]) == tg, bar);
            __builtin_amdgcn_fence(__ATOMIC_ACQUIRE, "agent");
            xb_add(&bar[XB_XGEN(b.x)], 1u);
            asm volatile("s_waitcnt vmcnt(0)" ::: "memory");
        } else {
            XB_SPIN(xb_ld(&bar[XB_XGEN(b.x)]) == gen, bar);
            __builtin_amdgcn_fence(__ATOMIC_ACQUIRE, "agent");
            asm volatile("s_waitcnt vmcnt(0)" ::: "memory");
        }
    }
    __syncthreads();
}


constexpr size_t MiB = 1u << 20;
constexpr size_t al256(size_t x) { return (x + 255) & ~(size_t)255; }
constexpr size_t WS_CTL = 0, CTL_ZERO_BYTES = 1 * MiB;
constexpr size_t WS_W1A = 1 * MiB;
constexpr size_t WS_W1B = WS_W1A + (size_t)NGU * D * 2;
constexpr size_t WS_WIN = WS_W1B + (size_t)D * FF * 2;
constexpr size_t WS_WPA = WS_WIN + (size_t)NINP * D * 2;
constexpr size_t WS_WPB = WS_WPA + (size_t)D * 512 * 2;
constexpr size_t WS_WOUT = WS_WPB + (size_t)D * D * 2;
constexpr size_t WS_W2A = WS_WOUT + (size_t)D * D * 2;
constexpr size_t WS_W2B = WS_W2A + (size_t)NGU * D * 2;
constexpr size_t WS_XB = al256(WS_W2B + (size_t)D * FF * 2);
constexpr size_t WS_RSTD1 = WS_XB + (size_t)MT * D * 2;
constexpr size_t WS_ACT = al256(WS_RSTD1 + (size_t)MT * 4);
constexpr size_t WS_X1 = WS_ACT + (size_t)MT * FF * 2;
constexpr size_t WS_X1B = WS_X1 + (size_t)MT * D * 4;
constexpr size_t WS_U = WS_X1B + (size_t)MT * D * 2;
constexpr size_t WS_BA = WS_U + (size_t)MT * NINP * 2;
constexpr size_t REC_BYTES = 90112;
constexpr int NREC = NB * 8 * 64;
constexpr size_t WS_REC = WS_BA + (size_t)MT * 16 * 4;
constexpr size_t WS_GE = WS_REC + (size_t)NREC * REC_BYTES;
constexpr size_t WS_OB = al256(WS_GE + (size_t)NREC * 4);
constexpr size_t WS_OG = WS_OB + (size_t)MT * D * 2;
constexpr size_t WS_LSE = WS_OG + (size_t)MT * 1536 * 2;
constexpr size_t WS_OA = al256(WS_LSE + (size_t)MT * 12 * 4);
constexpr size_t WS_M1 = WS_OA + (size_t)MT * 512 * 2;
constexpr size_t WS_MG = WS_M1 + (size_t)MT * D * 2;
constexpr size_t WS_X2 = WS_MG + (size_t)MT * D * 2;
constexpr size_t WS_X2B = WS_X2 + (size_t)MT * D * 4;
constexpr size_t WS_END = WS_X2B + (size_t)MT * D * 2;
constexpr int CW_TMO = 0;
constexpr int CW_BAR = 4096;
constexpr int CW_Q = 8192;
constexpr int CW_SSQ2 = 16384, CW_SSQ3 = CW_SSQ2 + 17408, CW_SSQ4 = CW_SSQ3 + 17408;
static_assert((CW_SSQ4 + 17408) * 4 <= (int)CTL_ZERO_BYTES, "CTL words inside the memset region");

constexpr size_t O_Y = 0;
constexpr size_t O_KVP0 = (size_t)MT * D;
constexpr size_t O_KVP1 = O_KVP0 + 524288;
constexpr size_t O_KVP2 = O_KVP1 + 2097152;
constexpr size_t O_CONVP = O_KVP2 + 8388608;
constexpr size_t O_SSMP = O_CONVP + 36864;
constexpr size_t O_KVS0 = O_SSMP + 524288;
constexpr size_t O_KVS1 = O_KVS0 + 524288;
constexpr size_t O_KVS2 = O_KVS1 + 524288;
constexpr size_t O_CONVS = O_KVS2 + 524288;
constexpr size_t O_SSMS = O_CONVS + 1179648;
constexpr size_t O_END = O_SSMS + 16777216;

constexpr int NWAVES = 8;
constexpr int RING_OFF = 0;
constexpr int LDSCTL_OFF = 151552, MISC_OFF = LDSCTL_OFF + 320;
constexpr int LDS_BYTES = 155648;

struct Frame {
    LAS unsigned char* lds;
    LAS unsigned char* ldv;
    volatile LAS unsigned* MISC;
    gu32* ctl;
    int tid, lane, wave, G, bx;
    const float* const* in; float* out; unsigned char* ws;
};
#define IN_XP 0
#define IN_XS 1
#define IN_C128 2
#define IN_C512 3
#define IN_C2048 4
#define IN_SCONV 5
#define IN_SSSM 6
#define IN_NF1 7
#define IN_W1GU 8
#define IN_W1D 9
#define IN_NMIX 10
#define IN_WIN 11
#define IN_CONVW 12
#define IN_ALOG 13
#define IN_DTB 14
#define IN_GNORM 15
#define IN_WPA 16
#define IN_WPB 17
#define IN_WOUT 18
#define IN_NF2 19
#define IN_W2GU 20
#define IN_W2D 21
#define IN_NOUT 22

template <class Map>
__device__ __forceinline__ void p0_transpose_item(const float* W, int K, int N, bf16* WT, const float* gain, LAS float* scr, int item, int lane, Map map) {
    const int nblk = (N + 31) / 32, kb = item / nblk, nb = item % nblk, k0 = 64 * kb, n0 = 32 * nb;
    const int nc = n0 + (lane & 31); const bool okc = nc < N;
    float wv[32];
#pragma unroll
    for (int i = 0; i < 32; ++i) { const int kk = 2 * i + (lane >> 5); wv[i] = okc ? W[(size_t)(k0 + kk) * N + nc] : 0.f; }
    if (gain) {
#pragma unroll
        for (int i = 0; i < 32; ++i) wv[i] *= gain[k0 + 2 * i + (lane >> 5)]; }
#pragma unroll
    for (int i = 0; i < 32; ++i) scr[(2 * i + (lane >> 5)) * 33 + (lane & 31)] = wv[i];
    LDS_WAIT(); asm volatile("" ::: "memory");
    const int c = lane & 7;
#pragma unroll
    for (int j = 0; j < 4; ++j) { const int n = (lane >> 3) + 8 * j; const LAS float* s = scr + (8 * c) * 33 + n;
        v4u o; o.x = pk2(s[0 * 33], s[1 * 33]); o.y = pk2(s[2 * 33], s[3 * 33]); o.z = pk2(s[4 * 33], s[5 * 33]); o.w = pk2(s[6 * 33], s[7 * 33]);
        if (n0 + n < N) *(GAS v4u*)(WT + (size_t)map(n0 + n) * K + k0 + 8 * c) = o; }
    LDS_WAIT(); asm volatile("" ::: "memory");
}
struct MapId { __device__ __forceinline__ int operator()(int c) const { return c; } };
struct MapGU { __device__ __forceinline__ int operator()(int c) const { return c < FF ? 256 * (c >> 7) + (c & 127) : 256 * ((c - FF) >> 7) + 128 + ((c - FF) & 127); } };
struct MapIn { __device__ __forceinline__ int operator()(int c) const { return c < 8704 ? c : (c < 8720 ? U_BA + (c - 8704) : c - 16); } };

__device__ __forceinline__ void p0_prologue(Frame& F) {
    LAS float* scr = (LAS float*)(F.ldv + RING_OFF + F.wave * 16384);
    const int gw = F.bx * NWAVES + F.wave, NGW = F.G * NWAVES;
    bf16* W1A = (bf16*)(F.ws + WS_W1A); bf16* W1B = (bf16*)(F.ws + WS_W1B); bf16* WIN = (bf16*)(F.ws + WS_WIN); bf16* WPA = (bf16*)(F.ws + WS_WPA);
    bf16* WPB = (bf16*)(F.ws + WS_WPB); bf16* WOUT = (bf16*)(F.ws + WS_WOUT); bf16* W2A = (bf16*)(F.ws + WS_W2A); bf16* W2B = (bf16*)(F.ws + WS_W2B);
    constexpr int I_GU = (D / 64) * (NGU / 32), I_DN = (FF / 64) * (D / 32), I_IN = (D / 64) * ((NIN + 31) / 32), I_PA = (512 / 64) * (D / 32), I_DD = (D / 64) * (D / 32);
    constexpr int NITEMS = 2 * I_GU + 2 * I_DN + I_IN + I_PA + 2 * I_DD;
    for (int it = gw; it < NITEMS; it += NGW) {
        int r = it;
        if (r < I_GU) { p0_transpose_item(F.in[IN_W1GU], D, NGU, W1A, F.in[IN_NF1], scr, r, F.lane, MapGU()); continue; } r -= I_GU;
        if (r < I_GU) { p0_transpose_item(F.in[IN_W2GU], D, NGU, W2A, F.in[IN_NF2], scr, r, F.lane, MapGU()); continue; } r -= I_GU;
        if (r < I_DN) { p0_transpose_item(F.in[IN_W1D], FF, D, W1B, nullptr, scr, r, F.lane, MapId()); continue; } r -= I_DN;
        if (r < I_DN) { p0_transpose_item(F.in[IN_W2D], FF, D, W2B, nullptr, scr, r, F.lane, MapId()); continue; } r -= I_DN;
        if (r < I_IN) { p0_transpose_item(F.in[IN_WIN], D, NIN, WIN, F.in[IN_NMIX], scr, r, F.lane, MapIn()); continue; } r -= I_IN;
        if (r < I_PA) { p0_transpose_item(F.in[IN_WPA], 512, D, WPA, nullptr, scr, r, F.lane, MapId()); continue; } r -= I_PA;
        if (r < I_DD) { p0_transpose_item(F.in[IN_WPB], D, D, WPB, nullptr, scr, r, F.lane, MapId()); continue; } r -= I_DD;
        p0_transpose_item(F.in[IN_WOUT], D, D, WOUT, nullptr, scr, r, F.lane, MapId());
    }
    { const int gt = F.bx * 512 + F.tid, NT = F.G * 512; GAS v4u* z = (GAS v4u*)(WIN + (size_t)NIN * D);
      for (int i = gt; i < (NINP - NIN) * D / 8; i += NT) z[i] = (v4u){0u, 0u, 0u, 0u}; }
    bf16* XB = (bf16*)(F.ws + WS_XB); float* RSTD1 = (float*)(F.ws + WS_RSTD1);
    for (int m0 = gw; m0 < MT; m0 += 2 * NGW) {
        f32x4 v[2][4]; float s[2];
#pragma unroll
        for (int r = 0; r < 2; ++r) { const int m = m0 + r * NGW; s[r] = 0.f;
            if (m < MT) { const float* xrow = (m < MP) ? F.in[IN_XP] + (size_t)m * D : F.in[IN_XS] + (size_t)(m - MP) * D; const GAS f32x4* xr = (const GAS f32x4*)xrow + F.lane;
#pragma unroll
                for (int j = 0; j < 4; ++j) v[r][j] = xr[64 * j]; } }
#pragma unroll
        for (int r = 0; r < 2; ++r) { const int m = m0 + r * NGW;
            if (m < MT) {
#pragma unroll
                for (int j = 0; j < 4; ++j) s[r] += (v[r][j].x * v[r][j].x + v[r][j].y * v[r][j].y) + (v[r][j].z * v[r][j].z + v[r][j].w * v[r][j].w);
                float t = row_sum16(s[r]); t += __shfl_xor(t, 16); t += __shfl_xor(t, 32);
                GAS v2u* o8 = (GAS v2u*)(XB + (size_t)m * D) + F.lane;
#pragma unroll
                for (int j = 0; j < 4; ++j) { v2u w; w.x = pk2(v[r][j].x, v[r][j].y); w.y = pk2(v[r][j].z, v[r][j].w); o8[64 * j] = w; }
                if (F.lane == 0) RSTD1[m] = rsqrtf(t * (1.0f / D) + EPS); } }
    }
}

__device__ __forceinline__ void final_norm(Frame& F) {
    const int gw = F.bx * NWAVES + F.wave, NGW = F.G * NWAVES;
    const float* ssq = (const float*)(F.ctl + CW_SSQ4); const GAS f32x4* nw = (const GAS f32x4*)F.in[IN_NOUT] + F.lane;
    f32x4 g[4];
#pragma unroll
    for (int j = 0; j < 4; ++j) g[j] = nw[64 * j];
    for (int m = gw; m < MT; m += NGW) {
        const float r = rsqrtf(ssq[m] * (1.0f / D) + EPS);
        GAS f32x4* xr = (GAS f32x4*)(F.out + O_Y + (size_t)m * D) + F.lane;
#pragma unroll
        for (int j = 0; j < 4; ++j) { f32x4 v = xr[64 * j]; xr[64 * j] = v * r * g[j]; }
    }
}

template <int K>
__device__ __forceinline__ void skinny_partial(const bf16* A, const bf16* Bt, int r0, int c0, int w, int lane, LAS unsigned char* part) {
    const int m16 = lane & 15, kg = lane >> 4;
    f32x4 acc[2][4];
#pragma unroll
    for (int i = 0; i < 2; ++i)
#pragma unroll
        for (int j = 0; j < 4; ++j) acc[i][j] = (f32x4){0.f, 0.f, 0.f, 0.f};
    const bf16* ap = A + (size_t)(r0 + m16) * K + w * (K / 8) + 8 * kg; const bf16* bp = Bt + (size_t)(c0 + m16) * K + w * (K / 8) + 8 * kg;
#pragma unroll 4
    for (int kb = 0; kb < K / 256; ++kb) {
        bf16x8 a[2], bq[4];
#pragma unroll
        for (int i = 0; i < 2; ++i) a[i] = *(const GAS bf16x8*)(ap + (size_t)16 * i * K + 32 * kb);
#pragma unroll
        for (int j = 0; j < 4; ++j) bq[j] = *(const GAS bf16x8*)(bp + (size_t)16 * j * K + 32 * kb);
#pragma unroll
        for (int i = 0; i < 2; ++i)
#pragma unroll
            for (int j = 0; j < 4; ++j) acc[i][j] = mfma16(bq[j], a[i], acc[i][j]);
    }
#pragma unroll
    for (int i = 0; i < 2; ++i)
#pragma unroll
        for (int j = 0; j < 4; ++j) *(LAS f32x4*)(part + ((w * 8 + i * 4 + j) * 64 + lane) * 16) = acc[i][j];
}
__device__ __forceinline__ f32x4 skinny_reduce(const LAS unsigned char* part, int w, int lane) {
    f32x4 s = {0.f, 0.f, 0.f, 0.f};
#pragma unroll
    for (int p = 0; p < 8; ++p) s = s + *(const LAS f32x4*)(part + ((p * 8 + w) * 64 + lane) * 16);
    return s;
}
template <int K>
__device__ __forceinline__ void skinny_resid(Frame& F, const bf16* A, const bf16* Bt, const float* base, float* out, bf16* xb, float* ssq, float scale) {
    const int lane = F.lane, w = F.wave, m16 = lane & 15, kg = lane >> 4, wr = w >> 2, wc = w & 3;
    for (int t = F.bx; t < 256; t += F.G) {
        const int r0 = MP + 32 * (t >> 4), c0 = 64 * (t & 15);
        skinny_partial<K>(A, Bt, r0, c0, w, lane, F.ldv);
        WG_BARRIER();
        const f32x4 acc = skinny_reduce(F.ldv, w, lane);
        const int row = r0 + 16 * wr + m16;
        const size_t off = (size_t)row * D + c0 + 16 * wc + 4 * kg;
        const f32x4 v = *(const GAS f32x4*)(base + off) + acc * scale;
        *(GAS f32x4*)(out + off) = v;
        if (xb) { v2u pk; pk.x = pk2(v[0], v[1]); pk.y = pk2(v[2], v[3]); *(GAS v2u*)(xb + off) = pk; }
        float s = (v[0] * v[0] + v[1] * v[1]) + (v[2] * v[2] + v[3] * v[3]);
        s += __shfl_xor(s, 16); s += __shfl_xor(s, 32);
        if (kg == 0) atomicAdd(ssq + row, s);
        WG_BARRIER();
    }
}
__device__ __forceinline__ void skinny_merge(Frame& F, const bf16* OA, const bf16* WPA, const bf16* OB, const bf16* WPB, const bf16* U, bf16* MG) {
    const int lane = F.lane, w = F.wave, m16 = lane & 15, kg = lane >> 4, wr = w >> 2, wc = w & 3;
    for (int t = F.bx; t < 256; t += F.G) {
        const int r0 = MP + 32 * (t >> 4), c0 = 64 * (t & 15);
        skinny_partial<512>(OA, WPA, r0, c0, w, lane, F.ldv);
        skinny_partial<D>(OB, WPB, r0, c0, w, lane, F.ldv + 65536);
        WG_BARRIER();
        const f32x4 aa = skinny_reduce(F.ldv, w, lane), ab = skinny_reduce(F.ldv + 65536, w, lane);
        const int row = r0 + 16 * wr + m16, col = c0 + 16 * wc + 4 * kg;
        const v2u ga = *(const GAS v2u*)(U + (size_t)row * NINP + U_GATE + col), gb = *(const GAS v2u*)(U + (size_t)row * NINP + U_GATE + D + col);
        v2u o; o.x = pk2(sigm(bflo(ga.x)) * aa[0] + sigm(bflo(gb.x)) * ab[0], sigm(bfhi(ga.x)) * aa[1] + sigm(bfhi(gb.x)) * ab[1]);
        o.y = pk2(sigm(bflo(ga.y)) * aa[2] + sigm(bflo(gb.y)) * ab[2], sigm(bfhi(ga.y)) * aa[3] + sigm(bfhi(gb.y)) * ab[3]);
        *(GAS v2u*)(MG + (size_t)row * D + col) = o;
        WG_BARRIER();
    }
}
__device__ __forceinline__ void skinny_ba(Frame& F, const bf16* X1B, const bf16* WIN, const float* ssq, float* BA) {
    const int lane = F.lane, m16 = lane & 15, kg = lane >> 4;
    for (int t = F.bx * NWAVES + F.wave; t < MT / 16; t += F.G * NWAVES) {
        const int row = 16 * t + m16;
        f32x4 acc = {0.f, 0.f, 0.f, 0.f}; { const bf16* ap = X1B + (size_t)row * D + 8 * kg; const bf16* bp = WIN + (size_t)(U_BA + m16) * D + 8 * kg;
#pragma unroll 16
            for (int kb = 0; kb < D / 32; ++kb) acc = mfma16(*(const GAS bf16x8*)(bp + 32 * kb), *(const GAS bf16x8*)(ap + 32 * kb), acc); }
        *(GAS f32x4*)(BA + (size_t)row * 16 + 4 * kg) = acc * rsqrtf(ssq[row] * (1.0f / D) + EPS);
    }
}

constexpr int GP_QR = 0, GP_KR = 17408, GP_KT = 34816, GP_KBG = 53248, GP_BVT = 71680, GP_GKK = 90112, GP_GQK = 107520, GP_TI = 124928, GP_TAB = 134144;
constexpr int GKP = 68;
__device__ __forceinline__ f32x4 mfma4(float a, float b, f32x4 c) { return __builtin_amdgcn_mfma_f32_16x16x4f32(a, b, c, 0, 0, 0); }
__device__ __forceinline__ f32x4 prod_ll(const LAS float* A, int ra, int ca, const LAS float* B, int rb, int cb, f32x4 c, int m16, int kg) {
    const f32x4 av = *(const LAS f32x4*)(A + (ra + m16) * GKP + ca + 4 * kg);
#pragma unroll
    for (int t = 0; t < 4; ++t) c = mfma4(av[t], B[(rb + 4 * kg + t) * GKP + cb + m16], c);
    return c;
}
__device__ __forceinline__ f32x4 prod_lr(const LAS float* A, int ra, int ca, f32x4 x, f32x4 c, int m16, int kg) {
    const f32x4 av = *(const LAS f32x4*)(A + (ra + m16) * GKP + ca + 4 * kg);
#pragma unroll
    for (int t = 0; t < 4; ++t) c = mfma4(av[t], x[t], c);
    return c;
}
__device__ __forceinline__ float softplusf(float x) { return x > 20.f ? x : log1pf(__expf(x)); }

struct PrepIn { v2u raw[19]; v4u zr0, zr1; f32x4 w0, w1, w2, w3; float bl, al; };
__device__ __forceinline__ void prep_fetch(Frame& F, int b, int h, int n, PrepIn& in) {
    const bf16* U = (const bf16*)(F.ws + WS_U); const float* BA = (const float*)(F.ws + WS_BA);
    const int tid = F.tid, row_base = b * SEQ + 64 * n;
    const int gz_t = tid >> 3, gz_c = (tid & 7) * 16;
    in.zr0 = *(const GAS v4u*)(U + (size_t)(row_base + gz_t) * NINP + U_Z + h * 128 + gz_c); in.zr1 = *(const GAS v4u*)(U + (size_t)(row_base + gz_t) * NINP + U_Z + h * 128 + gz_c + 8);
    const int cv_cq = tid & 31, cv_tq = (tid >> 5) & 3, cv_tensor = tid >> 7, cv_cw = cv_tensor * 1024 + h * 128 + 4 * cv_cq, cv_t0 = 16 * cv_tq;
    if (tid < 384) {
        in.w0 = *(const GAS f32x4*)(F.in[IN_CONVW] + cv_cw); in.w1 = *(const GAS f32x4*)(F.in[IN_CONVW] + 3072 + cv_cw); in.w2 = *(const GAS f32x4*)(F.in[IN_CONVW] + 2 * 3072 + cv_cw); in.w3 = *(const GAS f32x4*)(F.in[IN_CONVW] + 3 * 3072 + cv_cw);
#pragma unroll
        for (int i = 0; i < 19; ++i) { const int tok = 64 * n + cv_t0 - 3 + i; in.raw[i] = (v2u){0u, 0u}; if (tok >= 0) in.raw[i] = *(const GAS v2u*)(U + (size_t)(b * SEQ + tok) * NINP + U_QKVB + cv_cw); }
    }
    if (F.wave == 0) { in.bl = BA[(size_t)(row_base + F.lane) * 16 + h]; in.al = BA[(size_t)(row_base + F.lane) * 16 + 8 + h]; }
}
__device__ __forceinline__ void gdn_prep_unit(Frame& F, int b, int h, int n, PrepIn& in, bool has_next, int nb_, int nh_, int nn_) {
    LAS unsigned char* L = F.ldv;
    LAS float* TAB = (LAS float*)(L + GP_TAB);
    LAS float* GKK = (LAS float*)(L + GP_GKK);
    LAS float* GQK = (LAS float*)(L + GP_GQK);
    const bf16* U = (const bf16*)(F.ws + WS_U); const float* BA = (const float*)(F.ws + WS_BA);
    const int tid = F.tid, lane = F.lane, wave = F.wave;
    const int uidx = (b * 8 + h) * 64 + n;
    unsigned char* rec = F.ws + WS_REC + (size_t)uidx * REC_BYTES;
    const int row_base = b * SEQ + 64 * n;
    const int gz_t = tid >> 3, gz_c = (tid & 7) * 16;
    const int cv_cq = tid & 31, cv_tq = (tid >> 5) & 3, cv_tensor = tid >> 7, cv_c0 = 4 * cv_cq, cv_t0 = 16 * cv_tq;
    if (wave == 0) {
        const int t = lane; const float bl = in.bl, al = in.al;
        const float beta = sigm(bl); const float g = -__expf(F.in[IN_ALOG][h]) * softplusf(al + F.in[IN_DTB][h]);
        float gc = g;
#pragma unroll
        for (int o = 1; o < 64; o <<= 1) { const float v = __shfl_up(gc, o); if (lane >= o) gc += v; }
        const float gl = __shfl(gc, 63);
        TAB[t] = beta; TAB[64 + t] = gc; TAB[128 + t] = __expf(gc); TAB[192 + t] = __expf(gl - gc);
        if (lane == 0) ((float*)(F.ws + WS_GE))[uidx] = __expf(gl);
    }
    WG_BARRIER();
    if (tid < 384) {
        const int tensor = cv_tensor, c0 = cv_c0, t0 = cv_t0;
        f32x4 x[19];
#pragma unroll
        for (int i = 0; i < 19; ++i) x[i] = (f32x4){bflo(in.raw[i].x), bfhi(in.raw[i].x), bflo(in.raw[i].y), bfhi(in.raw[i].y)};
        const f32x4 w0 = in.w0, w1 = in.w1, w2 = in.w2, w3 = in.w3;
        unsigned tp[4][8];
#pragma unroll
        for (int i = 0; i < 16; ++i) { f32x4 y = w0 * x[i] + w1 * x[i + 1] + w2 * x[i + 2] + w3 * x[i + 3];
#pragma unroll
            for (int e = 0; e < 4; ++e) y[e] = siluf(y[e]);
            if (tensor == 2) y = y * TAB[t0 + i];
            if (tensor < 2) { v2u pk; pk.x = pk2(y[0], y[1]); pk.y = pk2(y[2], y[3]); *(LAS v2u*)(L + (tensor == 0 ? GP_QR : GP_KR) + (t0 + i) * 272 + 2 * c0) = pk; }
            if (tensor > 0) {
#pragma unroll
                for (int e = 0; e < 4; ++e) { const unsigned bq = f2bf(y[e]); if (i & 1) tp[e][i >> 1] |= bq << 16; else tp[e][i >> 1] = bq; } }
        }
        if (tensor > 0) {
#pragma unroll
            for (int e = 0; e < 4; ++e) { LAS unsigned char* dst = L + (tensor == 1 ? GP_KT : GP_BVT) + (c0 + e) * 144 + 2 * t0;
                *(LAS v4u*)dst = (v4u){tp[e][0], tp[e][1], tp[e][2], tp[e][3]}; *(LAS v4u*)(dst + 16) = (v4u){tp[e][4], tp[e][5], tp[e][6], tp[e][7]}; } }
    }
    WG_BARRIER();
    { const unsigned zi[8] = {in.zr0.x, in.zr0.y, in.zr0.z, in.zr0.w, in.zr1.x, in.zr1.y, in.zr1.z, in.zr1.w}; unsigned zo[8];
#pragma unroll
      for (int i = 0; i < 8; ++i) { const float za = bflo(zi[i]), zb = bfhi(zi[i]); const f32x2 nw2 = *(const GAS f32x2*)(F.in[IN_GNORM] + gz_c + 2 * i);
          zo[i] = pk2(za * sigm(za) * nw2[0], zb * sigm(zb) * nw2[1]); }
      *(GAS v4u*)(rec + 73728 + (gz_t * 128 + gz_c) * 2) = (v4u){zo[0], zo[1], zo[2], zo[3]}; *(GAS v4u*)(rec + 73728 + (gz_t * 128 + gz_c + 8) * 2) = (v4u){zo[4], zo[5], zo[6], zo[7]}; }
    if (has_next) prep_fetch(F, nb_, nh_, nn_, in);
    {
        const int m16 = lane & 15, kg = lane >> 4;
        for (int job = wave; job < 24; job += 8) {
            int kind, it, jt;
            if (job < 20) { kind = job >= 10; int j = job % 10; it = 0; while (j > it) { j -= it + 1; ++it; } jt = j; }
            else { kind = 2; it = jt = job - 20; }
            const int abase = (kind == 2 ? GP_QR : GP_KR) + (16 * (kind == 1 ? jt : it) + m16) * 272 + 16 * kg;
            const int bbase = (kind == 0 ? GP_KR : GP_QR) + (16 * (kind == 0 ? jt : it) + m16) * 272 + 16 * kg;
            f32x4 acc = {0.f, 0.f, 0.f, 0.f};
#pragma unroll
            for (int kb = 0; kb < 4; ++kb) { const bf16x8 a = *(const LAS bf16x8*)(L + abase + 64 * kb), bb = *(const LAS bf16x8*)(L + bbase + 64 * kb); acc = mfma16(a, bb, acc); }
            if (kind == 0) {
#pragma unroll
                for (int jj = 0; jj < 4; ++jj) GKK[(16 * it + 4 * kg + jj) * GKP + 16 * jt + m16] = acc[jj];
            } else if (kind == 1) {
                *(LAS f32x4*)(GQK + (16 * it + m16) * 68 + 16 * jt + 4 * kg) = acc;
            } else {
#pragma unroll
                for (int jj = 0; jj < 4; ++jj) if (4 * kg + jj == m16) TAB[576 + 16 * it + m16] = acc[jj];
            }
        }
    }
    WG_BARRIER();
    if (tid < 64) {
        const int t = tid; const float rk = rsqrtf(GKK[t * GKP + t] + EPS), rq = rsqrtf(TAB[576 + t] + EPS) * 0.08838834764831845f;
        TAB[256 + t] = rk; TAB[320 + t] = rq; TAB[384 + t] = rq * TAB[128 + t]; TAB[448 + t] = rk * TAB[192 + t]; TAB[512 + t] = rk * TAB[t] * TAB[128 + t];
    }
    WG_BARRIER();
    {
        for (int e = tid; e < 4096; e += 512) { const int i = e >> 6, j = e & 63;
            if (j < i) GKK[i * GKP + j] = TAB[i] * TAB[256 + i] * TAB[256 + j] * GKK[i * GKP + j] * __expf(TAB[64 + i] - TAB[64 + j]); }
        const int m16 = lane & 15, kg = lane >> 4;
        { const int it = wave >> 1, kb2 = wave & 1, i = 16 * it + m16; const float sc = TAB[320 + i], gi = TAB[64 + i];
          float o[8];
#pragma unroll
          for (int hlf = 0; hlf < 2; ++hlf) { const int j0 = 32 * kb2 + 16 * hlf + 4 * kg; const f32x4 g = *(const LAS f32x4*)(GQK + i * 68 + j0);
#pragma unroll
              for (int e = 0; e < 4; ++e) { const int j = j0 + e; o[4 * hlf + e] = (j <= i) ? sc * TAB[256 + j] * g[e] * __expf(gi - TAB[64 + j]) : 0.f; } }
          v4u w; w.x = pk2(o[0], o[1]); w.y = pk2(o[2], o[3]); w.z = pk2(o[4], o[5]); w.w = pk2(o[6], o[7]);
          *(GAS v4u*)(rec + 32768 + wave * 1024 + lane * 16) = w; }
#pragma unroll
        for (int r = 0; r < 2; ++r) { const int f = wave * 2 + r, mt = f >> 1, kb2 = f & 1, dk = 16 * mt + m16; float o[8];
#pragma unroll
            for (int hlf = 0; hlf < 2; ++hlf) { const int t0 = 32 * kb2 + 16 * hlf + 4 * kg; const v2u kk = *(const LAS v2u*)(L + GP_KT + dk * 144 + 2 * t0);
                o[4 * hlf + 0] = bflo(kk.x) * TAB[448 + t0]; o[4 * hlf + 1] = bfhi(kk.x) * TAB[448 + t0 + 1]; o[4 * hlf + 2] = bflo(kk.y) * TAB[448 + t0 + 2]; o[4 * hlf + 3] = bfhi(kk.y) * TAB[448 + t0 + 3]; }
            v4u w; w.x = pk2(o[0], o[1]); w.y = pk2(o[2], o[3]); w.z = pk2(o[4], o[5]); w.w = pk2(o[6], o[7]);
            *(GAS v4u*)(rec + 40960 + f * 1024 + lane * 16) = w; }
#pragma unroll
        for (int r = 0; r < 2; ++r) { const int f = wave * 2 + r, mtq = f >> 2, kb = f & 3, t = 16 * mtq + m16; const float sc = TAB[384 + t]; float o[8];
#pragma unroll
            for (int hlf = 0; hlf < 2; ++hlf) { const int d0 = 32 * kb + 16 * hlf + 4 * kg; const v2u qq = *(const LAS v2u*)(L + GP_QR + t * 272 + 2 * d0);
                o[4 * hlf + 0] = bflo(qq.x) * sc; o[4 * hlf + 1] = bfhi(qq.x) * sc; o[4 * hlf + 2] = bflo(qq.y) * sc; o[4 * hlf + 3] = bfhi(qq.y) * sc; }
            v4u w; w.x = pk2(o[0], o[1]); w.y = pk2(o[2], o[3]); w.z = pk2(o[4], o[5]); w.w = pk2(o[6], o[7]);
            *(GAS v4u*)(rec + ((4 + mtq) * 4 + kb) * 1024 + lane * 16) = w; }
        { const int dk = tid >> 2, t0 = (tid & 3) * 16; const v4u a = *(const LAS v4u*)(L + GP_KT + dk * 144 + 2 * t0), bq = *(const LAS v4u*)(L + GP_KT + dk * 144 + 2 * t0 + 16);
          const unsigned wi[8] = {a.x, a.y, a.z, a.w, bq.x, bq.y, bq.z, bq.w}; unsigned wo[8];
#pragma unroll
          for (int i = 0; i < 8; ++i) wo[i] = pk2(bflo(wi[i]) * TAB[512 + t0 + 2 * i], bfhi(wi[i]) * TAB[512 + t0 + 2 * i + 1]);
          *(LAS v4u*)(L + GP_KBG + dk * 144 + 2 * t0) = (v4u){wo[0], wo[1], wo[2], wo[3]}; *(LAS v4u*)(L + GP_KBG + dk * 144 + 2 * t0 + 16) = (v4u){wo[4], wo[5], wo[6], wo[7]}; }
    }
    WG_BARRIER();
    LAS float* TIF = GQK;
    {
        const int m16 = lane & 15, kg = lane >> 4;
        if (wave == 0) {
            const LAS float* Ab = GKK + (16 * kg) * GKP + 16 * kg; float r[16];
#pragma unroll
            for (int i = 0; i < 16; ++i) { int lo_ = m16; asm volatile("" : "+v"(lo_)); float a = (lo_ == i) ? 1.f : 0.f;
#pragma unroll
                for (int j4 = 0; j4 < (i + 3) / 4; ++j4) { const f32x4 av = *(const LAS f32x4*)(Ab + i * GKP + 4 * j4);
#pragma unroll
                    for (int e = 0; e < 4; ++e) { const int j = 4 * j4 + e; if (j < i) a -= av[e] * r[j]; } }
                r[i] = a; }
#pragma unroll
            for (int i = 0; i < 16; ++i) TIF[(16 * kg + i) * GKP + 16 * kg + m16] = r[i];
        }
        WG_BARRIER();
        const f32x4 z4 = {0.f, 0.f, 0.f, 0.f};
        if (wave < 3) { const int i = wave + 1, j = wave;
            f32x4 X = prod_ll(GKK, 16 * i, 16 * j, TIF, 16 * j, 16 * j, z4, m16, kg);
            f32x4 T = prod_lr(TIF, 16 * i, 16 * i, X, z4, m16, kg);
#pragma unroll
            for (int jj = 0; jj < 4; ++jj) TIF[(16 * i + 4 * kg + jj) * GKP + 16 * j + m16] = -T[jj]; }
        WG_BARRIER();
        if (wave < 2) { const int i = wave + 2, j = wave;
            f32x4 Y = prod_ll(GKK, 16 * i, 16 * j, TIF, 16 * j, 16 * j, z4, m16, kg);
            Y = prod_ll(GKK, 16 * i, 16 * (j + 1), TIF, 16 * (j + 1), 16 * j, Y, m16, kg);
            f32x4 T = prod_lr(TIF, 16 * i, 16 * i, Y, z4, m16, kg);
#pragma unroll
            for (int jj = 0; jj < 4; ++jj) TIF[(16 * i + 4 * kg + jj) * GKP + 16 * j + m16] = -T[jj]; }
        WG_BARRIER();
        if (wave == 0) {
            f32x4 Y = prod_ll(GKK, 48, 0, TIF, 0, 0, z4, m16, kg);
            Y = prod_ll(GKK, 48, 16, TIF, 16, 0, Y, m16, kg);
            Y = prod_ll(GKK, 48, 32, TIF, 32, 0, Y, m16, kg);
            f32x4 T = prod_lr(TIF, 48, 48, Y, z4, m16, kg);
#pragma unroll
            for (int jj = 0; jj < 4; ++jj) TIF[(48 + 4 * kg + jj) * GKP + m16] = -T[jj]; }
        WG_BARRIER();
        { const int row = tid >> 3, cg = tid & 7; v4u o = {0u, 0u, 0u, 0u};
          if ((cg >> 1) <= (row >> 4)) { const f32x4 a = *(const LAS f32x4*)(TIF + row * GKP + 8 * cg), c = *(const LAS f32x4*)(TIF + row * GKP + 8 * cg + 4);
              o.x = pk2(a[0], a[1]); o.y = pk2(a[2], a[3]); o.z = pk2(c[0], c[1]); o.w = pk2(c[2], c[3]); }
          *(LAS v4u*)(L + GP_TI + row * 144 + 16 * cg) = o; }
    }
    WG_BARRIER();
    {
        const int m16 = lane & 15, kg = lane >> 4;
#pragma unroll
        for (int it = 0; it < 4; ++it) {
            f32x4 au = {0.f, 0.f, 0.f, 0.f}, aw = {0.f, 0.f, 0.f, 0.f};
#pragma unroll
            for (int jb = 0; jb < 2; ++jb) {
                const bf16x8 ti = *(const LAS bf16x8*)(L + GP_TI + (16 * it + m16) * 144 + 64 * jb + 16 * kg);
                const bf16x8 bv = *(const LAS bf16x8*)(L + GP_BVT + (16 * wave + m16) * 144 + 64 * jb + 16 * kg);
                const bf16x8 kb = *(const LAS bf16x8*)(L + GP_KBG + (16 * wave + m16) * 144 + 64 * jb + 16 * kg);
                au = mfma16(ti, bv, au);
                aw = mfma16(kb, ti, aw);
            }
            v2u w; w.x = pk2(au[0], au[1]); w.y = pk2(au[2], au[3]);
            *(GAS v2u*)(rec + 57344 + ((wave * 4 + it) * 64 + lane) * 8) = w;
            v2u x; x.x = pk2(aw[0], aw[1]); x.y = pk2(aw[2], aw[3]);
            *(GAS v2u*)(rec + (it * 4 + (wave >> 1)) * 1024 + lane * 16 + (wave & 1) * 8) = x;
        }
    }
    WG_BARRIER();
}

constexpr int SC_BUF = 57344, SC_OT = 2 * SC_BUF, SC_OTB = 17408, SC_RED = SC_OT + 2 * SC_OTB;
static_assert(SC_RED + 2048 <= LDSCTL_OFF, "scan LDS map");
__device__ __forceinline__ void gdn_scan_chain(Frame& F, int bh) {
#ifdef NO_SCAN
    return;
#endif
    LAS unsigned char* L = F.ldv;
    const int tid = F.tid, lane = F.lane, w = F.wave, m16 = lane & 15, kg = lane >> 4;
    const int b = bh >> 3, h = bh & 7;
    const unsigned char* rec0 = F.ws + WS_REC + (size_t)(bh * 64) * REC_BYTES;
    if (w >= 4) {
        const int ht = tid - 256; bf16* OB = (bf16*)(F.ws + WS_OB);
        v4u st[14];
#pragma unroll
        for (int i = 0; i < 14; ++i) st[i] = *(const GAS v4u*)(rec0 + (size_t)(i * 256 + ht) * 16);
#pragma unroll
        for (int i = 0; i < 14; ++i) *(LAS v4u*)(L + (i * 256 + ht) * 16) = st[i];
#pragma unroll
        for (int i = 0; i < 14; ++i) st[i] = *(const GAS v4u*)(rec0 + REC_BYTES + (size_t)(i * 256 + ht) * 16);
        WG_BARRIER();
        for (int m = 0; m < 65; ++m) {
            if (m + 1 <= 63) { LAS unsigned char* nb = L + ((m + 1) & 1) * SC_BUF;
#pragma unroll
                for (int i = 0; i < 14; ++i) *(LAS v4u*)(nb + (i * 256 + ht) * 16) = st[i]; }
            if (m + 2 <= 63) { const unsigned char* rec = rec0 + (size_t)(m + 2) * REC_BYTES;
#pragma unroll
                for (int i = 0; i < 14; ++i) st[i] = *(const GAS v4u*)(rec + (size_t)(i * 256 + ht) * 16); }
            if (m >= 1) {
                const LAS unsigned char* ot = L + SC_OT + ((m - 1) & 1) * SC_OTB; const LAS float* RED = (const LAS float*)(L + SC_RED) + ((m - 1) & 1) * 256;
                const int row0 = b * SEQ + 64 * (m - 1); const unsigned char* gzt = rec0 + (size_t)(m - 1) * REC_BYTES + 73728;
                v4u gv[4];
#pragma unroll
                for (int r = 0; r < 4; ++r) gv[r] = *(const GAS v4u*)(gzt + (size_t)(ht + 256 * r) * 16);
#pragma unroll
                for (int r = 0; r < 4; ++r) { const int idx = ht + 256 * r, row = idx >> 4, ch = idx & 15;
                    const v4u ov = *(const LAS v4u*)(ot + row * 272 + ch * 16); const f32x4 r4 = *(const LAS f32x4*)(RED + row * 4);
                    const float rs = rsqrtf(((r4[0] + r4[1]) + (r4[2] + r4[3])) * (1.0f / 128.0f) + EPS);
                    v4u o; o.x = pk2(bflo(ov.x) * rs * bflo(gv[r].x), bfhi(ov.x) * rs * bfhi(gv[r].x)); o.y = pk2(bflo(ov.y) * rs * bflo(gv[r].y), bfhi(ov.y) * rs * bfhi(gv[r].y));
                    o.z = pk2(bflo(ov.z) * rs * bflo(gv[r].z), bfhi(ov.z) * rs * bfhi(gv[r].z)); o.w = pk2(bflo(ov.w) * rs * bflo(gv[r].w), bfhi(ov.w) * rs * bfhi(gv[r].w));
                    *(GAS v4u*)(OB + (size_t)(row0 + row) * D + h * 128 + ch * 8) = o; } }
            WG_BARRIER();
        }
    } else {
        const float* GE = (const float*)(F.ws + WS_GE) + bh * 64;
        f32x4 S[2][8], P[2][8];
#pragma unroll
        for (int hf = 0; hf < 2; ++hf)
#pragma unroll
            for (int i = 0; i < 8; ++i) { S[hf][i] = (f32x4){0.f, 0.f, 0.f, 0.f}; P[hf][i] = (f32x4){0.f, 0.f, 0.f, 0.f}; }
        WG_BARRIER();
        for (int m = 0; m < 65; ++m) {
            if (m <= 63) {
                const unsigned char* rec = rec0 + (size_t)m * REC_BYTES; const LAS unsigned char* buf = L + (m & 1) * SC_BUF;
                v2u ut[2][4];
#pragma unroll
                for (int hf = 0; hf < 2; ++hf)
#pragma unroll
                    for (int mt = 0; mt < 4; ++mt) ut[hf][mt] = *(const GAS v2u*)(rec + 57344 + (((2 * w + hf) * 4 + mt) * 64 + lane) * 8);
                const float ge = GE[m];
                bf16x8 Sb[2][4];
#pragma unroll
                for (int hf = 0; hf < 2; ++hf)
#pragma unroll
                    for (int kb = 0; kb < 4; ++kb) Sb[hf][kb] = pack8(S[hf][2 * kb], S[hf][2 * kb + 1]);
#pragma unroll
                for (int mt = 0; mt < 8; ++mt) { P[0][mt] = (f32x4){0.f, 0.f, 0.f, 0.f}; P[1][mt] = (f32x4){0.f, 0.f, 0.f, 0.f};
#pragma unroll
                    for (int kb = 0; kb < 4; ++kb) { const bf16x8 a = *(const LAS bf16x8*)(buf + (mt * 4 + kb) * 1024 + lane * 16); P[0][mt] = mfma16(a, Sb[0][kb], P[0][mt]); P[1][mt] = mfma16(a, Sb[1][kb], P[1][mt]); } }
                bf16x8 vb[2][2];
#pragma unroll
                for (int hf = 0; hf < 2; ++hf) { f32x4 vn[4];
#pragma unroll
                    for (int mt = 0; mt < 4; ++mt) { vn[mt][0] = bflo(ut[hf][mt].x) - P[hf][mt][0]; vn[mt][1] = bfhi(ut[hf][mt].x) - P[hf][mt][1]; vn[mt][2] = bflo(ut[hf][mt].y) - P[hf][mt][2]; vn[mt][3] = bfhi(ut[hf][mt].y) - P[hf][mt][3]; }
                    vb[hf][0] = pack8(vn[0], vn[1]); vb[hf][1] = pack8(vn[2], vn[3]); }
#pragma unroll
                for (int mt = 0; mt < 4; ++mt)
#pragma unroll
                    for (int kb2 = 0; kb2 < 2; ++kb2) { const bf16x8 a = *(const LAS bf16x8*)(buf + 32768 + (mt * 2 + kb2) * 1024 + lane * 16); P[0][4 + mt] = mfma16(a, vb[0][kb2], P[0][4 + mt]); P[1][4 + mt] = mfma16(a, vb[1][kb2], P[1][4 + mt]); }
#pragma unroll
                for (int mt = 0; mt < 8; ++mt) { S[0][mt] = S[0][mt] * ge; S[1][mt] = S[1][mt] * ge;
#pragma unroll
                    for (int kb2 = 0; kb2 < 2; ++kb2) { const bf16x8 a = *(const LAS bf16x8*)(buf + 40960 + (mt * 2 + kb2) * 1024 + lane * 16); S[0][mt] = mfma16(a, vb[0][kb2], S[0][mt]); S[1][mt] = mfma16(a, vb[1][kb2], S[1][mt]); } }
                LAS float* RED = (LAS float*)(L + SC_RED) + (m & 1) * 256; LAS unsigned char* ot = L + SC_OT + (m & 1) * SC_OTB;
#pragma unroll
                for (int mt = 0; mt < 4; ++mt)
#pragma unroll
                    for (int jj = 0; jj < 4; jj += 2) { const int t = 16 * mt + 4 * kg + jj;
#pragma unroll
                        for (int hf = 0; hf < 2; ++hf) { const unsigned pr = pk2(P[hf][4 + mt][jj], P[hf][4 + mt][jj + 1]);
                            *(LAS bf16*)(ot + t * 272 + (32 * w + 16 * hf + m16) * 2) = (bf16)(pr & 0xffffu); *(LAS bf16*)(ot + (t + 1) * 272 + (32 * w + 16 * hf + m16) * 2) = (bf16)(pr >> 16); } }
                float mine = 0.f;
#pragma unroll
                for (int mt = 0; mt < 4; ++mt)
#pragma unroll
                    for (int jj = 0; jj < 4; ++jj) { const float q = row_sum16(P[0][4 + mt][jj] * P[0][4 + mt][jj] + P[1][4 + mt][jj] * P[1][4 + mt][jj]); mine = (m16 == 4 * mt + jj) ? q : mine; }
                RED[(16 * (m16 >> 2) + 4 * kg + (m16 & 3)) * 4 + w] = mine;
            }
            WG_BARRIER();
        }
        float* so = F.out + O_SSMP + (size_t)bh * 16384;
#pragma unroll
        for (int hf = 0; hf < 2; ++hf)
#pragma unroll
            for (int mt = 0; mt < 8; ++mt)
#pragma unroll
                for (int jj = 0; jj < 4; ++jj) so[(16 * mt + 4 * kg + jj) * 128 + 32 * w + 16 * hf + m16] = S[hf][mt][jj];
    }
    WG_BARRIER();
}

__device__ __forceinline__ void gdn_sample_unit(Frame& F, int b, int h) {
    LAS float* L = (LAS float*)F.ldv;
    const int tid = F.tid, lane = F.lane, wave = F.wave;
    const bf16* U = (const bf16*)(F.ws + WS_U); const float* BA = (const float*)(F.ws + WS_BA);
    const int row0 = MP + 4 * b;
    const int dv = tid & 127, kq = tid >> 7;
    const float* S0 = F.in[IN_SSSM] + ((size_t)(b * 8 + h) * 128 + 32 * kq) * 128 + dv;
    float s[32];
#pragma unroll
    for (int i = 0; i < 32; ++i) s[i] = S0[(size_t)i * 128];
    LAS float* SC = L + 8704;
    if (tid < 4) { const float bl = BA[(size_t)(row0 + tid) * 16 + h], al = BA[(size_t)(row0 + tid) * 16 + 8 + h];
        SC[tid] = sigm(bl); SC[56 + tid] = -__expf(F.in[IN_ALOG][h]) * softplusf(al + F.in[IN_DTB][h]); }
    if (tid < 384) {
        const int tensor = tid >> 7, c = tid & 127, cw = tensor * 1024 + h * 128 + c, col = U_QKVB + cw;
        const float w0 = F.in[IN_CONVW][cw], w1 = F.in[IN_CONVW][3072 + cw], w2 = F.in[IN_CONVW][2 * 3072 + cw], w3 = F.in[IN_CONVW][3 * 3072 + cw];
        float x[7];
#pragma unroll
        for (int i = 0; i < 3; ++i) x[i] = F.in[IN_SCONV][((size_t)b * 3 + i) * 3072 + cw];
#pragma unroll
        for (int i = 0; i < 4; ++i) x[3 + i] = bf2f(U[(size_t)(row0 + i) * NINP + col]);
#pragma unroll
        for (int i = 0; i < 4; ++i) { const float v = w0 * x[i] + w1 * x[i + 1] + w2 * x[i + 2] + w3 * x[i + 3]; L[tensor * 512 + i * 128 + c] = siluf(v); }
    }
    WG_BARRIER();
    if (tid == 0) { float gc = 0.f;
#pragma unroll
        for (int i = 0; i < 4; ++i) { gc += SC[56 + i]; SC[4 + i] = gc; } SC[48] = __expf(gc); }
    { const int tensor = wave >> 2, s = wave & 3; const float a = L[tensor * 512 + s * 128 + lane], c2 = L[tensor * 512 + s * 128 + 64 + lane];
      const float ss = wave_sum(a * a + c2 * c2); if (lane == 0) SC[(tensor ? 8 : 12) + s] = rsqrtf(ss + EPS) * (tensor ? 1.f : 0.08838834764831845f); }
    WG_BARRIER();
#pragma unroll
    for (int r = 0; r < 4; ++r) { const int idx = 4 * wave + r, kind = idx >> 4, i = (idx >> 2) & 3, j = idx & 3;
        const LAS float* a = L + (kind ? 0 : 512) + i * 128; const LAS float* c2 = L + 512 + j * 128;
        const float d = wave_sum(a[lane] * c2[lane] + a[64 + lane] * c2[64 + lane]);
        if (lane == 0) SC[16 + idx] = d * SC[(kind ? 12 : 8) + i] * SC[8 + j]; }
    WG_BARRIER();
    float beta[4], gc[4], Ti[4][4], qkm[4][4];
#pragma unroll
    for (int i = 0; i < 4; ++i) { beta[i] = SC[i]; gc[i] = SC[4 + i]; }
    const float ge = SC[48];
    {
        float A[4][4];
#pragma unroll
        for (int i = 0; i < 4; ++i)
#pragma unroll
            for (int j = 0; j < 4; ++j) { const float dec = __expf(gc[i] - gc[j]); A[i][j] = (j < i) ? beta[i] * SC[16 + 4 * i + j] * dec : 0.f; qkm[i][j] = (j <= i) ? SC[32 + 4 * i + j] * dec : 0.f; }
#pragma unroll
        for (int i = 0; i < 4; ++i)
#pragma unroll
            for (int c = 0; c < 4; ++c) { float v = (i == c) ? 1.f : 0.f;
#pragma unroll
                for (int j = 0; j < 4; ++j) if (j < i) v -= A[i][j] * Ti[j][c];
                Ti[i][c] = v; }
    }
    { const int c = tid & 127, i = tid >> 7; float wv = 0.f, uv = 0.f;
#pragma unroll
      for (int j = 0; j < 4; ++j) { wv += Ti[i][j] * beta[j] * __expf(gc[j]) * SC[8 + j] * L[512 + j * 128 + c]; uv += Ti[i][j] * beta[j] * L[1024 + j * 128 + c]; }
      L[1536 + i * 128 + c] = wv; L[3072 + i * 128 + c] = uv;
      L[2048 + i * 128 + c] = L[i * 128 + c] * SC[12 + i] * __expf(gc[i]);
      L[2560 + i * 128 + c] = L[512 + i * 128 + c] * SC[8 + i] * __expf(gc[3] - gc[i]); }
    WG_BARRIER();
    float pw[4] = {0.f, 0.f, 0.f, 0.f}, pq[4] = {0.f, 0.f, 0.f, 0.f};
#pragma unroll
    for (int i = 0; i < 32; ++i)
#pragma unroll
        for (int c = 0; c < 4; ++c) { pw[c] += L[1536 + c * 128 + 32 * kq + i] * s[i]; pq[c] += L[2048 + c * 128 + 32 * kq + i] * s[i]; }
#pragma unroll
    for (int c = 0; c < 4; ++c) { L[3584 + (c * 4 + kq) * 128 + dv] = pw[c]; L[3584 + ((4 + c) * 4 + kq) * 128 + dv] = pq[c]; }
    WG_BARRIER();
    float vn[4], oo[4];
#pragma unroll
    for (int c = 0; c < 4; ++c) { const float ws_ = (L[3584 + (c * 4 + 0) * 128 + dv] + L[3584 + (c * 4 + 1) * 128 + dv]) + (L[3584 + (c * 4 + 2) * 128 + dv] + L[3584 + (c * 4 + 3) * 128 + dv]);
        vn[c] = L[3072 + c * 128 + dv] - ws_; }
#pragma unroll
    for (int c = 0; c < 4; ++c) { float o = (L[3584 + ((4 + c) * 4 + 0) * 128 + dv] + L[3584 + ((4 + c) * 4 + 1) * 128 + dv]) + (L[3584 + ((4 + c) * 4 + 2) * 128 + dv] + L[3584 + ((4 + c) * 4 + 3) * 128 + dv]);
#pragma unroll
        for (int j = 0; j < 4; ++j) o += qkm[c][j] * vn[j];
        oo[c] = o; }
    float* SO = F.out + O_SSMS + ((size_t)(b * 8 + h) * 128 + 32 * kq) * 128 + dv;
#pragma unroll
    for (int i = 0; i < 32; ++i) { float v = ge * s[i];
#pragma unroll
        for (int c = 0; c < 4; ++c) v += L[2560 + c * 128 + 32 * kq + i] * vn[c];
        SO[(size_t)i * 128] = v; }
    LAS float* RED = L + 8768;
    if (kq == 0) {
#pragma unroll
        for (int c = 0; c < 4; ++c) { const float q = wave_sum(oo[c] * oo[c]); if (lane == 0) RED[c * 2 + wave] = q; }
    }
    WG_BARRIER();
    if (kq == 0) {
        bf16* OB = (bf16*)(F.ws + WS_OB); const float nw = F.in[IN_GNORM][dv];
#pragma unroll
        for (int c = 0; c < 4; ++c) { const float rs = rsqrtf((RED[c * 2] + RED[c * 2 + 1]) * (1.0f / 128.0f) + EPS);
            const float z = bf2f(U[(size_t)(row0 + c) * NINP + U_Z + h * 128 + dv]);
            OB[(size_t)(row0 + c) * D + h * 128 + dv] = (bf16)f2bf(oo[c] * rs * nw * (z * sigm(z))); }
    }
    WG_BARRIER();
}

__device__ __forceinline__ void copy_outputs(Frame& F) {
    const bf16* U = (const bf16*)(F.ws + WS_U);
    const long gt = (long)F.bx * 512 + F.tid, NT = (long)F.G * 512;
    constexpr long C0 = 65536, C1 = 262144, C2 = 1048576, CS = 65536, CCP = 4608, CCS = 147456;
    constexpr long TOT = C0 + C1 + C2 + 3 * CS + CCP + CCS;
    for (long c = gt; c < TOT; c += NT) {
        long r = c; int srow, scol; float* dst;
        if (r < C0 + C1 + C2) {
            int g, keep; if (r < C0) { g = 0; keep = 128; dst = F.out + O_KVP0; } else if (r < C0 + C1) { r -= C0; g = 1; keep = 512; dst = F.out + O_KVP1; } else { r -= C0 + C1; g = 2; keep = 2048; dst = F.out + O_KVP2; }
            const int e8 = r & 15, hh = (r >> 4) & 3, kv = (r >> 6) & 1; const int rr = (int)((r >> 7) % keep), bb = (int)((r >> 7) / keep);
            srow = bb * SEQ + SEQ - keep + rr; scol = (kv ? U_VA : U_KA) + (g * 4 + hh) * 128 + e8 * 8; dst += r * 8;
        } else if ((r -= C0 + C1 + C2) < 3 * CS) {
            const int g = (int)(r / CS); r -= (long)g * CS; dst = F.out + (g == 0 ? O_KVS0 : (g == 1 ? O_KVS1 : O_KVS2)) + r * 8;
            const int e8 = r & 15, hh = (r >> 4) & 3, kv = (r >> 6) & 1, ss = (r >> 7) & 3, bb = (int)(r >> 9);
            srow = MP + 4 * bb + ss; scol = (kv ? U_VA : U_KA) + (g * 4 + hh) * 128 + e8 * 8;
        } else if ((r -= 3 * CS) < CCP) {
            const int ch8 = (int)(r % 384), i = (int)((r / 384) % 3), bb = (int)(r / 1152); dst = F.out + O_CONVP + r * 8;
            srow = bb * SEQ + SEQ - 3 + i; scol = U_QKVB + ch8 * 8;
        } else {
            r -= CCP; const int ch8 = (int)(r % 384), i = (int)((r / 384) % 3), bb = (int)(r / 1152); dst = F.out + O_CONVS + r * 8;
            srow = MP + 4 * bb + 1 + i; scol = U_QKVB + ch8 * 8;
        }
        const v4u v = *(const GAS v4u*)(U + (size_t)srow * NINP + scol);
        *(GAS f32x4*)dst = (f32x4){bflo(v.x), bfhi(v.x), bflo(v.y), bfhi(v.y)};
        *(GAS f32x4*)(dst + 4) = (f32x4){bflo(v.z), bfhi(v.z), bflo(v.w), bfhi(v.w)};
    }
}

constexpr int AT_K = 0, AT_V = 69632;
__device__ __forceinline__ int at_off(int row, int ch) { return 256 * row + 16 * (ch ^ (((row & 3) << 2) | ((row >> 2) & 3))); }
__device__ __forceinline__ void tr_read10(unsigned a, bf16x4 (&lo)[5], bf16x4 (&hi)[5]) {
    asm volatile("ds_read_b64_tr_b16 %0, %10\n\tds_read_b64_tr_b16 %1, %10 offset:4096\n\tds_read_b64_tr_b16 %2, %10 offset:8192\n\tds_read_b64_tr_b16 %3, %10 offset:12288\n\t"
                 "ds_read_b64_tr_b16 %4, %10 offset:16384\n\tds_read_b64_tr_b16 %5, %10 offset:20480\n\tds_read_b64_tr_b16 %6, %10 offset:24576\n\tds_read_b64_tr_b16 %7, %10 offset:28672\n\t"
                 "ds_read_b64_tr_b16 %8, %10 offset:32768\n\tds_read_b64_tr_b16 %9, %10 offset:36864\n\ts_waitcnt lgkmcnt(0)"
                 : "=&v"(lo[0]), "=&v"(hi[0]), "=&v"(lo[1]), "=&v"(hi[1]), "=&v"(lo[2]), "=&v"(hi[2]), "=&v"(lo[3]), "=&v"(hi[3]), "=&v"(lo[4]), "=&v"(hi[4]) : "v"(a) : "memory"); }

__device__ __forceinline__ void attn_prompt_unit(Frame& F, int unit) {
#ifdef NO_PATTN
    return;
#endif
    LAS unsigned char* L = F.ldv;
    const int tid = F.tid, lane = F.lane, w = F.wave, m16 = lane & 15, kg = lane >> 4;
    const bf16* U = (const bf16*)(F.ws + WS_U); bf16* OG = (bf16*)(F.ws + WS_OG); float* LSE = (float*)(F.ws + WS_LSE);
    const int h = unit & 3, rb = (unit >> 2) & 31, b = (unit >> 7) & 3, g = unit >> 9;
    const int dil = g == 0 ? 1 : (g == 1 ? 4 : 16), nb = 32 / dil, r = rb / nb, blk = rb % nb, hh = g * 4 + h;
    const float slope = exp2f(-8.0f * (float)(hh + 1) / 12.0f) * (float)dil;
#pragma unroll 1
    for (int hv = 0; hv < 3; ++hv) { v4u kreg[3], vreg[3];
#pragma unroll
      for (int it = 0; it < 3; ++it) { const int i = tid + 512 * (3 * hv + it), row = i >> 4, chp = i & 15, ch = chp ^ (((row & 3) << 2) | ((row >> 2) & 3));
          const int sub = blk * 128 + row - 128; kreg[it] = (v4u){0u, 0u, 0u, 0u}; vreg[it] = (v4u){0u, 0u, 0u, 0u};
          if (row < 256 && sub >= 0) { const size_t gr = (size_t)(b * SEQ + sub * dil + r) * NINP;
              kreg[it] = *(const GAS v4u*)(U + gr + U_KA + hh * 128 + ch * 8); vreg[it] = *(const GAS v4u*)(U + gr + U_VA + hh * 128 + ch * 8); } }
#pragma unroll
      for (int it = 0; it < 3; ++it) { const int i = tid + 512 * (3 * hv + it); if (i < 272 * 16) { *(LAS v4u*)(L + AT_K + i * 16) = kreg[it]; *(LAS v4u*)(L + AT_V + i * 16) = vreg[it]; } } }
    const int qi = 16 * w + m16; const size_t qrow = (size_t)(b * SEQ + (blk * 128 + qi) * dil + r);
    bf16x8 qf[4];
#pragma unroll
    for (int kb = 0; kb < 4; ++kb) qf[kb] = *(const GAS bf16x8*)(U + qrow * NINP + U_QA + hh * 128 + 32 * kb + 8 * kg);
    WG_BARRIER();
    f32x4 S[10];
    int kbase[4];
#pragma unroll
    for (int kb = 0; kb < 4; ++kb) kbase[kb] = AT_K + at_off(16 * w + m16, 4 * kb + kg);
#pragma unroll
    for (int kt = 0; kt < 10; ++kt) { S[kt] = (f32x4){0.f, 0.f, 0.f, 0.f};
#pragma unroll
        for (int kb = 0; kb < 4; ++kb) S[kt] = mfma16(*(const LAS bf16x8*)(L + kbase[kb] + kt * 4096), qf[kb], S[kt]); }
    const float sc = 0.08838834764831845f * 1.4426950408889634f, sl2 = slope * 1.4426950408889634f;
    float mx = -INFINITY;
#pragma unroll
    for (int kt = 0; kt < 10; ++kt)
#pragma unroll
        for (int jj = 0; jj < 4; ++jj) { const int kj = 16 * w + 16 * kt + 4 * kg + jj, delta = 128 + qi - kj;
            const bool ok = delta >= 0 && delta <= 128 && (blk > 0 || kj >= 128);
            const float v = ok ? S[kt][jj] * sc - sl2 * (float)delta : -INFINITY; S[kt][jj] = v; mx = fmaxf(mx, v); }
    mx = fmaxf(mx, __shfl_xor(mx, 16)); mx = fmaxf(mx, __shfl_xor(mx, 32));
    float sum = 0.f;
#pragma unroll
    for (int kt = 0; kt < 10; ++kt)
#pragma unroll
        for (int jj = 0; jj < 4; ++jj) { const float p = exp2f(S[kt][jj] - mx); S[kt][jj] = p; sum += p; }
    sum += __shfl_xor(sum, 16); sum += __shfl_xor(sum, 32);
    bf16x8 pb[5];
#pragma unroll
    for (int kb2 = 0; kb2 < 5; ++kb2) pb[kb2] = pack8(S[2 * kb2], S[2 * kb2 + 1]);
    f32x4 O[8];
    const int rq = m16 >> 2, cq = m16 & 3;
    unsigned vbase[8];
#pragma unroll
    for (int dt = 0; dt < 8; ++dt) vbase[dt] = (unsigned)(AT_V + at_off(16 * w + 4 * kg + rq, 2 * dt + (cq >> 1)) + 8 * (cq & 1));
#pragma unroll
    for (int dt = 0; dt < 8; ++dt) { O[dt] = (f32x4){0.f, 0.f, 0.f, 0.f}; bf16x4 lo[5], hi[5]; tr_read10(vbase[dt], lo, hi);
#pragma unroll
        for (int kb2 = 0; kb2 < 5; ++kb2) { bf16x8 vf; vf[0] = lo[kb2][0]; vf[1] = lo[kb2][1]; vf[2] = lo[kb2][2]; vf[3] = lo[kb2][3]; vf[4] = hi[kb2][0]; vf[5] = hi[kb2][1]; vf[6] = hi[kb2][2]; vf[7] = hi[kb2][3];
            O[dt] = mfma16(vf, pb[kb2], O[dt]); } }
    const float inv = 1.0f / sum;
#pragma unroll
    for (int dt = 0; dt < 8; ++dt) { v2u o; o.x = pk2(O[dt][0] * inv, O[dt][1] * inv); o.y = pk2(O[dt][2] * inv, O[dt][3] * inv);
        *(GAS v2u*)(OG + qrow * 1536 + hh * 128 + 16 * dt + 4 * kg) = o; }
    if (kg == 0) LSE[qrow * 12 + hh] = (mx + log2f(sum)) * 0.6931471805599453f;
    WG_BARRIER();
}

__device__ __forceinline__ float half_sum(float v) { v = row_sum16(v); v += __shfl_xor(v, 16); return v; }
__device__ __forceinline__ void attn_sample_unit(Frame& F, int unit) {
#ifdef NO_SATTN
    return;
#endif
    const int lane = F.lane, w = F.wave;
    const bf16* U = (const bf16*)(F.ws + WS_U); bf16* OG = (bf16*)(F.ws + WS_OG); float* LSE = (float*)(F.ws + WS_LSE);
    const int b = unit & 127, g = unit >> 7;
    const int s = w & 3, h = 2 * (w >> 2) + (lane >> 5), dl = lane & 31, hh = g * 4 + h;
    const int dil = g == 0 ? 1 : (g == 1 ? 4 : 16), wb = g == 0 ? 128 : (g == 1 ? 512 : 2048);
    const float* cache = F.in[g == 0 ? IN_C128 : (g == 1 ? IN_C512 : IN_C2048)] + (size_t)b * wb * 1024 + h * 128 + 4 * dl;
    const float L2E = 1.4426950408889634f;
    const float sl2 = exp2f(-8.0f * (float)(hh + 1) / 12.0f) * (float)dil * L2E;
    const size_t qrow = (size_t)(MP + 4 * b + s);
    f32x4 q; { const v2u qq = *(const GAS v2u*)(U + qrow * NINP + U_QA + hh * 128 + 4 * dl); const float sc = 0.08838834764831845f * L2E;
        q = (f32x4){bflo(qq.x) * sc, bfhi(qq.x) * sc, bflo(qq.y) * sc, bfhi(qq.y) * sc}; }
    float m = -INFINITY, l = 0.f; f32x4 o = {0.f, 0.f, 0.f, 0.f};
    const int jn = (g == 0) ? s : 0;
    for (int j = 0; j <= jn; ++j) { const size_t kr = (size_t)(MP + 4 * b + s - dil * j) * NINP + hh * 128 + 4 * dl;
        const v2u kk = *(const GAS v2u*)(U + kr + U_KA), vv = *(const GAS v2u*)(U + kr + U_VA);
        const float sc = half_sum(bflo(kk.x) * q[0] + bfhi(kk.x) * q[1] + bflo(kk.y) * q[2] + bfhi(kk.y) * q[3]) - sl2 * (float)j;
        const float mn = fmaxf(m, sc), al = exp2f(m - mn), p = exp2f(sc - mn); m = mn; l = l * al + p;
        o = o * al + (f32x4){bflo(vv.x), bfhi(vv.x), bflo(vv.y), bfhi(vv.y)} * p; }
    f32x4 kA[8], vA[8], kB[8], vB[8];
#define SA_LOAD(KF, VF, BLK) do { _Pragma("unroll") for (int i = 0; i < 8; ++i) { const int j = jn + 1 + 8 * (BLK) + i; int idx = wb + s - dil * j; idx = idx < 0 ? 0 : idx; \
        KF[i] = *(const GAS f32x4*)(cache + (size_t)idx * 1024); VF[i] = *(const GAS f32x4*)(cache + (size_t)idx * 1024 + 512); } } while (0)
#define SA_COMP(KF, VF, BLK) do { float sc[8]; float mb = -INFINITY; \
        _Pragma("unroll") for (int i = 0; i < 8; ++i) { const int j = jn + 1 + 8 * (BLK) + i; \
            float d = half_sum(KF[i][0] * q[0] + KF[i][1] * q[1] + KF[i][2] * q[2] + KF[i][3] * q[3]) - sl2 * (float)j; \
            d = (j <= 128) ? d : -INFINITY; sc[i] = d; mb = fmaxf(mb, d); } \
        const float mn = fmaxf(m, mb), al = exp2f(m - mn); m = mn; l *= al; o = o * al; \
        _Pragma("unroll") for (int i = 0; i < 8; ++i) { const float p = exp2f(sc[i] - mn); l += p; o = o + VF[i] * p; } } while (0)
    SA_LOAD(kA, vA, 0);
    for (int blk = 0; blk < 16; blk += 2) {
        SA_LOAD(kB, vB, blk + 1);
        SA_COMP(kA, vA, blk);
        if (blk + 2 < 16) SA_LOAD(kA, vA, blk + 2);
        SA_COMP(kB, vB, blk + 1);
    }
#undef SA_LOAD
#undef SA_COMP
    const float inv = 1.0f / l;
    v2u ov; ov.x = pk2(o[0] * inv, o[1] * inv); ov.y = pk2(o[2] * inv, o[3] * inv);
    *(GAS v2u*)(OG + qrow * 1536 + hh * 128 + 4 * dl) = ov;
    if (dl == 0) LSE[qrow * 12 + hh] = (m + log2f(l)) * 0.6931471805599453f;
}

__device__ __forceinline__ void attn_merge(Frame& F) {
    const bf16* OG = (const bf16*)(F.ws + WS_OG); const float* LSE = (const float*)(F.ws + WS_LSE); bf16* OA = (bf16*)(F.ws + WS_OA);
    const long gt = (long)F.bx * 512 + F.tid, NT = (long)F.G * 512;
    for (long c = gt; c < (long)MT * 64; c += NT) {
        const int row = (int)(c >> 6), hs = (int)(c >> 4) & 3, e8 = (int)c & 15;
        const float l0 = LSE[(size_t)row * 12 + hs], l1 = LSE[(size_t)row * 12 + 4 + hs], l2 = LSE[(size_t)row * 12 + 8 + hs];
        const float m = fmaxf(l0, fmaxf(l1, l2)); float w0 = __expf(l0 - m), w1 = __expf(l1 - m), w2 = __expf(l2 - m); const float inv = 1.0f / (w0 + w1 + w2); w0 *= inv; w1 *= inv; w2 *= inv;
        const v4u a = *(const GAS v4u*)(OG + (size_t)row * 1536 + hs * 128 + e8 * 8), bq = *(const GAS v4u*)(OG + (size_t)row * 1536 + (4 + hs) * 128 + e8 * 8), cq = *(const GAS v4u*)(OG + (size_t)row * 1536 + (8 + hs) * 128 + e8 * 8);
        v4u o;
        o.x = pk2(w0 * bflo(a.x) + w1 * bflo(bq.x) + w2 * bflo(cq.x), w0 * bfhi(a.x) + w1 * bfhi(bq.x) + w2 * bfhi(cq.x));
        o.y = pk2(w0 * bflo(a.y) + w1 * bflo(bq.y) + w2 * bflo(cq.y), w0 * bfhi(a.y) + w1 * bfhi(bq.y) + w2 * bfhi(cq.y));
        o.z = pk2(w0 * bflo(a.z) + w1 * bflo(bq.z) + w2 * bflo(cq.z), w0 * bfhi(a.z) + w1 * bfhi(bq.z) + w2 * bfhi(cq.z));
        o.w = pk2(w0 * bflo(a.w) + w1 * bflo(bq.w) + w2 * bflo(cq.w), w0 * bfhi(a.w) + w1 * bfhi(bq.w) + w2 * bfhi(cq.w));
        *(GAS v4u*)(OA + (size_t)row * 512 + hs * 128 + e8 * 8) = o;
    }
}

#ifndef MK_N_LAUNCHES
#define MK_N_LAUNCHES 1
#endif
constexpr int N_PHASES = 12;
struct Args { const float* in[23]; float* out; unsigned char* ws; int ph_lo, ph_hi, sub, qi; };
static_assert(sizeof(Args) == 23 * 8 + 8 + 8 + 16, "Args has no padding");

__device__ __forceinline__ int q_next(Frame& F, int qi) {
    if (F.tid == 0) F.MISC[16] = __hip_atomic_fetch_add((unsigned*)(F.ctl + CW_Q + 64 * qi), 1u, __ATOMIC_RELAXED, __HIP_MEMORY_SCOPE_AGENT);
    __syncthreads();
    const int v = (int)F.MISC[16];
    __syncthreads();
    return v;
}

#ifndef PH5_MASK
#define PH5_MASK 7
#endif
__device__ __forceinline__ void phase5(Frame& F, int qi, int sub) {
    if ((sub & 1) && F.bx < NB * 8) gdn_scan_chain(F, F.bx);
    if (F.bx >= 32 && F.bx < 96) for (;;) { const int u = q_next(F, 3 * qi); if (u >= 128) break; if (sub & 2) attn_sample_unit(F, 256 + u); }
    for (;;) { const int u = q_next(F, 3 * qi + 1); if (u >= 256) break; if (sub & 2) attn_sample_unit(F, (u < 128) ? 128 + u : u - 128); }
    for (;;) { const int u = q_next(F, 3 * qi + 2); if (u >= 1536) break; if (sub & 4) attn_prompt_unit(F, u); }
}
__global__ void __launch_bounds__(NWAVES * 64, 2) mk_fwd(Args args) {
    extern __shared__ __attribute__((aligned(16))) unsigned char lds[];
    Frame F;
    F.lds = (LAS unsigned char*)lds;
    { unsigned z = 0u; asm volatile("" : "+v"(z)); F.ldv = (LAS unsigned char*)lds + z; }
    F.MISC = (volatile LAS unsigned*)(F.lds + MISC_OFF);
    F.tid = threadIdx.x; F.lane = F.tid & 63; F.wave = __builtin_amdgcn_readfirstlane(F.tid >> 6);
    F.G = gridDim.x; F.bx = blockIdx.x;
    F.ws = args.ws; F.out = args.out; F.ctl = (gu32*)(args.ws + WS_CTL);
    F.in = args.in;
    for (int u = F.tid; u < (LDS_BYTES - LDSCTL_OFF) / 4; u += NWAVES * 64) ((LAS unsigned*)(F.lds + LDSCTL_OFF))[u] = 0u;
    __syncthreads();
    const bool one = (args.ph_hi - args.ph_lo) > 1;
    XcdBarrier bar; bar.bar = (unsigned*)(F.ctl + CW_BAR); bar.x = 0; bar.st = nullptr;
    if (one) bar = xcd_barrier_post((unsigned*)(F.ctl + CW_BAR), F.MISC + 8);
    const int lo = args.ph_lo, hi = args.ph_hi;
#ifndef PHASE_MASK
#define PHASE_MASK 0xFFF
#endif
#define IN(k) ((((PHASE_MASK) >> (k)) & 1) && lo <= (k) && (k) < hi)
#define SEAM(k) do { if (IN(k) && IN((k) + 1)) xcd_barrier(bar); } while (0)

    bf16* XB = (bf16*)(F.ws + WS_XB); bf16* ACT = (bf16*)(F.ws + WS_ACT); float* X1 = (float*)(F.ws + WS_X1); bf16* X1B = (bf16*)(F.ws + WS_X1B);
    bf16* UU = (bf16*)(F.ws + WS_U); float* BA = (float*)(F.ws + WS_BA); bf16* OB = (bf16*)(F.ws + WS_OB); bf16* OA = (bf16*)(F.ws + WS_OA);
    bf16* M1 = (bf16*)(F.ws + WS_M1); bf16* MG = (bf16*)(F.ws + WS_MG); float* X2 = (float*)(F.ws + WS_X2); bf16* X2B = (bf16*)(F.ws + WS_X2B);
    float* SSQ2 = (float*)(args.ws + WS_CTL) + CW_SSQ2; float* SSQ3 = (float*)(args.ws + WS_CTL) + CW_SSQ3; float* SSQ4 = (float*)(args.ws + WS_CTL) + CW_SSQ4;

#ifndef DUP_MASK
#define DUP_MASK 0
#endif
#define DUP(k) (((DUP_MASK) >> (k)) & 1)
    if (IN(0)) { p0_prologue(F); } SEAM(0);
    if (IN(1)) {
        pg8::Gemm g{XB, (const bf16*)(F.ws + WS_W1A), MT, NGU, D}; pg8::StaticOrder S; S.init(MT, NGU, F.G, F.bx);
        pg8::EpiSwiglu E{ACT, (const float*)(F.ws + WS_RSTD1), 0};
        pg8::gemm_phase<pg8::EpiSwiglu, pg8::StaticOrder, true, true>(F.lds + RING_OFF, g, S, E);
    } SEAM(1);
    if (IN(2)) {
        pg8::Gemm g{ACT, (const bf16*)(F.ws + WS_W1B), MP, D, FF}; pg8::StaticOrder S; S.init(MP, D, F.G, F.bx);
        pg8::EpiResid E{F.in[IN_XP], F.in[IN_XS] - (size_t)MP * D, X1, X1B, SSQ2, 0.5f};
        pg8::gemm_phase<pg8::EpiResid, pg8::StaticOrder, true, true>(F.lds + RING_OFF, g, S, E);
        if (args.sub & 8) skinny_resid<FF>(F, ACT, (const bf16*)(F.ws + WS_W1B), F.in[IN_XS] - (size_t)MP * D, X1, X1B, SSQ2, 0.5f);
    } SEAM(2);
    if (IN(3)) {
        pg8::Gemm g{X1B, (const bf16*)(F.ws + WS_WIN), MT, U_BA, D}; pg8::StaticOrder S; S.init(MT, U_BA, F.G, F.bx);
        pg8::EpiU E{UU, BA, SSQ2};
        pg8::gemm_phase<pg8::EpiU, pg8::StaticOrder, true, true>(F.lds + RING_OFF, g, S, E);
        skinny_ba(F, X1B, (const bf16*)(F.ws + WS_WIN), SSQ2, BA);
    } SEAM(3);
    if (IN(4)) {
        if (args.sub & 1) { PrepIn pin; int i = F.bx;
            if (i < NREC) prep_fetch(F, (i & 31) >> 3, i & 7, i >> 5, pin);
            for (; i < NREC; i += F.G) { const int nx = i + F.G; gdn_prep_unit(F, (i & 31) >> 3, i & 7, i >> 5, pin, nx < NREC, (nx & 31) >> 3, nx & 7, nx >> 5); } }
        if (args.sub & 2) for (int j = F.bx; j < DB * 8; j += F.G) gdn_sample_unit(F, j >> 3, j & 7);
        if (args.sub & 4) copy_outputs(F);
    } SEAM(4);
    if (IN(5)) {
        phase5(F, args.qi, args.sub);
    } SEAM(5);
    if (IN(6)) { attn_merge(F); } SEAM(6);
    if (IN(7)) {
        { pg8::Gemm g{OA, (const bf16*)(F.ws + WS_WPA), MP, D, 512}; pg8::StaticOrder S; S.init(MP, D, F.G, F.bx);
          pg8::EpiGate<0> E{UU, nullptr, M1};
          pg8::gemm_phase<pg8::EpiGate<0>, pg8::StaticOrder, true, true>(F.lds + RING_OFF, g, S, E); }
        { pg8::Gemm g{OB, (const bf16*)(F.ws + WS_WPB), MP, D, D}; pg8::StaticOrder S; S.init(MP, D, F.G, F.bx);
          pg8::EpiGate<1> E{UU, M1, MG};
          pg8::gemm_phase<pg8::EpiGate<1>, pg8::StaticOrder, true, true>(F.lds + RING_OFF, g, S, E); }
        if (args.sub & 8) skinny_merge(F, OA, (const bf16*)(F.ws + WS_WPA), OB, (const bf16*)(F.ws + WS_WPB), UU, MG);
    } SEAM(7);
    if (IN(8)) {
        pg8::Gemm g{MG, (const bf16*)(F.ws + WS_WOUT), MP, D, D}; pg8::StaticOrder S; S.init(MP, D, F.G, F.bx);
        pg8::EpiResid E{X1, X1, X2, X2B, SSQ3, 1.0f};
        pg8::gemm_phase<pg8::EpiResid, pg8::StaticOrder, true, true>(F.lds + RING_OFF, g, S, E);
        skinny_resid<D>(F, MG, (const bf16*)(F.ws + WS_WOUT), X1, X2, X2B, SSQ3, 1.0f);
    } SEAM(8);
    if (IN(9)) {
        pg8::Gemm g{X2B, (const bf16*)(F.ws + WS_W2A), MT, NGU, D}; pg8::StaticOrder S; S.init(MT, NGU, F.G, F.bx);
        pg8::EpiSwiglu E{ACT, SSQ3, 1};
        pg8::gemm_phase<pg8::EpiSwiglu, pg8::StaticOrder, true, true>(F.lds + RING_OFF, g, S, E);
    } SEAM(9);
    if (IN(10)) {
        pg8::Gemm g{ACT, (const bf16*)(F.ws + WS_W2B), MP, D, FF}; pg8::StaticOrder S; S.init(MP, D, F.G, F.bx);
        pg8::EpiResid E{X2, X2, F.out + O_Y, nullptr, SSQ4, 0.5f};
        pg8::gemm_phase<pg8::EpiResid, pg8::StaticOrder, true, true>(F.lds + RING_OFF, g, S, E);
        skinny_resid<FF>(F, ACT, (const bf16*)(F.ws + WS_W2B), X2, F.out + O_Y, nullptr, SSQ4, 0.5f);
    } SEAM(10);
    if (IN(11)) { final_norm(F); }
#undef IN
#undef SEAM
}

extern "C" void kernel_launch(void* const* d_in, const int* in_sizes, int n_in, void* d_out, int out_size, void* d_ws, size_t ws_size, hipStream_t stream) {
    static int grid = 0;
    if (grid == 0) {
        if (n_in != 23 || out_size != (int)O_END || ws_size < WS_END) { fprintf(stderr, "kernel_launch: unexpected sizes n_in %d out %d ws %zu (need %zu)\n", n_in, out_size, ws_size, (size_t)WS_END); grid = -1; return; }
        int dev = 0, cus = 0, per_cu = 0;
        if (hipGetDevice(&dev) != hipSuccess || hipDeviceGetAttribute(&cus, hipDeviceAttributeMultiprocessorCount, dev) != hipSuccess) { grid = -1; return; }
        if (hipFuncSetAttribute((const void*)mk_fwd, hipFuncAttributeMaxDynamicSharedMemorySize, LDS_BYTES) != hipSuccess) { fprintf(stderr, "kernel_launch: hipFuncSetAttribute failed\n"); grid = -1; return; }
        if (hipOccupancyMaxActiveBlocksPerMultiprocessor(&per_cu, (const void*)mk_fwd, NWAVES * 64, LDS_BYTES) != hipSuccess || per_cu < 1) { fprintf(stderr, "kernel_launch: occupancy query says %d\n", per_cu); per_cu = 1; }
        (void)hipGetLastError();
        grid = cus;
    }
    if (grid < 0) return;
    if (hipMemsetAsync((char*)d_ws + WS_CTL, 0, CTL_ZERO_BYTES, stream) != hipSuccess) return;
    Args a{};
    for (int i = 0; i < 23; ++i) a.in[i] = (const float*)d_in[i];
    a.out = (float*)d_out; a.ws = (unsigned char*)d_ws;
#if MK_N_LAUNCHES == 1
    a.ph_lo = 0; a.ph_hi = N_PHASES; a.sub = 15; a.qi = 0;
    hipLaunchKernelGGL(mk_fwd, dim3(grid), dim3(NWAVES * 64), LDS_BYTES, stream, a);
#ifdef EXTRA_MASK
    for (int p = 0; p < N_PHASES; ++p) if ((EXTRA_MASK >> p) & 1) { a.ph_lo = p; a.ph_hi = p + 1; a.sub = EXTRA_SUB; a.qi = 1; hipLaunchKernelGGL(mk_fwd, dim3(grid), dim3(NWAVES * 64), LDS_BYTES, stream, a); }
#endif
#else
    a.sub = 15; a.qi = 0;
    for (int p = 0; p < N_PHASES; ++p) { a.ph_lo = p; a.ph_hi = p + 1; hipLaunchKernelGGL(mk_fwd, dim3(grid), dim3(NWAVES * 64), LDS_BYTES, stream, a); }
#endif
}
```

```cpp
#include <hip/hip_runtime.h>
#include <cstdio>
#include <cstdint>
#define MK_N_LAUNCHES 1
namespace pg8 {
#define PG8_LAS __attribute__((address_space(3)))
typedef unsigned short bf16_t;
typedef short bf16x8 __attribute__((ext_vector_type(8)));
typedef float f32x4 __attribute__((ext_vector_type(4)));
typedef unsigned u32x4 __attribute__((ext_vector_type(4)));
constexpr int BM = 256, BK = 64, HALF = 128, HTB = HALF * BK * 2  , STAGE_BYTES = 8 * HTB, NXCD = 8, WGM = 8;

__host__ __device__ __forceinline__ int lds_byte(int r, int c) { const int st = (r >> 4) * 2 + (c >> 5), rr = r & 15, cc = c & 31, ob = rr * 64 + cc * 2; return st * 1024 + (ob ^ (((ob >> 9) & 1) << 5)); }
__host__ __device__ __forceinline__ void stage_rc(int b, int& R, int& C) { const int st = b / 1024, sb = b % 1024, swz = sb ^ (((sb >> 9) & 1) << 5); R = (st >> 1) * 16 + swz / 64; C = (st & 1) * 32 + (swz % 64) / 2; }
__host__ __device__ __forceinline__ int perm32(int rho) { const int n = rho >> 4, i = rho & 15; return 8 * (i >> 2) + 4 * n + (i & 3); }

struct Unit { int pm, pn; };
struct Gemm { const bf16_t* A; const bf16_t* Bt; int M, N, K; };
struct StaticOrder {
    int nM, nN, nwg, G, c;
    __host__ __device__ void init(int M, int N, int G_, int c_) { nM = M / BM; nN = N / BM; nwg = nM * nN; G = G_; c = c_; }
    __host__ __device__ bool next(int i, Unit& u) const {
        const long L = (long)i * G + c; if (L >= nwg) return false;
        int wgid = (int)L; { const int q = nwg / NXCD, r = nwg % NXCD, xcd = wgid % NXCD, off = wgid / NXCD; wgid = (xcd < r ? xcd * (q + 1) : r * (q + 1) + (xcd - r) * q) + off; }
        const int nig = WGM * nN, gid = wgid / nig, fm = gid * WGM, gsz = (nM - fm) < WGM ? (nM - fm) : WGM;
        u.pm = fm + ((wgid % nig) % gsz); u.pn = (wgid % nig) / gsz; return true;
    }
    __device__ __forceinline__ void a_ready(const Unit&) const {}
    __device__ __forceinline__ void done(const Unit&) const {}
};
__device__ __forceinline__ unsigned cvt_pk_bf16(float lo, float hi) { unsigned r; asm volatile("v_cvt_pk_bf16_f32 %0, %1, %2" : "=v"(r) : "v"(lo), "v"(hi)); return r; }
typedef float f32x2 __attribute__((ext_vector_type(2)));
template <class Epi, class Sched, bool ALIGN_EPI = false, bool SP2 = false>
__device__ __forceinline__ void gemm_phase(PG8_LAS unsigned char* lds, const Gemm g, const Sched& S, const Epi& E) {
    const int tid = threadIdx.x, wid = __builtin_amdgcn_readfirstlane(tid >> 6), lane = tid & 63, wr = wid >> 2, wc = wid & 3, fr = lane & 15, fq = lane >> 4;
    const int K = g.K, nt = K / BK;
    unsigned voffA[2], voffB[2];
#pragma unroll
    for (int i = 0; i < 2; ++i) { int R, C; stage_rc(tid * 16 + i * 8192, R, C); const int Rb = Epi::PERM ? ((R & ~31) + perm32(R & 31)) : R;
        voffA[i] = (unsigned)(R * K + C) * 2u; voffB[i] = (unsigned)(Rb * K + C) * 2u; }
    const size_t kstep = (size_t)(BK * 2);
    const size_t hstep = (size_t)HALF * K * 2;
    const size_t tstep = 2 * hstep;
    const unsigned ldsw = (unsigned)wid * 1024u;
    const int aoff = lds_byte(wr * 64 + fr, fq * 8), boff = lds_byte(wc * 32 + fr, fq * 8);
#define PG8_SA(b, h) (((b) * 2 + (h)) * HTB)
#define PG8_SB(b, h) ((4 + (b) * 2 + (h)) * HTB)
#define PG8_STAGE(bufoff, gbase, voff) do { _Pragma("unroll") for (int _i = 0; _i < 2; ++_i) \
        __builtin_amdgcn_global_load_lds((const unsigned*)((const char*)(gbase) + (voff)[_i]), (PG8_LAS unsigned*)(lds + (bufoff) + ldsw + _i * 8192), 16, 0, 0); } while (0)
#define PG8_LDA(dst, b, h) do { _Pragma("unroll") for (int m = 0; m < 4; ++m) _Pragma("unroll") for (int k = 0; k < 2; ++k) dst[m][k] = *(const PG8_LAS bf16x8*)(lds + PG8_SA(b, h) + aoff + m * 2048 + k * 1024); } while (0)
#define PG8_LDB(dst, b, h) do { _Pragma("unroll") for (int n = 0; n < 2; ++n) _Pragma("unroll") for (int k = 0; k < 2; ++k) dst[n][k] = *(const PG8_LAS bf16x8*)(lds + PG8_SB(b, h) + boff + n * 2048 + k * 1024); } while (0)
#define PG8_MMA(ai, bj, At, Bt) do { __builtin_amdgcn_s_setprio(1); _Pragma("unroll") for (int m = 0; m < 4; ++m) _Pragma("unroll") for (int n = 0; n < 2; ++n) _Pragma("unroll") for (int k = 0; k < 2; ++k) \
        acc[ai][bj][m][n] = __builtin_amdgcn_mfma_f32_16x16x32_bf16(Bt[n][k], At[m][k], acc[ai][bj][m][n], 0, 0, 0); __builtin_amdgcn_s_setprio(0); } while (0)
#define PG8_WAIT_V(n) asm volatile("s_waitcnt vmcnt(" #n ")" ::: "memory")
#define PG8_WAIT_L(n) asm volatile("s_waitcnt lgkmcnt(" #n ")" ::: "memory")
#define PG8_BAR __builtin_amdgcn_s_barrier()
#define PG8_SCHED __builtin_amdgcn_sched_barrier(0)
    Unit cur, nxt; int ui = 0;
    if (!S.next(0, cur)) return;
    f32x4 acc[2][2][4][2];
#pragma unroll
    for (int a = 0; a < 2; ++a)
#pragma unroll
        for (int b = 0; b < 2; ++b)
#pragma unroll
            for (int m = 0; m < 4; ++m)
#pragma unroll
                for (int n = 0; n < 2; ++n) acc[a][b][m][n] = (f32x4){0.f, 0.f, 0.f, 0.f};
    bf16x8 At[4][2], B0[2][2], B1[2][2];
    const char* cA = (const char*)g.A + (size_t)cur.pm * tstep; const char* cB = (const char*)g.Bt + (size_t)cur.pn * tstep;
    S.a_ready(cur);
    if constexpr (SP2) {
        PG8_STAGE(PG8_SB(0, 0), cB, voffB); PG8_STAGE(PG8_SB(0, 1), cB + hstep, voffB); PG8_STAGE(PG8_SA(0, 0), cA, voffA); PG8_STAGE(PG8_SA(0, 1), cA + hstep, voffA);
        if (wr == 1) PG8_BAR;
        PG8_WAIT_V(2); PG8_BAR;
        PG8_STAGE(PG8_SB(1, 0), cB + kstep, voffB); PG8_STAGE(PG8_SA(1, 0), cA + kstep, voffA); PG8_STAGE(PG8_SB(1, 1), cB + hstep + kstep, voffB);
        PG8_WAIT_V(6); PG8_BAR;
    } else {
        PG8_STAGE(PG8_SB(0, 0), cB, voffB); PG8_STAGE(PG8_SA(0, 0), cA, voffA); PG8_STAGE(PG8_SB(0, 1), cB + hstep, voffB); PG8_STAGE(PG8_SA(0, 1), cA + hstep, voffA);
        if (wr == 1) PG8_BAR;
        PG8_WAIT_V(4); PG8_BAR;
        PG8_STAGE(PG8_SB(1, 0), cB + kstep, voffB); PG8_STAGE(PG8_SA(1, 0), cA + kstep, voffA); PG8_STAGE(PG8_SB(1, 1), cB + hstep + kstep, voffB);
        PG8_WAIT_V(6); PG8_BAR;
    }
    for (;;) {
        const bool has_next = S.next(ui + 1, nxt);
        const char* nA = has_next ? (const char*)g.A + (size_t)nxt.pm * tstep : cA; const char* nB = has_next ? (const char*)g.Bt + (size_t)nxt.pn * tstep : cB;
        for (int t = 0; t < nt; t += 2) {
            const bool last = (t == nt - 2);
            const char* a1 = cA + (size_t)(t + 1) * kstep;
            const char* a2 = last ? nA : cA + (size_t)(t + 2) * kstep; const char* b2 = last ? nB : cB + (size_t)(t + 2) * kstep;
            const char* a3 = a2 + kstep; const char* b3 = b2 + kstep;
            if (last && has_next) S.a_ready(nxt);
            if constexpr (SP2) {
            PG8_LDB(B0, 0, 0); PG8_LDB(B1, 0, 1); PG8_SCHED; PG8_LDA(At, 0, 0); PG8_STAGE(PG8_SA(1, 1), a1 + hstep, voffA);
            PG8_WAIT_V(8); PG8_WAIT_L(0); PG8_BAR; PG8_MMA(0, 0, At, B0); PG8_MMA(0, 1, At, B1); PG8_BAR; PG8_SCHED;
            PG8_LDA(At, 0, 1); PG8_STAGE(PG8_SB(0, 0), b2, voffB); PG8_STAGE(PG8_SB(0, 1), b2 + hstep, voffB); PG8_STAGE(PG8_SA(0, 0), a2, voffA);
            PG8_WAIT_V(8); PG8_WAIT_L(0); PG8_BAR; PG8_MMA(1, 0, At, B0); PG8_MMA(1, 1, At, B1); PG8_BAR; PG8_SCHED;
            PG8_LDB(B0, 1, 0); PG8_LDB(B1, 1, 1); PG8_SCHED; PG8_LDA(At, 1, 0); PG8_STAGE(PG8_SA(0, 1), a2 + hstep, voffA);
            PG8_WAIT_V(8); PG8_WAIT_L(0); PG8_BAR; PG8_MMA(0, 0, At, B0); PG8_MMA(0, 1, At, B1); PG8_BAR; PG8_SCHED;
            PG8_LDA(At, 1, 1); PG8_STAGE(PG8_SB(1, 0), b3, voffB); PG8_STAGE(PG8_SB(1, 1), b3 + hstep, voffB); PG8_STAGE(PG8_SA(1, 0), a3, voffA);
            PG8_WAIT_V(8); PG8_WAIT_L(0); PG8_BAR; PG8_MMA(1, 0, At, B0); PG8_MMA(1, 1, At, B1); PG8_BAR; PG8_SCHED;
            } else {
            PG8_LDB(B0, 0, 0); PG8_SCHED; PG8_LDA(At, 0, 0); PG8_STAGE(PG8_SA(1, 1), a1 + hstep, voffA);
            PG8_WAIT_L(8); PG8_BAR; PG8_WAIT_L(0); PG8_MMA(0, 0, At, B0); PG8_BAR; PG8_SCHED;
            PG8_LDB(B1, 0, 1); PG8_STAGE(PG8_SB(0, 0), b2, voffB);
            PG8_BAR; PG8_WAIT_L(0); PG8_MMA(0, 1, At, B1); PG8_BAR;
            PG8_LDA(At, 0, 1); PG8_STAGE(PG8_SA(0, 0), a2, voffA);
            PG8_BAR; PG8_WAIT_L(0); PG8_MMA(1, 0, At, B0); PG8_BAR; PG8_SCHED;
            PG8_STAGE(PG8_SB(0, 1), b2 + hstep, voffB);
            PG8_WAIT_V(6); PG8_BAR; PG8_MMA(1, 1, At, B1); PG8_BAR;
            PG8_LDB(B0, 1, 0); PG8_SCHED; PG8_LDA(At, 1, 0); PG8_STAGE(PG8_SA(0, 1), a2 + hstep, voffA);
            PG8_WAIT_L(8); PG8_BAR; PG8_WAIT_L(0); PG8_MMA(0, 0, At, B0); PG8_BAR; PG8_SCHED;
            PG8_LDB(B1, 1, 1); PG8_STAGE(PG8_SB(1, 0), b3, voffB);
            PG8_BAR; PG8_WAIT_L(0); PG8_MMA(0, 1, At, B1); PG8_BAR;
            PG8_LDA(At, 1, 1); PG8_STAGE(PG8_SA(1, 0), a3, voffA);
            PG8_BAR; PG8_WAIT_L(0); PG8_MMA(1, 0, At, B0); PG8_BAR; PG8_SCHED;
            PG8_STAGE(PG8_SB(1, 1), b3 + hstep, voffB);
            PG8_WAIT_V(6); PG8_BAR; PG8_MMA(1, 1, At, B1); PG8_BAR;
            }
        }
        if constexpr (ALIGN_EPI) { if (wr == 0) PG8_BAR; }
        if constexpr (!Epi::AFTER_DRAIN) { E(acc, cur, wr, wc, fr, fq); S.done(cur); }
        if (!has_next) break;
#pragma unroll
        for (int a = 0; a < 2; ++a)
#pragma unroll
            for (int b = 0; b < 2; ++b)
#pragma unroll
                for (int m = 0; m < 4; ++m)
#pragma unroll
                    for (int n = 0; n < 2; ++n) acc[a][b][m][n] = (f32x4){0.f, 0.f, 0.f, 0.f};
        cur = nxt; cA = nA; cB = nB; ++ui;
        if constexpr (ALIGN_EPI) { if (wr == 1) PG8_BAR; }
    }
    PG8_WAIT_V(0);
    if constexpr (!ALIGN_EPI) { if (wr == 0) PG8_BAR; }
    PG8_BAR;
    if constexpr (Epi::AFTER_DRAIN) { E.fused(acc, cur, wr, wc, fr, fq, lds, wid, lane); S.done(cur); }
#undef PG8_SA
#undef PG8_SB
#undef PG8_STAGE
#undef PG8_LDA
#undef PG8_LDB
#undef PG8_MMA
#undef PG8_WAIT_V
#undef PG8_WAIT_L
#undef PG8_BAR
#undef PG8_SCHED
}
}

constexpr int D = 1024, MP = 16384, MS = 512, MT = MP + MS, FF = 2816, NGU = 2 * FF;
constexpr int SEQ = 4096, NB = 4, DB = 128, DS = 4;
constexpr int NIN = 10768, NINP = 11008;
constexpr int U_QA = 0, U_KA = 1536, U_VA = 3072, U_QKVB = 4608, U_Z = 7680, U_GATE = 8704, U_BA = 10752;
constexpr float EPS = 1e-6f;

namespace pg8 {
typedef unsigned u32x2 __attribute__((ext_vector_type(2)));
__device__ __forceinline__ float sigm(float x) { return __builtin_amdgcn_rcpf(1.f + __expf(-x)); }
__device__ __forceinline__ float bf2f(unsigned short b) { return __uint_as_float(((unsigned)b) << 16); }
__device__ __forceinline__ float bflo(unsigned w) { return __uint_as_float(w << 16); }
__device__ __forceinline__ float bfhi(unsigned w) { return __uint_as_float(w & 0xffff0000u); }

struct EpiSwiglu {
    static constexpr bool PERM = true, AFTER_DRAIN = false;
    bf16_t* O; const float* rs; int mode;
    __device__ __forceinline__ void operator()(const f32x4 (&acc)[2][2][4][2], const Unit& u, int wr, int wc, int fr, int fq) const {
        const int row0 = u.pm * BM + wr * 64 + fr, col0 = u.pn * 128 + wc * 32 + 8 * fq;
#pragma unroll
        for (int ai = 0; ai < 2; ++ai)
#pragma unroll
            for (int m = 0; m < 4; ++m) {
                const int row = row0 + ai * HALF + m * 16;
                float r = rs[row]; if (mode) r = rsqrtf(r * (1.0f / D) + EPS);
                float o[8];
#pragma unroll
                for (int n = 0; n < 2; ++n)
#pragma unroll
                    for (int j = 0; j < 4; ++j) { const float g = acc[ai][0][m][n][j] * r, up = acc[ai][1][m][n][j] * r; o[4 * n + j] = g * sigm(g) * up; }
                u32x4 w; w.x = cvt_pk_bf16(o[0], o[1]); w.y = cvt_pk_bf16(o[2], o[3]); w.z = cvt_pk_bf16(o[4], o[5]); w.w = cvt_pk_bf16(o[6], o[7]);
                *(u32x4*)(O + (size_t)row * FF + col0) = w;
            }
    }
};
struct EpiResid {
    static constexpr bool PERM = false, AFTER_DRAIN = false;
    const float* base; const float* base2; float* out; bf16_t* xb; float* ssq; float scale;
    __device__ __forceinline__ void operator()(const f32x4 (&acc)[2][2][4][2], const Unit& u, int wr, int wc, int fr, int fq) const {
        const int row0 = u.pm * BM + wr * 64 + fr, col0 = u.pn * BM + wc * 32 + 4 * fq;
        const float* base = (u.pm * BM < MP) ? this->base : base2;
#pragma unroll
        for (int ai = 0; ai < 2; ++ai)
#pragma unroll
            for (int m = 0; m < 4; ++m) {
                const int row = row0 + ai * HALF + m * 16; const size_t off = (size_t)row * D + col0; float s = 0.f;
#pragma unroll
                for (int bj = 0; bj < 2; ++bj)
#pragma unroll
                    for (int n = 0; n < 2; ++n) {
                        const f32x4 b = *(const f32x4*)(base + off + bj * HALF + n * 16); const f32x4 v = b + acc[ai][bj][m][n] * scale;
                        *(f32x4*)(out + off + bj * HALF + n * 16) = v;
                        if (xb) { u32x2 w; w.x = cvt_pk_bf16(v[0], v[1]); w.y = cvt_pk_bf16(v[2], v[3]); *(u32x2*)(xb + off + bj * HALF + n * 16) = w; }
                        s += (v[0] * v[0] + v[1] * v[1]) + (v[2] * v[2] + v[3] * v[3]);
                    }
                s += __shfl_xor(s, 16); s += __shfl_xor(s, 32);
                if (fq == 0) atomicAdd(ssq + row, s);
            }
    }
};
struct EpiU {
    static constexpr bool PERM = true, AFTER_DRAIN = false;
    bf16_t* U; float* BA; const float* ssq;
    __device__ __forceinline__ void operator()(const f32x4 (&acc)[2][2][4][2], const Unit& u, int wr, int wc, int fr, int fq) const {
        const int row0 = u.pm * BM + wr * 64 + fr, col0 = u.pn * BM + wc * 32 + 8 * fq;
        const bool ba = (u.pn * BM == U_BA);
#pragma unroll
        for (int ai = 0; ai < 2; ++ai)
#pragma unroll
            for (int m = 0; m < 4; ++m) {
                const int row = row0 + ai * HALF + m * 16; const float r = rsqrtf(ssq[row] * (1.0f / D) + EPS);
                if (!ba) {
#pragma unroll
                    for (int bj = 0; bj < 2; ++bj) { const f32x4 v0 = acc[ai][bj][m][0] * r, v1 = acc[ai][bj][m][1] * r;
                        u32x4 w; w.x = cvt_pk_bf16(v0[0], v0[1]); w.y = cvt_pk_bf16(v0[2], v0[3]); w.z = cvt_pk_bf16(v1[0], v1[1]); w.w = cvt_pk_bf16(v1[2], v1[3]);
                        *(u32x4*)(U + (size_t)row * NINP + col0 + bj * HALF) = w; }
                } else if (wc == 0 && fq < 2) {
                    *(f32x4*)(BA + (size_t)row * 16 + 8 * fq) = acc[ai][0][m][0] * r; *(f32x4*)(BA + (size_t)row * 16 + 8 * fq + 4) = acc[ai][0][m][1] * r;
                }
            }
    }
};
template <int SECOND> struct EpiGate {
    static constexpr bool PERM = true, AFTER_DRAIN = false;
    const bf16_t* U; const bf16_t* M1; bf16_t* O;
    __device__ __forceinline__ void operator()(const f32x4 (&acc)[2][2][4][2], const Unit& u, int wr, int wc, int fr, int fq) const {
        const int row0 = u.pm * BM + wr * 64 + fr, col0 = u.pn * BM + wc * 32 + 8 * fq;
#pragma unroll
        for (int ai = 0; ai < 2; ++ai)
#pragma unroll
            for (int m = 0; m < 4; ++m) {
                const int row = row0 + ai * HALF + m * 16;
#pragma unroll
                for (int bj = 0; bj < 2; ++bj) {
                    const int col = col0 + bj * HALF;
                    const u32x4 g = *(const u32x4*)(U + (size_t)row * NINP + U_GATE + SECOND * D + col);
                    float o[8]; const f32x4 a0 = acc[ai][bj][m][0], a1 = acc[ai][bj][m][1];
                    o[0] = sigm(bflo(g.x)) * a0[0]; o[1] = sigm(bfhi(g.x)) * a0[1]; o[2] = sigm(bflo(g.y)) * a0[2]; o[3] = sigm(bfhi(g.y)) * a0[3];
                    o[4] = sigm(bflo(g.z)) * a1[0]; o[5] = sigm(bfhi(g.z)) * a1[1]; o[6] = sigm(bflo(g.w)) * a1[2]; o[7] = sigm(bfhi(g.w)) * a1[3];
                    if (SECOND) { const u32x4 p = *(const u32x4*)(M1 + (size_t)row * D + col);
                        o[0] += bflo(p.x); o[1] += bfhi(p.x); o[2] += bflo(p.y); o[3] += bfhi(p.y); o[4] += bflo(p.z); o[5] += bfhi(p.z); o[6] += bflo(p.w); o[7] += bfhi(p.w); }
                    u32x4 w; w.x = cvt_pk_bf16(o[0], o[1]); w.y = cvt_pk_bf16(o[2], o[3]); w.z = cvt_pk_bf16(o[4], o[5]); w.w = cvt_pk_bf16(o[6], o[7]);
                    *(u32x4*)(O + (size_t)row * D + col) = w;
                }
            }
    }
};
}

#define GAS __attribute__((address_space(1)))
#define LAS __attribute__((address_space(3)))
typedef unsigned short bf16;
typedef unsigned v4u __attribute__((ext_vector_type(4)));
typedef unsigned v2u __attribute__((ext_vector_type(2)));
typedef float f32x4 __attribute__((ext_vector_type(4)));
typedef float f32x2 __attribute__((ext_vector_type(2)));
typedef short bf16x8 __attribute__((ext_vector_type(8)));
typedef short bf16x4 __attribute__((ext_vector_type(4)));
typedef GAS unsigned gu32;
#define RLX_AGENT __ATOMIC_RELAXED, __HIP_MEMORY_SCOPE_AGENT
#define LDS_WAIT() asm volatile("s_waitcnt lgkmcnt(0)" ::: "memory")
#define VM_WAIT() asm volatile("s_waitcnt vmcnt(0)" ::: "memory")
__device__ __forceinline__ unsigned f2bf(float f) { unsigned u = __builtin_bit_cast(unsigned, f); return (u + 0x7fffu + ((u >> 16) & 1u)) >> 16; }
typedef __bf16 bf16x2_t __attribute__((ext_vector_type(2)));
__device__ __forceinline__ unsigned pk2(float lo, float hi) { const bf16x2_t v = __builtin_convertvector((f32x2){lo, hi}, bf16x2_t); return __builtin_bit_cast(unsigned, v); }
__device__ __forceinline__ float bf2f(unsigned short b) { return __uint_as_float(((unsigned)b) << 16); }
__device__ __forceinline__ float bflo(unsigned w) { return __uint_as_float(w << 16); }
__device__ __forceinline__ float bfhi(unsigned w) { return __uint_as_float(w & 0xffff0000u); }
__device__ __forceinline__ float sigm(float x) { return __builtin_amdgcn_rcpf(1.f + __expf(-x)); }
__device__ __forceinline__ float siluf(float x) { return x * __builtin_amdgcn_rcpf(1.f + __expf(-x)); }
__device__ __forceinline__ float wave_sum(float v) {
#pragma unroll
    for (int o = 1; o < 64; o <<= 1) v += __shfl_xor(v, o);
    return v;
}
__device__ __forceinline__ float wave_max(float v) {
#pragma unroll
    for (int o = 1; o < 64; o <<= 1) v = fmaxf(v, __shfl_xor(v, o));
    return v;
}
template <int CTRL> __device__ __forceinline__ float dpp_f(float v) { return __builtin_bit_cast(float, __builtin_amdgcn_update_dpp(0, __builtin_bit_cast(int, v), CTRL, 0xf, 0xf, true)); }
__device__ __forceinline__ float row_sum16(float v) { v += dpp_f<0xB1>(v); v += dpp_f<0x4E>(v); v += dpp_f<0x141>(v); v += dpp_f<0x140>(v); return v; }
__device__ __forceinline__ f32x4 mfma16(bf16x8 a, bf16x8 b, f32x4 c) { return __builtin_amdgcn_mfma_f32_16x16x32_bf16(a, b, c, 0, 0, 0); }
__device__ __forceinline__ bf16x8 pack8(f32x4 a, f32x4 b) {
    v4u w; w.x = pk2(a[0], a[1]); w.y = pk2(a[2], a[3]); w.z = pk2(b[0], b[1]); w.w = pk2(b[2], b[3]); return __builtin_bit_cast(bf16x8, w);
}
#define WG_BARRIER() do { asm volatile("s_waitcnt lgkmcnt(0)" ::: "memory"); __builtin_amdgcn_s_barrier(); asm volatile("" ::: "memory"); } while (0)
#define XB_TMO      128
#define XB_XCNT(j)  (256  + 64 * (j))
#define XB_XSUB(j)  (1280 + 64 * (j))
#define XB_XGEN(j)  (2304 + 64 * (j))
#define XB_TOP      3328
#define XB_TOPGEN   3392
#define XCD_BAR_WORDS 3456
#define XB_SPIN_CAP (1u << 18)

__device__ __forceinline__ unsigned xb_ld(unsigned* p)              { return __hip_atomic_load(p, __ATOMIC_RELAXED, __HIP_MEMORY_SCOPE_AGENT); }
__device__ __forceinline__ unsigned xb_add(unsigned* p, unsigned v) { return __hip_atomic_fetch_add(p, v, __ATOMIC_RELAXED, __HIP_MEMORY_SCOPE_AGENT); }
__device__ __forceinline__ unsigned xb_xcc_id() { return (unsigned)__builtin_amdgcn_s_getreg((3 << 11) | 20) & 0xFu; }
#define XB_SPIN(cond, bar) do { unsigned _sp = 0; while (cond) { __builtin_amdgcn_s_sleep(1); \
    if ((++_sp & 255u) == 0u) { if (xb_ld(&(bar)[XB_TMO])) break; if (_sp > XB_SPIN_CAP) { atomicAdd(&(bar)[XB_TMO], 1u); break; } } } } while (0)

struct XcdBarrier {
    unsigned* bar; unsigned x;
    volatile LAS unsigned* st;
};

__device__ __forceinline__ XcdBarrier xcd_barrier_post(unsigned* bar, volatile LAS unsigned* st) {
    XcdBarrier b; b.bar = bar; b.x = xb_xcc_id(); b.st = st;
    if (threadIdx.x == 0) (void)xb_add(&bar[XB_XCNT(b.x)], 1u);
    return b;
}
__device__ __forceinline__ void xcd_barrier_complete(unsigned* bar, unsigned x, unsigned& nloc, unsigned& nx) {
    const unsigned G = gridDim.x * gridDim.y * gridDim.z;
    unsigned sum, cnt, mine, sp = 0u;
    for (;;) {
        sum = 0u; cnt = 0u; mine = 0u;
#pragma unroll
        for (unsigned j = 0; j < 16; ++j) { const unsigned c = xb_ld(&bar[XB_XCNT(j)]); sum += c; cnt += (c > 0u) ? 1u : 0u; mine = (j == x) ? c : mine; }
        if (sum == G) break;
        __builtin_amdgcn_s_sleep(1);
        if ((++sp & 255u) == 0u) { if (xb_ld(&bar[XB_TMO])) break; if (sp > XB_SPIN_CAP) { atomicAdd(&bar[XB_TMO], 1u); break; } }
    }
    nloc = mine > 0u ? mine : 1u; nx = cnt > 0u ? cnt : 1u;
}

__device__ __forceinline__ void xcd_barrier(const XcdBarrier& b) {
    asm volatile("s_waitcnt vmcnt(0)" ::: "memory");
    __syncthreads();
    if (threadIdx.x == 0) {
        unsigned* bar = b.bar;
        __builtin_amdgcn_s_waitcnt(0);
        unsigned nloc = b.st[0], nx = b.st[1];
        if (nloc == 0u) { xcd_barrier_complete(bar, b.x, nloc, nx); b.st[0] = nloc; b.st[1] = nx; }
        const unsigned old = xb_add(&bar[XB_XSUB(b.x)], 1u);
        const unsigned gen = old / nloc;
        if (old + 1u == (gen + 1u) * nloc) {
            __builtin_amdgcn_fence(__ATOMIC_RELEASE, "agent");
            asm volatile("s_waitcnt vmcnt(0)" ::: "memory");
            const unsigned og = xb_add(&bar[XB_TOP], 1u);
            const unsigned tg = og / nx;
            if (og + 1u == (tg + 1u) * nx) xb_add(&bar[XB_TOPGEN], 1u);
            else XB_SPIN(xb_ld(&bar[XB_TOPGEN]) == tg, bar);
            __builtin_amdgcn_fence(__ATOMIC_ACQUIRE, "agent");
            xb_add(&bar[XB_XGEN(b.x)], 1u);
            asm volatile("s_waitcnt vmcnt(0)" ::: "memory");
        } else {
            XB_SPIN(xb_ld(&bar[XB_XGEN(b.x)]) == gen, bar);
            __builtin_amdgcn_fence(__ATOMIC_ACQUIRE, "agent");
            asm volatile("s_waitcnt vmcnt(0)" ::: "memory");
        }
    }
    __syncthreads();
}


constexpr size_t MiB = 1u << 20;
constexpr size_t al256(size_t x) { return (x + 255) & ~(size_t)255; }
constexpr size_t WS_CTL = 0, CTL_ZERO_BYTES = 1 * MiB;
constexpr size_t WS_W1A = 1 * MiB;
constexpr size_t WS_W1B = WS_W1A + (size_t)NGU * D * 2;
constexpr size_t WS_WIN = WS_W1B + (size_t)D * FF * 2;
constexpr size_t WS_WPA = WS_WIN + (size_t)NINP * D * 2;
constexpr size_t WS_WPB = WS_WPA + (size_t)D * 512 * 2;
constexpr size_t WS_WOUT = WS_WPB + (size_t)D * D * 2;
constexpr size_t WS_W2A = WS_WOUT + (size_t)D * D * 2;
constexpr size_t WS_W2B = WS_W2A + (size_t)NGU * D * 2;
constexpr size_t WS_XB = al256(WS_W2B + (size_t)D * FF * 2);
constexpr size_t WS_RSTD1 = WS_XB + (size_t)MT * D * 2;
constexpr size_t WS_ACT = al256(WS_RSTD1 + (size_t)MT * 4);
constexpr size_t WS_X1 = WS_ACT + (size_t)MT * FF * 2;
constexpr size_t WS_X1B = WS_X1 + (size_t)MT * D * 4;
constexpr size_t WS_U = WS_X1B + (size_t)MT * D * 2;
constexpr size_t WS_BA = WS_U + (size_t)MT * NINP * 2;
constexpr size_t REC_BYTES = 90112;
constexpr int NREC = NB * 8 * 64;
constexpr size_t WS_REC = WS_BA + (size_t)MT * 16 * 4;
constexpr size_t WS_GE = WS_REC + (size_t)NREC * REC_BYTES;
constexpr size_t WS_OB = al256(WS_GE + (size_t)NREC * 4);
constexpr size_t WS_OG = WS_OB + (size_t)MT * D * 2;
constexpr size_t WS_LSE = WS_OG + (size_t)MT * 1536 * 2;
constexpr size_t WS_OA = al256(WS_LSE + (size_t)MT * 12 * 4);
constexpr size_t WS_M1 = WS_OA + (size_t)MT * 512 * 2;
constexpr size_t WS_MG = WS_M1 + (size_t)MT * D * 2;
constexpr size_t WS_X2 = WS_MG + (size_t)MT * D * 2;
constexpr size_t WS_X2B = WS_X2 + (size_t)MT * D * 4;
constexpr size_t WS_END = WS_X2B + (size_t)MT * D * 2;
constexpr int CW_TMO = 0;
constexpr int CW_BAR = 4096;
constexpr int CW_Q = 8192;
constexpr int CW_SSQ2 = 16384, CW_SSQ3 = CW_SSQ2 + 17408, CW_SSQ4 = CW_SSQ3 + 17408;
static_assert((CW_SSQ4 + 17408) * 4 <= (int)CTL_ZERO_BYTES, "CTL words inside the memset region");

constexpr size_t O_Y = 0;
constexpr size_t O_KVP0 = (size_t)MT * D;
constexpr size_t O_KVP1 = O_KVP0 + 524288;
constexpr size_t O_KVP2 = O_KVP1 + 2097152;
constexpr size_t O_CONVP = O_KVP2 + 8388608;
constexpr size_t O_SSMP = O_CONVP + 36864;
constexpr size_t O_KVS0 = O_SSMP + 524288;
constexpr size_t O_KVS1 = O_KVS0 + 524288;
constexpr size_t O_KVS2 = O_KVS1 + 524288;
constexpr size_t O_CONVS = O_KVS2 + 524288;
constexpr size_t O_SSMS = O_CONVS + 1179648;
constexpr size_t O_END = O_SSMS + 16777216;

constexpr int NWAVES = 8;
constexpr int RING_OFF = 0;
constexpr int LDSCTL_OFF = 151552, MISC_OFF = LDSCTL_OFF + 320;
constexpr int LDS_BYTES = 155648;

struct Frame {
    LAS unsigned char* lds;
    LAS unsigned char* ldv;
    volatile LAS unsigned* MISC;
    gu32* ctl;
    int tid, lane, wave, G, bx;
    const float* const* in; float* out; unsigned char* ws;
};
#define IN_XP 0
#define IN_XS 1
#define IN_C128 2
#define IN_C512 3
#define IN_C2048 4
#define IN_SCONV 5
#define IN_SSSM 6
#define IN_NF1 7
#define IN_W1GU 8
#define IN_W1D 9
#define IN_NMIX 10
#define IN_WIN 11
#define IN_CONVW 12
#define IN_ALOG 13
#define IN_DTB 14
#define IN_GNORM 15
#define IN_WPA 16
#define IN_WPB 17
#define IN_WOUT 18
#define IN_NF2 19
#define IN_W2GU 20
#define IN_W2D 21
#define IN_NOUT 22

template <class Map>
__device__ __forceinline__ void p0_transpose_item(const float* W, int K, int N, bf16* WT, const float* gain, LAS float* scr, int item, int lane, Map map) {
    const int nblk = (N + 31) / 32, kb = item / nblk, nb = item % nblk, k0 = 64 * kb, n0 = 32 * nb;
    const int nc = n0 + (lane & 31); const bool okc = nc < N;
    float wv[32];
#pragma unroll
    for (int i = 0; i < 32; ++i) { const int kk = 2 * i + (lane >> 5); wv[i] = okc ? W[(size_t)(k0 + kk) * N + nc] : 0.f; }
    if (gain) {
#pragma unroll
        for (int i = 0; i < 32; ++i) wv[i] *= gain[k0 + 2 * i + (lane >> 5)]; }
#pragma unroll
    for (int i = 0; i < 32; ++i) scr[(2 * i + (lane >> 5)) * 33 + (lane & 31)] = wv[i];
    LDS_WAIT(); asm volatile("" ::: "memory");
    const int c = lane & 7;
#pragma unroll
    for (int j = 0; j < 4; ++j) { const int n = (lane >> 3) + 8 * j; const LAS float* s = scr + (8 * c) * 33 + n;
        v4u o; o.x = pk2(s[0 * 33], s[1 * 33]); o.y = pk2(s[2 * 33], s[3 * 33]); o.z = pk2(s[4 * 33], s[5 * 33]); o.w = pk2(s[6 * 33], s[7 * 33]);
        if (n0 + n < N) *(GAS v4u*)(WT + (size_t)map(n0 + n) * K + k0 + 8 * c) = o; }
    LDS_WAIT(); asm volatile("" ::: "memory");
}
struct MapId { __device__ __forceinline__ int operator()(int c) const { return c; } };
struct MapGU { __device__ __forceinline__ int operator()(int c) const { return c < FF ? 256 * (c >> 7) + (c & 127) : 256 * ((c - FF) >> 7) + 128 + ((c - FF) & 127); } };
struct MapIn { __device__ __forceinline__ int operator()(int c) const { return c < 8704 ? c : (c < 8720 ? U_BA + (c - 8704) : c - 16); } };

__device__ __forceinline__ void p0_prologue(Frame& F) {
    LAS float* scr = (LAS float*)(F.ldv + RING_OFF + F.wave * 16384);
    const int gw = F.bx * NWAVES + F.wave, NGW = F.G * NWAVES;
    bf16* W1A = (bf16*)(F.ws + WS_W1A); bf16* W1B = (bf16*)(F.ws + WS_W1B); bf16* WIN = (bf16*)(F.ws + WS_WIN); bf16* WPA = (bf16*)(F.ws + WS_WPA);
    bf16* WPB = (bf16*)(F.ws + WS_WPB); bf16* WOUT = (bf16*)(F.ws + WS_WOUT); bf16* W2A = (bf16*)(F.ws + WS_W2A); bf16* W2B = (bf16*)(F.ws + WS_W2B);
    constexpr int I_GU = (D / 64) * (NGU / 32), I_DN = (FF / 64) * (D / 32), I_IN = (D / 64) * ((NIN + 31) / 32), I_PA = (512 / 64) * (D / 32), I_DD = (D / 64) * (D / 32);
    constexpr int NITEMS = 2 * I_GU + 2 * I_DN + I_IN + I_PA + 2 * I_DD;
    for (int it = gw; it < NITEMS; it += NGW) {
        int r = it;
        if (r < I_GU) { p0_transpose_item(F.in[IN_W1GU], D, NGU, W1A, F.in[IN_NF1], scr, r, F.lane, MapGU()); continue; } r -= I_GU;
        if (r < I_GU) { p0_transpose_item(F.in[IN_W2GU], D, NGU, W2A, F.in[IN_NF2], scr, r, F.lane, MapGU()); continue; } r -= I_GU;
        if (r < I_DN) { p0_transpose_item(F.in[IN_W1D], FF, D, W1B, nullptr, scr, r, F.lane, MapId()); continue; } r -= I_DN;
        if (r < I_DN) { p0_transpose_item(F.in[IN_W2D], FF, D, W2B, nullptr, scr, r, F.lane, MapId()); continue; } r -= I_DN;
        if (r < I_IN) { p0_transpose_item(F.in[IN_WIN], D, NIN, WIN, F.in[IN_NMIX], scr, r, F.lane, MapIn()); continue; } r -= I_IN;
        if (r < I_PA) { p0_transpose_item(F.in[IN_WPA], 512, D, WPA, nullptr, scr, r, F.lane, MapId()); continue; } r -= I_PA;
        if (r < I_DD) { p0_transpose_item(F.in[IN_WPB], D, D, WPB, nullptr, scr, r, F.lane, MapId()); continue; } r -= I_DD;
        p0_transpose_item(F.in[IN_WOUT], D, D, WOUT, nullptr, scr, r, F.lane, MapId());
    }
    { const int gt = F.bx * 512 + F.tid, NT = F.G * 512; GAS v4u* z = (GAS v4u*)(WIN + (size_t)NIN * D);
      for (int i = gt; i < (NINP - NIN) * D / 8; i += NT) z[i] = (v4u){0u, 0u, 0u, 0u}; }
    bf16* XB = (bf16*)(F.ws + WS_XB); float* RSTD1 = (float*)(F.ws + WS_RSTD1);
    for (int m0 = gw; m0 < MT; m0 += 2 * NGW) {
        f32x4 v[2][4]; float s[2];
#pragma unroll
        for (int r = 0; r < 2; ++r) { const int m = m0 + r * NGW; s[r] = 0.f;
            if (m < MT) { const float* xrow = (m < MP) ? F.in[IN_XP] + (size_t)m * D : F.in[IN_XS] + (size_t)(m - MP) * D; const GAS f32x4* xr = (const GAS f32x4*)xrow + F.lane;
#pragma unroll
                for (int j = 0; j < 4; ++j) v[r][j] = xr[64 * j]; } }
#pragma unroll
        for (int r = 0; r < 2; ++r) { const int m = m0 + r * NGW;
            if (m < MT) {
#pragma unroll
                for (int j = 0; j < 4; ++j) s[r] += (v[r][j].x * v[r][j].x + v[r][j].y * v[r][j].y) + (v[r][j].z * v[r][j].z + v[r][j].w * v[r][j].w);
                float t = row_sum16(s[r]); t += __shfl_xor(t, 16); t += __shfl_xor(t, 32);
                GAS v2u* o8 = (GAS v2u*)(XB + (size_t)m * D) + F.lane;
#pragma unroll
                for (int j = 0; j < 4; ++j) { v2u w; w.x = pk2(v[r][j].x, v[r][j].y); w.y = pk2(v[r][j].z, v[r][j].w); o8[64 * j] = w; }
                if (F.lane == 0) RSTD1[m] = rsqrtf(t * (1.0f / D) + EPS); } }
    }
}

__device__ __forceinline__ void final_norm(Frame& F) {
    const int gw = F.bx * NWAVES + F.wave, NGW = F.G * NWAVES;
    const float* ssq = (const float*)(F.ctl + CW_SSQ4); const GAS f32x4* nw = (const GAS f32x4*)F.in[IN_NOUT] + F.lane;
    f32x4 g[4];
#pragma unroll
    for (int j = 0; j < 4; ++j) g[j] = nw[64 * j];
    for (int m = gw; m < MT; m += NGW) {
        const float r = rsqrtf(ssq[m] * (1.0f / D) + EPS);
        GAS f32x4* xr = (GAS f32x4*)(F.out + O_Y + (size_t)m * D) + F.lane;
#pragma unroll
        for (int j = 0; j < 4; ++j) { f32x4 v = xr[64 * j]; xr[64 * j] = v * r * g[j]; }
    }
}

template <int K>
__device__ __forceinline__ void skinny_partial(const bf16* A, const bf16* Bt, int r0, int c0, int w, int lane, LAS unsigned char* part) {
    const int m16 = lane & 15, kg = lane >> 4;
    f32x4 acc[2][4];
#pragma unroll
    for (int i = 0; i < 2; ++i)
#pragma unroll
        for (int j = 0; j < 4; ++j) acc[i][j] = (f32x4){0.f, 0.f, 0.f, 0.f};
    const bf16* ap = A + (size_t)(r0 + m16) * K + w * (K / 8) + 8 * kg; const bf16* bp = Bt + (size_t)(c0 + m16) * K + w * (K / 8) + 8 * kg;
#pragma unroll 4
    for (int kb = 0; kb < K / 256; ++kb) {
        bf16x8 a[2], bq[4];
#pragma unroll
        for (int i = 0; i < 2; ++i) a[i] = *(const GAS bf16x8*)(ap + (size_t)16 * i * K + 32 * kb);
#pragma unroll
        for (int j = 0; j < 4; ++j) bq[j] = *(const GAS bf16x8*)(bp + (size_t)16 * j * K + 32 * kb);
#pragma unroll
        for (int i = 0; i < 2; ++i)
#pragma unroll
            for (int j = 0; j < 4; ++j) acc[i][j] = mfma16(bq[j], a[i], acc[i][j]);
    }
#pragma unroll
    for (int i = 0; i < 2; ++i)
#pragma unroll
        for (int j = 0; j < 4; ++j) *(LAS f32x4*)(part + ((w * 8 + i * 4 + j) * 64 + lane) * 16) = acc[i][j];
}
__device__ __forceinline__ f32x4 skinny_reduce(const LAS unsigned char* part, int w, int lane) {
    f32x4 s = {0.f, 0.f, 0.f, 0.f};
#pragma unroll
    for (int p = 0; p < 8; ++p) s = s + *(const LAS f32x4*)(part + ((p * 8 + w) * 64 + lane) * 16);
    return s;
}
template <int K>
__device__ __forceinline__ void skinny_resid(Frame& F, const bf16* A, const bf16* Bt, const float* base, float* out, bf16* xb, float* ssq, float scale) {
    const int lane = F.lane, w = F.wave, m16 = lane & 15, kg = lane >> 4, wr = w >> 2, wc = w & 3;
    for (int t = F.bx; t < 256; t += F.G) {
        const int r0 = MP + 32 * (t >> 4), c0 = 64 * (t & 15);
        skinny_partial<K>(A, Bt, r0, c0, w, lane, F.ldv);
        WG_BARRIER();
        const f32x4 acc = skinny_reduce(F.ldv, w, lane);
        const int row = r0 + 16 * wr + m16;
        const size_t off = (size_t)row * D + c0 + 16 * wc + 4 * kg;
        const f32x4 v = *(const GAS f32x4*)(base + off) + acc * scale;
        *(GAS f32x4*)(out + off) = v;
        if (xb) { v2u pk; pk.x = pk2(v[0], v[1]); pk.y = pk2(v[2], v[3]); *(GAS v2u*)(xb + off) = pk; }
        float s = (v[0] * v[0] + v[1] * v[1]) + (v[2] * v[2] + v[3] * v[3]);
        s += __shfl_xor(s, 16); s += __shfl_xor(s, 32);
        if (kg == 0) atomicAdd(ssq + row, s);
        WG_BARRIER();
    }
}
__device__ __forceinline__ void skinny_merge(Frame& F, const bf16* OA, const bf16* WPA, const bf16* OB, const bf16* WPB, const bf16* U, bf16* MG) {
    const int lane = F.lane, w = F.wave, m16 = lane & 15, kg = lane >> 4, wr = w >> 2, wc = w & 3;
    for (int t = F.bx; t < 256; t += F.G) {
        const int r0 = MP + 32 * (t >> 4), c0 = 64 * (t & 15);
        skinny_partial<512>(OA, WPA, r0, c0, w, lane, F.ldv);
        skinny_partial<D>(OB, WPB, r0, c0, w, lane, F.ldv + 65536);
        WG_BARRIER();
        const f32x4 aa = skinny_reduce(F.ldv, w, lane), ab = skinny_reduce(F.ldv + 65536, w, lane);
        const int row = r0 + 16 * wr + m16, col = c0 + 16 * wc + 4 * kg;
        const v2u ga = *(const GAS v2u*)(U + (size_t)row * NINP + U_GATE + col), gb = *(const GAS v2u*)(U + (size_t)row * NINP + U_GATE + D + col);
        v2u o; o.x = pk2(sigm(bflo(ga.x)) * aa[0] + sigm(bflo(gb.x)) * ab[0], sigm(bfhi(ga.x)) * aa[1] + sigm(bfhi(gb.x)) * ab[1]);
        o.y = pk2(sigm(bflo(ga.y)) * aa[2] + sigm(bflo(gb.y)) * ab[2], sigm(bfhi(ga.y)) * aa[3] + sigm(bfhi(gb.y)) * ab[3]);
        *(GAS v2u*)(MG + (size_t)row * D + col) = o;
        WG_BARRIER();
    }
}
__device__ __forceinline__ void skinny_ba(Frame& F, const bf16* X1B, const bf16* WIN, const float* ssq, float* BA) {
    const int lane = F.lane, m16 = lane & 15, kg = lane >> 4;
    for (int t = F.bx * NWAVES + F.wave; t < MT / 16; t += F.G * NWAVES) {
        const int row = 16 * t + m16;
        f32x4 acc = {0.f, 0.f, 0.f, 0.f}; { const bf16* ap = X1B + (size_t)row * D + 8 * kg; const bf16* bp = WIN + (size_t)(U_BA + m16) * D + 8 * kg;
#pragma unroll 16
            for (int kb = 0; kb < D / 32; ++kb) acc = mfma16(*(const GAS bf16x8*)(bp + 32 * kb), *(const GAS bf16x8*)(ap + 32 * kb), acc); }
        *(GAS f32x4*)(BA + (size_t)row * 16 + 4 * kg) = acc * rsqrtf(ssq[row] * (1.0f / D) + EPS);
    }
}

constexpr int GP_QR = 0, GP_KR = 17408, GP_KT = 34816, GP_KBG = 53248, GP_BVT = 71680, GP_GKK = 90112, GP_GQK = 107520, GP_TI = 124928, GP_TAB = 134144;
constexpr int GKP = 68;
__device__ __forceinline__ f32x4 mfma4(float a, float b, f32x4 c) { return __builtin_amdgcn_mfma_f32_16x16x4f32(a, b, c, 0, 0, 0); }
__device__ __forceinline__ f32x4 prod_ll(const LAS float* A, int ra, int ca, const LAS float* B, int rb, int cb, f32x4 c, int m16, int kg) {
    const f32x4 av = *(const LAS f32x4*)(A + (ra + m16) * GKP + ca + 4 * kg);
#pragma unroll
    for (int t = 0; t < 4; ++t) c = mfma4(av[t], B[(rb + 4 * kg + t) * GKP + cb + m16], c);
    return c;
}
__device__ __forceinline__ f32x4 prod_lr(const LAS float* A, int ra, int ca, f32x4 x, f32x4 c, int m16, int kg) {
    const f32x4 av = *(const LAS f32x4*)(A + (ra + m16) * GKP + ca + 4 * kg);
#pragma unroll
    for (int t = 0; t < 4; ++t) c = mfma4(av[t], x[t], c);
    return c;
}
__device__ __forceinline__ float softplusf(float x) { return x > 20.f ? x : log1pf(__expf(x)); }

struct PrepIn { v2u raw[19]; v4u zr0, zr1; f32x4 w0, w1, w2, w3; float bl, al; };
__device__ __forceinline__ void prep_fetch(Frame& F, int b, int h, int n, PrepIn& in) {
    const bf16* U = (const bf16*)(F.ws + WS_U); const float* BA = (const float*)(F.ws + WS_BA);
    const int tid = F.tid, row_base = b * SEQ + 64 * n;
    const int gz_t = tid >> 3, gz_c = (tid & 7) * 16;
    in.zr0 = *(const GAS v4u*)(U + (size_t)(row_base + gz_t) * NINP + U_Z + h * 128 + gz_c); in.zr1 = *(const GAS v4u*)(U + (size_t)(row_base + gz_t) * NINP + U_Z + h * 128 + gz_c + 8);
    const int cv_cq = tid & 31, cv_tq = (tid >> 5) & 3, cv_tensor = tid >> 7, cv_cw = cv_tensor * 1024 + h * 128 + 4 * cv_cq, cv_t0 = 16 * cv_tq;
    if (tid < 384) {
        in.w0 = *(const GAS f32x4*)(F.in[IN_CONVW] + cv_cw); in.w1 = *(const GAS f32x4*)(F.in[IN_CONVW] + 3072 + cv_cw); in.w2 = *(const GAS f32x4*)(F.in[IN_CONVW] + 2 * 3072 + cv_cw); in.w3 = *(const GAS f32x4*)(F.in[IN_CONVW] + 3 * 3072 + cv_cw);
#pragma unroll
        for (int i = 0; i < 19; ++i) { const int tok = 64 * n + cv_t0 - 3 + i; in.raw[i] = (v2u){0u, 0u}; if (tok >= 0) in.raw[i] = *(const GAS v2u*)(U + (size_t)(b * SEQ + tok) * NINP + U_QKVB + cv_cw); }
    }
    if (F.wave == 0) { in.bl = BA[(size_t)(row_base + F.lane) * 16 + h]; in.al = BA[(size_t)(row_base + F.lane) * 16 + 8 + h]; }
}
__device__ __forceinline__ void gdn_prep_unit(Frame& F, int b, int h, int n, PrepIn& in, bool has_next, int nb_, int nh_, int nn_) {
    LAS unsigned char* L = F.ldv;
    LAS float* TAB = (LAS float*)(L + GP_TAB);
    LAS float* GKK = (LAS float*)(L + GP_GKK);
    LAS float* GQK = (LAS float*)(L + GP_GQK);
    const bf16* U = (const bf16*)(F.ws + WS_U); const float* BA = (const float*)(F.ws + WS_BA);
    const int tid = F.tid, lane = F.lane, wave = F.wave;
    const int uidx = (b * 8 + h) * 64 + n;
    unsigned char* rec = F.ws + WS_REC + (size_t)uidx * REC_BYTES;
    const int row_base = b * SEQ + 64 * n;
    const int gz_t = tid >> 3, gz_c = (tid & 7) * 16;
    const int cv_cq = tid & 31, cv_tq = (tid >> 5) & 3, cv_tensor = tid >> 7, cv_c0 = 4 * cv_cq, cv_t0 = 16 * cv_tq;
    if (wave == 0) {
        const int t = lane; const float bl = in.bl, al = in.al;
        const float beta = sigm(bl); const float g = -__expf(F.in[IN_ALOG][h]) * softplusf(al + F.in[IN_DTB][h]);
        float gc = g;
#pragma unroll
        for (int o = 1; o < 64; o <<= 1) { const float v = __shfl_up(gc, o); if (lane >= o) gc += v; }
        const float gl = __shfl(gc, 63);
        TAB[t] = beta; TAB[64 + t] = gc; TAB[128 + t] = __expf(gc); TAB[192 + t] = __expf(gl - gc);
        if (lane == 0) ((float*)(F.ws + WS_GE))[uidx] = __expf(gl);
    }
    WG_BARRIER();
    if (tid < 384) {
        const int tensor = cv_tensor, c0 = cv_c0, t0 = cv_t0;
        f32x4 x[19];
#pragma unroll
        for (int i = 0; i < 19; ++i) x[i] = (f32x4){bflo(in.raw[i].x), bfhi(in.raw[i].x), bflo(in.raw[i].y), bfhi(in.raw[i].y)};
        const f32x4 w0 = in.w0, w1 = in.w1, w2 = in.w2, w3 = in.w3;
        unsigned tp[4][8];
#pragma unroll
        for (int i = 0; i < 16; ++i) { f32x4 y = w0 * x[i] + w1 * x[i + 1] + w2 * x[i + 2] + w3 * x[i + 3];
#pragma unroll
            for (int e = 0; e < 4; ++e) y[e] = siluf(y[e]);
            if (tensor == 2) y = y * TAB[t0 + i];
            if (tensor < 2) { v2u pk; pk.x = pk2(y[0], y[1]); pk.y = pk2(y[2], y[3]); *(LAS v2u*)(L + (tensor == 0 ? GP_QR : GP_KR) + (t0 + i) * 272 + 2 * c0) = pk; }
            if (tensor > 0) {
#pragma unroll
                for (int e = 0; e < 4; ++e) { const unsigned bq = f2bf(y[e]); if (i & 1) tp[e][i >> 1] |= bq << 16; else tp[e][i >> 1] = bq; } }
        }
        if (tensor > 0) {
#pragma unroll
            for (int e = 0; e < 4; ++e) { LAS unsigned char* dst = L + (tensor == 1 ? GP_KT : GP_BVT) + (c0 + e) * 144 + 2 * t0;
                *(LAS v4u*)dst = (v4u){tp[e][0], tp[e][1], tp[e][2], tp[e][3]}; *(LAS v4u*)(dst + 16) = (v4u){tp[e][4], tp[e][5], tp[e][6], tp[e][7]}; } }
    }
    WG_BARRIER();
    { const unsigned zi[8] = {in.zr0.x, in.zr0.y, in.zr0.z, in.zr0.w, in.zr1.x, in.zr1.y, in.zr1.z, in.zr1.w}; unsigned zo[8];
#pragma unroll
      for (int i = 0; i < 8; ++i) { const float za = bflo(zi[i]), zb = bfhi(zi[i]); const f32x2 nw2 = *(const GAS f32x2*)(F.in[IN_GNORM] + gz_c + 2 * i);
          zo[i] = pk2(za * sigm(za) * nw2[0], zb * sigm(zb) * nw2[1]); }
      *(GAS v4u*)(rec + 73728 + (gz_t * 128 + gz_c) * 2) = (v4u){zo[0], zo[1], zo[2], zo[3]}; *(GAS v4u*)(rec + 73728 + (gz_t * 128 + gz_c + 8) * 2) = (v4u){zo[4], zo[5], zo[6], zo[7]}; }
    if (has_next) prep_fetch(F, nb_, nh_, nn_, in);
    {
        const int m16 = lane & 15, kg = lane >> 4;
        for (int job = wave; job < 24; job += 8) {
            int kind, it, jt;
            if (job < 20) { kind = job >= 10; int j = job % 10; it = 0; while (j > it) { j -= it + 1; ++it; } jt = j; }
            else { kind = 2; it = jt = job - 20; }
            const int abase = (kind == 2 ? GP_QR : GP_KR) + (16 * (kind == 1 ? jt : it) + m16) * 272 + 16 * kg;
            const int bbase = (kind == 0 ? GP_KR : GP_QR) + (16 * (kind == 0 ? jt : it) + m16) * 272 + 16 * kg;
            f32x4 acc = {0.f, 0.f, 0.f, 0.f};
#pragma unroll
            for (int kb = 0; kb < 4; ++kb) { const bf16x8 a = *(const LAS bf16x8*)(L + abase + 64 * kb), bb = *(const LAS bf16x8*)(L + bbase + 64 * kb); acc = mfma16(a, bb, acc); }
            if (kind == 0) {
#pragma unroll
                for (int jj = 0; jj < 4; ++jj) GKK[(16 * it + 4 * kg + jj) * GKP + 16 * jt + m16] = acc[jj];
            } else if (kind == 1) {
                *(LAS f32x4*)(GQK + (16 * it + m16) * 68 + 16 * jt + 4 * kg) = acc;
            } else {
#pragma unroll
                for (int jj = 0; jj < 4; ++jj) if (4 * kg + jj == m16) TAB[576 + 16 * it + m16] = acc[jj];
            }
        }
    }
    WG_BARRIER();
    if (tid < 64) {
        const int t = tid; const float rk = rsqrtf(GKK[t * GKP + t] + EPS), rq = rsqrtf(TAB[576 + t] + EPS) * 0.08838834764831845f;
        TAB[256 + t] = rk; TAB[320 + t] = rq; TAB[384 + t] = rq * TAB[128 + t]; TAB[448 + t] = rk * TAB[192 + t]; TAB[512 + t] = rk * TAB[t] * TAB[128 + t];
    }
    WG_BARRIER();
    {
        for (int e = tid; e < 4096; e += 512) { const int i = e >> 6, j = e & 63;
            if (j < i) GKK[i * GKP + j] = TAB[i] * TAB[256 + i] * TAB[256 + j] * GKK[i * GKP + j] * __expf(TAB[64 + i] - TAB[64 + j]); }
        const int m16 = lane & 15, kg = lane >> 4;
        { const int it = wave >> 1, kb2 = wave & 1, i = 16 * it + m16; const float sc = TAB[320 + i], gi = TAB[64 + i];
          float o[8];
#pragma unroll
          for (int hlf = 0; hlf < 2; ++hlf) { const int j0 = 32 * kb2 + 16 * hlf + 4 * kg; const f32x4 g = *(const LAS f32x4*)(GQK + i * 68 + j0);
#pragma unroll
              for (int e = 0; e < 4; ++e) { const int j = j0 + e; o[4 * hlf + e] = (j <= i) ? sc * TAB[256 + j] * g[e] * __expf(gi - TAB[64 + j]) : 0.f; } }
          v4u w; w.x = pk2(o[0], o[1]); w.y = pk2(o[2], o[3]); w.z = pk2(o[4], o[5]); w.w = pk2(o[6], o[7]);
          *(GAS v4u*)(rec + 32768 + wave * 1024 + lane * 16) = w; }
#pragma unroll
        for (int r = 0; r < 2; ++r) { const int f = wave * 2 + r, mt = f >> 1, kb2 = f & 1, dk = 16 * mt + m16; float o[8];
#pragma unroll
            for (int hlf = 0; hlf < 2; ++hlf) { const int t0 = 32 * kb2 + 16 * hlf + 4 * kg; const v2u kk = *(const LAS v2u*)(L + GP_KT + dk * 144 + 2 * t0);
                o[4 * hlf + 0] = bflo(kk.x) * TAB[448 + t0]; o[4 * hlf + 1] = bfhi(kk.x) * TAB[448 + t0 + 1]; o[4 * hlf + 2] = bflo(kk.y) * TAB[448 + t0 + 2]; o[4 * hlf + 3] = bfhi(kk.y) * TAB[448 + t0 + 3]; }
            v4u w; w.x = pk2(o[0], o[1]); w.y = pk2(o[2], o[3]); w.z = pk2(o[4], o[5]); w.w = pk2(o[6], o[7]);
            *(GAS v4u*)(rec + 40960 + f * 1024 + lane * 16) = w; }
#pragma unroll
        for (int r = 0; r < 2; ++r) { const int f = wave * 2 + r, mtq = f >> 2, kb = f & 3, t = 16 * mtq + m16; const float sc = TAB[384 + t]; float o[8];
#pragma unroll
            for (int hlf = 0; hlf < 2; ++hlf) { const int d0 = 32 * kb + 16 * hlf + 4 * kg; const v2u qq = *(const LAS v2u*)(L + GP_QR + t * 272 + 2 * d0);
                o[4 * hlf + 0] = bflo(qq.x) * sc; o[4 * hlf + 1] = bfhi(qq.x) * sc; o[4 * hlf + 2] = bflo(qq.y) * sc; o[4 * hlf + 3] = bfhi(qq.y) * sc; }
            v4u w; w.x = pk2(o[0], o[1]); w.y = pk2(o[2], o[3]); w.z = pk2(o[4], o[5]); w.w = pk2(o[6], o[7]);
            *(GAS v4u*)(rec + ((4 + mtq) * 4 + kb) * 1024 + lane * 16) = w; }
        { const int dk = tid >> 2, t0 = (tid & 3) * 16; const v4u a = *(const LAS v4u*)(L + GP_KT + dk * 144 + 2 * t0), bq = *(const LAS v4u*)(L + GP_KT + dk * 144 + 2 * t0 + 16);
          const unsigned wi[8] = {a.x, a.y, a.z, a.w, bq.x, bq.y, bq.z, bq.w}; unsigned wo[8];
#pragma unroll
          for (int i = 0; i < 8; ++i) wo[i] = pk2(bflo(wi[i]) * TAB[512 + t0 + 2 * i], bfhi(wi[i]) * TAB[512 + t0 + 2 * i + 1]);
          *(LAS v4u*)(L + GP_KBG + dk * 144 + 2 * t0) = (v4u){wo[0], wo[1], wo[2], wo[3]}; *(LAS v4u*)(L + GP_KBG + dk * 144 + 2 * t0 + 16) = (v4u){wo[4], wo[5], wo[6], wo[7]}; }
    }
    WG_BARRIER();
    LAS float* TIF = GQK;
    {
        const int m16 = lane & 15, kg = lane >> 4;
        if (wave == 0) {
            const LAS float* Ab = GKK + (16 * kg) * GKP + 16 * kg; float r[16];
#pragma unroll
            for (int i = 0; i < 16; ++i) { int lo_ = m16; asm volatile("" : "+v"(lo_)); float a = (lo_ == i) ? 1.f : 0.f;
#pragma unroll
                for (int j4 = 0; j4 < (i + 3) / 4; ++j4) { const f32x4 av = *(const LAS f32x4*)(Ab + i * GKP + 4 * j4);
#pragma unroll
                    for (int e = 0; e < 4; ++e) { const int j = 4 * j4 + e; if (j < i) a -= av[e] * r[j]; } }
                r[i] = a; }
#pragma unroll
            for (int i = 0; i < 16; ++i) TIF[(16 * kg + i) * GKP + 16 * kg + m16] = r[i];
        }
        WG_BARRIER();
        const f32x4 z4 = {0.f, 0.f, 0.f, 0.f};
        if (wave < 3) { const int i = wave + 1, j = wave;
            f32x4 X = prod_ll(GKK, 16 * i, 16 * j, TIF, 16 * j, 16 * j, z4, m16, kg);
            f32x4 T = prod_lr(TIF, 16 * i, 16 * i, X, z4, m16, kg);
#pragma unroll
            for (int jj = 0; jj < 4; ++jj) TIF[(16 * i + 4 * kg + jj) * GKP + 16 * j + m16] = -T[jj]; }
        WG_BARRIER();
        if (wave < 2) { const int i = wave + 2, j = wave;
            f32x4 Y = prod_ll(GKK, 16 * i, 16 * j, TIF, 16 * j, 16 * j, z4, m16, kg);
            Y = prod_ll(GKK, 16 * i, 16 * (j + 1), TIF, 16 * (j + 1), 16 * j, Y, m16, kg);
            f32x4 T = prod_lr(TIF, 16 * i, 16 * i, Y, z4, m16, kg);
#pragma unroll
            for (int jj = 0; jj < 4; ++jj) TIF[(16 * i + 4 * kg + jj) * GKP + 16 * j + m16] = -T[jj]; }
        WG_BARRIER();
        if (wave == 0) {
            f32x4 Y = prod_ll(GKK, 48, 0, TIF, 0, 0, z4, m16, kg);
            Y = prod_ll(GKK, 48, 16, TIF, 16, 0, Y, m16, kg);
            Y = prod_ll(GKK, 48, 32, TIF, 32, 0, Y, m16, kg);
            f32x4 T = prod_lr(TIF, 48, 48, Y, z4, m16, kg);
#pragma unroll
            for (int jj = 0; jj < 4; ++jj) TIF[(48 + 4 * kg + jj) * GKP + m16] = -T[jj]; }
        WG_BARRIER();
        { const int row = tid >> 3, cg = tid & 7; v4u o = {0u, 0u, 0u, 0u};
          if ((cg >> 1) <= (row >> 4)) { const f32x4 a = *(const LAS f32x4*)(TIF + row * GKP + 8 * cg), c = *(const LAS f32x4*)(TIF + row * GKP + 8 * cg + 4);
              o.x = pk2(a[0], a[1]); o.y = pk2(a[2], a[3]); o.z = pk2(c[0], c[1]); o.w = pk2(c[2], c[3]); }
          *(LAS v4u*)(L + GP_TI + row * 144 + 16 * cg) = o; }
    }
    WG_BARRIER();
    {
        const int m16 = lane & 15, kg = lane >> 4;
#pragma unroll
        for (int it = 0; it < 4; ++it) {
            f32x4 au = {0.f, 0.f, 0.f, 0.f}, aw = {0.f, 0.f, 0.f, 0.f};
#pragma unroll
            for (int jb = 0; jb < 2; ++jb) {
                const bf16x8 ti = *(const LAS bf16x8*)(L + GP_TI + (16 * it + m16) * 144 + 64 * jb + 16 * kg);
                const bf16x8 bv = *(const LAS bf16x8*)(L + GP_BVT + (16 * wave + m16) * 144 + 64 * jb + 16 * kg);
                const bf16x8 kb = *(const LAS bf16x8*)(L + GP_KBG + (16 * wave + m16) * 144 + 64 * jb + 16 * kg);
                au = mfma16(ti, bv, au);
                aw = mfma16(kb, ti, aw);
            }
            v2u w; w.x = pk2(au[0], au[1]); w.y = pk2(au[2], au[3]);
            *(GAS v2u*)(rec + 57344 + ((wave * 4 + it) * 64 + lane) * 8) = w;
            v2u x; x.x = pk2(aw[0], aw[1]); x.y = pk2(aw[2], aw[3]);
            *(GAS v2u*)(rec + (it * 4 + (wave >> 1)) * 1024 + lane * 16 + (wave & 1) * 8) = x;
        }
    }
    WG_BARRIER();
}

constexpr int SC_BUF = 57344, SC_OT = 2 * SC_BUF, SC_OTB = 17408, SC_RED = SC_OT + 2 * SC_OTB;
static_assert(SC_RED + 2048 <= LDSCTL_OFF, "scan LDS map");
__device__ __forceinline__ void gdn_scan_chain(Frame& F, int bh) {
#ifdef NO_SCAN
    return;
#endif
    LAS unsigned char* L = F.ldv;
    const int tid = F.tid, lane = F.lane, w = F.wave, m16 = lane & 15, kg = lane >> 4;
    const int b = bh >> 3, h = bh & 7;
    const unsigned char* rec0 = F.ws + WS_REC + (size_t)(bh * 64) * REC_BYTES;
    if (w >= 4) {
        const int ht = tid - 256; bf16* OB = (bf16*)(F.ws + WS_OB);
        v4u st[14];
#pragma unroll
        for (int i = 0; i < 14; ++i) st[i] = *(const GAS v4u*)(rec0 + (size_t)(i * 256 + ht) * 16);
#pragma unroll
        for (int i = 0; i < 14; ++i) *(LAS v4u*)(L + (i * 256 + ht) * 16) = st[i];
#pragma unroll
        for (int i = 0; i < 14; ++i) st[i] = *(const GAS v4u*)(rec0 + REC_BYTES + (size_t)(i * 256 + ht) * 16);
        WG_BARRIER();
        for (int m = 0; m < 65; ++m) {
            if (m + 1 <= 63) { LAS unsigned char* nb = L + ((m + 1) & 1) * SC_BUF;
#pragma unroll
                for (int i = 0; i < 14; ++i) *(LAS v4u*)(nb + (i * 256 + ht) * 16) = st[i]; }
            if (m + 2 <= 63) { const unsigned char* rec = rec0 + (size_t)(m + 2) * REC_BYTES;
#pragma unroll
                for (int i = 0; i < 14; ++i) st[i] = *(const GAS v4u*)(rec + (size_t)(i * 256 + ht) * 16); }
            if (m >= 1) {
                const LAS unsigned char* ot = L + SC_OT + ((m - 1) & 1) * SC_OTB; const LAS float* RED = (const LAS float*)(L + SC_RED) + ((m - 1) & 1) * 256;
                const int row0 = b * SEQ + 64 * (m - 1); const unsigned char* gzt = rec0 + (size_t)(m - 1) * REC_BYTES + 73728;
                v4u gv[4];
#pragma unroll
                for (int r = 0; r < 4; ++r) gv[r] = *(const GAS v4u*)(gzt + (size_t)(ht + 256 * r) * 16);
#pragma unroll
                for (int r = 0; r < 4; ++r) { const int idx = ht + 256 * r, row = idx >> 4, ch = idx & 15;
                    const v4u ov = *(const LAS v4u*)(ot + row * 272 + ch * 16); const f32x4 r4 = *(const LAS f32x4*)(RED + row * 4);
                    const float rs = rsqrtf(((r4[0] + r4[1]) + (r4[2] + r4[3])) * (1.0f / 128.0f) + EPS);
                    v4u o; o.x = pk2(bflo(ov.x) * rs * bflo(gv[r].x), bfhi(ov.x) * rs * bfhi(gv[r].x)); o.y = pk2(bflo(ov.y) * rs * bflo(gv[r].y), bfhi(ov.y) * rs * bfhi(gv[r].y));
                    o.z = pk2(bflo(ov.z) * rs * bflo(gv[r].z), bfhi(ov.z) * rs * bfhi(gv[r].z)); o.w = pk2(bflo(ov.w) * rs * bflo(gv[r].w), bfhi(ov.w) * rs * bfhi(gv[r].w));
                    *(GAS v4u*)(OB + (size_t)(row0 + row) * D + h * 128 + ch * 8) = o; } }
            WG_BARRIER();
        }
    } else {
        const float* GE = (const float*)(F.ws + WS_GE) + bh * 64;
        f32x4 S[2][8], P[2][8];
#pragma unroll
        for (int hf = 0; hf < 2; ++hf)
#pragma unroll
            for (int i = 0; i < 8; ++i) { S[hf][i] = (f32x4){0.f, 0.f, 0.f, 0.f}; P[hf][i] = (f32x4){0.f, 0.f, 0.f, 0.f}; }
        WG_BARRIER();
        for (int m = 0; m < 65; ++m) {
            if (m <= 63) {
                const unsigned char* rec = rec0 + (size_t)m * REC_BYTES; const LAS unsigned char* buf = L + (m & 1) * SC_BUF;
                v2u ut[2][4];
#pragma unroll
                for (int hf = 0; hf < 2; ++hf)
#pragma unroll
                    for (int mt = 0; mt < 4; ++mt) ut[hf][mt] = *(const GAS v2u*)(rec + 57344 + (((2 * w + hf) * 4 + mt) * 64 + lane) * 8);
                const float ge = GE[m];
                bf16x8 Sb[2][4];
#pragma unroll
                for (int hf = 0; hf < 2; ++hf)
#pragma unroll
                    for (int kb = 0; kb < 4; ++kb) Sb[hf][kb] = pack8(S[hf][2 * kb], S[hf][2 * kb + 1]);
#pragma unroll
                for (int mt = 0; mt < 8; ++mt) { P[0][mt] = (f32x4){0.f, 0.f, 0.f, 0.f}; P[1][mt] = (f32x4){0.f, 0.f, 0.f, 0.f};
#pragma unroll
                    for (int kb = 0; kb < 4; ++kb) { const bf16x8 a = *(const LAS bf16x8*)(buf + (mt * 4 + kb) * 1024 + lane * 16); P[0][mt] = mfma16(a, Sb[0][kb], P[0][mt]); P[1][mt] = mfma16(a, Sb[1][kb], P[1][mt]); } }
                bf16x8 vb[2][2];
#pragma unroll
                for (int hf = 0; hf < 2; ++hf) { f32x4 vn[4];
#pragma unroll
                    for (int mt = 0; mt < 4; ++mt) { vn[mt][0] = bflo(ut[hf][mt].x) - P[hf][mt][0]; vn[mt][1] = bfhi(ut[hf][mt].x) - P[hf][mt][1]; vn[mt][2] = bflo(ut[hf][mt].y) - P[hf][mt][2]; vn[mt][3] = bfhi(ut[hf][mt].y) - P[hf][mt][3]; }
                    vb[hf][0] = pack8(vn[0], vn[1]); vb[hf][1] = pack8(vn[2], vn[3]); }
#pragma unroll
                for (int mt = 0; mt < 4; ++mt)
#pragma unroll
                    for (int kb2 = 0; kb2 < 2; ++kb2) { const bf16x8 a = *(const LAS bf16x8*)(buf + 32768 + (mt * 2 + kb2) * 1024 + lane * 16); P[0][4 + mt] = mfma16(a, vb[0][kb2], P[0][4 + mt]); P[1][4 + mt] = mfma16(a, vb[1][kb2], P[1][4 + mt]); }
#pragma unroll
                for (int mt = 0; mt < 8; ++mt) { S[0][mt] = S[0][mt] * ge; S[1][mt] = S[1][mt] * ge;
#pragma unroll
                    for (int kb2 = 0; kb2 < 2; ++kb2) { const bf16x8 a = *(const LAS bf16x8*)(buf + 40960 + (mt * 2 + kb2) * 1024 + lane * 16); S[0][mt] = mfma16(a, vb[0][kb2], S[0][mt]); S[1][mt] = mfma16(a, vb[1][kb2], S[1][mt]); } }
                LAS float* RED = (LAS float*)(L + SC_RED) + (m & 1) * 256; LAS unsigned char* ot = L + SC_OT + (m & 1) * SC_OTB;
#pragma unroll
                for (int mt = 0; mt < 4; ++mt)
#pragma unroll
                    for (int jj = 0; jj < 4; jj += 2) { const int t = 16 * mt + 4 * kg + jj;
#pragma unroll
                        for (int hf = 0; hf < 2; ++hf) { const unsigned pr = pk2(P[hf][4 + mt][jj], P[hf][4 + mt][jj + 1]);
                            *(LAS bf16*)(ot + t * 272 + (32 * w + 16 * hf + m16) * 2) = (bf16)(pr & 0xffffu); *(LAS bf16*)(ot + (t + 1) * 272 + (32 * w + 16 * hf + m16) * 2) = (bf16)(pr >> 16); } }
                float mine = 0.f;
#pragma unroll
                for (int mt = 0; mt < 4; ++mt)
#pragma unroll
                    for (int jj = 0; jj < 4; ++jj) { const float q = row_sum16(P[0][4 + mt][jj] * P[0][4 + mt][jj] + P[1][4 + mt][jj] * P[1][4 + mt][jj]); mine = (m16 == 4 * mt + jj) ? q : mine; }
                RED[(16 * (m16 >> 2) + 4 * kg + (m16 & 3)) * 4 + w] = mine;
            }
            WG_BARRIER();
        }
        float* so = F.out + O_SSMP + (size_t)bh * 16384;
#pragma unroll
        for (int hf = 0; hf < 2; ++hf)
#pragma unroll
            for (int mt = 0; mt < 8; ++mt)
#pragma unroll
                for (int jj = 0; jj < 4; ++jj) so[(16 * mt + 4 * kg + jj) * 128 + 32 * w + 16 * hf + m16] = S[hf][mt][jj];
    }
    WG_BARRIER();
}

__device__ __forceinline__ void gdn_sample_unit(Frame& F, int b, int h) {
    LAS float* L = (LAS float*)F.ldv;
    const int tid = F.tid, lane = F.lane, wave = F.wave;
    const bf16* U = (const bf16*)(F.ws + WS_U); const float* BA = (const float*)(F.ws + WS_BA);
    const int row0 = MP + 4 * b;
    const int dv = tid & 127, kq = tid >> 7;
    const float* S0 = F.in[IN_SSSM] + ((size_t)(b * 8 + h) * 128 + 32 * kq) * 128 + dv;
    float s[32];
#pragma unroll
    for (int i = 0; i < 32; ++i) s[i] = S0[(size_t)i * 128];
    LAS float* SC = L + 8704;
    if (tid < 4) { const float bl = BA[(size_t)(row0 + tid) * 16 + h], al = BA[(size_t)(row0 + tid) * 16 + 8 + h];
        SC[tid] = sigm(bl); SC[56 + tid] = -__expf(F.in[IN_ALOG][h]) * softplusf(al + F.in[IN_DTB][h]); }
    if (tid < 384) {
        const int tensor = tid >> 7, c = tid & 127, cw = tensor * 1024 + h * 128 + c, col = U_QKVB + cw;
        const float w0 = F.in[IN_CONVW][cw], w1 = F.in[IN_CONVW][3072 + cw], w2 = F.in[IN_CONVW][2 * 3072 + cw], w3 = F.in[IN_CONVW][3 * 3072 + cw];
        float x[7];
#pragma unroll
        for (int i = 0; i < 3; ++i) x[i] = F.in[IN_SCONV][((size_t)b * 3 + i) * 3072 + cw];
#pragma unroll
        for (int i = 0; i < 4; ++i) x[3 + i] = bf2f(U[(size_t)(row0 + i) * NINP + col]);
#pragma unroll
        for (int i = 0; i < 4; ++i) { const float v = w0 * x[i] + w1 * x[i + 1] + w2 * x[i + 2] + w3 * x[i + 3]; L[tensor * 512 + i * 128 + c] = siluf(v); }
    }
    WG_BARRIER();
    if (tid == 0) { float gc = 0.f;
#pragma unroll
        for (int i = 0; i < 4; ++i) { gc += SC[56 + i]; SC[4 + i] = gc; } SC[48] = __expf(gc); }
    { const int tensor = wave >> 2, s = wave & 3; const float a = L[tensor * 512 + s * 128 + lane], c2 = L[tensor * 512 + s * 128 + 64 + lane];
      const float ss = wave_sum(a * a + c2 * c2); if (lane == 0) SC[(tensor ? 8 : 12) + s] = rsqrtf(ss + EPS) * (tensor ? 1.f : 0.08838834764831845f); }
    WG_BARRIER();
#pragma unroll
    for (int r = 0; r < 4; ++r) { const int idx = 4 * wave + r, kind = idx >> 4, i = (idx >> 2) & 3, j = idx & 3;
        const LAS float* a = L + (kind ? 0 : 512) + i * 128; const LAS float* c2 = L + 512 + j * 128;
        const float d = wave_sum(a[lane] * c2[lane] + a[64 + lane] * c2[64 + lane]);
        if (lane == 0) SC[16 + idx] = d * SC[(kind ? 12 : 8) + i] * SC[8 + j]; }
    WG_BARRIER();
    float beta[4], gc[4], Ti[4][4], qkm[4][4];
#pragma unroll
    for (int i = 0; i < 4; ++i) { beta[i] = SC[i]; gc[i] = SC[4 + i]; }
    const float ge = SC[48];
    {
        float A[4][4];
#pragma unroll
        for (int i = 0; i < 4; ++i)
#pragma unroll
            for (int j = 0; j < 4; ++j) { const float dec = __expf(gc[i] - gc[j]); A[i][j] = (j < i) ? beta[i] * SC[16 + 4 * i + j] * dec : 0.f; qkm[i][j] = (j <= i) ? SC[32 + 4 * i + j] * dec : 0.f; }
#pragma unroll
        for (int i = 0; i < 4; ++i)
#pragma unroll
            for (int c = 0; c < 4; ++c) { float v = (i == c) ? 1.f : 0.f;
#pragma unroll
                for (int j = 0; j < 4; ++j) if (j < i) v -= A[i][j] * Ti[j][c];
                Ti[i][c] = v; }
    }
    { const int c = tid & 127, i = tid >> 7; float wv = 0.f, uv = 0.f;
#pragma unroll
      for (int j = 0; j < 4; ++j) { wv += Ti[i][j] * beta[j] * __expf(gc[j]) * SC[8 + j] * L[512 + j * 128 + c]; uv += Ti[i][j] * beta[j] * L[1024 + j * 128 + c]; }
      L[1536 + i * 128 + c] = wv; L[3072 + i * 128 + c] = uv;
      L[2048 + i * 128 + c] = L[i * 128 + c] * SC[12 + i] * __expf(gc[i]);
      L[2560 + i * 128 + c] = L[512 + i * 128 + c] * SC[8 + i] * __expf(gc[3] - gc[i]); }
    WG_BARRIER();
    float pw[4] = {0.f, 0.f, 0.f, 0.f}, pq[4] = {0.f, 0.f, 0.f, 0.f};
#pragma unroll
    for (int i = 0; i < 32; ++i)
#pragma unroll
        for (int c = 0; c < 4; ++c) { pw[c] += L[1536 + c * 128 + 32 * kq + i] * s[i]; pq[c] += L[2048 + c * 128 + 32 * kq + i] * s[i]; }
#pragma unroll
    for (int c = 0; c < 4; ++c) { L[3584 + (c * 4 + kq) * 128 + dv] = pw[c]; L[3584 + ((4 + c) * 4 + kq) * 128 + dv] = pq[c]; }
    WG_BARRIER();
    float vn[4], oo[4];
#pragma unroll
    for (int c = 0; c < 4; ++c) { const float ws_ = (L[3584 + (c * 4 + 0) * 128 + dv] + L[3584 + (c * 4 + 1) * 128 + dv]) + (L[3584 + (c * 4 + 2) * 128 + dv] + L[3584 + (c * 4 + 3) * 128 + dv]);
        vn[c] = L[3072 + c * 128 + dv] - ws_; }
#pragma unroll
    for (int c = 0; c < 4; ++c) { float o = (L[3584 + ((4 + c) * 4 + 0) * 128 + dv] + L[3584 + ((4 + c) * 4 + 1) * 128 + dv]) + (L[3584 + ((4 + c) * 4 + 2) * 128 + dv] + L[3584 + ((4 + c) * 4 + 3) * 128 + dv]);
#pragma unroll
        for (int j = 0; j < 4; ++j) o += qkm[c][j] * vn[j];
        oo[c] = o; }
    float* SO = F.out + O_SSMS + ((size_t)(b * 8 + h) * 128 + 32 * kq) * 128 + dv;
#pragma unroll
    for (int i = 0; i < 32; ++i) { float v = ge * s[i];
#pragma unroll
        for (int c = 0; c < 4; ++c) v += L[2560 + c * 128 + 32 * kq + i] * vn[c];
        SO[(size_t)i * 128] = v; }
    LAS float* RED = L + 8768;
    if (kq == 0) {
#pragma unroll
        for (int c = 0; c < 4; ++c) { const float q = wave_sum(oo[c] * oo[c]); if (lane == 0) RED[c * 2 + wave] = q; }
    }
    WG_BARRIER();
    if (kq == 0) {
        bf16* OB = (bf16*)(F.ws + WS_OB); const float nw = F.in[IN_GNORM][dv];
#pragma unroll
        for (int c = 0; c < 4; ++c) { const float rs = rsqrtf((RED[c * 2] + RED[c * 2 + 1]) * (1.0f / 128.0f) + EPS);
            const float z = bf2f(U[(size_t)(row0 + c) * NINP + U_Z + h * 128 + dv]);
            OB[(size_t)(row0 + c) * D + h * 128 + dv] = (bf16)f2bf(oo[c] * rs * nw * (z * sigm(z))); }
    }
    WG_BARRIER();
}

__device__ __forceinline__ void copy_outputs(Frame& F) {
    const bf16* U = (const bf16*)(F.ws + WS_U);
    const long gt = (long)F.bx * 512 + F.tid, NT = (long)F.G * 512;
    constexpr long C0 = 65536, C1 = 262144, C2 = 1048576, CS = 65536, CCP = 4608, CCS = 147456;
    constexpr long TOT = C0 + C1 + C2 + 3 * CS + CCP + CCS;
    for (long c = gt; c < TOT; c += NT) {
        long r = c; int srow, scol; float* dst;
        if (r < C0 + C1 + C2) {
            int g, keep; if (r < C0) { g = 0; keep = 128; dst = F.out + O_KVP0; } else if (r < C0 + C1) { r -= C0; g = 1; keep = 512; dst = F.out + O_KVP1; } else { r -= C0 + C1; g = 2; keep = 2048; dst = F.out + O_KVP2; }
            const int e8 = r & 15, hh = (r >> 4) & 3, kv = (r >> 6) & 1; const int rr = (int)((r >> 7) % keep), bb = (int)((r >> 7) / keep);
            srow = bb * SEQ + SEQ - keep + rr; scol = (kv ? U_VA : U_KA) + (g * 4 + hh) * 128 + e8 * 8; dst += r * 8;
        } else if ((r -= C0 + C1 + C2) < 3 * CS) {
            const int g = (int)(r / CS); r -= (long)g * CS; dst = F.out + (g == 0 ? O_KVS0 : (g == 1 ? O_KVS1 : O_KVS2)) + r * 8;
            const int e8 = r & 15, hh = (r >> 4) & 3, kv = (r >> 6) & 1, ss = (r >> 7) & 3, bb = (int)(r >> 9);
            srow = MP + 4 * bb + ss; scol = (kv ? U_VA : U_KA) + (g * 4 + hh) * 128 + e8 * 8;
        } else if ((r -= 3 * CS) < CCP) {
            const int ch8 = (int)(r % 384), i = (int)((r / 384) % 3), bb = (int)(r / 1152); dst = F.out + O_CONVP + r * 8;
            srow = bb * SEQ + SEQ - 3 + i; scol = U_QKVB + ch8 * 8;
        } else {
            r -= CCP; const int ch8 = (int)(r % 384), i = (int)((r / 384) % 3), bb = (int)(r / 1152); dst = F.out + O_CONVS + r * 8;
            srow = MP + 4 * bb + 1 + i; scol = U_QKVB + ch8 * 8;
        }
        const v4u v = *(const GAS v4u*)(U + (size_t)srow * NINP + scol);
        *(GAS f32x4*)dst = (f32x4){bflo(v.x), bfhi(v.x), bflo(v.y), bfhi(v.y)};
        *(GAS f32x4*)(dst + 4) = (f32x4){bflo(v.z), bfhi(v.z), bflo(v.w), bfhi(v.w)};
    }
}

constexpr int AT_K = 0, AT_V = 69632;
__device__ __forceinline__ int at_off(int row, int ch) { return 256 * row + 16 * (ch ^ (((row & 3) << 2) | ((row >> 2) & 3))); }
__device__ __forceinline__ void tr_read10(unsigned a, bf16x4 (&lo)[5], bf16x4 (&hi)[5]) {
    asm volatile("ds_read_b64_tr_b16 %0, %10\n\tds_read_b64_tr_b16 %1, %10 offset:4096\n\tds_read_b64_tr_b16 %2, %10 offset:8192\n\tds_read_b64_tr_b16 %3, %10 offset:12288\n\t"
                 "ds_read_b64_tr_b16 %4, %10 offset:16384\n\tds_read_b64_tr_b16 %5, %10 offset:20480\n\tds_read_b64_tr_b16 %6, %10 offset:24576\n\tds_read_b64_tr_b16 %7, %10 offset:28672\n\t"
                 "ds_read_b64_tr_b16 %8, %10 offset:32768\n\tds_read_b64_tr_b16 %9, %10 offset:36864\n\ts_waitcnt lgkmcnt(0)"
                 : "=&v"(lo[0]), "=&v"(hi[0]), "=&v"(lo[1]), "=&v"(hi[1]), "=&v"(lo[2]), "=&v"(hi[2]), "=&v"(lo[3]), "=&v"(hi[3]), "=&v"(lo[4]), "=&v"(hi[4]) : "v"(a) : "memory"); }

__device__ __forceinline__ void attn_prompt_unit(Frame& F, int unit) {
#ifdef NO_PATTN
    return;
#endif
    LAS unsigned char* L = F.ldv;
    const int tid = F.tid, lane = F.lane, w = F.wave, m16 = lane & 15, kg = lane >> 4;
    const bf16* U = (const bf16*)(F.ws + WS_U); bf16* OG = (bf16*)(F.ws + WS_OG); float* LSE = (float*)(F.ws + WS_LSE);
    const int h = unit & 3, rb = (unit >> 2) & 31, b = (unit >> 7) & 3, g = unit >> 9;
    const int dil = g == 0 ? 1 : (g == 1 ? 4 : 16), nb = 32 / dil, r = rb / nb, blk = rb % nb, hh = g * 4 + h;
    const float slope = exp2f(-8.0f * (float)(hh + 1) / 12.0f) * (float)dil;
    { LAS unsigned char* Ls = F.lds;
#pragma unroll 1
      for (int it = 0; it < 8; ++it) { const int i = tid + 512 * it, row = i >> 4, chp = i & 15, ch = chp ^ (((row & 3) << 2) | ((row >> 2) & 3));
          if (blk > 0 || it >= 4) { const size_t gr = (size_t)(b * SEQ + (blk * 128 + row - 128) * dil + r) * NINP;
              __builtin_amdgcn_global_load_lds((const unsigned*)(U + gr + U_KA + hh * 128 + ch * 8), (LAS unsigned*)(Ls + AT_K + (it * 512 + w * 64) * 16), 16, 0, 0);
              __builtin_amdgcn_global_load_lds((const unsigned*)(U + gr + U_VA + hh * 128 + ch * 8), (LAS unsigned*)(Ls + AT_V + (it * 512 + w * 64) * 16), 16, 0, 0);
          } else { *(LAS v4u*)(L + AT_K + i * 16) = (v4u){0u, 0u, 0u, 0u}; *(LAS v4u*)(L + AT_V + i * 16) = (v4u){0u, 0u, 0u, 0u}; } }
      if (tid < 256) { *(LAS v4u*)(L + AT_K + (4096 + tid) * 16) = (v4u){0u, 0u, 0u, 0u}; *(LAS v4u*)(L + AT_V + (4096 + tid) * 16) = (v4u){0u, 0u, 0u, 0u}; } }
    const int qi = 16 * w + m16; const size_t qrow = (size_t)(b * SEQ + (blk * 128 + qi) * dil + r);
    bf16x8 qf[4];
#pragma unroll
    for (int kb = 0; kb < 4; ++kb) qf[kb] = *(const GAS bf16x8*)(U + qrow * NINP + U_QA + hh * 128 + 32 * kb + 8 * kg);
    asm volatile("s_waitcnt vmcnt(0)" ::: "memory");
    WG_BARRIER();
    f32x4 S[10];
    int kbase[4];
#pragma unroll
    for (int kb = 0; kb < 4; ++kb) kbase[kb] = AT_K + at_off(16 * w + m16, 4 * kb + kg);
#pragma unroll
    for (int kt = 0; kt < 10; ++kt) { S[kt] = (f32x4){0.f, 0.f, 0.f, 0.f};
#pragma unroll
        for (int kb = 0; kb < 4; ++kb) S[kt] = mfma16(*(const LAS bf16x8*)(L + kbase[kb] + kt * 4096), qf[kb], S[kt]); }
    const float sc = 0.08838834764831845f * 1.4426950408889634f, sl2 = slope * 1.4426950408889634f;
    float mx = -INFINITY;
#pragma unroll
    for (int kt = 0; kt < 10; ++kt)
#pragma unroll
        for (int jj = 0; jj < 4; ++jj) { const int kj = 16 * w + 16 * kt + 4 * kg + jj, delta = 128 + qi - kj;
            const bool ok = delta >= 0 && delta <= 128 && (blk > 0 || kj >= 128);
            const float v = ok ? S[kt][jj] * sc - sl2 * (float)delta : -INFINITY; S[kt][jj] = v; mx = fmaxf(mx, v); }
    mx = fmaxf(mx, __shfl_xor(mx, 16)); mx = fmaxf(mx, __shfl_xor(mx, 32));
    float sum = 0.f;
#pragma unroll
    for (int kt = 0; kt < 10; ++kt)
#pragma unroll
        for (int jj = 0; jj < 4; ++jj) { const float p = exp2f(S[kt][jj] - mx); S[kt][jj] = p; sum += p; }
    sum += __shfl_xor(sum, 16); sum += __shfl_xor(sum, 32);
    bf16x8 pb[5];
#pragma unroll
    for (int kb2 = 0; kb2 < 5; ++kb2) pb[kb2] = pack8(S[2 * kb2], S[2 * kb2 + 1]);
    f32x4 O[8];
    const int rq = m16 >> 2, cq = m16 & 3;
    unsigned vbase[8];
#pragma unroll
    for (int dt = 0; dt < 8; ++dt) vbase[dt] = (unsigned)(AT_V + at_off(16 * w + 4 * kg + rq, 2 * dt + (cq >> 1)) + 8 * (cq & 1));
#pragma unroll
    for (int dt = 0; dt < 8; ++dt) { O[dt] = (f32x4){0.f, 0.f, 0.f, 0.f}; bf16x4 lo[5], hi[5]; tr_read10(vbase[dt], lo, hi);
#pragma unroll
        for (int kb2 = 0; kb2 < 5; ++kb2) { bf16x8 vf; vf[0] = lo[kb2][0]; vf[1] = lo[kb2][1]; vf[2] = lo[kb2][2]; vf[3] = lo[kb2][3]; vf[4] = hi[kb2][0]; vf[5] = hi[kb2][1]; vf[6] = hi[kb2][2]; vf[7] = hi[kb2][3];
            O[dt] = mfma16(vf, pb[kb2], O[dt]); } }
    const float inv = 1.0f / sum;
#pragma unroll
    for (int dt = 0; dt < 8; ++dt) { v2u o; o.x = pk2(O[dt][0] * inv, O[dt][1] * inv); o.y = pk2(O[dt][2] * inv, O[dt][3] * inv);
        *(GAS v2u*)(OG + qrow * 1536 + hh * 128 + 16 * dt + 4 * kg) = o; }
    if (kg == 0) LSE[qrow * 12 + hh] = (mx + log2f(sum)) * 0.6931471805599453f;
    WG_BARRIER();
}

__device__ __forceinline__ float half_sum(float v) { v = row_sum16(v); v += __shfl_xor(v, 16); return v; }
__device__ __forceinline__ void attn_sample_unit(Frame& F, int unit) {
#ifdef NO_SATTN
    return;
#endif
    const int lane = F.lane, w = F.wave;
    const bf16* U = (const bf16*)(F.ws + WS_U); bf16* OG = (bf16*)(F.ws + WS_OG); float* LSE = (float*)(F.ws + WS_LSE);
    const int b = unit & 127, g = unit >> 7;
    const int s = w & 3, h = 2 * (w >> 2) + (lane >> 5), dl = lane & 31, hh = g * 4 + h;
    const int dil = g == 0 ? 1 : (g == 1 ? 4 : 16), wb = g == 0 ? 128 : (g == 1 ? 512 : 2048);
    const float* cache = F.in[g == 0 ? IN_C128 : (g == 1 ? IN_C512 : IN_C2048)] + (size_t)b * wb * 1024 + h * 128 + 4 * dl;
    const float L2E = 1.4426950408889634f;
    const float sl2 = exp2f(-8.0f * (float)(hh + 1) / 12.0f) * (float)dil * L2E;
    const size_t qrow = (size_t)(MP + 4 * b + s);
    f32x4 q; { const v2u qq = *(const GAS v2u*)(U + qrow * NINP + U_QA + hh * 128 + 4 * dl); const float sc = 0.08838834764831845f * L2E;
        q = (f32x4){bflo(qq.x) * sc, bfhi(qq.x) * sc, bflo(qq.y) * sc, bfhi(qq.y) * sc}; }
    float m = -INFINITY, l = 0.f; f32x4 o = {0.f, 0.f, 0.f, 0.f};
    const int jn = (g == 0) ? s : 0;
    for (int j = 0; j <= jn; ++j) { const size_t kr = (size_t)(MP + 4 * b + s - dil * j) * NINP + hh * 128 + 4 * dl;
        const v2u kk = *(const GAS v2u*)(U + kr + U_KA), vv = *(const GAS v2u*)(U + kr + U_VA);
        const float sc = half_sum(bflo(kk.x) * q[0] + bfhi(kk.x) * q[1] + bflo(kk.y) * q[2] + bfhi(kk.y) * q[3]) - sl2 * (float)j;
        const float mn = fmaxf(m, sc), al = exp2f(m - mn), p = exp2f(sc - mn); m = mn; l = l * al + p;
        o = o * al + (f32x4){bflo(vv.x), bfhi(vv.x), bflo(vv.y), bfhi(vv.y)} * p; }
    f32x4 kA[8], vA[8], kB[8], vB[8];
#define SA_LOAD(KF, VF, BLK) do { _Pragma("unroll") for (int i = 0; i < 8; ++i) { const int j = jn + 1 + 8 * (BLK) + i; int idx = wb + s - dil * j; idx = idx < 0 ? 0 : idx; \
        KF[i] = *(const GAS f32x4*)(cache + (size_t)idx * 1024); VF[i] = *(const GAS f32x4*)(cache + (size_t)idx * 1024 + 512); } } while (0)
#define SA_COMP(KF, VF, BLK) do { float sc[8]; float mb = -INFINITY; \
        _Pragma("unroll") for (int i = 0; i < 8; ++i) { const int j = jn + 1 + 8 * (BLK) + i; \
            float d = half_sum(KF[i][0] * q[0] + KF[i][1] * q[1] + KF[i][2] * q[2] + KF[i][3] * q[3]) - sl2 * (float)j; \
            d = (j <= 128) ? d : -INFINITY; sc[i] = d; mb = fmaxf(mb, d); } \
        const float mn = fmaxf(m, mb), al = exp2f(m - mn); m = mn; l *= al; o = o * al; \
        _Pragma("unroll") for (int i = 0; i < 8; ++i) { const float p = exp2f(sc[i] - mn); l += p; o = o + VF[i] * p; } } while (0)
    SA_LOAD(kA, vA, 0);
    for (int blk = 0; blk < 16; blk += 2) {
        SA_LOAD(kB, vB, blk + 1);
        SA_COMP(kA, vA, blk);
        if (blk + 2 < 16) SA_LOAD(kA, vA, blk + 2);
        SA_COMP(kB, vB, blk + 1);
    }
#undef SA_LOAD
#undef SA_COMP
    const float inv = 1.0f / l;
    v2u ov; ov.x = pk2(o[0] * inv, o[1] * inv); ov.y = pk2(o[2] * inv, o[3] * inv);
    *(GAS v2u*)(OG + qrow * 1536 + hh * 128 + 4 * dl) = ov;
    if (dl == 0) LSE[qrow * 12 + hh] = (m + log2f(l)) * 0.6931471805599453f;
}

__device__ __forceinline__ void attn_merge(Frame& F) {
    const bf16* OG = (const bf16*)(F.ws + WS_OG); const float* LSE = (const float*)(F.ws + WS_LSE); bf16* OA = (bf16*)(F.ws + WS_OA);
    const long gt = (long)F.bx * 512 + F.tid, NT = (long)F.G * 512;
    for (long c = gt; c < (long)MT * 64; c += NT) {
        const int row = (int)(c >> 6), hs = (int)(c >> 4) & 3, e8 = (int)c & 15;
        const float l0 = LSE[(size_t)row * 12 + hs], l1 = LSE[(size_t)row * 12 + 4 + hs], l2 = LSE[(size_t)row * 12 + 8 + hs];
        const float m = fmaxf(l0, fmaxf(l1, l2)); float w0 = __expf(l0 - m), w1 = __expf(l1 - m), w2 = __expf(l2 - m); const float inv = 1.0f / (w0 + w1 + w2); w0 *= inv; w1 *= inv; w2 *= inv;
        const v4u a = *(const GAS v4u*)(OG + (size_t)row * 1536 + hs * 128 + e8 * 8), bq = *(const GAS v4u*)(OG + (size_t)row * 1536 + (4 + hs) * 128 + e8 * 8), cq = *(const GAS v4u*)(OG + (size_t)row * 1536 + (8 + hs) * 128 + e8 * 8);
        v4u o;
        o.x = pk2(w0 * bflo(a.x) + w1 * bflo(bq.x) + w2 * bflo(cq.x), w0 * bfhi(a.x) + w1 * bfhi(bq.x) + w2 * bfhi(cq.x));
        o.y = pk2(w0 * bflo(a.y) + w1 * bflo(bq.y) + w2 * bflo(cq.y), w0 * bfhi(a.y) + w1 * bfhi(bq.y) + w2 * bfhi(cq.y));
        o.z = pk2(w0 * bflo(a.z) + w1 * bflo(bq.z) + w2 * bflo(cq.z), w0 * bfhi(a.z) + w1 * bfhi(bq.z) + w2 * bfhi(cq.z));
        o.w = pk2(w0 * bflo(a.w) + w1 * bflo(bq.w) + w2 * bflo(cq.w), w0 * bfhi(a.w) + w1 * bfhi(bq.w) + w2 * bfhi(cq.w));
        *(GAS v4u*)(OA + (size_t)row * 512 + hs * 128 + e8 * 8) = o;
    }
}

#ifndef MK_N_LAUNCHES
#define MK_N_LAUNCHES 1
#endif
constexpr int N_PHASES = 12;
struct Args { const float* in[23]; float* out; unsigned char* ws; int ph_lo, ph_hi, sub, qi; };
static_assert(sizeof(Args) == 23 * 8 + 8 + 8 + 16, "Args has no padding");

__device__ __forceinline__ int q_next(Frame& F, int qi) {
    if (F.tid == 0) F.MISC[16] = __hip_atomic_fetch_add((unsigned*)(F.ctl + CW_Q + 64 * qi), 1u, __ATOMIC_RELAXED, __HIP_MEMORY_SCOPE_AGENT);
    __syncthreads();
    const int v = (int)F.MISC[16];
    __syncthreads();
    return v;
}

#ifndef PH5_MASK
#define PH5_MASK 7
#endif
__device__ __forceinline__ void phase5(Frame& F, int qi, int sub) {
    if ((sub & 1) && F.bx < NB * 8) gdn_scan_chain(F, F.bx);
    if (F.bx >= 32 && F.bx < 96) for (;;) { const int u = q_next(F, 3 * qi); if (u >= 128) break; if (sub & 2) attn_sample_unit(F, 256 + u); }
    for (;;) { const int u = q_next(F, 3 * qi + 1); if (u >= 256) break; if (sub & 2) attn_sample_unit(F, (u < 128) ? 128 + u : u - 128); }
    for (;;) { const int u = q_next(F, 3 * qi + 2); if (u >= 1536) break; if (sub & 4) attn_prompt_unit(F, u); }
}
__global__ void __launch_bounds__(NWAVES * 64, 2) mk_fwd(Args args) {
    extern __shared__ __attribute__((aligned(16))) unsigned char lds[];
    Frame F;
    F.lds = (LAS unsigned char*)lds;
    { unsigned z = 0u; asm volatile("" : "+v"(z)); F.ldv = (LAS unsigned char*)lds + z; }
    F.MISC = (volatile LAS unsigned*)(F.lds + MISC_OFF);
    F.tid = threadIdx.x; F.lane = F.tid & 63; F.wave = __builtin_amdgcn_readfirstlane(F.tid >> 6);
    F.G = gridDim.x; F.bx = blockIdx.x;
    F.ws = args.ws; F.out = args.out; F.ctl = (gu32*)(args.ws + WS_CTL);
    F.in = args.in;
    for (int u = F.tid; u < (LDS_BYTES - LDSCTL_OFF) / 4; u += NWAVES * 64) ((LAS unsigned*)(F.lds + LDSCTL_OFF))[u] = 0u;
    __syncthreads();
    const bool one = (args.ph_hi - args.ph_lo) > 1;
    XcdBarrier bar; bar.bar = (unsigned*)(F.ctl + CW_BAR); bar.x = 0; bar.st = nullptr;
    if (one) bar = xcd_barrier_post((unsigned*)(F.ctl + CW_BAR), F.MISC + 8);
    const int lo = args.ph_lo, hi = args.ph_hi;
#ifndef PHASE_MASK
#define PHASE_MASK 0xFFF
#endif
#define IN(k) ((((PHASE_MASK) >> (k)) & 1) && lo <= (k) && (k) < hi)
#define SEAM(k) do { if (IN(k) && IN((k) + 1)) xcd_barrier(bar); } while (0)

    bf16* XB = (bf16*)(F.ws + WS_XB); bf16* ACT = (bf16*)(F.ws + WS_ACT); float* X1 = (float*)(F.ws + WS_X1); bf16* X1B = (bf16*)(F.ws + WS_X1B);
    bf16* UU = (bf16*)(F.ws + WS_U); float* BA = (float*)(F.ws + WS_BA); bf16* OB = (bf16*)(F.ws + WS_OB); bf16* OA = (bf16*)(F.ws + WS_OA);
    bf16* M1 = (bf16*)(F.ws + WS_M1); bf16* MG = (bf16*)(F.ws + WS_MG); float* X2 = (float*)(F.ws + WS_X2); bf16* X2B = (bf16*)(F.ws + WS_X2B);
    float* SSQ2 = (float*)(args.ws + WS_CTL) + CW_SSQ2; float* SSQ3 = (float*)(args.ws + WS_CTL) + CW_SSQ3; float* SSQ4 = (float*)(args.ws + WS_CTL) + CW_SSQ4;

#ifndef DUP_MASK
#define DUP_MASK 0
#endif
#define DUP(k) (((DUP_MASK) >> (k)) & 1)
    if (IN(0)) { p0_prologue(F); } SEAM(0);
    if (IN(1)) {
        pg8::Gemm g{XB, (const bf16*)(F.ws + WS_W1A), MT, NGU, D}; pg8::StaticOrder S; S.init(MT, NGU, F.G, F.bx);
        pg8::EpiSwiglu E{ACT, (const float*)(F.ws + WS_RSTD1), 0};
        pg8::gemm_phase<pg8::EpiSwiglu, pg8::StaticOrder, true, true>(F.lds + RING_OFF, g, S, E);
    } SEAM(1);
    if (IN(2)) {
        pg8::Gemm g{ACT, (const bf16*)(F.ws + WS_W1B), MP, D, FF}; pg8::StaticOrder S; S.init(MP, D, F.G, F.bx);
        pg8::EpiResid E{F.in[IN_XP], F.in[IN_XS] - (size_t)MP * D, X1, X1B, SSQ2, 0.5f};
        pg8::gemm_phase<pg8::EpiResid, pg8::StaticOrder, true, true>(F.lds + RING_OFF, g, S, E);
        if (args.sub & 8) skinny_resid<FF>(F, ACT, (const bf16*)(F.ws + WS_W1B), F.in[IN_XS] - (size_t)MP * D, X1, X1B, SSQ2, 0.5f);
    } SEAM(2);
    if (IN(3)) {
        pg8::Gemm g{X1B, (const bf16*)(F.ws + WS_WIN), MT, U_BA, D}; pg8::StaticOrder S; S.init(MT, U_BA, F.G, F.bx);
        pg8::EpiU E{UU, BA, SSQ2};
        pg8::gemm_phase<pg8::EpiU, pg8::StaticOrder, true, true>(F.lds + RING_OFF, g, S, E);
        skinny_ba(F, X1B, (const bf16*)(F.ws + WS_WIN), SSQ2, BA);
    } SEAM(3);
    if (IN(4)) {
        if (args.sub & 1) { PrepIn pin; int i = F.bx;
            if (i < NREC) prep_fetch(F, (i & 31) >> 3, i & 7, i >> 5, pin);
            for (; i < NREC; i += F.G) { const int nx = i + F.G; gdn_prep_unit(F, (i & 31) >> 3, i & 7, i >> 5, pin, nx < NREC, (nx & 31) >> 3, nx & 7, nx >> 5); } }
        if (args.sub & 2) for (int j = F.bx; j < DB * 8; j += F.G) gdn_sample_unit(F, j >> 3, j & 7);
        if (args.sub & 4) copy_outputs(F);
    } SEAM(4);
    if (IN(5)) {
        phase5(F, args.qi, args.sub);
    } SEAM(5);
    if (IN(6)) { attn_merge(F); } SEAM(6);
    if (IN(7)) {
        { pg8::Gemm g{OA, (const bf16*)(F.ws + WS_WPA), MP, D, 512}; pg8::StaticOrder S; S.init(MP, D, F.G, F.bx);
          pg8::EpiGate<0> E{UU, nullptr, M1};
          pg8::gemm_phase<pg8::EpiGate<0>, pg8::StaticOrder, true, true>(F.lds + RING_OFF, g, S, E); }
        { pg8::Gemm g{OB, (const bf16*)(F.ws + WS_WPB), MP, D, D}; pg8::StaticOrder S; S.init(MP, D, F.G, F.bx);
          pg8::EpiGate<1> E{UU, M1, MG};
          pg8::gemm_phase<pg8::EpiGate<1>, pg8::StaticOrder, true, true>(F.lds + RING_OFF, g, S, E); }
        if (args.sub & 8) skinny_merge(F, OA, (const bf16*)(F.ws + WS_WPA), OB, (const bf16*)(F.ws + WS_WPB), UU, MG);
    } SEAM(7);
    if (IN(8)) {
        pg8::Gemm g{MG, (const bf16*)(F.ws + WS_WOUT), MP, D, D}; pg8::StaticOrder S; S.init(MP, D, F.G, F.bx);
        pg8::EpiResid E{X1, X1, X2, X2B, SSQ3, 1.0f};
        pg8::gemm_phase<pg8::EpiResid, pg8::StaticOrder, true, true>(F.lds + RING_OFF, g, S, E);
        skinny_resid<D>(F, MG, (const bf16*)(F.ws + WS_WOUT), X1, X2, X2B, SSQ3, 1.0f);
    } SEAM(8);
    if (IN(9)) {
        pg8::Gemm g{X2B, (const bf16*)(F.ws + WS_W2A), MT, NGU, D}; pg8::StaticOrder S; S.init(MT, NGU, F.G, F.bx);
        pg8::EpiSwiglu E{ACT, SSQ3, 1};
        pg8::gemm_phase<pg8::EpiSwiglu, pg8::StaticOrder, true, true>(F.lds + RING_OFF, g, S, E);
    } SEAM(9);
    if (IN(10)) {
        pg8::Gemm g{ACT, (const bf16*)(F.ws + WS_W2B), MP, D, FF}; pg8::StaticOrder S; S.init(MP, D, F.G, F.bx);
        pg8::EpiResid E{X2, X2, F.out + O_Y, nullptr, SSQ4, 0.5f};
        pg8::gemm_phase<pg8::EpiResid, pg8::StaticOrder, true, true>(F.lds + RING_OFF, g, S, E);
        skinny_resid<FF>(F, ACT, (const bf16*)(F.ws + WS_W2B), X2, F.out + O_Y, nullptr, SSQ4, 0.5f);
    } SEAM(10);
    if (IN(11)) { final_norm(F); }
#undef IN
#undef SEAM
}

extern "C" void kernel_launch(void* const* d_in, const int* in_sizes, int n_in, void* d_out, int out_size, void* d_ws, size_t ws_size, hipStream_t stream) {
    static int grid = 0;
    if (grid == 0) {
        if (n_in != 23 || out_size != (int)O_END || ws_size < WS_END) { fprintf(stderr, "kernel_launch: unexpected sizes n_in %d out %d ws %zu (need %zu)\n", n_in, out_size, ws_size, (size_t)WS_END); grid = -1; return; }
        int dev = 0, cus = 0, per_cu = 0;
        if (hipGetDevice(&dev) != hipSuccess || hipDeviceGetAttribute(&cus, hipDeviceAttributeMultiprocessorCount, dev) != hipSuccess) { grid = -1; return; }
        if (hipFuncSetAttribute((const void*)mk_fwd, hipFuncAttributeMaxDynamicSharedMemorySize, LDS_BYTES) != hipSuccess) { fprintf(stderr, "kernel_launch: hipFuncSetAttribute failed\n"); grid = -1; return; }
        if (hipOccupancyMaxActiveBlocksPerMultiprocessor(&per_cu, (const void*)mk_fwd, NWAVES * 64, LDS_BYTES) != hipSuccess || per_cu < 1) { fprintf(stderr, "kernel_launch: occupancy query says %d\n", per_cu); per_cu = 1; }
        (void)hipGetLastError();
        grid = cus;
    }
    if (grid < 0) return;
    if (hipMemsetAsync((char*)d_ws + WS_CTL, 0, CTL_ZERO_BYTES, stream) != hipSuccess) return;
    Args a{};
    for (int i = 0; i < 23; ++i) a.in[i] = (const float*)d_in[i];
    a.out = (float*)d_out; a.ws = (unsigned char*)d_ws;
#if MK_N_LAUNCHES == 1
    a.ph_lo = 0; a.ph_hi = N_PHASES; a.sub = 15; a.qi = 0;
    hipLaunchKernelGGL(mk_fwd, dim3(grid), dim3(NWAVES * 64), LDS_BYTES, stream, a);
#ifdef EXTRA_MASK
    for (int p = 0; p < N_PHASES; ++p) if ((EXTRA_MASK >> p) & 1) { a.ph_lo = p; a.ph_hi = p + 1; a.sub = EXTRA_SUB; a.qi = 1; hipLaunchKernelGGL(mk_fwd, dim3(grid), dim3(NWAVES * 64), LDS_BYTES, stream, a); }
#endif
#else
    a.sub = 15; a.qi = 0;
    for (int p = 0; p < N_PHASES; ++p) { a.ph_lo = p; a.ph_hi = p + 1; hipLaunchKernelGGL(mk_fwd, dim3(grid), dim3(NWAVES * 64), LDS_BYTES, stream, a); }
#endif
}
```

```cpp
#include <hip/hip_runtime.h>
#include <cstdio>
#include <cstdint>
#define MK_N_LAUNCHES 1
namespace pg8 {
#define PG8_LAS __attribute__((address_space(3)))
typedef unsigned short bf16_t;
typedef short bf16x8 __attribute__((ext_vector_type(8)));
typedef float f32x4 __attribute__((ext_vector_type(4)));
typedef unsigned u32x4 __attribute__((ext_vector_type(4)));
constexpr int BM = 256, BK = 64, HALF = 128, HTB = HALF * BK * 2  , STAGE_BYTES = 8 * HTB, NXCD = 8, WGM = 8;

__host__ __device__ __forceinline__ int lds_byte(int r, int c) { const int st = (r >> 4) * 2 + (c >> 5), rr = r & 15, cc = c & 31, ob = rr * 64 + cc * 2; return st * 1024 + (ob ^ (((ob >> 9) & 1) << 5)); }
__host__ __device__ __forceinline__ void stage_rc(int b, int& R, int& C) { const int st = b / 1024, sb = b % 1024, swz = sb ^ (((sb >> 9) & 1) << 5); R = (st >> 1) * 16 + swz / 64; C = (st & 1) * 32 + (swz % 64) / 2; }
__host__ __device__ __forceinline__ int perm32(int rho) { const int n = rho >> 4, i = rho & 15; return 8 * (i >> 2) + 4 * n + (i & 3); }

struct Unit { int pm, pn; };
struct Gemm { const bf16_t* A; const bf16_t* Bt; int M, N, K; };
struct StaticOrder {
    int nM, nN, nwg, G, c;
    __host__ __device__ void init(int M, int N, int G_, int c_) { nM = M / BM; nN = N / BM; nwg = nM * nN; G = G_; c = c_; }
    __host__ __device__ bool next(int i, Unit& u) const {
        const long L = (long)i * G + c; if (L >= nwg) return false;
        int wgid = (int)L; { const int q = nwg / NXCD, r = nwg % NXCD, xcd = wgid % NXCD, off = wgid / NXCD; wgid = (xcd < r ? xcd * (q + 1) : r * (q + 1) + (xcd - r) * q) + off; }
        const int nig = WGM * nN, gid = wgid / nig, fm = gid * WGM, gsz = (nM - fm) < WGM ? (nM - fm) : WGM;
        u.pm = fm + ((wgid % nig) % gsz); u.pn = (wgid % nig) / gsz; return true;
    }
    __device__ __forceinline__ void a_ready(const Unit&) const {}
    __device__ __forceinline__ void done(const Unit&) const {}
};
__device__ __forceinline__ unsigned cvt_pk_bf16(float lo, float hi) { unsigned r; asm volatile("v_cvt_pk_bf16_f32 %0, %1, %2" : "=v"(r) : "v"(lo), "v"(hi)); return r; }
typedef float f32x2 __attribute__((ext_vector_type(2)));
template <class Epi, class Sched, bool ALIGN_EPI = false, bool SP2 = false>
__device__ __forceinline__ void gemm_phase(PG8_LAS unsigned char* lds, const Gemm g, const Sched& S, const Epi& E) {
    const int tid = threadIdx.x, wid = __builtin_amdgcn_readfirstlane(tid >> 6), lane = tid & 63, wr = wid >> 2, wc = wid & 3, fr = lane & 15, fq = lane >> 4;
    const int K = g.K, nt = K / BK;
    unsigned voffA[2], voffB[2];
#pragma unroll
    for (int i = 0; i < 2; ++i) { int R, C; stage_rc(tid * 16 + i * 8192, R, C); const int Rb = Epi::PERM ? ((R & ~31) + perm32(R & 31)) : R;
        voffA[i] = (unsigned)(R * K + C) * 2u; voffB[i] = (unsigned)(Rb * K + C) * 2u; }
    const size_t kstep = (size_t)(BK * 2);
    const size_t hstep = (size_t)HALF * K * 2;
    const size_t tstep = 2 * hstep;
    const unsigned ldsw = (unsigned)wid * 1024u;
    const int aoff = lds_byte(wr * 64 + fr, fq * 8), boff = lds_byte(wc * 32 + fr, fq * 8);
#define PG8_SA(b, h) (((b) * 2 + (h)) * HTB)
#define PG8_SB(b, h) ((4 + (b) * 2 + (h)) * HTB)
#define PG8_STAGE(bufoff, gbase, voff) do { _Pragma("unroll") for (int _i = 0; _i < 2; ++_i) \
        __builtin_amdgcn_global_load_lds((const unsigned*)((const char*)(gbase) + (voff)[_i]), (PG8_LAS unsigned*)(lds + (bufoff) + ldsw + _i * 8192), 16, 0, 0); } while (0)
#define PG8_LDA(dst, b, h) do { _Pragma("unroll") for (int m = 0; m < 4; ++m) _Pragma("unroll") for (int k = 0; k < 2; ++k) dst[m][k] = *(const PG8_LAS bf16x8*)(lds + PG8_SA(b, h) + aoff + m * 2048 + k * 1024); } while (0)
#define PG8_LDB(dst, b, h) do { _Pragma("unroll") for (int n = 0; n < 2; ++n) _Pragma("unroll") for (int k = 0; k < 2; ++k) dst[n][k] = *(const PG8_LAS bf16x8*)(lds + PG8_SB(b, h) + boff + n * 2048 + k * 1024); } while (0)
#define PG8_MMA(ai, bj, At, Bt) do { __builtin_amdgcn_s_setprio(1); _Pragma("unroll") for (int m = 0; m < 4; ++m) _Pragma("unroll") for (int n = 0; n < 2; ++n) _Pragma("unroll") for (int k = 0; k < 2; ++k) \
        acc[ai][bj][m][n] = __builtin_amdgcn_mfma_f32_16x16x32_bf16(Bt[n][k], At[m][k], acc[ai][bj][m][n], 0, 0, 0); __builtin_amdgcn_s_setprio(0); } while (0)
#define PG8_WAIT_V(n) asm volatile("s_waitcnt vmcnt(" #n ")" ::: "memory")
#define PG8_WAIT_L(n) asm volatile("s_waitcnt lgkmcnt(" #n ")" ::: "memory")
#define PG8_BAR __builtin_amdgcn_s_barrier()
#define PG8_SCHED __builtin_amdgcn_sched_barrier(0)
    Unit cur, nxt; int ui = 0;
    if (!S.next(0, cur)) return;
    f32x4 acc[2][2][4][2];
#pragma unroll
    for (int a = 0; a < 2; ++a)
#pragma unroll
        for (int b = 0; b < 2; ++b)
#pragma unroll
            for (int m = 0; m < 4; ++m)
#pragma unroll
                for (int n = 0; n < 2; ++n) acc[a][b][m][n] = (f32x4){0.f, 0.f, 0.f, 0.f};
    bf16x8 At[4][2], B0[2][2], B1[2][2];
    const char* cA = (const char*)g.A + (size_t)cur.pm * tstep; const char* cB = (const char*)g.Bt + (size_t)cur.pn * tstep;
    S.a_ready(cur);
    if constexpr (SP2) {
        PG8_STAGE(PG8_SB(0, 0), cB, voffB); PG8_STAGE(PG8_SB(0, 1), cB + hstep, voffB); PG8_STAGE(PG8_SA(0, 0), cA, voffA); PG8_STAGE(PG8_SA(0, 1), cA + hstep, voffA);
        if (wr == 1) PG8_BAR;
        PG8_WAIT_V(2); PG8_BAR;
        PG8_STAGE(PG8_SB(1, 0), cB + kstep, voffB); PG8_STAGE(PG8_SA(1, 0), cA + kstep, voffA); PG8_STAGE(PG8_SB(1, 1), cB + hstep + kstep, voffB);
        PG8_WAIT_V(6); PG8_BAR;
    } else {
        PG8_STAGE(PG8_SB(0, 0), cB, voffB); PG8_STAGE(PG8_SA(0, 0), cA, voffA); PG8_STAGE(PG8_SB(0, 1), cB + hstep, voffB); PG8_STAGE(PG8_SA(0, 1), cA + hstep, voffA);
        if (wr == 1) PG8_BAR;
        PG8_WAIT_V(4); PG8_BAR;
        PG8_STAGE(PG8_SB(1, 0), cB + kstep, voffB); PG8_STAGE(PG8_SA(1, 0), cA + kstep, voffA); PG8_STAGE(PG8_SB(1, 1), cB + hstep + kstep, voffB);
        PG8_WAIT_V(6); PG8_BAR;
    }
    for (;;) {
        const bool has_next = S.next(ui + 1, nxt);
        const char* nA = has_next ? (const char*)g.A + (size_t)nxt.pm * tstep : cA; const char* nB = has_next ? (const char*)g.Bt + (size_t)nxt.pn * tstep : cB;
        for (int t = 0; t < nt; t += 2) {
            const bool last = (t == nt - 2);
            const char* a1 = cA + (size_t)(t + 1) * kstep;
            const char* a2 = last ? nA : cA + (size_t)(t + 2) * kstep; const char* b2 = last ? nB : cB + (size_t)(t + 2) * kstep;
            const char* a3 = a2 + kstep; const char* b3 = b2 + kstep;
            if (last && has_next) S.a_ready(nxt);
            if constexpr (SP2) {
            PG8_LDB(B0, 0, 0); PG8_LDB(B1, 0, 1); PG8_SCHED; PG8_LDA(At, 0, 0); PG8_STAGE(PG8_SA(1, 1), a1 + hstep, voffA);
            PG8_WAIT_V(8); PG8_WAIT_L(0); PG8_BAR; PG8_MMA(0, 0, At, B0); PG8_MMA(0, 1, At, B1); PG8_BAR; PG8_SCHED;
            PG8_LDA(At, 0, 1); PG8_STAGE(PG8_SB(0, 0), b2, voffB); PG8_STAGE(PG8_SB(0, 1), b2 + hstep, voffB); PG8_STAGE(PG8_SA(0, 0), a2, voffA);
            PG8_WAIT_V(8); PG8_WAIT_L(0); PG8_BAR; PG8_MMA(1, 0, At, B0); PG8_MMA(1, 1, At, B1); PG8_BAR; PG8_SCHED;
            PG8_LDB(B0, 1, 0); PG8_LDB(B1, 1, 1); PG8_SCHED; PG8_LDA(At, 1, 0); PG8_STAGE(PG8_SA(0, 1), a2 + hstep, voffA);
            PG8_WAIT_V(8); PG8_WAIT_L(0); PG8_BAR; PG8_MMA(0, 0, At, B0); PG8_MMA(0, 1, At, B1); PG8_BAR; PG8_SCHED;
            PG8_LDA(At, 1, 1); PG8_STAGE(PG8_SB(1, 0), b3, voffB); PG8_STAGE(PG8_SB(1, 1), b3 + hstep, voffB); PG8_STAGE(PG8_SA(1, 0), a3, voffA);
            PG8_WAIT_V(8); PG8_WAIT_L(0); PG8_BAR; PG8_MMA(1, 0, At, B0); PG8_MMA(1, 1, At, B1); PG8_BAR; PG8_SCHED;
            } else {
            PG8_LDB(B0, 0, 0); PG8_SCHED; PG8_LDA(At, 0, 0); PG8_STAGE(PG8_SA(1, 1), a1 + hstep, voffA);
            PG8_WAIT_L(8); PG8_BAR; PG8_WAIT_L(0); PG8_MMA(0, 0, At, B0); PG8_BAR; PG8_SCHED;
            PG8_LDB(B1, 0, 1); PG8_STAGE(PG8_SB(0, 0), b2, voffB);
            PG8_BAR; PG8_WAIT_L(0); PG8_MMA(0, 1, At, B1); PG8_BAR;
            PG8_LDA(At, 0, 1); PG8_STAGE(PG8_SA(0, 0), a2, voffA);
            PG8_BAR; PG8_WAIT_L(0); PG8_MMA(1, 0, At, B0); PG8_BAR; PG8_SCHED;
            PG8_STAGE(PG8_SB(0, 1), b2 + hstep, voffB);
            PG8_WAIT_V(6); PG8_BAR; PG8_MMA(1, 1, At, B1); PG8_BAR;
            PG8_LDB(B0, 1, 0); PG8_SCHED; PG8_LDA(At, 1, 0); PG8_STAGE(PG8_SA(0, 1), a2 + hstep, voffA);
            PG8_WAIT_L(8); PG8_BAR; PG8_WAIT_L(0); PG8_MMA(0, 0, At, B0); PG8_BAR; PG8_SCHED;
            PG8_LDB(B1, 1, 1); PG8_STAGE(PG8_SB(1, 0), b3, voffB);
            PG8_BAR; PG8_WAIT_L(0); PG8_MMA(0, 1, At, B1); PG8_BAR;
            PG8_LDA(At, 1, 1); PG8_STAGE(PG8_SA(1, 0), a3, voffA);
            PG8_BAR; PG8_WAIT_L(0); PG8_MMA(1, 0, At, B0); PG8_BAR; PG8_SCHED;
            PG8_STAGE(PG8_SB(1, 1), b3 + hstep, voffB);
            PG8_WAIT_V(6); PG8_BAR; PG8_MMA(1, 1, At, B1); PG8_BAR;
            }
        }
        if constexpr (ALIGN_EPI) { if (wr == 0) PG8_BAR; }
        if constexpr (!Epi::AFTER_DRAIN) { E(acc, cur, wr, wc, fr, fq); S.done(cur); }
        if (!has_next) break;
#pragma unroll
        for (int a = 0; a < 2; ++a)
#pragma unroll
            for (int b = 0; b < 2; ++b)
#pragma unroll
                for (int m = 0; m < 4; ++m)
#pragma unroll
                    for (int n = 0; n < 2; ++n) acc[a][b][m][n] = (f32x4){0.f, 0.f, 0.f, 0.f};
        cur = nxt; cA = nA; cB = nB; ++ui;
        if constexpr (ALIGN_EPI) { if (wr == 1) PG8_BAR; }
    }
    PG8_WAIT_V(0);
    if constexpr (!ALIGN_EPI) { if (wr == 0) PG8_BAR; }
    PG8_BAR;
    if constexpr (Epi::AFTER_DRAIN) { E.fused(acc, cur, wr, wc, fr, fq, lds, wid, lane); S.done(cur); }
#undef PG8_SA
#undef PG8_SB
#undef PG8_STAGE
#undef PG8_LDA
#undef PG8_LDB
#undef PG8_MMA
#undef PG8_WAIT_V
#undef PG8_WAIT_L
#undef PG8_BAR
#undef PG8_SCHED
}
}

constexpr int D = 1024, MP = 16384, MS = 512, MT = MP + MS, FF = 2816, NGU = 2 * FF;
constexpr int SEQ = 4096, NB = 4, DB = 128, DS = 4;
constexpr int NIN = 10768, NINP = 11008;
constexpr int U_QA = 0, U_KA = 1536, U_VA = 3072, U_QKVB = 4608, U_Z = 7680, U_GATE = 8704, U_BA = 10752;
constexpr float EPS = 1e-6f;

namespace pg8 {
typedef unsigned u32x2 __attribute__((ext_vector_type(2)));
__device__ __forceinline__ float sigm(float x) { return __builtin_amdgcn_rcpf(1.f + __expf(-x)); }
__device__ __forceinline__ float bf2f(unsigned short b) { return __uint_as_float(((unsigned)b) << 16); }
__device__ __forceinline__ float bflo(unsigned w) { return __uint_as_float(w << 16); }
__device__ __forceinline__ float bfhi(unsigned w) { return __uint_as_float(w & 0xffff0000u); }

struct EpiSwiglu {
    static constexpr bool PERM = true, AFTER_DRAIN = false;
    bf16_t* O; const float* rs; int mode;
    __device__ __forceinline__ void operator()(const f32x4 (&acc)[2][2][4][2], const Unit& u, int wr, int wc, int fr, int fq) const {
        const int row0 = u.pm * BM + wr * 64 + fr, col0 = u.pn * 128 + wc * 32 + 8 * fq;
#pragma unroll
        for (int ai = 0; ai < 2; ++ai)
#pragma unroll
            for (int m = 0; m < 4; ++m) {
                const int row = row0 + ai * HALF + m * 16;
                float r = rs[row]; if (mode) r = rsqrtf(r * (1.0f / D) + EPS);
                float o[8];
#pragma unroll
                for (int n = 0; n < 2; ++n)
#pragma unroll
                    for (int j = 0; j < 4; ++j) { const float g = acc[ai][0][m][n][j] * r, up = acc[ai][1][m][n][j] * r; o[4 * n + j] = g * sigm(g) * up; }
                u32x4 w; w.x = cvt_pk_bf16(o[0], o[1]); w.y = cvt_pk_bf16(o[2], o[3]); w.z = cvt_pk_bf16(o[4], o[5]); w.w = cvt_pk_bf16(o[6], o[7]);
                *(u32x4*)(O + (size_t)row * FF + col0) = w;
            }
    }
};
struct EpiResid {
    static constexpr bool PERM = false, AFTER_DRAIN = false;
    const float* base; const float* base2; float* out; bf16_t* xb; float* ssq; float scale;
    __device__ __forceinline__ void operator()(const f32x4 (&acc)[2][2][4][2], const Unit& u, int wr, int wc, int fr, int fq) const {
        const int row0 = u.pm * BM + wr * 64 + fr, col0 = u.pn * BM + wc * 32 + 4 * fq;
        const float* base = (u.pm * BM < MP) ? this->base : base2;
#pragma unroll
        for (int ai = 0; ai < 2; ++ai)
#pragma unroll
            for (int m = 0; m < 4; ++m) {
                const int row = row0 + ai * HALF + m * 16; const size_t off = (size_t)row * D + col0; float s = 0.f;
#pragma unroll
                for (int bj = 0; bj < 2; ++bj)
#pragma unroll
                    for (int n = 0; n < 2; ++n) {
                        const f32x4 b = *(const f32x4*)(base + off + bj * HALF + n * 16); const f32x4 v = b + acc[ai][bj][m][n] * scale;
                        *(f32x4*)(out + off + bj * HALF + n * 16) = v;
                        if (xb) { u32x2 w; w.x = cvt_pk_bf16(v[0], v[1]); w.y = cvt_pk_bf16(v[2], v[3]); *(u32x2*)(xb + off + bj * HALF + n * 16) = w; }
                        s += (v[0] * v[0] + v[1] * v[1]) + (v[2] * v[2] + v[3] * v[3]);
                    }
                s += __shfl_xor(s, 16); s += __shfl_xor(s, 32);
                if (fq == 0) atomicAdd(ssq + row, s);
            }
    }
};
template <int MODE> struct EpiResidB {
    static constexpr bool PERM = true, AFTER_DRAIN = false;
    const float* basef; const float* basef2; const bf16_t* baseb; bf16_t* outb; float* outf; float* ssq; float scale;
    __device__ __forceinline__ void operator()(const f32x4 (&acc)[2][2][4][2], const Unit& u, int wr, int wc, int fr, int fq) const {
        const int row0 = u.pm * BM + wr * 64 + fr, col0 = u.pn * BM + wc * 32 + 8 * fq;
        const float* bf = (u.pm * BM < MP) ? basef : basef2;
#pragma unroll
        for (int ai = 0; ai < 2; ++ai)
#pragma unroll
            for (int m = 0; m < 4; ++m) {
                const int row = row0 + ai * HALF + m * 16; float s = 0.f;
#pragma unroll
                for (int bj = 0; bj < 2; ++bj) {
                    const size_t off = (size_t)row * D + col0 + bj * HALF; f32x4 b0, b1;
                    if (MODE == 0) { b0 = *(const f32x4*)(bf + off); b1 = *(const f32x4*)(bf + off + 4); }
                    else { const u32x4 p = *(const u32x4*)(baseb + off); b0 = (f32x4){bflo(p.x), bfhi(p.x), bflo(p.y), bfhi(p.y)}; b1 = (f32x4){bflo(p.z), bfhi(p.z), bflo(p.w), bfhi(p.w)}; }
                    const f32x4 v0 = b0 + acc[ai][bj][m][0] * scale, v1 = b1 + acc[ai][bj][m][1] * scale;
                    if (MODE == 2) { *(f32x4*)(outf + off) = v0; *(f32x4*)(outf + off + 4) = v1; }
                    else { u32x4 w; w.x = cvt_pk_bf16(v0[0], v0[1]); w.y = cvt_pk_bf16(v0[2], v0[3]); w.z = cvt_pk_bf16(v1[0], v1[1]); w.w = cvt_pk_bf16(v1[2], v1[3]); *(u32x4*)(outb + off) = w; }
                    s += ((v0[0] * v0[0] + v0[1] * v0[1]) + (v0[2] * v0[2] + v0[3] * v0[3])) + ((v1[0] * v1[0] + v1[1] * v1[1]) + (v1[2] * v1[2] + v1[3] * v1[3]));
                }
                s += __shfl_xor(s, 16); s += __shfl_xor(s, 32);
                if (fq == 0) atomicAdd(ssq + row, s);
            }
    }
};
struct EpiU {
    static constexpr bool PERM = true, AFTER_DRAIN = false;
    bf16_t* U; float* BA; const float* ssq;
    __device__ __forceinline__ void operator()(const f32x4 (&acc)[2][2][4][2], const Unit& u, int wr, int wc, int fr, int fq) const {
        const int row0 = u.pm * BM + wr * 64 + fr, col0 = u.pn * BM + wc * 32 + 8 * fq;
        const bool ba = (u.pn * BM == U_BA);
#pragma unroll
        for (int ai = 0; ai < 2; ++ai)
#pragma unroll
            for (int m = 0; m < 4; ++m) {
                const int row = row0 + ai * HALF + m * 16; const float r = rsqrtf(ssq[row] * (1.0f / D) + EPS);
                if (!ba) {
#pragma unroll
                    for (int bj = 0; bj < 2; ++bj) { const f32x4 v0 = acc[ai][bj][m][0] * r, v1 = acc[ai][bj][m][1] * r;
                        u32x4 w; w.x = cvt_pk_bf16(v0[0], v0[1]); w.y = cvt_pk_bf16(v0[2], v0[3]); w.z = cvt_pk_bf16(v1[0], v1[1]); w.w = cvt_pk_bf16(v1[2], v1[3]);
                        *(u32x4*)(U + (size_t)row * NINP + col0 + bj * HALF) = w; }
                } else if (wc == 0 && fq < 2) {
                    *(f32x4*)(BA + (size_t)row * 16 + 8 * fq) = acc[ai][0][m][0] * r; *(f32x4*)(BA + (size_t)row * 16 + 8 * fq + 4) = acc[ai][0][m][1] * r;
                }
            }
    }
};
template <int SECOND> struct EpiGate {
    static constexpr bool PERM = true, AFTER_DRAIN = false;
    const bf16_t* U; const bf16_t* M1; bf16_t* O;
    __device__ __forceinline__ void operator()(const f32x4 (&acc)[2][2][4][2], const Unit& u, int wr, int wc, int fr, int fq) const {
        const int row0 = u.pm * BM + wr * 64 + fr, col0 = u.pn * BM + wc * 32 + 8 * fq;
#pragma unroll
        for (int ai = 0; ai < 2; ++ai)
#pragma unroll
            for (int m = 0; m < 4; ++m) {
                const int row = row0 + ai * HALF + m * 16;
#pragma unroll
                for (int bj = 0; bj < 2; ++bj) {
                    const int col = col0 + bj * HALF;
                    const u32x4 g = *(const u32x4*)(U + (size_t)row * NINP + U_GATE + SECOND * D + col);
                    float o[8]; const f32x4 a0 = acc[ai][bj][m][0], a1 = acc[ai][bj][m][1];
                    o[0] = sigm(bflo(g.x)) * a0[0]; o[1] = sigm(bfhi(g.x)) * a0[1]; o[2] = sigm(bflo(g.y)) * a0[2]; o[3] = sigm(bfhi(g.y)) * a0[3];
                    o[4] = sigm(bflo(g.z)) * a1[0]; o[5] = sigm(bfhi(g.z)) * a1[1]; o[6] = sigm(bflo(g.w)) * a1[2]; o[7] = sigm(bfhi(g.w)) * a1[3];
                    if (SECOND) { const u32x4 p = *(const u32x4*)(M1 + (size_t)row * D + col);
                        o[0] += bflo(p.x); o[1] += bfhi(p.x); o[2] += bflo(p.y); o[3] += bfhi(p.y); o[4] += bflo(p.z); o[5] += bfhi(p.z); o[6] += bflo(p.w); o[7] += bfhi(p.w); }
                    u32x4 w; w.x = cvt_pk_bf16(o[0], o[1]); w.y = cvt_pk_bf16(o[2], o[3]); w.z = cvt_pk_bf16(o[4], o[5]); w.w = cvt_pk_bf16(o[6], o[7]);
                    *(u32x4*)(O + (size_t)row * D + col) = w;
                }
            }
    }
};
}

#define GAS __attribute__((address_space(1)))
#define LAS __attribute__((address_space(3)))
typedef unsigned short bf16;
typedef unsigned v4u __attribute__((ext_vector_type(4)));
typedef unsigned v2u __attribute__((ext_vector_type(2)));
typedef float f32x4 __attribute__((ext_vector_type(4)));
typedef float f32x2 __attribute__((ext_vector_type(2)));
typedef short bf16x8 __attribute__((ext_vector_type(8)));
typedef short bf16x4 __attribute__((ext_vector_type(4)));
typedef GAS unsigned gu32;
#define RLX_AGENT __ATOMIC_RELAXED, __HIP_MEMORY_SCOPE_AGENT
#define LDS_WAIT() asm volatile("s_waitcnt lgkmcnt(0)" ::: "memory")
#define VM_WAIT() asm volatile("s_waitcnt vmcnt(0)" ::: "memory")
__device__ __forceinline__ unsigned f2bf(float f) { unsigned u = __builtin_bit_cast(unsigned, f); return (u + 0x7fffu + ((u >> 16) & 1u)) >> 16; }
typedef __bf16 bf16x2_t __attribute__((ext_vector_type(2)));
__device__ __forceinline__ unsigned pk2(float lo, float hi) { const bf16x2_t v = __builtin_convertvector((f32x2){lo, hi}, bf16x2_t); return __builtin_bit_cast(unsigned, v); }
__device__ __forceinline__ float bf2f(unsigned short b) { return __uint_as_float(((unsigned)b) << 16); }
__device__ __forceinline__ float bflo(unsigned w) { return __uint_as_float(w << 16); }
__device__ __forceinline__ float bfhi(unsigned w) { return __uint_as_float(w & 0xffff0000u); }
__device__ __forceinline__ float sigm(float x) { return __builtin_amdgcn_rcpf(1.f + __expf(-x)); }
__device__ __forceinline__ float siluf(float x) { return x * __builtin_amdgcn_rcpf(1.f + __expf(-x)); }
__device__ __forceinline__ float wave_sum(float v) {
#pragma unroll
    for (int o = 1; o < 64; o <<= 1) v += __shfl_xor(v, o);
    return v;
}
__device__ __forceinline__ float wave_max(float v) {
#pragma unroll
    for (int o = 1; o < 64; o <<= 1) v = fmaxf(v, __shfl_xor(v, o));
    return v;
}
template <int CTRL> __device__ __forceinline__ float dpp_f(float v) { return __builtin_bit_cast(float, __builtin_amdgcn_update_dpp(0, __builtin_bit_cast(int, v), CTRL, 0xf, 0xf, true)); }
__device__ __forceinline__ float row_sum16(float v) { v += dpp_f<0xB1>(v); v += dpp_f<0x4E>(v); v += dpp_f<0x141>(v); v += dpp_f<0x140>(v); return v; }
__device__ __forceinline__ f32x4 mfma16(bf16x8 a, bf16x8 b, f32x4 c) { return __builtin_amdgcn_mfma_f32_16x16x32_bf16(a, b, c, 0, 0, 0); }
__device__ __forceinline__ bf16x8 pack8(f32x4 a, f32x4 b) {
    v4u w; w.x = pk2(a[0], a[1]); w.y = pk2(a[2], a[3]); w.z = pk2(b[0], b[1]); w.w = pk2(b[2], b[3]); return __builtin_bit_cast(bf16x8, w);
}
#define WG_BARRIER() do { asm volatile("s_waitcnt lgkmcnt(0)" ::: "memory"); __builtin_amdgcn_s_barrier(); asm volatile("" ::: "memory"); } while (0)
#define XB_TMO      128
#define XB_XCNT(j)  (256  + 64 * (j))
#define XB_XSUB(j)  (1280 + 64 * (j))
#define XB_XGEN(j)  (2304 + 64 * (j))
#define XB_TOP      3328
#define XB_TOPGEN   3392
#define XCD_BAR_WORDS 3456
#define XB_SPIN_CAP (1u << 18)

__device__ __forceinline__ unsigned xb_ld(unsigned* p)              { return __hip_atomic_load(p, __ATOMIC_RELAXED, __HIP_MEMORY_SCOPE_AGENT); }
__device__ __forceinline__ unsigned xb_add(unsigned* p, unsigned v) { return __hip_atomic_fetch_add(p, v, __ATOMIC_RELAXED, __HIP_MEMORY_SCOPE_AGENT); }
__device__ __forceinline__ unsigned xb_xcc_id() { return (unsigned)__builtin_amdgcn_s_getreg((3 << 11) | 20) & 0xFu; }
#define XB_SPIN(cond, bar) do { unsigned _sp = 0; while (cond) { __builtin_amdgcn_s_sleep(1); \
    if ((++_sp & 255u) == 0u) { if (xb_ld(&(bar)[XB_TMO])) break; if (_sp > XB_SPIN_CAP) { atomicAdd(&(bar)[XB_TMO], 1u); break; } } } } while (0)

struct XcdBarrier {
    unsigned* bar; unsigned x;
    volatile LAS unsigned* st;
};

__device__ __forceinline__ XcdBarrier xcd_barrier_post(unsigned* bar, volatile LAS unsigned* st) {
    XcdBarrier b; b.bar = bar; b.x = xb_xcc_id(); b.st = st;
    if (threadIdx.x == 0) (void)xb_add(&bar[XB_XCNT(b.x)], 1u);
    return b;
}
__device__ __forceinline__ void xcd_barrier_complete(unsigned* bar, unsigned x, unsigned& nloc, unsigned& nx) {
    const unsigned G = gridDim.x * gridDim.y * gridDim.z;
    unsigned sum, cnt, mine, sp = 0u;
    for (;;) {
        sum = 0u; cnt = 0u; mine = 0u;
#pragma unroll
        for (unsigned j = 0; j < 16; ++j) { const unsigned c = xb_ld(&bar[XB_XCNT(j)]); sum += c; cnt += (c > 0u) ? 1u : 0u; mine = (j == x) ? c : mine; }
        if (sum == G) break;
        __builtin_amdgcn_s_sleep(1);
        if ((++sp & 255u) == 0u) { if (xb_ld(&bar[XB_TMO])) break; if (sp > XB_SPIN_CAP) { atomicAdd(&bar[XB_TMO], 1u); break; } }
    }
    nloc = mine > 0u ? mine : 1u; nx = cnt > 0u ? cnt : 1u;
}

__device__ __forceinline__ void xcd_barrier(const XcdBarrier& b) {
    asm volatile("s_waitcnt vmcnt(0)" ::: "memory");
    __syncthreads();
    if (threadIdx.x == 0) {
        unsigned* bar = b.bar;
        __builtin_amdgcn_s_waitcnt(0);
        unsigned nloc = b.st[0], nx = b.st[1];
        if (nloc == 0u) { xcd_barrier_complete(bar, b.x, nloc, nx); b.st[0] = nloc; b.st[1] = nx; }
        const unsigned old = xb_add(&bar[XB_XSUB(b.x)], 1u);
        const unsigned gen = old / nloc;
        if (old + 1u == (gen + 1u) * nloc) {
            __builtin_amdgcn_fence(__ATOMIC_RELEASE, "agent");
            asm volatile("s_waitcnt vmcnt(0)" ::: "memory");
            const unsigned og = xb_add(&bar[XB_TOP], 1u);
            const unsigned tg = og / nx;
            if (og + 1u == (tg + 1u) * nx) xb_add(&bar[XB_TOPGEN], 1u);
            else XB_SPIN(xb_ld(&bar[XB_TOPGEN]) == tg, bar);
            __builtin_amdgcn_fence(__ATOMIC_ACQUIRE, "agent");
            xb_add(&bar[XB_XGEN(b.x)], 1u);
            asm volatile("s_waitcnt vmcnt(0)" ::: "memory");
        } else {
            XB_SPIN(xb_ld(&bar[XB_XGEN(b.x)]) == gen, bar);
            __builtin_amdgcn_fence(__ATOMIC_ACQUIRE, "agent");
            asm volatile("s_waitcnt vmcnt(0)" ::: "memory");
        }
    }
    __syncthreads();
}


constexpr size_t MiB = 1u << 20;
constexpr size_t al256(size_t x) { return (x + 255) & ~(size_t)255; }
constexpr size_t WS_CTL = 0, CTL_ZERO_BYTES = 1 * MiB;
constexpr size_t WS_W1A = 1 * MiB;
constexpr size_t WS_W1B = WS_W1A + (size_t)NGU * D * 2;
constexpr size_t WS_WIN = WS_W1B + (size_t)D * FF * 2;
constexpr size_t WS_WPA = WS_WIN + (size_t)NINP * D * 2;
constexpr size_t WS_WPB = WS_WPA + (size_t)D * 512 * 2;
constexpr size_t WS_WOUT = WS_WPB + (size_t)D * D * 2;
constexpr size_t WS_W2A = WS_WOUT + (size_t)D * D * 2;
constexpr size_t WS_W2B = WS_W2A + (size_t)NGU * D * 2;
constexpr size_t WS_XB = al256(WS_W2B + (size_t)D * FF * 2);
constexpr size_t WS_RSTD1 = WS_XB + (size_t)MT * D * 2;
constexpr size_t WS_ACT = al256(WS_RSTD1 + (size_t)MT * 4);
constexpr size_t WS_X1 = WS_ACT + (size_t)MT * FF * 2;
constexpr size_t WS_X1B = WS_X1 + (size_t)MT * D * 4;
constexpr size_t WS_U = WS_X1B + (size_t)MT * D * 2;
constexpr size_t WS_BA = WS_U + (size_t)MT * NINP * 2;
constexpr size_t REC_BYTES = 90112;
constexpr int NREC = NB * 8 * 64;
constexpr size_t WS_REC = WS_BA + (size_t)MT * 16 * 4;
constexpr size_t WS_GE = WS_REC + (size_t)NREC * REC_BYTES;
constexpr size_t WS_OB = al256(WS_GE + (size_t)NREC * 4);
constexpr size_t WS_OG = WS_OB + (size_t)MT * D * 2;
constexpr size_t WS_LSE = WS_OG + (size_t)MT * 1536 * 2;
constexpr size_t WS_OA = al256(WS_LSE + (size_t)MT * 12 * 4);
constexpr size_t WS_M1 = WS_OA + (size_t)MT * 512 * 2;
constexpr size_t WS_MG = WS_M1 + (size_t)MT * D * 2;
constexpr size_t WS_X2 = WS_MG + (size_t)MT * D * 2;
constexpr size_t WS_X2B = WS_X2 + (size_t)MT * D * 4;
constexpr size_t WS_END = WS_X2B + (size_t)MT * D * 2;
constexpr int CW_TMO = 0;
constexpr int CW_BAR = 4096;
constexpr int CW_Q = 8192;
constexpr int CW_SSQ2 = 16384, CW_SSQ3 = CW_SSQ2 + 17408, CW_SSQ4 = CW_SSQ3 + 17408;
static_assert((CW_SSQ4 + 17408) * 4 <= (int)CTL_ZERO_BYTES, "CTL words inside the memset region");

constexpr size_t O_Y = 0;
constexpr size_t O_KVP0 = (size_t)MT * D;
constexpr size_t O_KVP1 = O_KVP0 + 524288;
constexpr size_t O_KVP2 = O_KVP1 + 2097152;
constexpr size_t O_CONVP = O_KVP2 + 8388608;
constexpr size_t O_SSMP = O_CONVP + 36864;
constexpr size_t O_KVS0 = O_SSMP + 524288;
constexpr size_t O_KVS1 = O_KVS0 + 524288;
constexpr size_t O_KVS2 = O_KVS1 + 524288;
constexpr size_t O_CONVS = O_KVS2 + 524288;
constexpr size_t O_SSMS = O_CONVS + 1179648;
constexpr size_t O_END = O_SSMS + 16777216;

constexpr int NWAVES = 8;
constexpr int RING_OFF = 0;
constexpr int LDSCTL_OFF = 151552, MISC_OFF = LDSCTL_OFF + 320;
constexpr int LDS_BYTES = 155648;

struct Frame {
    LAS unsigned char* lds;
    LAS unsigned char* ldv;
    volatile LAS unsigned* MISC;
    gu32* ctl;
    int tid, lane, wave, G, bx;
    const float* const* in; float* out; unsigned char* ws;
};
#define IN_XP 0
#define IN_XS 1
#define IN_C128 2
#define IN_C512 3
#define IN_C2048 4
#define IN_SCONV 5
#define IN_SSSM 6
#define IN_NF1 7
#define IN_W1GU 8
#define IN_W1D 9
#define IN_NMIX 10
#define IN_WIN 11
#define IN_CONVW 12
#define IN_ALOG 13
#define IN_DTB 14
#define IN_GNORM 15
#define IN_WPA 16
#define IN_WPB 17
#define IN_WOUT 18
#define IN_NF2 19
#define IN_W2GU 20
#define IN_W2D 21
#define IN_NOUT 22

template <class Map>
__device__ __forceinline__ void p0_transpose_item(const float* W, int K, int N, bf16* WT, const float* gain, LAS float* scr, int item, int lane, Map map) {
    const int nblk = (N + 31) / 32, kb = item / nblk, nb = item % nblk, k0 = 64 * kb, n0 = 32 * nb;
    const int nc = n0 + (lane & 31); const bool okc = nc < N;
    float wv[32];
#pragma unroll
    for (int i = 0; i < 32; ++i) { const int kk = 2 * i + (lane >> 5); wv[i] = okc ? W[(size_t)(k0 + kk) * N + nc] : 0.f; }
    if (gain) {
#pragma unroll
        for (int i = 0; i < 32; ++i) wv[i] *= gain[k0 + 2 * i + (lane >> 5)]; }
#pragma unroll
    for (int i = 0; i < 32; ++i) scr[(2 * i + (lane >> 5)) * 33 + (lane & 31)] = wv[i];
    LDS_WAIT(); asm volatile("" ::: "memory");
    const int c = lane & 7;
#pragma unroll
    for (int j = 0; j < 4; ++j) { const int n = (lane >> 3) + 8 * j; const LAS float* s = scr + (8 * c) * 33 + n;
        v4u o; o.x = pk2(s[0 * 33], s[1 * 33]); o.y = pk2(s[2 * 33], s[3 * 33]); o.z = pk2(s[4 * 33], s[5 * 33]); o.w = pk2(s[6 * 33], s[7 * 33]);
        if (n0 + n < N) *(GAS v4u*)(WT + (size_t)map(n0 + n) * K + k0 + 8 * c) = o; }
    LDS_WAIT(); asm volatile("" ::: "memory");
}
struct MapId { __device__ __forceinline__ int operator()(int c) const { return c; } };
struct MapGU { __device__ __forceinline__ int operator()(int c) const { return c < FF ? 256 * (c >> 7) + (c & 127) : 256 * ((c - FF) >> 7) + 128 + ((c - FF) & 127); } };
struct MapIn { __device__ __forceinline__ int operator()(int c) const { return c < 8704 ? c : (c < 8720 ? U_BA + (c - 8704) : c - 16); } };

__device__ __forceinline__ void p0_prologue(Frame& F) {
    LAS float* scr = (LAS float*)(F.ldv + RING_OFF + F.wave * 16384);
    const int gw = F.bx * NWAVES + F.wave, NGW = F.G * NWAVES;
    bf16* W1A = (bf16*)(F.ws + WS_W1A); bf16* W1B = (bf16*)(F.ws + WS_W1B); bf16* WIN = (bf16*)(F.ws + WS_WIN); bf16* WPA = (bf16*)(F.ws + WS_WPA);
    bf16* WPB = (bf16*)(F.ws + WS_WPB); bf16* WOUT = (bf16*)(F.ws + WS_WOUT); bf16* W2A = (bf16*)(F.ws + WS_W2A); bf16* W2B = (bf16*)(F.ws + WS_W2B);
    constexpr int I_GU = (D / 64) * (NGU / 32), I_DN = (FF / 64) * (D / 32), I_IN = (D / 64) * ((NIN + 31) / 32), I_PA = (512 / 64) * (D / 32), I_DD = (D / 64) * (D / 32);
    constexpr int NITEMS = 2 * I_GU + 2 * I_DN + I_IN + I_PA + 2 * I_DD;
    for (int it = gw; it < NITEMS; it += NGW) {
        int r = it;
        if (r < I_GU) { p0_transpose_item(F.in[IN_W1GU], D, NGU, W1A, F.in[IN_NF1], scr, r, F.lane, MapGU()); continue; } r -= I_GU;
        if (r < I_GU) { p0_transpose_item(F.in[IN_W2GU], D, NGU, W2A, F.in[IN_NF2], scr, r, F.lane, MapGU()); continue; } r -= I_GU;
        if (r < I_DN) { p0_transpose_item(F.in[IN_W1D], FF, D, W1B, nullptr, scr, r, F.lane, MapId()); continue; } r -= I_DN;
        if (r < I_DN) { p0_transpose_item(F.in[IN_W2D], FF, D, W2B, nullptr, scr, r, F.lane, MapId()); continue; } r -= I_DN;
        if (r < I_IN) { p0_transpose_item(F.in[IN_WIN], D, NIN, WIN, F.in[IN_NMIX], scr, r, F.lane, MapIn()); continue; } r -= I_IN;
        if (r < I_PA) { p0_transpose_item(F.in[IN_WPA], 512, D, WPA, nullptr, scr, r, F.lane, MapId()); continue; } r -= I_PA;
        if (r < I_DD) { p0_transpose_item(F.in[IN_WPB], D, D, WPB, nullptr, scr, r, F.lane, MapId()); continue; } r -= I_DD;
        p0_transpose_item(F.in[IN_WOUT], D, D, WOUT, nullptr, scr, r, F.lane, MapId());
    }
    { const int gt = F.bx * 512 + F.tid, NT = F.G * 512; GAS v4u* z = (GAS v4u*)(WIN + (size_t)NIN * D);
      for (int i = gt; i < (NINP - NIN) * D / 8; i += NT) z[i] = (v4u){0u, 0u, 0u, 0u}; }
    bf16* XB = (bf16*)(F.ws + WS_XB); float* RSTD1 = (float*)(F.ws + WS_RSTD1);
    for (int m0 = gw; m0 < MT; m0 += 2 * NGW) {
        f32x4 v[2][4]; float s[2];
#pragma unroll
        for (int r = 0; r < 2; ++r) { const int m = m0 + r * NGW; s[r] = 0.f;
            if (m < MT) { const float* xrow = (m < MP) ? F.in[IN_XP] + (size_t)m * D : F.in[IN_XS] + (size_t)(m - MP) * D; const GAS f32x4* xr = (const GAS f32x4*)xrow + F.lane;
#pragma unroll
                for (int j = 0; j < 4; ++j) v[r][j] = xr[64 * j]; } }
#pragma unroll
        for (int r = 0; r < 2; ++r) { const int m = m0 + r * NGW;
            if (m < MT) {
#pragma unroll
                for (int j = 0; j < 4; ++j) s[r] += (v[r][j].x * v[r][j].x + v[r][j].y * v[r][j].y) + (v[r][j].z * v[r][j].z + v[r][j].w * v[r][j].w);
                float t = row_sum16(s[r]); t += __shfl_xor(t, 16); t += __shfl_xor(t, 32);
                GAS v2u* o8 = (GAS v2u*)(XB + (size_t)m * D) + F.lane;
#pragma unroll
                for (int j = 0; j < 4; ++j) { v2u w; w.x = pk2(v[r][j].x, v[r][j].y); w.y = pk2(v[r][j].z, v[r][j].w); o8[64 * j] = w; }
                if (F.lane == 0) RSTD1[m] = rsqrtf(t * (1.0f / D) + EPS); } }
    }
}

__device__ __forceinline__ void final_norm(Frame& F) {
    const int gw = F.bx * NWAVES + F.wave, NGW = F.G * NWAVES;
    const float* ssq = (const float*)(F.ctl + CW_SSQ4); const GAS f32x4* nw = (const GAS f32x4*)F.in[IN_NOUT] + F.lane;
    f32x4 g[4];
#pragma unroll
    for (int j = 0; j < 4; ++j) g[j] = nw[64 * j];
    for (int m = gw; m < MT; m += NGW) {
        const float r = rsqrtf(ssq[m] * (1.0f / D) + EPS);
        GAS f32x4* xr = (GAS f32x4*)(F.out + O_Y + (size_t)m * D) + F.lane;
#pragma unroll
        for (int j = 0; j < 4; ++j) { f32x4 v = xr[64 * j]; xr[64 * j] = v * r * g[j]; }
    }
}

template <int K>
__device__ __forceinline__ void skinny_partial(const bf16* A, const bf16* Bt, int r0, int c0, int w, int lane, LAS unsigned char* part) {
    const int m16 = lane & 15, kg = lane >> 4;
    f32x4 acc[2][4];
#pragma unroll
    for (int i = 0; i < 2; ++i)
#pragma unroll
        for (int j = 0; j < 4; ++j) acc[i][j] = (f32x4){0.f, 0.f, 0.f, 0.f};
    const bf16* ap = A + (size_t)(r0 + m16) * K + w * (K / 8) + 8 * kg; const bf16* bp = Bt + (size_t)(c0 + m16) * K + w * (K / 8) + 8 * kg;
#pragma unroll 4
    for (int kb = 0; kb < K / 256; ++kb) {
        bf16x8 a[2], bq[4];
#pragma unroll
        for (int i = 0; i < 2; ++i) a[i] = *(const GAS bf16x8*)(ap + (size_t)16 * i * K + 32 * kb);
#pragma unroll
        for (int j = 0; j < 4; ++j) bq[j] = *(const GAS bf16x8*)(bp + (size_t)16 * j * K + 32 * kb);
#pragma unroll
        for (int i = 0; i < 2; ++i)
#pragma unroll
            for (int j = 0; j < 4; ++j) acc[i][j] = mfma16(bq[j], a[i], acc[i][j]);
    }
#pragma unroll
    for (int i = 0; i < 2; ++i)
#pragma unroll
        for (int j = 0; j < 4; ++j) *(LAS f32x4*)(part + ((w * 8 + i * 4 + j) * 64 + lane) * 16) = acc[i][j];
}
__device__ __forceinline__ f32x4 skinny_reduce(const LAS unsigned char* part, int w, int lane) {
    f32x4 s = {0.f, 0.f, 0.f, 0.f};
#pragma unroll
    for (int p = 0; p < 8; ++p) s = s + *(const LAS f32x4*)(part + ((p * 8 + w) * 64 + lane) * 16);
    return s;
}
template <int K, int MODE>
__device__ __forceinline__ void skinny_resid(Frame& F, const bf16* A, const bf16* Bt, const float* basef, const bf16* baseb, bf16* outb, float* outf, float* ssq, float scale) {
    const int lane = F.lane, w = F.wave, m16 = lane & 15, kg = lane >> 4, wr = w >> 2, wc = w & 3;
    for (int t = F.bx; t < 256; t += F.G) {
        const int r0 = MP + 32 * (t >> 4), c0 = 64 * (t & 15);
        skinny_partial<K>(A, Bt, r0, c0, w, lane, F.ldv);
        WG_BARRIER();
        const f32x4 acc = skinny_reduce(F.ldv, w, lane);
        const int row = r0 + 16 * wr + m16;
        const size_t off = (size_t)row * D + c0 + 16 * wc + 4 * kg;
        f32x4 b;
        if (MODE == 0) b = *(const GAS f32x4*)(basef + off); else { const v2u p = *(const GAS v2u*)(baseb + off); b = (f32x4){bflo(p.x), bfhi(p.x), bflo(p.y), bfhi(p.y)}; }
        const f32x4 v = b + acc * scale;
        if (MODE == 2) *(GAS f32x4*)(outf + off) = v; else { v2u pk; pk.x = pk2(v[0], v[1]); pk.y = pk2(v[2], v[3]); *(GAS v2u*)(outb + off) = pk; }
        float s = (v[0] * v[0] + v[1] * v[1]) + (v[2] * v[2] + v[3] * v[3]);
        s += __shfl_xor(s, 16); s += __shfl_xor(s, 32);
        if (kg == 0) atomicAdd(ssq + row, s);
        WG_BARRIER();
    }
}
__device__ __forceinline__ void skinny_merge(Frame& F, const bf16* OA, const bf16* WPA, const bf16* OB, const bf16* WPB, const bf16* U, bf16* MG) {
    const int lane = F.lane, w = F.wave, m16 = lane & 15, kg = lane >> 4, wr = w >> 2, wc = w & 3;
    for (int t = F.bx; t < 256; t += F.G) {
        const int r0 = MP + 32 * (t >> 4), c0 = 64 * (t & 15);
        skinny_partial<512>(OA, WPA, r0, c0, w, lane, F.ldv);
        skinny_partial<D>(OB, WPB, r0, c0, w, lane, F.ldv + 65536);
        WG_BARRIER();
        const f32x4 aa = skinny_reduce(F.ldv, w, lane), ab = skinny_reduce(F.ldv + 65536, w, lane);
        const int row = r0 + 16 * wr + m16, col = c0 + 16 * wc + 4 * kg;
        const v2u ga = *(const GAS v2u*)(U + (size_t)row * NINP + U_GATE + col), gb = *(const GAS v2u*)(U + (size_t)row * NINP + U_GATE + D + col);
        v2u o; o.x = pk2(sigm(bflo(ga.x)) * aa[0] + sigm(bflo(gb.x)) * ab[0], sigm(bfhi(ga.x)) * aa[1] + sigm(bfhi(gb.x)) * ab[1]);
        o.y = pk2(sigm(bflo(ga.y)) * aa[2] + sigm(bflo(gb.y)) * ab[2], sigm(bfhi(ga.y)) * aa[3] + sigm(bfhi(gb.y)) * ab[3]);
        *(GAS v2u*)(MG + (size_t)row * D + col) = o;
        WG_BARRIER();
    }
}
__device__ __forceinline__ void skinny_ba(Frame& F, const bf16* X1B, const bf16* WIN, const float* ssq, float* BA) {
    const int lane = F.lane, m16 = lane & 15, kg = lane >> 4;
    for (int t = F.bx * NWAVES + F.wave; t < MT / 16; t += F.G * NWAVES) {
        const int row = 16 * t + m16;
        f32x4 acc = {0.f, 0.f, 0.f, 0.f}; { const bf16* ap = X1B + (size_t)row * D + 8 * kg; const bf16* bp = WIN + (size_t)(U_BA + m16) * D + 8 * kg;
#pragma unroll 16
            for (int kb = 0; kb < D / 32; ++kb) acc = mfma16(*(const GAS bf16x8*)(bp + 32 * kb), *(const GAS bf16x8*)(ap + 32 * kb), acc); }
        *(GAS f32x4*)(BA + (size_t)row * 16 + 4 * kg) = acc * rsqrtf(ssq[row] * (1.0f / D) + EPS);
    }
}

constexpr int GP_QR = 0, GP_KR = 17408, GP_KT = 34816, GP_KBG = 53248, GP_BVT = 71680, GP_GKK = 90112, GP_GQK = 107520, GP_TI = 124928, GP_TAB = 134144;
constexpr int GKP = 68;
__device__ __forceinline__ f32x4 mfma4(float a, float b, f32x4 c) { return __builtin_amdgcn_mfma_f32_16x16x4f32(a, b, c, 0, 0, 0); }
__device__ __forceinline__ f32x4 prod_ll(const LAS float* A, int ra, int ca, const LAS float* B, int rb, int cb, f32x4 c, int m16, int kg) {
    const f32x4 av = *(const LAS f32x4*)(A + (ra + m16) * GKP + ca + 4 * kg);
#pragma unroll
    for (int t = 0; t < 4; ++t) c = mfma4(av[t], B[(rb + 4 * kg + t) * GKP + cb + m16], c);
    return c;
}
__device__ __forceinline__ f32x4 prod_lr(const LAS float* A, int ra, int ca, f32x4 x, f32x4 c, int m16, int kg) {
    const f32x4 av = *(const LAS f32x4*)(A + (ra + m16) * GKP + ca + 4 * kg);
#pragma unroll
    for (int t = 0; t < 4; ++t) c = mfma4(av[t], x[t], c);
    return c;
}
__device__ __forceinline__ float softplusf(float x) { return x > 20.f ? x : log1pf(__expf(x)); }

struct PrepIn { v2u raw[19]; v4u zr0, zr1; f32x4 w0, w1, w2, w3; float bl, al; };
__device__ __forceinline__ void prep_fetch(Frame& F, int b, int h, int n, PrepIn& in) {
    const bf16* U = (const bf16*)(F.ws + WS_U); const float* BA = (const float*)(F.ws + WS_BA);
    const int tid = F.tid, row_base = b * SEQ + 64 * n;
    const int gz_t = tid >> 3, gz_c = (tid & 7) * 16;
    in.zr0 = *(const GAS v4u*)(U + (size_t)(row_base + gz_t) * NINP + U_Z + h * 128 + gz_c); in.zr1 = *(const GAS v4u*)(U + (size_t)(row_base + gz_t) * NINP + U_Z + h * 128 + gz_c + 8);
    const int cv_cq = tid & 31, cv_tq = (tid >> 5) & 3, cv_tensor = tid >> 7, cv_cw = cv_tensor * 1024 + h * 128 + 4 * cv_cq, cv_t0 = 16 * cv_tq;
    if (tid < 384) {
        in.w0 = *(const GAS f32x4*)(F.in[IN_CONVW] + cv_cw); in.w1 = *(const GAS f32x4*)(F.in[IN_CONVW] + 3072 + cv_cw); in.w2 = *(const GAS f32x4*)(F.in[IN_CONVW] + 2 * 3072 + cv_cw); in.w3 = *(const GAS f32x4*)(F.in[IN_CONVW] + 3 * 3072 + cv_cw);
#pragma unroll
        for (int i = 0; i < 19; ++i) { const int tok = 64 * n + cv_t0 - 3 + i; in.raw[i] = (v2u){0u, 0u}; if (tok >= 0) in.raw[i] = *(const GAS v2u*)(U + (size_t)(b * SEQ + tok) * NINP + U_QKVB + cv_cw); }
    }
    if (F.wave == 0) { in.bl = BA[(size_t)(row_base + F.lane) * 16 + h]; in.al = BA[(size_t)(row_base + F.lane) * 16 + 8 + h]; }
}
__device__ __forceinline__ void gdn_prep_unit(Frame& F, int b, int h, int n, PrepIn& in, bool has_next, int nb_, int nh_, int nn_) {
    LAS unsigned char* L = F.ldv;
    LAS float* TAB = (LAS float*)(L + GP_TAB);
    LAS float* GKK = (LAS float*)(L + GP_GKK);
    LAS float* GQK = (LAS float*)(L + GP_GQK);
    const bf16* U = (const bf16*)(F.ws + WS_U); const float* BA = (const float*)(F.ws + WS_BA);
    const int tid = F.tid, lane = F.lane, wave = F.wave;
    const int uidx = (b * 8 + h) * 64 + n;
    unsigned char* rec = F.ws + WS_REC + (size_t)uidx * REC_BYTES;
    const int row_base = b * SEQ + 64 * n;
    const int gz_t = tid >> 3, gz_c = (tid & 7) * 16;
    const int cv_cq = tid & 31, cv_tq = (tid >> 5) & 3, cv_tensor = tid >> 7, cv_c0 = 4 * cv_cq, cv_t0 = 16 * cv_tq;
    if (wave == 0) {
        const int t = lane; const float bl = in.bl, al = in.al;
        const float beta = sigm(bl); const float g = -__expf(F.in[IN_ALOG][h]) * softplusf(al + F.in[IN_DTB][h]);
        float gc = g;
#pragma unroll
        for (int o = 1; o < 64; o <<= 1) { const float v = __shfl_up(gc, o); if (lane >= o) gc += v; }
        const float gl = __shfl(gc, 63);
        TAB[t] = beta; TAB[64 + t] = gc; TAB[128 + t] = __expf(gc); TAB[192 + t] = __expf(gl - gc);
        if (lane == 0) ((float*)(F.ws + WS_GE))[uidx] = __expf(gl);
    }
    WG_BARRIER();
    if (tid < 384) {
        const int tensor = cv_tensor, c0 = cv_c0, t0 = cv_t0;
        f32x4 x[19];
#pragma unroll
        for (int i = 0; i < 19; ++i) x[i] = (f32x4){bflo(in.raw[i].x), bfhi(in.raw[i].x), bflo(in.raw[i].y), bfhi(in.raw[i].y)};
        const f32x4 w0 = in.w0, w1 = in.w1, w2 = in.w2, w3 = in.w3;
        unsigned tp[4][8];
#pragma unroll
        for (int i = 0; i < 16; ++i) { f32x4 y = w0 * x[i] + w1 * x[i + 1] + w2 * x[i + 2] + w3 * x[i + 3];
#pragma unroll
            for (int e = 0; e < 4; ++e) y[e] = siluf(y[e]);
            if (tensor == 2) y = y * TAB[t0 + i];
            if (tensor < 2) { v2u pk; pk.x = pk2(y[0], y[1]); pk.y = pk2(y[2], y[3]); *(LAS v2u*)(L + (tensor == 0 ? GP_QR : GP_KR) + (t0 + i) * 272 + 2 * c0) = pk; }
            if (tensor > 0) {
#pragma unroll
                for (int e = 0; e < 4; ++e) { const unsigned bq = f2bf(y[e]); if (i & 1) tp[e][i >> 1] |= bq << 16; else tp[e][i >> 1] = bq; } }
        }
        if (tensor > 0) {
#pragma unroll
            for (int e = 0; e < 4; ++e) { LAS unsigned char* dst = L + (tensor == 1 ? GP_KT : GP_BVT) + (c0 + e) * 144 + 2 * t0;
                *(LAS v4u*)dst = (v4u){tp[e][0], tp[e][1], tp[e][2], tp[e][3]}; *(LAS v4u*)(dst + 16) = (v4u){tp[e][4], tp[e][5], tp[e][6], tp[e][7]}; } }
    }
    WG_BARRIER();
    { const unsigned zi[8] = {in.zr0.x, in.zr0.y, in.zr0.z, in.zr0.w, in.zr1.x, in.zr1.y, in.zr1.z, in.zr1.w}; unsigned zo[8];
#pragma unroll
      for (int i = 0; i < 8; ++i) { const float za = bflo(zi[i]), zb = bfhi(zi[i]); const f32x2 nw2 = *(const GAS f32x2*)(F.in[IN_GNORM] + gz_c + 2 * i);
          zo[i] = pk2(za * sigm(za) * nw2[0], zb * sigm(zb) * nw2[1]); }
      *(GAS v4u*)(rec + 73728 + (gz_t * 128 + gz_c) * 2) = (v4u){zo[0], zo[1], zo[2], zo[3]}; *(GAS v4u*)(rec + 73728 + (gz_t * 128 + gz_c + 8) * 2) = (v4u){zo[4], zo[5], zo[6], zo[7]}; }
    if (has_next) prep_fetch(F, nb_, nh_, nn_, in);
    {
        const int m16 = lane & 15, kg = lane >> 4;
        for (int job = wave; job < 24; job += 8) {
            int kind, it, jt;
            if (job < 20) { kind = job >= 10; int j = job % 10; it = 0; while (j > it) { j -= it + 1; ++it; } jt = j; }
            else { kind = 2; it = jt = job - 20; }
            const int abase = (kind == 2 ? GP_QR : GP_KR) + (16 * (kind == 1 ? jt : it) + m16) * 272 + 16 * kg;
            const int bbase = (kind == 0 ? GP_KR : GP_QR) + (16 * (kind == 0 ? jt : it) + m16) * 272 + 16 * kg;
            f32x4 acc = {0.f, 0.f, 0.f, 0.f};
#pragma unroll
            for (int kb = 0; kb < 4; ++kb) { const bf16x8 a = *(const LAS bf16x8*)(L + abase + 64 * kb), bb = *(const LAS bf16x8*)(L + bbase + 64 * kb); acc = mfma16(a, bb, acc); }
            if (kind == 0) {
#pragma unroll
                for (int jj = 0; jj < 4; ++jj) GKK[(16 * it + 4 * kg + jj) * GKP + 16 * jt + m16] = acc[jj];
            } else if (kind == 1) {
                *(LAS f32x4*)(GQK + (16 * it + m16) * 68 + 16 * jt + 4 * kg) = acc;
            } else {
#pragma unroll
                for (int jj = 0; jj < 4; ++jj) if (4 * kg + jj == m16) TAB[576 + 16 * it + m16] = acc[jj];
            }
        }
    }
    WG_BARRIER();
    if (tid < 64) {
        const int t = tid; const float rk = rsqrtf(GKK[t * GKP + t] + EPS), rq = rsqrtf(TAB[576 + t] + EPS) * 0.08838834764831845f;
        TAB[256 + t] = rk; TAB[320 + t] = rq; TAB[384 + t] = rq * TAB[128 + t]; TAB[448 + t] = rk * TAB[192 + t]; TAB[512 + t] = rk * TAB[t] * TAB[128 + t];
    }
    WG_BARRIER();
    {
        for (int e = tid; e < 4096; e += 512) { const int i = e >> 6, j = e & 63;
            if (j < i) GKK[i * GKP + j] = TAB[i] * TAB[256 + i] * TAB[256 + j] * GKK[i * GKP + j] * __expf(TAB[64 + i] - TAB[64 + j]); }
        const int m16 = lane & 15, kg = lane >> 4;
        { const int it = wave >> 1, kb2 = wave & 1, i = 16 * it + m16; const float sc = TAB[320 + i], gi = TAB[64 + i];
          float o[8];
#pragma unroll
          for (int hlf = 0; hlf < 2; ++hlf) { const int j0 = 32 * kb2 + 16 * hlf + 4 * kg; const f32x4 g = *(const LAS f32x4*)(GQK + i * 68 + j0);
#pragma unroll
              for (int e = 0; e < 4; ++e) { const int j = j0 + e; o[4 * hlf + e] = (j <= i) ? sc * TAB[256 + j] * g[e] * __expf(gi - TAB[64 + j]) : 0.f; } }
          v4u w; w.x = pk2(o[0], o[1]); w.y = pk2(o[2], o[3]); w.z = pk2(o[4], o[5]); w.w = pk2(o[6], o[7]);
          *(GAS v4u*)(rec + 32768 + wave * 1024 + lane * 16) = w; }
#pragma unroll
        for (int r = 0; r < 2; ++r) { const int f = wave * 2 + r, mt = f >> 1, kb2 = f & 1, dk = 16 * mt + m16; float o[8];
#pragma unroll
            for (int hlf = 0; hlf < 2; ++hlf) { const int t0 = 32 * kb2 + 16 * hlf + 4 * kg; const v2u kk = *(const LAS v2u*)(L + GP_KT + dk * 144 + 2 * t0);
                o[4 * hlf + 0] = bflo(kk.x) * TAB[448 + t0]; o[4 * hlf + 1] = bfhi(kk.x) * TAB[448 + t0 + 1]; o[4 * hlf + 2] = bflo(kk.y) * TAB[448 + t0 + 2]; o[4 * hlf + 3] = bfhi(kk.y) * TAB[448 + t0 + 3]; }
            v4u w; w.x = pk2(o[0], o[1]); w.y = pk2(o[2], o[3]); w.z = pk2(o[4], o[5]); w.w = pk2(o[6], o[7]);
            *(GAS v4u*)(rec + 40960 + f * 1024 + lane * 16) = w; }
#pragma unroll
        for (int r = 0; r < 2; ++r) { const int f = wave * 2 + r, mtq = f >> 2, kb = f & 3, t = 16 * mtq + m16; const float sc = TAB[384 + t]; float o[8];
#pragma unroll
            for (int hlf = 0; hlf < 2; ++hlf) { const int d0 = 32 * kb + 16 * hlf + 4 * kg; const v2u qq = *(const LAS v2u*)(L + GP_QR + t * 272 + 2 * d0);
                o[4 * hlf + 0] = bflo(qq.x) * sc; o[4 * hlf + 1] = bfhi(qq.x) * sc; o[4 * hlf + 2] = bflo(qq.y) * sc; o[4 * hlf + 3] = bfhi(qq.y) * sc; }
            v4u w; w.x = pk2(o[0], o[1]); w.y = pk2(o[2], o[3]); w.z = pk2(o[4], o[5]); w.w = pk2(o[6], o[7]);
            *(GAS v4u*)(rec + ((4 + mtq) * 4 + kb) * 1024 + lane * 16) = w; }
        { const int dk = tid >> 2, t0 = (tid & 3) * 16; const v4u a = *(const LAS v4u*)(L + GP_KT + dk * 144 + 2 * t0), bq = *(const LAS v4u*)(L + GP_KT + dk * 144 + 2 * t0 + 16);
          const unsigned wi[8] = {a.x, a.y, a.z, a.w, bq.x, bq.y, bq.z, bq.w}; unsigned wo[8];
#pragma unroll
          for (int i = 0; i < 8; ++i) wo[i] = pk2(bflo(wi[i]) * TAB[512 + t0 + 2 * i], bfhi(wi[i]) * TAB[512 + t0 + 2 * i + 1]);
          *(LAS v4u*)(L + GP_KBG + dk * 144 + 2 * t0) = (v4u){wo[0], wo[1], wo[2], wo[3]}; *(LAS v4u*)(L + GP_KBG + dk * 144 + 2 * t0 + 16) = (v4u){wo[4], wo[5], wo[6], wo[7]}; }
    }
    WG_BARRIER();
    LAS float* TIF = GQK;
    {
        const int m16 = lane & 15, kg = lane >> 4;
        if (wave == 0) {
            const LAS float* Ab = GKK + (16 * kg) * GKP + 16 * kg; float r[16];
#pragma unroll
            for (int i = 0; i < 16; ++i) { int lo_ = m16; asm volatile("" : "+v"(lo_)); float a = (lo_ == i) ? 1.f : 0.f;
#pragma unroll
                for (int j4 = 0; j4 < (i + 3) / 4; ++j4) { const f32x4 av = *(const LAS f32x4*)(Ab + i * GKP + 4 * j4);
#pragma unroll
                    for (int e = 0; e < 4; ++e) { const int j = 4 * j4 + e; if (j < i) a -= av[e] * r[j]; } }
                r[i] = a; }
#pragma unroll
            for (int i = 0; i < 16; ++i) TIF[(16 * kg + i) * GKP + 16 * kg + m16] = r[i];
        }
        WG_BARRIER();
        const f32x4 z4 = {0.f, 0.f, 0.f, 0.f};
        if (wave < 3) { const int i = wave + 1, j = wave;
            f32x4 X = prod_ll(GKK, 16 * i, 16 * j, TIF, 16 * j, 16 * j, z4, m16, kg);
            f32x4 T = prod_lr(TIF, 16 * i, 16 * i, X, z4, m16, kg);
#pragma unroll
            for (int jj = 0; jj < 4; ++jj) TIF[(16 * i + 4 * kg + jj) * GKP + 16 * j + m16] = -T[jj]; }
        WG_BARRIER();
        if (wave < 2) { const int i = wave + 2, j = wave;
            f32x4 Y = prod_ll(GKK, 16 * i, 16 * j, TIF, 16 * j, 16 * j, z4, m16, kg);
            Y = prod_ll(GKK, 16 * i, 16 * (j + 1), TIF, 16 * (j + 1), 16 * j, Y, m16, kg);
            f32x4 T = prod_lr(TIF, 16 * i, 16 * i, Y, z4, m16, kg);
#pragma unroll
            for (int jj = 0; jj < 4; ++jj) TIF[(16 * i + 4 * kg + jj) * GKP + 16 * j + m16] = -T[jj]; }
        WG_BARRIER();
        if (wave == 0) {
            f32x4 Y = prod_ll(GKK, 48, 0, TIF, 0, 0, z4, m16, kg);
            Y = prod_ll(GKK, 48, 16, TIF, 16, 0, Y, m16, kg);
            Y = prod_ll(GKK, 48, 32, TIF, 32, 0, Y, m16, kg);
            f32x4 T = prod_lr(TIF, 48, 48, Y, z4, m16, kg);
#pragma unroll
            for (int jj = 0; jj < 4; ++jj) TIF[(48 + 4 * kg + jj) * GKP + m16] = -T[jj]; }
        WG_BARRIER();
        { const int row = tid >> 3, cg = tid & 7; v4u o = {0u, 0u, 0u, 0u};
          if ((cg >> 1) <= (row >> 4)) { const f32x4 a = *(const LAS f32x4*)(TIF + row * GKP + 8 * cg), c = *(const LAS f32x4*)(TIF + row * GKP + 8 * cg + 4);
              o.x = pk2(a[0], a[1]); o.y = pk2(a[2], a[3]); o.z = pk2(c[0], c[1]); o.w = pk2(c[2], c[3]); }
          *(LAS v4u*)(L + GP_TI + row * 144 + 16 * cg) = o; }
    }
    WG_BARRIER();
    {
        const int m16 = lane & 15, kg = lane >> 4;
#pragma unroll
        for (int it = 0; it < 4; ++it) {
            f32x4 au = {0.f, 0.f, 0.f, 0.f}, aw = {0.f, 0.f, 0.f, 0.f};
#pragma unroll
            for (int jb = 0; jb < 2; ++jb) {
                const bf16x8 ti = *(const LAS bf16x8*)(L + GP_TI + (16 * it + m16) * 144 + 64 * jb + 16 * kg);
                const bf16x8 bv = *(const LAS bf16x8*)(L + GP_BVT + (16 * wave + m16) * 144 + 64 * jb + 16 * kg);
                const bf16x8 kb = *(const LAS bf16x8*)(L + GP_KBG + (16 * wave + m16) * 144 + 64 * jb + 16 * kg);
                au = mfma16(ti, bv, au);
                aw = mfma16(kb, ti, aw);
            }
            v2u w; w.x = pk2(au[0], au[1]); w.y = pk2(au[2], au[3]);
            *(GAS v2u*)(rec + 57344 + ((wave * 4 + it) * 64 + lane) * 8) = w;
            v2u x; x.x = pk2(aw[0], aw[1]); x.y = pk2(aw[2], aw[3]);
            *(GAS v2u*)(rec + (it * 4 + (wave >> 1)) * 1024 + lane * 16 + (wave & 1) * 8) = x;
        }
    }
    WG_BARRIER();
}

constexpr int SC_BUF = 57344, SC_OT = 2 * SC_BUF, SC_OTB = 17408, SC_RED = SC_OT + 2 * SC_OTB;
static_assert(SC_RED + 2048 <= LDSCTL_OFF, "scan LDS map");
__device__ __forceinline__ void gdn_scan_chain(Frame& F, int bh) {
#ifdef NO_SCAN
    return;
#endif
    LAS unsigned char* L = F.ldv;
    const int tid = F.tid, lane = F.lane, w = F.wave, m16 = lane & 15, kg = lane >> 4;
    const int b = bh >> 3, h = bh & 7;
    const unsigned char* rec0 = F.ws + WS_REC + (size_t)(bh * 64) * REC_BYTES;
    if (w >= 4) {
        const int ht = tid - 256; bf16* OB = (bf16*)(F.ws + WS_OB);
        v4u st[14];
#pragma unroll
        for (int i = 0; i < 14; ++i) st[i] = *(const GAS v4u*)(rec0 + (size_t)(i * 256 + ht) * 16);
#pragma unroll
        for (int i = 0; i < 14; ++i) *(LAS v4u*)(L + (i * 256 + ht) * 16) = st[i];
#pragma unroll
        for (int i = 0; i < 14; ++i) st[i] = *(const GAS v4u*)(rec0 + REC_BYTES + (size_t)(i * 256 + ht) * 16);
        WG_BARRIER();
        for (int m = 0; m < 65; ++m) {
            if (m + 1 <= 63) { LAS unsigned char* nb = L + ((m + 1) & 1) * SC_BUF;
#pragma unroll
                for (int i = 0; i < 14; ++i) *(LAS v4u*)(nb + (i * 256 + ht) * 16) = st[i]; }
            if (m + 2 <= 63) { const unsigned char* rec = rec0 + (size_t)(m + 2) * REC_BYTES;
#pragma unroll
                for (int i = 0; i < 14; ++i) st[i] = *(const GAS v4u*)(rec + (size_t)(i * 256 + ht) * 16); }
            if (m >= 1) {
                const LAS unsigned char* ot = L + SC_OT + ((m - 1) & 1) * SC_OTB; const LAS float* RED = (const LAS float*)(L + SC_RED) + ((m - 1) & 1) * 256;
                const int row0 = b * SEQ + 64 * (m - 1); const unsigned char* gzt = rec0 + (size_t)(m - 1) * REC_BYTES + 73728;
                v4u gv[4];
#pragma unroll
                for (int r = 0; r < 4; ++r) gv[r] = *(const GAS v4u*)(gzt + (size_t)(ht + 256 * r) * 16);
#pragma unroll
                for (int r = 0; r < 4; ++r) { const int idx = ht + 256 * r, row = idx >> 4, ch = idx & 15;
                    const v4u ov = *(const LAS v4u*)(ot + row * 272 + ch * 16); const f32x4 r4 = *(const LAS f32x4*)(RED + row * 4);
                    const float rs = rsqrtf(((r4[0] + r4[1]) + (r4[2] + r4[3])) * (1.0f / 128.0f) + EPS);
                    v4u o; o.x = pk2(bflo(ov.x) * rs * bflo(gv[r].x), bfhi(ov.x) * rs * bfhi(gv[r].x)); o.y = pk2(bflo(ov.y) * rs * bflo(gv[r].y), bfhi(ov.y) * rs * bfhi(gv[r].y));
                    o.z = pk2(bflo(ov.z) * rs * bflo(gv[r].z), bfhi(ov.z) * rs * bfhi(gv[r].z)); o.w = pk2(bflo(ov.w) * rs * bflo(gv[r].w), bfhi(ov.w) * rs * bfhi(gv[r].w));
                    *(GAS v4u*)(OB + (size_t)(row0 + row) * D + h * 128 + ch * 8) = o; } }
            WG_BARRIER();
        }
    } else {
        const float* GE = (const float*)(F.ws + WS_GE) + bh * 64;
        f32x4 S[2][8], P[2][8];
#pragma unroll
        for (int hf = 0; hf < 2; ++hf)
#pragma unroll
            for (int i = 0; i < 8; ++i) { S[hf][i] = (f32x4){0.f, 0.f, 0.f, 0.f}; P[hf][i] = (f32x4){0.f, 0.f, 0.f, 0.f}; }
        WG_BARRIER();
        for (int m = 0; m < 65; ++m) {
            if (m <= 63) {
                const unsigned char* rec = rec0 + (size_t)m * REC_BYTES; const LAS unsigned char* buf = L + (m & 1) * SC_BUF;
                v2u ut[2][4];
#pragma unroll
                for (int hf = 0; hf < 2; ++hf)
#pragma unroll
                    for (int mt = 0; mt < 4; ++mt) ut[hf][mt] = *(const GAS v2u*)(rec + 57344 + (((2 * w + hf) * 4 + mt) * 64 + lane) * 8);
                const float ge = GE[m];
                bf16x8 Sb[2][4];
#pragma unroll
                for (int hf = 0; hf < 2; ++hf)
#pragma unroll
                    for (int kb = 0; kb < 4; ++kb) Sb[hf][kb] = pack8(S[hf][2 * kb], S[hf][2 * kb + 1]);
#pragma unroll
                for (int mt = 0; mt < 8; ++mt) { P[0][mt] = (f32x4){0.f, 0.f, 0.f, 0.f}; P[1][mt] = (f32x4){0.f, 0.f, 0.f, 0.f};
#pragma unroll
                    for (int kb = 0; kb < 4; ++kb) { const bf16x8 a = *(const LAS bf16x8*)(buf + (mt * 4 + kb) * 1024 + lane * 16); P[0][mt] = mfma16(a, Sb[0][kb], P[0][mt]); P[1][mt] = mfma16(a, Sb[1][kb], P[1][mt]); } }
                bf16x8 vb[2][2];
#pragma unroll
                for (int hf = 0; hf < 2; ++hf) { f32x4 vn[4];
#pragma unroll
                    for (int mt = 0; mt < 4; ++mt) { vn[mt][0] = bflo(ut[hf][mt].x) - P[hf][mt][0]; vn[mt][1] = bfhi(ut[hf][mt].x) - P[hf][mt][1]; vn[mt][2] = bflo(ut[hf][mt].y) - P[hf][mt][2]; vn[mt][3] = bfhi(ut[hf][mt].y) - P[hf][mt][3]; }
                    vb[hf][0] = pack8(vn[0], vn[1]); vb[hf][1] = pack8(vn[2], vn[3]); }
#pragma unroll
                for (int mt = 0; mt < 4; ++mt)
#pragma unroll
                    for (int kb2 = 0; kb2 < 2; ++kb2) { const bf16x8 a = *(const LAS bf16x8*)(buf + 32768 + (mt * 2 + kb2) * 1024 + lane * 16); P[0][4 + mt] = mfma16(a, vb[0][kb2], P[0][4 + mt]); P[1][4 + mt] = mfma16(a, vb[1][kb2], P[1][4 + mt]); }
#pragma unroll
                for (int mt = 0; mt < 8; ++mt) { S[0][mt] = S[0][mt] * ge; S[1][mt] = S[1][mt] * ge;
#pragma unroll
                    for (int kb2 = 0; kb2 < 2; ++kb2) { const bf16x8 a = *(const LAS bf16x8*)(buf + 40960 + (mt * 2 + kb2) * 1024 + lane * 16); S[0][mt] = mfma16(a, vb[0][kb2], S[0][mt]); S[1][mt] = mfma16(a, vb[1][kb2], S[1][mt]); } }
                LAS float* RED = (LAS float*)(L + SC_RED) + (m & 1) * 256; LAS unsigned char* ot = L + SC_OT + (m & 1) * SC_OTB;
#pragma unroll
                for (int mt = 0; mt < 4; ++mt)
#pragma unroll
                    for (int jj = 0; jj < 4; jj += 2) { const int t = 16 * mt + 4 * kg + jj;
#pragma unroll
                        for (int hf = 0; hf < 2; ++hf) { const unsigned pr = pk2(P[hf][4 + mt][jj], P[hf][4 + mt][jj + 1]);
                            *(LAS bf16*)(ot + t * 272 + (32 * w + 16 * hf + m16) * 2) = (bf16)(pr & 0xffffu); *(LAS bf16*)(ot + (t + 1) * 272 + (32 * w + 16 * hf + m16) * 2) = (bf16)(pr >> 16); } }
                float mine = 0.f;
#pragma unroll
                for (int mt = 0; mt < 4; ++mt)
#pragma unroll
                    for (int jj = 0; jj < 4; ++jj) { const float q = row_sum16(P[0][4 + mt][jj] * P[0][4 + mt][jj] + P[1][4 + mt][jj] * P[1][4 + mt][jj]); mine = (m16 == 4 * mt + jj) ? q : mine; }
                RED[(16 * (m16 >> 2) + 4 * kg + (m16 & 3)) * 4 + w] = mine;
            }
            WG_BARRIER();
        }
        float* so = F.out + O_SSMP + (size_t)bh * 16384;
#pragma unroll
        for (int hf = 0; hf < 2; ++hf)
#pragma unroll
            for (int mt = 0; mt < 8; ++mt)
#pragma unroll
                for (int jj = 0; jj < 4; ++jj) so[(16 * mt + 4 * kg + jj) * 128 + 32 * w + 16 * hf + m16] = S[hf][mt][jj];
    }
    WG_BARRIER();
}

__device__ __forceinline__ void gdn_sample_unit(Frame& F, int b, int h) {
    LAS float* L = (LAS float*)F.ldv;
    const int tid = F.tid, lane = F.lane, wave = F.wave;
    const bf16* U = (const bf16*)(F.ws + WS_U); const float* BA = (const float*)(F.ws + WS_BA);
    const int row0 = MP + 4 * b;
    const int dv = tid & 127, kq = tid >> 7;
    const float* S0 = F.in[IN_SSSM] + ((size_t)(b * 8 + h) * 128 + 32 * kq) * 128 + dv;
    float s[32];
#pragma unroll
    for (int i = 0; i < 32; ++i) s[i] = S0[(size_t)i * 128];
    LAS float* SC = L + 8704;
    if (tid < 4) { const float bl = BA[(size_t)(row0 + tid) * 16 + h], al = BA[(size_t)(row0 + tid) * 16 + 8 + h];
        SC[tid] = sigm(bl); SC[56 + tid] = -__expf(F.in[IN_ALOG][h]) * softplusf(al + F.in[IN_DTB][h]); }
    if (tid < 384) {
        const int tensor = tid >> 7, c = tid & 127, cw = tensor * 1024 + h * 128 + c, col = U_QKVB + cw;
        const float w0 = F.in[IN_CONVW][cw], w1 = F.in[IN_CONVW][3072 + cw], w2 = F.in[IN_CONVW][2 * 3072 + cw], w3 = F.in[IN_CONVW][3 * 3072 + cw];
        float x[7];
#pragma unroll
        for (int i = 0; i < 3; ++i) x[i] = F.in[IN_SCONV][((size_t)b * 3 + i) * 3072 + cw];
#pragma unroll
        for (int i = 0; i < 4; ++i) x[3 + i] = bf2f(U[(size_t)(row0 + i) * NINP + col]);
#pragma unroll
        for (int i = 0; i < 4; ++i) { const float v = w0 * x[i] + w1 * x[i + 1] + w2 * x[i + 2] + w3 * x[i + 3]; L[tensor * 512 + i * 128 + c] = siluf(v); }
    }
    WG_BARRIER();
    if (tid == 0) { float gc = 0.f;
#pragma unroll
        for (int i = 0; i < 4; ++i) { gc += SC[56 + i]; SC[4 + i] = gc; } SC[48] = __expf(gc); }
    { const int tensor = wave >> 2, s = wave & 3; const float a = L[tensor * 512 + s * 128 + lane], c2 = L[tensor * 512 + s * 128 + 64 + lane];
      const float ss = wave_sum(a * a + c2 * c2); if (lane == 0) SC[(tensor ? 8 : 12) + s] = rsqrtf(ss + EPS) * (tensor ? 1.f : 0.08838834764831845f); }
    WG_BARRIER();
#pragma unroll
    for (int r = 0; r < 4; ++r) { const int idx = 4 * wave + r, kind = idx >> 4, i = (idx >> 2) & 3, j = idx & 3;
        const LAS float* a = L + (kind ? 0 : 512) + i * 128; const LAS float* c2 = L + 512 + j * 128;
        const float d = wave_sum(a[lane] * c2[lane] + a[64 + lane] * c2[64 + lane]);
        if (lane == 0) SC[16 + idx] = d * SC[(kind ? 12 : 8) + i] * SC[8 + j]; }
    WG_BARRIER();
    float beta[4], gc[4], Ti[4][4], qkm[4][4];
#pragma unroll
    for (int i = 0; i < 4; ++i) { beta[i] = SC[i]; gc[i] = SC[4 + i]; }
    const float ge = SC[48];
    {
        float A[4][4];
#pragma unroll
        for (int i = 0; i < 4; ++i)
#pragma unroll
            for (int j = 0; j < 4; ++j) { const float dec = __expf(gc[i] - gc[j]); A[i][j] = (j < i) ? beta[i] * SC[16 + 4 * i + j] * dec : 0.f; qkm[i][j] = (j <= i) ? SC[32 + 4 * i + j] * dec : 0.f; }
#pragma unroll
        for (int i = 0; i < 4; ++i)
#pragma unroll
            for (int c = 0; c < 4; ++c) { float v = (i == c) ? 1.f : 0.f;
#pragma unroll
                for (int j = 0; j < 4; ++j) if (j < i) v -= A[i][j] * Ti[j][c];
                Ti[i][c] = v; }
    }
    { const int c = tid & 127, i = tid >> 7; float wv = 0.f, uv = 0.f;
#pragma unroll
      for (int j = 0; j < 4; ++j) { wv += Ti[i][j] * beta[j] * __expf(gc[j]) * SC[8 + j] * L[512 + j * 128 + c]; uv += Ti[i][j] * beta[j] * L[1024 + j * 128 + c]; }
      L[1536 + i * 128 + c] = wv; L[3072 + i * 128 + c] = uv;
      L[2048 + i * 128 + c] = L[i * 128 + c] * SC[12 + i] * __expf(gc[i]);
      L[2560 + i * 128 + c] = L[512 + i * 128 + c] * SC[8 + i] * __expf(gc[3] - gc[i]); }
    WG_BARRIER();
    float pw[4] = {0.f, 0.f, 0.f, 0.f}, pq[4] = {0.f, 0.f, 0.f, 0.f};
#pragma unroll
    for (int i = 0; i < 32; ++i)
#pragma unroll
        for (int c = 0; c < 4; ++c) { pw[c] += L[1536 + c * 128 + 32 * kq + i] * s[i]; pq[c] += L[2048 + c * 128 + 32 * kq + i] * s[i]; }
#pragma unroll
    for (int c = 0; c < 4; ++c) { L[3584 + (c * 4 + kq) * 128 + dv] = pw[c]; L[3584 + ((4 + c) * 4 + kq) * 128 + dv] = pq[c]; }
    WG_BARRIER();
    float vn[4], oo[4];
#pragma unroll
    for (int c = 0; c < 4; ++c) { const float ws_ = (L[3584 + (c * 4 + 0) * 128 + dv] + L[3584 + (c * 4 + 1) * 128 + dv]) + (L[3584 + (c * 4 + 2) * 128 + dv] + L[3584 + (c * 4 + 3) * 128 + dv]);
        vn[c] = L[3072 + c * 128 + dv] - ws_; }
#pragma unroll
    for (int c = 0; c < 4; ++c) { float o = (L[3584 + ((4 + c) * 4 + 0) * 128 + dv] + L[3584 + ((4 + c) * 4 + 1) * 128 + dv]) + (L[3584 + ((4 + c) * 4 + 2) * 128 + dv] + L[3584 + ((4 + c) * 4 + 3) * 128 + dv]);
#pragma unroll
        for (int j = 0; j < 4; ++j) o += qkm[c][j] * vn[j];
        oo[c] = o; }
    float* SO = F.out + O_SSMS + ((size_t)(b * 8 + h) * 128 + 32 * kq) * 128 + dv;
#pragma unroll
    for (int i = 0; i < 32; ++i) { float v = ge * s[i];
#pragma unroll
        for (int c = 0; c < 4; ++c) v += L[2560 + c * 128 + 32 * kq + i] * vn[c];
        SO[(size_t)i * 128] = v; }
    LAS float* RED = L + 8768;
    if (kq == 0) {
#pragma unroll
        for (int c = 0; c < 4; ++c) { const float q = wave_sum(oo[c] * oo[c]); if (lane == 0) RED[c * 2 + wave] = q; }
    }
    WG_BARRIER();
    if (kq == 0) {
        bf16* OB = (bf16*)(F.ws + WS_OB); const float nw = F.in[IN_GNORM][dv];
#pragma unroll
        for (int c = 0; c < 4; ++c) { const float rs = rsqrtf((RED[c * 2] + RED[c * 2 + 1]) * (1.0f / 128.0f) + EPS);
            const float z = bf2f(U[(size_t)(row0 + c) * NINP + U_Z + h * 128 + dv]);
            OB[(size_t)(row0 + c) * D + h * 128 + dv] = (bf16)f2bf(oo[c] * rs * nw * (z * sigm(z))); }
    }
    WG_BARRIER();
}

__device__ __forceinline__ void copy_map(Frame& F, int c, size_t& src, float*& dst) {
    constexpr int C0 = 65536, C1 = 262144, C2 = 1048576, CS = 65536, CCP = 4608;
    int r = c, srow, scol;
    if (r < C0 + C1 + C2) {
        int g, kl; if (r < C0) { g = 0; kl = 7; dst = F.out + O_KVP0; } else if (r < C0 + C1) { r -= C0; g = 1; kl = 9; dst = F.out + O_KVP1; } else { r -= C0 + C1; g = 2; kl = 11; dst = F.out + O_KVP2; }
        const int e8 = r & 15, hh = (r >> 4) & 3, kv = (r >> 6) & 1, rr = (r >> 7) & ((1 << kl) - 1), bb = r >> (7 + kl);
        srow = bb * SEQ + SEQ - (1 << kl) + rr; scol = (kv ? U_VA : U_KA) + (g * 4 + hh) * 128 + e8 * 8; dst += (size_t)r * 8;
    } else if ((r -= C0 + C1 + C2) < 3 * CS) {
        const int g = r >> 16; r &= 65535; dst = F.out + (g == 0 ? O_KVS0 : (g == 1 ? O_KVS1 : O_KVS2)) + (size_t)r * 8;
        const int e8 = r & 15, hh = (r >> 4) & 3, kv = (r >> 6) & 1, ss = (r >> 7) & 3, bb = r >> 9;
        srow = MP + 4 * bb + ss; scol = (kv ? U_VA : U_KA) + (g * 4 + hh) * 128 + e8 * 8;
    } else if ((r -= 3 * CS) < CCP) {
        const int ch8 = r % 384, i = (r / 384) % 3, bb = r / 1152; dst = F.out + O_CONVP + (size_t)r * 8;
        srow = bb * SEQ + SEQ - 3 + i; scol = U_QKVB + ch8 * 8;
    } else {
        r -= CCP; const int ch8 = r % 384, i = (r / 384) % 3, bb = r / 1152; dst = F.out + O_CONVS + (size_t)r * 8;
        srow = MP + 4 * bb + 1 + i; scol = U_QKVB + ch8 * 8;
    }
    src = (size_t)srow * NINP + scol;
}
__device__ __forceinline__ void copy_outputs(Frame& F) {
    const bf16* U = (const bf16*)(F.ws + WS_U);
    const int gt = F.bx * 512 + F.tid, NT = F.G * 512;
    constexpr int TOT = 65536 + 262144 + 1048576 + 3 * 65536 + 4608 + 147456;
    for (int c0 = gt; c0 < TOT; c0 += 4 * NT) {
        v4u v[4]; float* dst[4];
#pragma unroll
        for (int k = 0; k < 4; ++k) { const int c = c0 + k * NT; dst[k] = nullptr; v[k] = (v4u){0u, 0u, 0u, 0u}; if (c < TOT) { size_t so; copy_map(F, c, so, dst[k]); v[k] = *(const GAS v4u*)(U + so); } }
#pragma unroll
        for (int k = 0; k < 4; ++k) if (dst[k]) { *(GAS f32x4*)dst[k] = (f32x4){bflo(v[k].x), bfhi(v[k].x), bflo(v[k].y), bfhi(v[k].y)}; *(GAS f32x4*)(dst[k] + 4) = (f32x4){bflo(v[k].z), bfhi(v[k].z), bflo(v[k].w), bfhi(v[k].w)}; }
    }
}

constexpr int AT_K = 0, AT_V = 69632;
__device__ __forceinline__ int at_off(int row, int ch) { return 256 * row + 16 * (ch ^ (((row & 3) << 2) | ((row >> 2) & 3))); }
__device__ __forceinline__ void tr_read10(unsigned a, bf16x4 (&lo)[5], bf16x4 (&hi)[5]) {
    asm volatile("ds_read_b64_tr_b16 %0, %10\n\tds_read_b64_tr_b16 %1, %10 offset:4096\n\tds_read_b64_tr_b16 %2, %10 offset:8192\n\tds_read_b64_tr_b16 %3, %10 offset:12288\n\t"
                 "ds_read_b64_tr_b16 %4, %10 offset:16384\n\tds_read_b64_tr_b16 %5, %10 offset:20480\n\tds_read_b64_tr_b16 %6, %10 offset:24576\n\tds_read_b64_tr_b16 %7, %10 offset:28672\n\t"
                 "ds_read_b64_tr_b16 %8, %10 offset:32768\n\tds_read_b64_tr_b16 %9, %10 offset:36864\n\ts_waitcnt lgkmcnt(0)"
                 : "=&v"(lo[0]), "=&v"(hi[0]), "=&v"(lo[1]), "=&v"(hi[1]), "=&v"(lo[2]), "=&v"(hi[2]), "=&v"(lo[3]), "=&v"(hi[3]), "=&v"(lo[4]), "=&v"(hi[4]) : "v"(a) : "memory"); }

__device__ __forceinline__ void attn_prompt_unit(Frame& F, int unit) {
#ifdef NO_PATTN
    return;
#endif
    LAS unsigned char* L = F.ldv;
    const int tid = F.tid, lane = F.lane, w = F.wave, m16 = lane & 15, kg = lane >> 4;
    const bf16* U = (const bf16*)(F.ws + WS_U); bf16* OG = (bf16*)(F.ws + WS_OG); float* LSE = (float*)(F.ws + WS_LSE);
    const int h = unit & 3, rb = (unit >> 2) & 31, b = (unit >> 7) & 3, g = unit >> 9;
    const int dil = g == 0 ? 1 : (g == 1 ? 4 : 16), nb = 32 / dil, r = rb / nb, blk = rb % nb, hh = g * 4 + h;
    const float slope = exp2f(-8.0f * (float)(hh + 1) / 12.0f) * (float)dil;
    { LAS unsigned char* Ls = F.lds;
#pragma unroll 1
      for (int it = 0; it < 8; ++it) { const int i = tid + 512 * it, row = i >> 4, chp = i & 15, ch = chp ^ (((row & 3) << 2) | ((row >> 2) & 3));
          if (blk > 0 || it >= 4) { const size_t gr = (size_t)(b * SEQ + (blk * 128 + row - 128) * dil + r) * NINP;
              __builtin_amdgcn_global_load_lds((const unsigned*)(U + gr + U_KA + hh * 128 + ch * 8), (LAS unsigned*)(Ls + AT_K + (it * 512 + w * 64) * 16), 16, 0, 0);
              __builtin_amdgcn_global_load_lds((const unsigned*)(U + gr + U_VA + hh * 128 + ch * 8), (LAS unsigned*)(Ls + AT_V + (it * 512 + w * 64) * 16), 16, 0, 0);
          } else { *(LAS v4u*)(L + AT_K + i * 16) = (v4u){0u, 0u, 0u, 0u}; *(LAS v4u*)(L + AT_V + i * 16) = (v4u){0u, 0u, 0u, 0u}; } }
      if (tid < 256) { *(LAS v4u*)(L + AT_K + (4096 + tid) * 16) = (v4u){0u, 0u, 0u, 0u}; *(LAS v4u*)(L + AT_V + (4096 + tid) * 16) = (v4u){0u, 0u, 0u, 0u}; } }
    const int qi = 16 * w + m16; const size_t qrow = (size_t)(b * SEQ + (blk * 128 + qi) * dil + r);
    bf16x8 qf[4];
#pragma unroll
    for (int kb = 0; kb < 4; ++kb) qf[kb] = *(const GAS bf16x8*)(U + qrow * NINP + U_QA + hh * 128 + 32 * kb + 8 * kg);
    asm volatile("s_waitcnt vmcnt(0)" ::: "memory");
    WG_BARRIER();
    f32x4 S[10];
    int kbase[4];
#pragma unroll
    for (int kb = 0; kb < 4; ++kb) kbase[kb] = AT_K + at_off(16 * w + m16, 4 * kb + kg);
#pragma unroll
    for (int kt = 0; kt < 10; ++kt) { S[kt] = (f32x4){0.f, 0.f, 0.f, 0.f};
#pragma unroll
        for (int kb = 0; kb < 4; ++kb) S[kt] = mfma16(*(const LAS bf16x8*)(L + kbase[kb] + kt * 4096), qf[kb], S[kt]); }
    const float sc = 0.08838834764831845f * 1.4426950408889634f, sl2 = slope * 1.4426950408889634f;
    float mx = -INFINITY;
#pragma unroll
    for (int kt = 0; kt < 10; ++kt)
#pragma unroll
        for (int jj = 0; jj < 4; ++jj) { const int kj = 16 * w + 16 * kt + 4 * kg + jj, delta = 128 + qi - kj;
            const bool ok = delta >= 0 && delta <= 128 && (blk > 0 || kj >= 128);
            const float v = ok ? S[kt][jj] * sc - sl2 * (float)delta : -INFINITY; S[kt][jj] = v; mx = fmaxf(mx, v); }
    mx = fmaxf(mx, __shfl_xor(mx, 16)); mx = fmaxf(mx, __shfl_xor(mx, 32));
    float sum = 0.f;
#pragma unroll
    for (int kt = 0; kt < 10; ++kt)
#pragma unroll
        for (int jj = 0; jj < 4; ++jj) { const float p = exp2f(S[kt][jj] - mx); S[kt][jj] = p; sum += p; }
    sum += __shfl_xor(sum, 16); sum += __shfl_xor(sum, 32);
    bf16x8 pb[5];
#pragma unroll
    for (int kb2 = 0; kb2 < 5; ++kb2) pb[kb2] = pack8(S[2 * kb2], S[2 * kb2 + 1]);
    f32x4 O[8];
    const int rq = m16 >> 2, cq = m16 & 3;
    unsigned vbase[8];
#pragma unroll
    for (int dt = 0; dt < 8; ++dt) vbase[dt] = (unsigned)(AT_V + at_off(16 * w + 4 * kg + rq, 2 * dt + (cq >> 1)) + 8 * (cq & 1));
#pragma unroll
    for (int dt = 0; dt < 8; ++dt) { O[dt] = (f32x4){0.f, 0.f, 0.f, 0.f}; bf16x4 lo[5], hi[5]; tr_read10(vbase[dt], lo, hi);
#pragma unroll
        for (int kb2 = 0; kb2 < 5; ++kb2) { bf16x8 vf; vf[0] = lo[kb2][0]; vf[1] = lo[kb2][1]; vf[2] = lo[kb2][2]; vf[3] = lo[kb2][3]; vf[4] = hi[kb2][0]; vf[5] = hi[kb2][1]; vf[6] = hi[kb2][2]; vf[7] = hi[kb2][3];
            O[dt] = mfma16(vf, pb[kb2], O[dt]); } }
    const float inv = 1.0f / sum;
#pragma unroll
    for (int dt = 0; dt < 8; ++dt) { v2u o; o.x = pk2(O[dt][0] * inv, O[dt][1] * inv); o.y = pk2(O[dt][2] * inv, O[dt][3] * inv);
        *(GAS v2u*)(OG + qrow * 1536 + hh * 128 + 16 * dt + 4 * kg) = o; }
    if (kg == 0) LSE[qrow * 12 + hh] = (mx + log2f(sum)) * 0.6931471805599453f;
    WG_BARRIER();
}

__device__ __forceinline__ float half_sum(float v) { v = row_sum16(v); v += __shfl_xor(v, 16); return v; }
__device__ __forceinline__ void attn_sample_unit(Frame& F, int unit) {
#ifdef NO_SATTN
    return;
#endif
    const int lane = F.lane, w = F.wave;
    const bf16* U = (const bf16*)(F.ws + WS_U); bf16* OG = (bf16*)(F.ws + WS_OG); float* LSE = (float*)(F.ws + WS_LSE);
    const int b = unit & 127, g = unit >> 7;
    const int s = w & 3, h = 2 * (w >> 2) + (lane >> 5), dl = lane & 31, hh = g * 4 + h;
    const int dil = g == 0 ? 1 : (g == 1 ? 4 : 16), wb = g == 0 ? 128 : (g == 1 ? 512 : 2048);
    const float* cache = F.in[g == 0 ? IN_C128 : (g == 1 ? IN_C512 : IN_C2048)] + (size_t)b * wb * 1024 + h * 128 + 4 * dl;
    const float L2E = 1.4426950408889634f;
    const float sl2 = exp2f(-8.0f * (float)(hh + 1) / 12.0f) * (float)dil * L2E;
    const size_t qrow = (size_t)(MP + 4 * b + s);
    f32x4 q; { const v2u qq = *(const GAS v2u*)(U + qrow * NINP + U_QA + hh * 128 + 4 * dl); const float sc = 0.08838834764831845f * L2E;
        q = (f32x4){bflo(qq.x) * sc, bfhi(qq.x) * sc, bflo(qq.y) * sc, bfhi(qq.y) * sc}; }
    float m = -INFINITY, l = 0.f; f32x4 o = {0.f, 0.f, 0.f, 0.f};
    const int jn = (g == 0) ? s : 0;
    for (int j = 0; j <= jn; ++j) { const size_t kr = (size_t)(MP + 4 * b + s - dil * j) * NINP + hh * 128 + 4 * dl;
        const v2u kk = *(const GAS v2u*)(U + kr + U_KA), vv = *(const GAS v2u*)(U + kr + U_VA);
        const float sc = half_sum(bflo(kk.x) * q[0] + bfhi(kk.x) * q[1] + bflo(kk.y) * q[2] + bfhi(kk.y) * q[3]) - sl2 * (float)j;
        const float mn = fmaxf(m, sc), al = exp2f(m - mn), p = exp2f(sc - mn); m = mn; l = l * al + p;
        o = o * al + (f32x4){bflo(vv.x), bfhi(vv.x), bflo(vv.y), bfhi(vv.y)} * p; }
    f32x4 kA[8], vA[8], kB[8], vB[8];
#define SA_LOAD(KF, VF, BLK) do { _Pragma("unroll") for (int i = 0; i < 8; ++i) { const int j = jn + 1 + 8 * (BLK) + i; int idx = wb + s - dil * j; idx = idx < 0 ? 0 : idx; \
        KF[i] = *(const GAS f32x4*)(cache + (size_t)idx * 1024); VF[i] = *(const GAS f32x4*)(cache + (size_t)idx * 1024 + 512); } } while (0)
#define SA_COMP(KF, VF, BLK) do { float sc[8]; float mb = -INFINITY; \
        _Pragma("unroll") for (int i = 0; i < 8; ++i) { const int j = jn + 1 + 8 * (BLK) + i; \
            float d = half_sum(KF[i][0] * q[0] + KF[i][1] * q[1] + KF[i][2] * q[2] + KF[i][3] * q[3]) - sl2 * (float)j; \
            d = (j <= 128) ? d : -INFINITY; sc[i] = d; mb = fmaxf(mb, d); } \
        const float mn = fmaxf(m, mb), al = exp2f(m - mn); m = mn; l *= al; o = o * al; \
        _Pragma("unroll") for (int i = 0; i < 8; ++i) { const float p = exp2f(sc[i] - mn); l += p; o = o + VF[i] * p; } } while (0)
    SA_LOAD(kA, vA, 0);
    for (int blk = 0; blk < 16; blk += 2) {
        SA_LOAD(kB, vB, blk + 1);
        SA_COMP(kA, vA, blk);
        if (blk + 2 < 16) SA_LOAD(kA, vA, blk + 2);
        SA_COMP(kB, vB, blk + 1);
    }
#undef SA_LOAD
#undef SA_COMP
    const float inv = 1.0f / l;
    v2u ov; ov.x = pk2(o[0] * inv, o[1] * inv); ov.y = pk2(o[2] * inv, o[3] * inv);
    *(GAS v2u*)(OG + qrow * 1536 + hh * 128 + 4 * dl) = ov;
    if (dl == 0) LSE[qrow * 12 + hh] = (m + log2f(l)) * 0.6931471805599453f;
}

__device__ __forceinline__ void attn_merge(Frame& F) {
    const bf16* OG = (const bf16*)(F.ws + WS_OG); const float* LSE = (const float*)(F.ws + WS_LSE); bf16* OA = (bf16*)(F.ws + WS_OA);
    const long gt = (long)F.bx * 512 + F.tid, NT = (long)F.G * 512;
    for (long c = gt; c < (long)MT * 64; c += NT) {
        const int row = (int)(c >> 6), hs = (int)(c >> 4) & 3, e8 = (int)c & 15;
        const float l0 = LSE[(size_t)row * 12 + hs], l1 = LSE[(size_t)row * 12 + 4 + hs], l2 = LSE[(size_t)row * 12 + 8 + hs];
        const float m = fmaxf(l0, fmaxf(l1, l2)); float w0 = __expf(l0 - m), w1 = __expf(l1 - m), w2 = __expf(l2 - m); const float inv = 1.0f / (w0 + w1 + w2); w0 *= inv; w1 *= inv; w2 *= inv;
        const v4u a = *(const GAS v4u*)(OG + (size_t)row * 1536 + hs * 128 + e8 * 8), bq = *(const GAS v4u*)(OG + (size_t)row * 1536 + (4 + hs) * 128 + e8 * 8), cq = *(const GAS v4u*)(OG + (size_t)row * 1536 + (8 + hs) * 128 + e8 * 8);
        v4u o;
        o.x = pk2(w0 * bflo(a.x) + w1 * bflo(bq.x) + w2 * bflo(cq.x), w0 * bfhi(a.x) + w1 * bfhi(bq.x) + w2 * bfhi(cq.x));
        o.y = pk2(w0 * bflo(a.y) + w1 * bflo(bq.y) + w2 * bflo(cq.y), w0 * bfhi(a.y) + w1 * bfhi(bq.y) + w2 * bfhi(cq.y));
        o.z = pk2(w0 * bflo(a.z) + w1 * bflo(bq.z) + w2 * bflo(cq.z), w0 * bfhi(a.z) + w1 * bfhi(bq.z) + w2 * bfhi(cq.z));
        o.w = pk2(w0 * bflo(a.w) + w1 * bflo(bq.w) + w2 * bflo(cq.w), w0 * bfhi(a.w) + w1 * bfhi(bq.w) + w2 * bfhi(cq.w));
        *(GAS v4u*)(OA + (size_t)row * 512 + hs * 128 + e8 * 8) = o;
    }
}

#ifndef MK_N_LAUNCHES
#define MK_N_LAUNCHES 1
#endif
constexpr int N_PHASES = 12;
struct Args { const float* in[23]; float* out; unsigned char* ws; int ph_lo, ph_hi, sub, qi; };
static_assert(sizeof(Args) == 23 * 8 + 8 + 8 + 16, "Args has no padding");

__device__ __forceinline__ int q_next(Frame& F, int qi) {
    if (F.tid == 0) F.MISC[16] = __hip_atomic_fetch_add((unsigned*)(F.ctl + CW_Q + 64 * qi), 1u, __ATOMIC_RELAXED, __HIP_MEMORY_SCOPE_AGENT);
    __syncthreads();
    const int v = (int)F.MISC[16];
    __syncthreads();
    return v;
}

#ifndef PH5_MASK
#define PH5_MASK 7
#endif
__device__ __forceinline__ void phase5(Frame& F, int qi, int sub) {
    if ((sub & 1) && F.bx < NB * 8) gdn_scan_chain(F, F.bx);
    if (F.bx >= 32 && F.bx < 96) for (;;) { const int u = q_next(F, 3 * qi); if (u >= 128) break; if (sub & 2) attn_sample_unit(F, 256 + u); }
    for (;;) { const int u = q_next(F, 3 * qi + 1); if (u >= 256) break; if (sub & 2) attn_sample_unit(F, (u < 128) ? 128 + u : u - 128); }
    for (;;) { const int u = q_next(F, 3 * qi + 2); if (u >= 1536) break; if (sub & 4) attn_prompt_unit(F, u); }
}
__global__ void __launch_bounds__(NWAVES * 64, 2) mk_fwd(Args args) {
    extern __shared__ __attribute__((aligned(16))) unsigned char lds[];
    Frame F;
    F.lds = (LAS unsigned char*)lds;
    { unsigned z = 0u; asm volatile("" : "+v"(z)); F.ldv = (LAS unsigned char*)lds + z; }
    F.MISC = (volatile LAS unsigned*)(F.lds + MISC_OFF);
    F.tid = threadIdx.x; F.lane = F.tid & 63; F.wave = __builtin_amdgcn_readfirstlane(F.tid >> 6);
    F.G = gridDim.x; F.bx = blockIdx.x;
    F.ws = args.ws; F.out = args.out; F.ctl = (gu32*)(args.ws + WS_CTL);
    F.in = args.in;
    for (int u = F.tid; u < (LDS_BYTES - LDSCTL_OFF) / 4; u += NWAVES * 64) ((LAS unsigned*)(F.lds + LDSCTL_OFF))[u] = 0u;
    __syncthreads();
    const bool one = (args.ph_hi - args.ph_lo) > 1;
    XcdBarrier bar; bar.bar = (unsigned*)(F.ctl + CW_BAR); bar.x = 0; bar.st = nullptr;
    if (one) bar = xcd_barrier_post((unsigned*)(F.ctl + CW_BAR), F.MISC + 8);
    const int lo = args.ph_lo, hi = args.ph_hi;
#ifndef PHASE_MASK
#define PHASE_MASK 0xFFF
#endif
#define IN(k) ((((PHASE_MASK) >> (k)) & 1) && lo <= (k) && (k) < hi)
#define SEAM(k) do { if (IN(k) && IN((k) + 1)) xcd_barrier(bar); } while (0)

    bf16* XB = (bf16*)(F.ws + WS_XB); bf16* ACT = (bf16*)(F.ws + WS_ACT); float* X1 = (float*)(F.ws + WS_X1); bf16* X1B = (bf16*)(F.ws + WS_X1B);
    bf16* UU = (bf16*)(F.ws + WS_U); float* BA = (float*)(F.ws + WS_BA); bf16* OB = (bf16*)(F.ws + WS_OB); bf16* OA = (bf16*)(F.ws + WS_OA);
    bf16* M1 = (bf16*)(F.ws + WS_M1); bf16* MG = (bf16*)(F.ws + WS_MG); float* X2 = (float*)(F.ws + WS_X2); bf16* X2B = (bf16*)(F.ws + WS_X2B);
    float* SSQ2 = (float*)(args.ws + WS_CTL) + CW_SSQ2; float* SSQ3 = (float*)(args.ws + WS_CTL) + CW_SSQ3; float* SSQ4 = (float*)(args.ws + WS_CTL) + CW_SSQ4;

#ifndef DUP_MASK
#define DUP_MASK 0
#endif
#define DUP(k) (((DUP_MASK) >> (k)) & 1)
    if (IN(0)) { p0_prologue(F); } SEAM(0);
    if (IN(1)) {
        pg8::Gemm g{XB, (const bf16*)(F.ws + WS_W1A), MT, NGU, D}; pg8::StaticOrder S; S.init(MT, NGU, F.G, F.bx);
        pg8::EpiSwiglu E{ACT, (const float*)(F.ws + WS_RSTD1), 0};
        pg8::gemm_phase<pg8::EpiSwiglu, pg8::StaticOrder, true, true>(F.lds + RING_OFF, g, S, E);
    } SEAM(1);
    if (IN(2)) {
        pg8::Gemm g{ACT, (const bf16*)(F.ws + WS_W1B), MP, D, FF}; pg8::StaticOrder S; S.init(MP, D, F.G, F.bx);
        pg8::EpiResidB<0> E{F.in[IN_XP], F.in[IN_XS] - (size_t)MP * D, nullptr, X1B, nullptr, SSQ2, 0.5f};
        pg8::gemm_phase<pg8::EpiResidB<0>, pg8::StaticOrder, true, true>(F.lds + RING_OFF, g, S, E);
        if (args.sub & 8) skinny_resid<FF, 0>(F, ACT, (const bf16*)(F.ws + WS_W1B), F.in[IN_XS] - (size_t)MP * D, nullptr, X1B, nullptr, SSQ2, 0.5f);
    } SEAM(2);
    if (IN(3)) {
        pg8::Gemm g{X1B, (const bf16*)(F.ws + WS_WIN), MT, U_BA, D}; pg8::StaticOrder S; S.init(MT, U_BA, F.G, F.bx);
        pg8::EpiU E{UU, BA, SSQ2};
        pg8::gemm_phase<pg8::EpiU, pg8::StaticOrder, true, true>(F.lds + RING_OFF, g, S, E);
        skinny_ba(F, X1B, (const bf16*)(F.ws + WS_WIN), SSQ2, BA);
    } SEAM(3);
    if (IN(4)) {
        if (args.sub & 1) { PrepIn pin; int i = F.bx;
            if (i < NREC) prep_fetch(F, (i & 31) >> 3, i & 7, i >> 5, pin);
            for (; i < NREC; i += F.G) { const int nx = i + F.G; gdn_prep_unit(F, (i & 31) >> 3, i & 7, i >> 5, pin, nx < NREC, (nx & 31) >> 3, nx & 7, nx >> 5); } }
        if (args.sub & 2) for (int j = F.bx; j < DB * 8; j += F.G) gdn_sample_unit(F, j >> 3, j & 7);
        if (args.sub & 4) copy_outputs(F);
    } SEAM(4);
    if (IN(5)) {
        phase5(F, args.qi, args.sub);
    } SEAM(5);
    if (IN(6)) { attn_merge(F); } SEAM(6);
    if (IN(7)) {
        { pg8::Gemm g{OA, (const bf16*)(F.ws + WS_WPA), MP, D, 512}; pg8::StaticOrder S; S.init(MP, D, F.G, F.bx);
          pg8::EpiGate<0> E{UU, nullptr, M1};
          pg8::gemm_phase<pg8::EpiGate<0>, pg8::StaticOrder, true, true>(F.lds + RING_OFF, g, S, E); }
        { pg8::Gemm g{OB, (const bf16*)(F.ws + WS_WPB), MP, D, D}; pg8::StaticOrder S; S.init(MP, D, F.G, F.bx);
          pg8::EpiGate<1> E{UU, M1, MG};
          pg8::gemm_phase<pg8::EpiGate<1>, pg8::StaticOrder, true, true>(F.lds + RING_OFF, g, S, E); }
        if (args.sub & 8) skinny_merge(F, OA, (const bf16*)(F.ws + WS_WPA), OB, (const bf16*)(F.ws + WS_WPB), UU, MG);
    } SEAM(7);
    if (IN(8)) {
        pg8::Gemm g{MG, (const bf16*)(F.ws + WS_WOUT), MP, D, D}; pg8::StaticOrder S; S.init(MP, D, F.G, F.bx);
        pg8::EpiResidB<1> E{nullptr, nullptr, X1B, X2B, nullptr, SSQ3, 1.0f};
        pg8::gemm_phase<pg8::EpiResidB<1>, pg8::StaticOrder, true, true>(F.lds + RING_OFF, g, S, E);
        skinny_resid<D, 1>(F, MG, (const bf16*)(F.ws + WS_WOUT), nullptr, X1B, X2B, nullptr, SSQ3, 1.0f);
    } SEAM(8);
    if (IN(9)) {
        pg8::Gemm g{X2B, (const bf16*)(F.ws + WS_W2A), MT, NGU, D}; pg8::StaticOrder S; S.init(MT, NGU, F.G, F.bx);
        pg8::EpiSwiglu E{ACT, SSQ3, 1};
        pg8::gemm_phase<pg8::EpiSwiglu, pg8::StaticOrder, true, true>(F.lds + RING_OFF, g, S, E);
    } SEAM(9);
    if (IN(10)) {
        pg8::Gemm g{ACT, (const bf16*)(F.ws + WS_W2B), MP, D, FF}; pg8::StaticOrder S; S.init(MP, D, F.G, F.bx);
        pg8::EpiResidB<2> E{nullptr, nullptr, X2B, nullptr, F.out + O_Y, SSQ4, 0.5f};
        pg8::gemm_phase<pg8::EpiResidB<2>, pg8::StaticOrder, true, true>(F.lds + RING_OFF, g, S, E);
        skinny_resid<FF, 2>(F, ACT, (const bf16*)(F.ws + WS_W2B), nullptr, X2B, nullptr, F.out + O_Y, SSQ4, 0.5f);
    } SEAM(10);
    if (IN(11)) { final_norm(F); }
#undef IN
#undef SEAM
}

extern "C" void kernel_launch(void* const* d_in, const int* in_sizes, int n_in, void* d_out, int out_size, void* d_ws, size_t ws_size, hipStream_t stream) {
    static int grid = 0;
    if (grid == 0) {
        if (n_in != 23 || out_size != (int)O_END || ws_size < WS_END) { fprintf(stderr, "kernel_launch: unexpected sizes n_in %d out %d ws %zu (need %zu)\n", n_in, out_size, ws_size, (size_t)WS_END); grid = -1; return; }
        int dev = 0, cus = 0, per_cu = 0;
        if (hipGetDevice(&dev) != hipSuccess || hipDeviceGetAttribute(&cus, hipDeviceAttributeMultiprocessorCount, dev) != hipSuccess) { grid = -1; return; }
        if (hipFuncSetAttribute((const void*)mk_fwd, hipFuncAttributeMaxDynamicSharedMemorySize, LDS_BYTES) != hipSuccess) { fprintf(stderr, "kernel_launch: hipFuncSetAttribute failed\n"); grid = -1; return; }
        if (hipOccupancyMaxActiveBlocksPerMultiprocessor(&per_cu, (const void*)mk_fwd, NWAVES * 64, LDS_BYTES) != hipSuccess || per_cu < 1) { fprintf(stderr, "kernel_launch: occupancy query says %d\n", per_cu); per_cu = 1; }
        (void)hipGetLastError();
        grid = cus;
    }
    if (grid < 0) return;
    if (hipMemsetAsync((char*)d_ws + WS_CTL, 0, CTL_ZERO_BYTES, stream) != hipSuccess) return;
    Args a{};
    for (int i = 0; i < 23; ++i) a.in[i] = (const float*)d_in[i];
    a.out = (float*)d_out; a.ws = (unsigned char*)d_ws;
#if MK_N_LAUNCHES == 1
    a.ph_lo = 0; a.ph_hi = N_PHASES; a.sub = 15; a.qi = 0;
    hipLaunchKernelGGL(mk_fwd, dim3(grid), dim3(NWAVES * 64), LDS_BYTES, stream, a);
#ifdef EXTRA_MASK
    for (int p = 0; p < N_PHASES; ++p) if ((EXTRA_MASK >> p) & 1) { a.ph_lo = p; a.ph_hi = p + 1; a.sub = EXTRA_SUB; a.qi = 1; hipLaunchKernelGGL(mk_fwd, dim3(grid), dim3(NWAVES * 64), LDS_BYTES, stream, a); }
#endif
#else
    a.sub = 15; a.qi = 0;
    for (int p = 0; p < N_PHASES; ++p) { a.ph_lo = p; a.ph_hi = p + 1; hipLaunchKernelGGL(mk_fwd, dim3(grid), dim3(NWAVES * 64), LDS_BYTES, stream, a); }
#endif
}
```

```cpp
#include <hip/hip_runtime.h>
#include <cstdio>
#include <cstdint>
#define MK_N_LAUNCHES 1
namespace pg8 {
#define PG8_LAS __attribute__((address_space(3)))
typedef unsigned short bf16_t;
typedef short bf16x8 __attribute__((ext_vector_type(8)));
typedef float f32x4 __attribute__((ext_vector_type(4)));
typedef unsigned u32x4 __attribute__((ext_vector_type(4)));
constexpr int BM = 256, BK = 64, HALF = 128, HTB = HALF * BK * 2  , STAGE_BYTES = 8 * HTB, NXCD = 8, WGM = 8;

__host__ __device__ __forceinline__ int lds_byte(int r, int c) { const int st = (r >> 4) * 2 + (c >> 5), rr = r & 15, cc = c & 31, ob = rr * 64 + cc * 2; return st * 1024 + (ob ^ (((ob >> 9) & 1) << 5)); }
__host__ __device__ __forceinline__ void stage_rc(int b, int& R, int& C) { const int st = b / 1024, sb = b % 1024, swz = sb ^ (((sb >> 9) & 1) << 5); R = (st >> 1) * 16 + swz / 64; C = (st & 1) * 32 + (swz % 64) / 2; }
__host__ __device__ __forceinline__ int perm32(int rho) { const int n = rho >> 4, i = rho & 15; return 8 * (i >> 2) + 4 * n + (i & 3); }

struct Unit { int pm, pn; };
struct Gemm { const bf16_t* A; const bf16_t* Bt; int M, N, K; };
struct StaticOrder {
    int nM, nN, nwg, G, c;
    __host__ __device__ void init(int M, int N, int G_, int c_) { nM = M / BM; nN = N / BM; nwg = nM * nN; G = G_; c = c_; }
    __host__ __device__ bool next(int i, Unit& u) const {
        const long L = (long)i * G + c; if (L >= nwg) return false;
        int wgid = (int)L; { const int q = nwg / NXCD, r = nwg % NXCD, xcd = wgid % NXCD, off = wgid / NXCD; wgid = (xcd < r ? xcd * (q + 1) : r * (q + 1) + (xcd - r) * q) + off; }
        const int nig = WGM * nN, gid = wgid / nig, fm = gid * WGM, gsz = (nM - fm) < WGM ? (nM - fm) : WGM;
        u.pm = fm + ((wgid % nig) % gsz); u.pn = (wgid % nig) / gsz; return true;
    }
    __device__ __forceinline__ void a_ready(const Unit&) const {}
    __device__ __forceinline__ void done(const Unit&) const {}
};
__device__ __forceinline__ unsigned cvt_pk_bf16(float lo, float hi) { unsigned r; asm volatile("v_cvt_pk_bf16_f32 %0, %1, %2" : "=v"(r) : "v"(lo), "v"(hi)); return r; }
typedef float f32x2 __attribute__((ext_vector_type(2)));
template <class Epi, class Sched, bool ALIGN_EPI = false, bool SP2 = false>
__device__ __forceinline__ void gemm_phase(PG8_LAS unsigned char* lds, const Gemm g, const Sched& S, const Epi& E) {
    const int tid = threadIdx.x, wid = __builtin_amdgcn_readfirstlane(tid >> 6), lane = tid & 63, wr = wid >> 2, wc = wid & 3, fr = lane & 15, fq = lane >> 4;
    const int K = g.K, nt = K / BK;
    unsigned voffA[2], voffB[2];
#pragma unroll
    for (int i = 0; i < 2; ++i) { int R, C; stage_rc(tid * 16 + i * 8192, R, C); const int Rb = Epi::PERM ? ((R & ~31) + perm32(R & 31)) : R;
        voffA[i] = (unsigned)(R * K + C) * 2u; voffB[i] = (unsigned)(Rb * K + C) * 2u; }
    const size_t kstep = (size_t)(BK * 2);
    const size_t hstep = (size_t)HALF * K * 2;
    const size_t tstep = 2 * hstep;
    const unsigned ldsw = (unsigned)wid * 1024u;
    const int aoff = lds_byte(wr * 64 + fr, fq * 8), boff = lds_byte(wc * 32 + fr, fq * 8);
#define PG8_SA(b, h) (((b) * 2 + (h)) * HTB)
#define PG8_SB(b, h) ((4 + (b) * 2 + (h)) * HTB)
#define PG8_STAGE(bufoff, gbase, voff) do { _Pragma("unroll") for (int _i = 0; _i < 2; ++_i) \
        __builtin_amdgcn_global_load_lds((const unsigned*)((const char*)(gbase) + (voff)[_i]), (PG8_LAS unsigned*)(lds + (bufoff) + ldsw + _i * 8192), 16, 0, 0); } while (0)
#define PG8_LDA(dst, b, h) do { _Pragma("unroll") for (int m = 0; m < 4; ++m) _Pragma("unroll") for (int k = 0; k < 2; ++k) dst[m][k] = *(const PG8_LAS bf16x8*)(lds + PG8_SA(b, h) + aoff + m * 2048 + k * 1024); } while (0)
#define PG8_LDB(dst, b, h) do { _Pragma("unroll") for (int n = 0; n < 2; ++n) _Pragma("unroll") for (int k = 0; k < 2; ++k) dst[n][k] = *(const PG8_LAS bf16x8*)(lds + PG8_SB(b, h) + boff + n * 2048 + k * 1024); } while (0)
#define PG8_MMA(ai, bj, At, Bt) do { __builtin_amdgcn_s_setprio(1); _Pragma("unroll") for (int m = 0; m < 4; ++m) _Pragma("unroll") for (int n = 0; n < 2; ++n) _Pragma("unroll") for (int k = 0; k < 2; ++k) \
        acc[ai][bj][m][n] = __builtin_amdgcn_mfma_f32_16x16x32_bf16(Bt[n][k], At[m][k], acc[ai][bj][m][n], 0, 0, 0); __builtin_amdgcn_s_setprio(0); } while (0)
#define PG8_WAIT_V(n) asm volatile("s_waitcnt vmcnt(" #n ")" ::: "memory")
#define PG8_WAIT_L(n) asm volatile("s_waitcnt lgkmcnt(" #n ")" ::: "memory")
#define PG8_BAR __builtin_amdgcn_s_barrier()
#define PG8_SCHED __builtin_amdgcn_sched_barrier(0)
    Unit cur, nxt; int ui = 0;
    if (!S.next(0, cur)) return;
    f32x4 acc[2][2][4][2];
#pragma unroll
    for (int a = 0; a < 2; ++a)
#pragma unroll
        for (int b = 0; b < 2; ++b)
#pragma unroll
            for (int m = 0; m < 4; ++m)
#pragma unroll
                for (int n = 0; n < 2; ++n) acc[a][b][m][n] = (f32x4){0.f, 0.f, 0.f, 0.f};
    bf16x8 At[4][2], B0[2][2], B1[2][2];
    const char* cA = (const char*)g.A + (size_t)cur.pm * tstep; const char* cB = (const char*)g.Bt + (size_t)cur.pn * tstep;
    S.a_ready(cur);
    if constexpr (SP2) {
        PG8_STAGE(PG8_SB(0, 0), cB, voffB); PG8_STAGE(PG8_SB(0, 1), cB + hstep, voffB); PG8_STAGE(PG8_SA(0, 0), cA, voffA); PG8_STAGE(PG8_SA(0, 1), cA + hstep, voffA);
        if (wr == 1) PG8_BAR;
        PG8_WAIT_V(2); PG8_BAR;
        PG8_STAGE(PG8_SB(1, 0), cB + kstep, voffB); PG8_STAGE(PG8_SA(1, 0), cA + kstep, voffA); PG8_STAGE(PG8_SB(1, 1), cB + hstep + kstep, voffB);
        PG8_WAIT_V(6); PG8_BAR;
    } else {
        PG8_STAGE(PG8_SB(0, 0), cB, voffB); PG8_STAGE(PG8_SA(0, 0), cA, voffA); PG8_STAGE(PG8_SB(0, 1), cB + hstep, voffB); PG8_STAGE(PG8_SA(0, 1), cA + hstep, voffA);
        if (wr == 1) PG8_BAR;
        PG8_WAIT_V(4); PG8_BAR;
        PG8_STAGE(PG8_SB(1, 0), cB + kstep, voffB); PG8_STAGE(PG8_SA(1, 0), cA + kstep, voffA); PG8_STAGE(PG8_SB(1, 1), cB + hstep + kstep, voffB);
        PG8_WAIT_V(6); PG8_BAR;
    }
    for (;;) {
        const bool has_next = S.next(ui + 1, nxt);
        const char* nA = has_next ? (const char*)g.A + (size_t)nxt.pm * tstep : cA; const char* nB = has_next ? (const char*)g.Bt + (size_t)nxt.pn * tstep : cB;
        for (int t = 0; t < nt; t += 2) {
            const bool last = (t == nt - 2);
            const char* a1 = cA + (size_t)(t + 1) * kstep;
            const char* a2 = last ? nA : cA + (size_t)(t + 2) * kstep; const char* b2 = last ? nB : cB + (size_t)(t + 2) * kstep;
            const char* a3 = a2 + kstep; const char* b3 = b2 + kstep;
            if (last && has_next) S.a_ready(nxt);
            if constexpr (SP2) {
            PG8_LDB(B0, 0, 0); PG8_LDB(B1, 0, 1); PG8_SCHED; PG8_LDA(At, 0, 0); PG8_STAGE(PG8_SA(1, 1), a1 + hstep, voffA);
            PG8_WAIT_V(8); PG8_WAIT_L(0); PG8_BAR; PG8_MMA(0, 0, At, B0); PG8_MMA(0, 1, At, B1); PG8_BAR; PG8_SCHED;
            PG8_LDA(At, 0, 1); PG8_STAGE(PG8_SB(0, 0), b2, voffB); PG8_STAGE(PG8_SB(0, 1), b2 + hstep, voffB); PG8_STAGE(PG8_SA(0, 0), a2, voffA);
            PG8_WAIT_V(8); PG8_WAIT_L(0); PG8_BAR; PG8_MMA(1, 0, At, B0); PG8_MMA(1, 1, At, B1); PG8_BAR; PG8_SCHED;
            PG8_LDB(B0, 1, 0); PG8_LDB(B1, 1, 1); PG8_SCHED; PG8_LDA(At, 1, 0); PG8_STAGE(PG8_SA(0, 1), a2 + hstep, voffA);
            PG8_WAIT_V(8); PG8_WAIT_L(0); PG8_BAR; PG8_MMA(0, 0, At, B0); PG8_MMA(0, 1, At, B1); PG8_BAR; PG8_SCHED;
            PG8_LDA(At, 1, 1); PG8_STAGE(PG8_SB(1, 0), b3, voffB); PG8_STAGE(PG8_SB(1, 1), b3 + hstep, voffB); PG8_STAGE(PG8_SA(1, 0), a3, voffA);
            PG8_WAIT_V(8); PG8_WAIT_L(0); PG8_BAR; PG8_MMA(1, 0, At, B0); PG8_MMA(1, 1, At, B1); PG8_BAR; PG8_SCHED;
            } else {
            PG8_LDB(B0, 0, 0); PG8_SCHED; PG8_LDA(At, 0, 0); PG8_STAGE(PG8_SA(1, 1), a1 + hstep, voffA);
            PG8_WAIT_L(8); PG8_BAR; PG8_WAIT_L(0); PG8_MMA(0, 0, At, B0); PG8_BAR; PG8_SCHED;
            PG8_LDB(B1, 0, 1); PG8_STAGE(PG8_SB(0, 0), b2, voffB);
            PG8_BAR; PG8_WAIT_L(0); PG8_MMA(0, 1, At, B1); PG8_BAR;
            PG8_LDA(At, 0, 1); PG8_STAGE(PG8_SA(0, 0), a2, voffA);
            PG8_BAR; PG8_WAIT_L(0); PG8_MMA(1, 0, At, B0); PG8_BAR; PG8_SCHED;
            PG8_STAGE(PG8_SB(0, 1), b2 + hstep, voffB);
            PG8_WAIT_V(6); PG8_BAR; PG8_MMA(1, 1, At, B1); PG8_BAR;
            PG8_LDB(B0, 1, 0); PG8_SCHED; PG8_LDA(At, 1, 0); PG8_STAGE(PG8_SA(0, 1), a2 + hstep, voffA);
            PG8_WAIT_L(8); PG8_BAR; PG8_WAIT_L(0); PG8_MMA(0, 0, At, B0); PG8_BAR; PG8_SCHED;
            PG8_LDB(B1, 1, 1); PG8_STAGE(PG8_SB(1, 0), b3, voffB);
            PG8_BAR; PG8_WAIT_L(0); PG8_MMA(0, 1, At, B1); PG8_BAR;
            PG8_LDA(At, 1, 1); PG8_STAGE(PG8_SA(1, 0), a3, voffA);
            PG8_BAR; PG8_WAIT_L(0); PG8_MMA(1, 0, At, B0); PG8_BAR; PG8_SCHED;
            PG8_STAGE(PG8_SB(1, 1), b3 + hstep, voffB);
            PG8_WAIT_V(6); PG8_BAR; PG8_MMA(1, 1, At, B1); PG8_BAR;
            }
        }
        if constexpr (ALIGN_EPI) { if (wr == 0) PG8_BAR; }
        if constexpr (!Epi::AFTER_DRAIN) { E(acc, cur, wr, wc, fr, fq); S.done(cur); }
        if (!has_next) break;
#pragma unroll
        for (int a = 0; a < 2; ++a)
#pragma unroll
            for (int b = 0; b < 2; ++b)
#pragma unroll
                for (int m = 0; m < 4; ++m)
#pragma unroll
                    for (int n = 0; n < 2; ++n) acc[a][b][m][n] = (f32x4){0.f, 0.f, 0.f, 0.f};
        cur = nxt; cA = nA; cB = nB; ++ui;
        if constexpr (ALIGN_EPI) { if (wr == 1) PG8_BAR; }
    }
    PG8_WAIT_V(0);
    if constexpr (!ALIGN_EPI) { if (wr == 0) PG8_BAR; }
    PG8_BAR;
    if constexpr (Epi::AFTER_DRAIN) { E.fused(acc, cur, wr, wc, fr, fq, lds, wid, lane); S.done(cur); }
#undef PG8_SA
#undef PG8_SB
#undef PG8_STAGE
#undef PG8_LDA
#undef PG8_LDB
#undef PG8_MMA
#undef PG8_WAIT_V
#undef PG8_WAIT_L
#undef PG8_BAR
#undef PG8_SCHED
}
}

constexpr int D = 1024, MP = 16384, MS = 512, MT = MP + MS, FF = 2816, NGU = 2 * FF;
constexpr int SEQ = 4096, NB = 4, DB = 128, DS = 4;
constexpr int NIN = 10768, NINP = 11008;
constexpr int U_QA = 0, U_KA = 1536, U_VA = 3072, U_QKVB = 4608, U_Z = 7680, U_GATE = 8704, U_BA = 10752;
constexpr float EPS = 1e-6f;

namespace pg8 {
typedef unsigned u32x2 __attribute__((ext_vector_type(2)));
__device__ __forceinline__ float sigm(float x) { return __builtin_amdgcn_rcpf(1.f + __expf(-x)); }
__device__ __forceinline__ float bf2f(unsigned short b) { return __uint_as_float(((unsigned)b) << 16); }
__device__ __forceinline__ float bflo(unsigned w) { return __uint_as_float(w << 16); }
__device__ __forceinline__ float bfhi(unsigned w) { return __uint_as_float(w & 0xffff0000u); }

struct EpiSwiglu {
    static constexpr bool PERM = true, AFTER_DRAIN = false;
    bf16_t* O; const float* rs; int mode;
    __device__ __forceinline__ void operator()(const f32x4 (&acc)[2][2][4][2], const Unit& u, int wr, int wc, int fr, int fq) const {
        const int row0 = u.pm * BM + wr * 64 + fr, col0 = u.pn * 128 + wc * 32 + 8 * fq;
#pragma unroll
        for (int ai = 0; ai < 2; ++ai)
#pragma unroll
            for (int m = 0; m < 4; ++m) {
                const int row = row0 + ai * HALF + m * 16;
                float r = rs[row]; if (mode) r = rsqrtf(r * (1.0f / D) + EPS);
                float o[8];
#pragma unroll
                for (int n = 0; n < 2; ++n)
#pragma unroll
                    for (int j = 0; j < 4; ++j) { const float g = acc[ai][0][m][n][j] * r, up = acc[ai][1][m][n][j] * r; o[4 * n + j] = g * sigm(g) * up; }
                u32x4 w; w.x = cvt_pk_bf16(o[0], o[1]); w.y = cvt_pk_bf16(o[2], o[3]); w.z = cvt_pk_bf16(o[4], o[5]); w.w = cvt_pk_bf16(o[6], o[7]);
                *(u32x4*)(O + (size_t)row * FF + col0) = w;
            }
    }
};
struct EpiResid {
    static constexpr bool PERM = false, AFTER_DRAIN = false;
    const float* base; const float* base2; float* out; bf16_t* xb; float* ssq; float scale;
    __device__ __forceinline__ void operator()(const f32x4 (&acc)[2][2][4][2], const Unit& u, int wr, int wc, int fr, int fq) const {
        const int row0 = u.pm * BM + wr * 64 + fr, col0 = u.pn * BM + wc * 32 + 4 * fq;
        const float* base = (u.pm * BM < MP) ? this->base : base2;
#pragma unroll
        for (int ai = 0; ai < 2; ++ai)
#pragma unroll
            for (int m = 0; m < 4; ++m) {
                const int row = row0 + ai * HALF + m * 16; const size_t off = (size_t)row * D + col0; float s = 0.f;
#pragma unroll
                for (int bj = 0; bj < 2; ++bj)
#pragma unroll
                    for (int n = 0; n < 2; ++n) {
                        const f32x4 b = *(const f32x4*)(base + off + bj * HALF + n * 16); const f32x4 v = b + acc[ai][bj][m][n] * scale;
                        *(f32x4*)(out + off + bj * HALF + n * 16) = v;
                        if (xb) { u32x2 w; w.x = cvt_pk_bf16(v[0], v[1]); w.y = cvt_pk_bf16(v[2], v[3]); *(u32x2*)(xb + off + bj * HALF + n * 16) = w; }
                        s += (v[0] * v[0] + v[1] * v[1]) + (v[2] * v[2] + v[3] * v[3]);
                    }
                s += __shfl_xor(s, 16); s += __shfl_xor(s, 32);
                if (fq == 0) atomicAdd(ssq + row, s);
            }
    }
};
template <int MODE> struct EpiResidB {
    static constexpr bool PERM = true, AFTER_DRAIN = false;
    const float* basef; const float* basef2; const bf16_t* baseb; bf16_t* outb; float* outf; float* ssq; float scale;
    __device__ __forceinline__ void operator()(const f32x4 (&acc)[2][2][4][2], const Unit& u, int wr, int wc, int fr, int fq) const {
        const int row0 = u.pm * BM + wr * 64 + fr, col0 = u.pn * BM + wc * 32 + 8 * fq;
        const float* bf = (u.pm * BM < MP) ? basef : basef2;
#pragma unroll
        for (int ai = 0; ai < 2; ++ai)
#pragma unroll
            for (int m = 0; m < 4; ++m) {
                const int row = row0 + ai * HALF + m * 16; float s = 0.f;
#pragma unroll
                for (int bj = 0; bj < 2; ++bj) {
                    const size_t off = (size_t)row * D + col0 + bj * HALF; f32x4 b0, b1;
                    if (MODE == 0) { b0 = *(const f32x4*)(bf + off); b1 = *(const f32x4*)(bf + off + 4); }
                    else { const u32x4 p = *(const u32x4*)(baseb + off); b0 = (f32x4){bflo(p.x), bfhi(p.x), bflo(p.y), bfhi(p.y)}; b1 = (f32x4){bflo(p.z), bfhi(p.z), bflo(p.w), bfhi(p.w)}; }
                    const f32x4 v0 = b0 + acc[ai][bj][m][0] * scale, v1 = b1 + acc[ai][bj][m][1] * scale;
                    if (MODE == 2) { *(f32x4*)(outf + off) = v0; *(f32x4*)(outf + off + 4) = v1; }
                    else { u32x4 w; w.x = cvt_pk_bf16(v0[0], v0[1]); w.y = cvt_pk_bf16(v0[2], v0[3]); w.z = cvt_pk_bf16(v1[0], v1[1]); w.w = cvt_pk_bf16(v1[2], v1[3]); *(u32x4*)(outb + off) = w; }
                    s += ((v0[0] * v0[0] + v0[1] * v0[1]) + (v0[2] * v0[2] + v0[3] * v0[3])) + ((v1[0] * v1[0] + v1[1] * v1[1]) + (v1[2] * v1[2] + v1[3] * v1[3]));
                }
                s += __shfl_xor(s, 16); s += __shfl_xor(s, 32);
                if (fq == 0) atomicAdd(ssq + row, s);
            }
    }
};
struct EpiU {
    static constexpr bool PERM = true, AFTER_DRAIN = false;
    bf16_t* U; float* BA; const float* ssq;
    __device__ __forceinline__ void operator()(const f32x4 (&acc)[2][2][4][2], const Unit& u, int wr, int wc, int fr, int fq) const {
        const int row0 = u.pm * BM + wr * 64 + fr, col0 = u.pn * BM + wc * 32 + 8 * fq;
        const bool ba = (u.pn * BM == U_BA);
#pragma unroll
        for (int ai = 0; ai < 2; ++ai)
#pragma unroll
            for (int m = 0; m < 4; ++m) {
                const int row = row0 + ai * HALF + m * 16; const float r = rsqrtf(ssq[row] * (1.0f / D) + EPS);
                if (!ba) {
#pragma unroll
                    for (int bj = 0; bj < 2; ++bj) { const f32x4 v0 = acc[ai][bj][m][0] * r, v1 = acc[ai][bj][m][1] * r;
                        u32x4 w; w.x = cvt_pk_bf16(v0[0], v0[1]); w.y = cvt_pk_bf16(v0[2], v0[3]); w.z = cvt_pk_bf16(v1[0], v1[1]); w.w = cvt_pk_bf16(v1[2], v1[3]);
                        *(u32x4*)(U + (size_t)row * NINP + col0 + bj * HALF) = w; }
                } else if (wc == 0 && fq < 2) {
                    *(f32x4*)(BA + (size_t)row * 16 + 8 * fq) = acc[ai][0][m][0] * r; *(f32x4*)(BA + (size_t)row * 16 + 8 * fq + 4) = acc[ai][0][m][1] * r;
                }
            }
    }
};
template <int SECOND> struct EpiGate {
    static constexpr bool PERM = true, AFTER_DRAIN = false;
    const bf16_t* U; const bf16_t* M1; bf16_t* O;
    __device__ __forceinline__ void operator()(const f32x4 (&acc)[2][2][4][2], const Unit& u, int wr, int wc, int fr, int fq) const {
        const int row0 = u.pm * BM + wr * 64 + fr, col0 = u.pn * BM + wc * 32 + 8 * fq;
#pragma unroll
        for (int ai = 0; ai < 2; ++ai)
#pragma unroll
            for (int m = 0; m < 4; ++m) {
                const int row = row0 + ai * HALF + m * 16;
#pragma unroll
                for (int bj = 0; bj < 2; ++bj) {
                    const int col = col0 + bj * HALF;
                    const u32x4 g = *(const u32x4*)(U + (size_t)row * NINP + U_GATE + SECOND * D + col);
                    float o[8]; const f32x4 a0 = acc[ai][bj][m][0], a1 = acc[ai][bj][m][1];
                    o[0] = sigm(bflo(g.x)) * a0[0]; o[1] = sigm(bfhi(g.x)) * a0[1]; o[2] = sigm(bflo(g.y)) * a0[2]; o[3] = sigm(bfhi(g.y)) * a0[3];
                    o[4] = sigm(bflo(g.z)) * a1[0]; o[5] = sigm(bfhi(g.z)) * a1[1]; o[6] = sigm(bflo(g.w)) * a1[2]; o[7] = sigm(bfhi(g.w)) * a1[3];
                    if (SECOND) { const u32x4 p = *(const u32x4*)(M1 + (size_t)row * D + col);
                        o[0] += bflo(p.x); o[1] += bfhi(p.x); o[2] += bflo(p.y); o[3] += bfhi(p.y); o[4] += bflo(p.z); o[5] += bfhi(p.z); o[6] += bflo(p.w); o[7] += bfhi(p.w); }
                    u32x4 w; w.x = cvt_pk_bf16(o[0], o[1]); w.y = cvt_pk_bf16(o[2], o[3]); w.z = cvt_pk_bf16(o[4], o[5]); w.w = cvt_pk_bf16(o[6], o[7]);
                    *(u32x4*)(O + (size_t)row * D + col) = w;
                }
            }
    }
};
}

#define GAS __attribute__((address_space(1)))
#define LAS __attribute__((address_space(3)))
typedef unsigned short bf16;
typedef unsigned v4u __attribute__((ext_vector_type(4)));
typedef unsigned v2u __attribute__((ext_vector_type(2)));
typedef float f32x4 __attribute__((ext_vector_type(4)));
typedef float f32x2 __attribute__((ext_vector_type(2)));
typedef short bf16x8 __attribute__((ext_vector_type(8)));
typedef short bf16x4 __attribute__((ext_vector_type(4)));
typedef GAS unsigned gu32;
#define RLX_AGENT __ATOMIC_RELAXED, __HIP_MEMORY_SCOPE_AGENT
#define LDS_WAIT() asm volatile("s_waitcnt lgkmcnt(0)" ::: "memory")
#define VM_WAIT() asm volatile("s_waitcnt vmcnt(0)" ::: "memory")
__device__ __forceinline__ unsigned f2bf(float f) { unsigned u = __builtin_bit_cast(unsigned, f); return (u + 0x7fffu + ((u >> 16) & 1u)) >> 16; }
typedef __bf16 bf16x2_t __attribute__((ext_vector_type(2)));
__device__ __forceinline__ unsigned pk2(float lo, float hi) { const bf16x2_t v = __builtin_convertvector((f32x2){lo, hi}, bf16x2_t); return __builtin_bit_cast(unsigned, v); }
__device__ __forceinline__ float bf2f(unsigned short b) { return __uint_as_float(((unsigned)b) << 16); }
__device__ __forceinline__ float bflo(unsigned w) { return __uint_as_float(w << 16); }
__device__ __forceinline__ float bfhi(unsigned w) { return __uint_as_float(w & 0xffff0000u); }
__device__ __forceinline__ float sigm(float x) { return __builtin_amdgcn_rcpf(1.f + __expf(-x)); }
__device__ __forceinline__ float siluf(float x) { return x * __builtin_amdgcn_rcpf(1.f + __expf(-x)); }
__device__ __forceinline__ float wave_sum(float v) {
#pragma unroll
    for (int o = 1; o < 64; o <<= 1) v += __shfl_xor(v, o);
    return v;
}
__device__ __forceinline__ float wave_max(float v) {
#pragma unroll
    for (int o = 1; o < 64; o <<= 1) v = fmaxf(v, __shfl_xor(v, o));
    return v;
}
template <int CTRL> __device__ __forceinline__ float dpp_f(float v) { return __builtin_bit_cast(float, __builtin_amdgcn_update_dpp(0, __builtin_bit_cast(int, v), CTRL, 0xf, 0xf, true)); }
__device__ __forceinline__ float row_sum16(float v) { v += dpp_f<0xB1>(v); v += dpp_f<0x4E>(v); v += dpp_f<0x141>(v); v += dpp_f<0x140>(v); return v; }
__device__ __forceinline__ f32x4 mfma16(bf16x8 a, bf16x8 b, f32x4 c) { return __builtin_amdgcn_mfma_f32_16x16x32_bf16(a, b, c, 0, 0, 0); }
__device__ __forceinline__ bf16x8 pack8(f32x4 a, f32x4 b) {
    v4u w; w.x = pk2(a[0], a[1]); w.y = pk2(a[2], a[3]); w.z = pk2(b[0], b[1]); w.w = pk2(b[2], b[3]); return __builtin_bit_cast(bf16x8, w);
}
#define WG_BARRIER() do { asm volatile("s_waitcnt lgkmcnt(0)" ::: "memory"); __builtin_amdgcn_s_barrier(); asm volatile("" ::: "memory"); } while (0)
#define XB_TMO      128
#define XB_XCNT(j)  (256  + 64 * (j))
#define XB_XSUB(j)  (1280 + 64 * (j))
#define XB_XGEN(j)  (2304 + 64 * (j))
#define XB_TOP      3328
#define XB_TOPGEN   3392
#define XCD_BAR_WORDS 3456
#define XB_SPIN_CAP (1u << 18)

__device__ __forceinline__ unsigned xb_ld(unsigned* p)              { return __hip_atomic_load(p, __ATOMIC_RELAXED, __HIP_MEMORY_SCOPE_AGENT); }
__device__ __forceinline__ unsigned xb_add(unsigned* p, unsigned v) { return __hip_atomic_fetch_add(p, v, __ATOMIC_RELAXED, __HIP_MEMORY_SCOPE_AGENT); }
__device__ __forceinline__ unsigned xb_xcc_id() { return (unsigned)__builtin_amdgcn_s_getreg((3 << 11) | 20) & 0xFu; }
#define XB_SPIN(cond, bar) do { unsigned _sp = 0; while (cond) { __builtin_amdgcn_s_sleep(1); \
    if ((++_sp & 255u) == 0u) { if (xb_ld(&(bar)[XB_TMO])) break; if (_sp > XB_SPIN_CAP) { atomicAdd(&(bar)[XB_TMO], 1u); break; } } } } while (0)

struct XcdBarrier {
    unsigned* bar; unsigned x;
    volatile LAS unsigned* st;
};

__device__ __forceinline__ XcdBarrier xcd_barrier_post(unsigned* bar, volatile LAS unsigned* st) {
    XcdBarrier b; b.bar = bar; b.x = xb_xcc_id(); b.st = st;
    if (threadIdx.x == 0) (void)xb_add(&bar[XB_XCNT(b.x)], 1u);
    return b;
}
__device__ __forceinline__ void xcd_barrier_complete(unsigned* bar, unsigned x, unsigned& nloc, unsigned& nx) {
    const unsigned G = gridDim.x * gridDim.y * gridDim.z;
    unsigned sum, cnt, mine, sp = 0u;
    for (;;) {
        sum = 0u; cnt = 0u; mine = 0u;
#pragma unroll
        for (unsigned j = 0; j < 16; ++j) { const unsigned c = xb_ld(&bar[XB_XCNT(j)]); sum += c; cnt += (c > 0u) ? 1u : 0u; mine = (j == x) ? c : mine; }
        if (sum == G) break;
        __builtin_amdgcn_s_sleep(1);
        if ((++sp & 255u) == 0u) { if (xb_ld(&bar[XB_TMO])) break; if (sp > XB_SPIN_CAP) { atomicAdd(&bar[XB_TMO], 1u); break; } }
    }
    nloc = mine > 0u ? mine : 1u; nx = cnt > 0u ? cnt : 1u;
}

__device__ __forceinline__ void xcd_barrier(const XcdBarrier& b) {
    asm volatile("s_waitcnt vmcnt(0)" ::: "memory");
    __syncthreads();
    if (threadIdx.x == 0) {
        unsigned* bar = b.bar;
        __builtin_amdgcn_s_waitcnt(0);
        unsigned nloc = b.st[0], nx = b.st[1];
        if (nloc == 0u) { xcd_barrier_complete(bar, b.x, nloc, nx); b.st[0] = nloc; b.st[1] = nx; }
        const unsigned old = xb_add(&bar[XB_XSUB(b.x)], 1u);
        const unsigned gen = old / nloc;
        if (old + 1u == (gen + 1u) * nloc) {
            __builtin_amdgcn_fence(__ATOMIC_RELEASE, "agent");
            asm volatile("s_waitcnt vmcnt(0)" ::: "memory");
            const unsigned og = xb_add(&bar[XB_TOP], 1u);
            const unsigned tg = og / nx;
            if (og + 1u == (tg + 1u) * nx) xb_add(&bar[XB_TOPGEN], 1u);
            else XB_SPIN(xb_ld(&bar[XB_TOPGEN]) == tg, bar);
            __builtin_amdgcn_fence(__ATOMIC_ACQUIRE, "agent");
            xb_add(&bar[XB_XGEN(b.x)], 1u);
            asm volatile("s_waitcnt vmcnt(0)" ::: "memory");
        } else {
            XB_SPIN(xb_ld(&bar[XB_XGEN(b.x)]) == gen, bar);
            __builtin_amdgcn_fence(__ATOMIC_ACQUIRE, "agent");
            asm volatile("s_waitcnt vmcnt(0)" ::: "memory");
        }
    }
    __syncthreads();
}


constexpr size_t MiB = 1u << 20;
constexpr size_t al256(size_t x) { return (x + 255) & ~(size_t)255; }
constexpr size_t WS_CTL = 0, CTL_ZERO_BYTES = 1 * MiB;
constexpr size_t WS_W1A = 1 * MiB;
constexpr size_t WS_W1B = WS_W1A + (size_t)NGU * D * 2;
constexpr size_t WS_WIN = WS_W1B + (size_t)D * FF * 2;
constexpr size_t WS_WPA = WS_WIN + (size_t)NINP * D * 2;
constexpr size_t WS_WPB = WS_WPA + (size_t)D * 512 * 2;
constexpr size_t WS_WOUT = WS_WPB + (size_t)D * D * 2;
constexpr size_t WS_W2A = WS_WOUT + (size_t)D * D * 2;
constexpr size_t WS_W2B = WS_W2A + (size_t)NGU * D * 2;
constexpr size_t WS_XB = al256(WS_W2B + (size_t)D * FF * 2);
constexpr size_t WS_RSTD1 = WS_XB + (size_t)MT * D * 2;
constexpr size_t WS_ACT = al256(WS_RSTD1 + (size_t)MT * 4);
constexpr size_t WS_X1 = WS_ACT + (size_t)MT * FF * 2;
constexpr size_t WS_X1B = WS_X1 + (size_t)MT * D * 4;
constexpr size_t WS_U = WS_X1B + (size_t)MT * D * 2;
constexpr size_t WS_BA = WS_U + (size_t)MT * NINP * 2;
constexpr size_t REC_BYTES = 90112;
constexpr int NREC = NB * 8 * 64;
constexpr size_t WS_REC = WS_BA + (size_t)MT * 16 * 4;
constexpr size_t WS_GE = WS_REC + (size_t)NREC * REC_BYTES;
constexpr size_t WS_OB = al256(WS_GE + (size_t)NREC * 4);
constexpr size_t WS_OG = WS_OB + (size_t)MT * D * 2;
constexpr size_t WS_LSE = WS_OG + (size_t)MT * 1536 * 2;
constexpr size_t WS_OA = al256(WS_LSE + (size_t)MT * 12 * 4);
constexpr size_t WS_M1 = WS_OA + (size_t)MT * 512 * 2;
constexpr size_t WS_MG = WS_M1 + (size_t)MT * D * 2;
constexpr size_t WS_X2 = WS_MG + (size_t)MT * D * 2;
constexpr size_t WS_X2B = WS_X2 + (size_t)MT * D * 4;
constexpr size_t WS_END = WS_X2B + (size_t)MT * D * 2;
constexpr int CW_TMO = 0;
constexpr int CW_BAR = 4096;
constexpr int CW_Q = 8192;
constexpr int CW_SSQ2 = 16384, CW_SSQ3 = CW_SSQ2 + 17408, CW_SSQ4 = CW_SSQ3 + 17408;
static_assert((CW_SSQ4 + 17408) * 4 <= (int)CTL_ZERO_BYTES, "CTL words inside the memset region");

constexpr size_t O_Y = 0;
constexpr size_t O_KVP0 = (size_t)MT * D;
constexpr size_t O_KVP1 = O_KVP0 + 524288;
constexpr size_t O_KVP2 = O_KVP1 + 2097152;
constexpr size_t O_CONVP = O_KVP2 + 8388608;
constexpr size_t O_SSMP = O_CONVP + 36864;
constexpr size_t O_KVS0 = O_SSMP + 524288;
constexpr size_t O_KVS1 = O_KVS0 + 524288;
constexpr size_t O_KVS2 = O_KVS1 + 524288;
constexpr size_t O_CONVS = O_KVS2 + 524288;
constexpr size_t O_SSMS = O_CONVS + 1179648;
constexpr size_t O_END = O_SSMS + 16777216;

constexpr int NWAVES = 8;
constexpr int RING_OFF = 0;
constexpr int LDSCTL_OFF = 151552, MISC_OFF = LDSCTL_OFF + 320;
constexpr int LDS_BYTES = 155648;

struct Frame {
    LAS unsigned char* lds;
    LAS unsigned char* ldv;
    volatile LAS unsigned* MISC;
    gu32* ctl;
    int tid, lane, wave, G, bx;
    const float* const* in; float* out; unsigned char* ws;
};
__device__ __forceinline__ int q_next(Frame& F, int qi) {
    if (F.tid == 0) F.MISC[16] = __hip_atomic_fetch_add((unsigned*)(F.ctl + CW_Q + 64 * qi), 1u, __ATOMIC_RELAXED, __HIP_MEMORY_SCOPE_AGENT);
    __syncthreads();
    const int v = (int)F.MISC[16];
    __syncthreads();
    return v;
}

#define IN_XP 0
#define IN_XS 1
#define IN_C128 2
#define IN_C512 3
#define IN_C2048 4
#define IN_SCONV 5
#define IN_SSSM 6
#define IN_NF1 7
#define IN_W1GU 8
#define IN_W1D 9
#define IN_NMIX 10
#define IN_WIN 11
#define IN_CONVW 12
#define IN_ALOG 13
#define IN_DTB 14
#define IN_GNORM 15
#define IN_WPA 16
#define IN_WPB 17
#define IN_WOUT 18
#define IN_NF2 19
#define IN_W2GU 20
#define IN_W2D 21
#define IN_NOUT 22

template <class Map>
__device__ __forceinline__ void p0_transpose_item(const float* W, int K, int N, bf16* WT, const float* gain, LAS float* scr, int item, int lane, Map map) {
    const int nblk = (N + 31) / 32, kb = item / nblk, nb = item % nblk, k0 = 64 * kb, n0 = 32 * nb;
    const int nc = n0 + (lane & 31); const bool okc = nc < N;
    float wv[32];
#pragma unroll
    for (int i = 0; i < 32; ++i) { const int kk = 2 * i + (lane >> 5); wv[i] = okc ? W[(size_t)(k0 + kk) * N + nc] : 0.f; }
    if (gain) {
#pragma unroll
        for (int i = 0; i < 32; ++i) wv[i] *= gain[k0 + 2 * i + (lane >> 5)]; }
#pragma unroll
    for (int i = 0; i < 32; ++i) scr[(2 * i + (lane >> 5)) * 33 + (lane & 31)] = wv[i];
    LDS_WAIT(); asm volatile("" ::: "memory");
    const int c = lane & 7;
#pragma unroll
    for (int j = 0; j < 4; ++j) { const int n = (lane >> 3) + 8 * j; const LAS float* s = scr + (8 * c) * 33 + n;
        v4u o; o.x = pk2(s[0 * 33], s[1 * 33]); o.y = pk2(s[2 * 33], s[3 * 33]); o.z = pk2(s[4 * 33], s[5 * 33]); o.w = pk2(s[6 * 33], s[7 * 33]);
        if (n0 + n < N) *(GAS v4u*)(WT + (size_t)map(n0 + n) * K + k0 + 8 * c) = o; }
    LDS_WAIT(); asm volatile("" ::: "memory");
}
struct MapId { __device__ __forceinline__ int operator()(int c) const { return c; } };
struct MapGU { __device__ __forceinline__ int operator()(int c) const { return c < FF ? 256 * (c >> 7) + (c & 127) : 256 * ((c - FF) >> 7) + 128 + ((c - FF) & 127); } };
struct MapIn { __device__ __forceinline__ int operator()(int c) const { return c < 8704 ? c : (c < 8720 ? U_BA + (c - 8704) : c - 16); } };

__device__ __forceinline__ void p0_prologue(Frame& F) {
    LAS float* scr = (LAS float*)(F.ldv + RING_OFF + F.wave * 16384);
    const int gw = F.bx * NWAVES + F.wave, NGW = F.G * NWAVES;
    bf16* W1A = (bf16*)(F.ws + WS_W1A); bf16* W1B = (bf16*)(F.ws + WS_W1B); bf16* WIN = (bf16*)(F.ws + WS_WIN); bf16* WPA = (bf16*)(F.ws + WS_WPA);
    bf16* WPB = (bf16*)(F.ws + WS_WPB); bf16* WOUT = (bf16*)(F.ws + WS_WOUT); bf16* W2A = (bf16*)(F.ws + WS_W2A); bf16* W2B = (bf16*)(F.ws + WS_W2B);
    constexpr int I_GU = (D / 64) * (NGU / 32), I_DN = (FF / 64) * (D / 32), I_IN = (D / 64) * ((NIN + 31) / 32), I_PA = (512 / 64) * (D / 32), I_DD = (D / 64) * (D / 32);
    constexpr int NITEMS = 2 * I_GU + 2 * I_DN + I_IN + I_PA + 2 * I_DD;
    for (int it = gw; it < NITEMS; it += NGW) {
        int r = it;
        if (r < I_GU) { p0_transpose_item(F.in[IN_W1GU], D, NGU, W1A, F.in[IN_NF1], scr, r, F.lane, MapGU()); continue; } r -= I_GU;
        if (r < I_GU) { p0_transpose_item(F.in[IN_W2GU], D, NGU, W2A, F.in[IN_NF2], scr, r, F.lane, MapGU()); continue; } r -= I_GU;
        if (r < I_DN) { p0_transpose_item(F.in[IN_W1D], FF, D, W1B, nullptr, scr, r, F.lane, MapId()); continue; } r -= I_DN;
        if (r < I_DN) { p0_transpose_item(F.in[IN_W2D], FF, D, W2B, nullptr, scr, r, F.lane, MapId()); continue; } r -= I_DN;
        if (r < I_IN) { p0_transpose_item(F.in[IN_WIN], D, NIN, WIN, F.in[IN_NMIX], scr, r, F.lane, MapIn()); continue; } r -= I_IN;
        if (r < I_PA) { p0_transpose_item(F.in[IN_WPA], 512, D, WPA, nullptr, scr, r, F.lane, MapId()); continue; } r -= I_PA;
        if (r < I_DD) { p0_transpose_item(F.in[IN_WPB], D, D, WPB, nullptr, scr, r, F.lane, MapId()); continue; } r -= I_DD;
        p0_transpose_item(F.in[IN_WOUT], D, D, WOUT, nullptr, scr, r, F.lane, MapId());
    }
    { const int gt = F.bx * 512 + F.tid, NT = F.G * 512; GAS v4u* z = (GAS v4u*)(WIN + (size_t)NIN * D);
      for (int i = gt; i < (NINP - NIN) * D / 8; i += NT) z[i] = (v4u){0u, 0u, 0u, 0u}; }
    bf16* XB = (bf16*)(F.ws + WS_XB); float* RSTD1 = (float*)(F.ws + WS_RSTD1);
    for (int m0 = gw; m0 < MT; m0 += 2 * NGW) {
        f32x4 v[2][4]; float s[2];
#pragma unroll
        for (int r = 0; r < 2; ++r) { const int m = m0 + r * NGW; s[r] = 0.f;
            if (m < MT) { const float* xrow = (m < MP) ? F.in[IN_XP] + (size_t)m * D : F.in[IN_XS] + (size_t)(m - MP) * D; const GAS f32x4* xr = (const GAS f32x4*)xrow + F.lane;
#pragma unroll
                for (int j = 0; j < 4; ++j) v[r][j] = xr[64 * j]; } }
#pragma unroll
        for (int r = 0; r < 2; ++r) { const int m = m0 + r * NGW;
            if (m < MT) {
#pragma unroll
                for (int j = 0; j < 4; ++j) s[r] += (v[r][j].x * v[r][j].x + v[r][j].y * v[r][j].y) + (v[r][j].z * v[r][j].z + v[r][j].w * v[r][j].w);
                float t = row_sum16(s[r]); t += __shfl_xor(t, 16); t += __shfl_xor(t, 32);
                GAS v2u* o8 = (GAS v2u*)(XB + (size_t)m * D) + F.lane;
#pragma unroll
                for (int j = 0; j < 4; ++j) { v2u w; w.x = pk2(v[r][j].x, v[r][j].y); w.y = pk2(v[r][j].z, v[r][j].w); o8[64 * j] = w; }
                if (F.lane == 0) RSTD1[m] = rsqrtf(t * (1.0f / D) + EPS); } }
    }
}

__device__ __forceinline__ void final_norm(Frame& F) {
    const int gw = F.bx * NWAVES + F.wave, NGW = F.G * NWAVES;
    const float* ssq = (const float*)(F.ctl + CW_SSQ4); const GAS f32x4* nw = (const GAS f32x4*)F.in[IN_NOUT] + F.lane;
    f32x4 g[4];
#pragma unroll
    for (int j = 0; j < 4; ++j) g[j] = nw[64 * j];
    for (int m = gw; m < MT; m += NGW) {
        const float r = rsqrtf(ssq[m] * (1.0f / D) + EPS);
        GAS f32x4* xr = (GAS f32x4*)(F.out + O_Y + (size_t)m * D) + F.lane;
#pragma unroll
        for (int j = 0; j < 4; ++j) { f32x4 v = xr[64 * j]; xr[64 * j] = v * r * g[j]; }
    }
}

template <int K>
__device__ __forceinline__ void skinny_partial(const bf16* A, const bf16* Bt, int r0, int c0, int w, int lane, LAS unsigned char* part) {
    const int m16 = lane & 15, kg = lane >> 4;
    f32x4 acc[2][4];
#pragma unroll
    for (int i = 0; i < 2; ++i)
#pragma unroll
        for (int j = 0; j < 4; ++j) acc[i][j] = (f32x4){0.f, 0.f, 0.f, 0.f};
    const bf16* ap = A + (size_t)(r0 + m16) * K + w * (K / 8) + 8 * kg; const bf16* bp = Bt + (size_t)(c0 + m16) * K + w * (K / 8) + 8 * kg;
#pragma unroll 4
    for (int kb = 0; kb < K / 256; ++kb) {
        bf16x8 a[2], bq[4];
#pragma unroll
        for (int i = 0; i < 2; ++i) a[i] = *(const GAS bf16x8*)(ap + (size_t)16 * i * K + 32 * kb);
#pragma unroll
        for (int j = 0; j < 4; ++j) bq[j] = *(const GAS bf16x8*)(bp + (size_t)16 * j * K + 32 * kb);
#pragma unroll
        for (int i = 0; i < 2; ++i)
#pragma unroll
            for (int j = 0; j < 4; ++j) acc[i][j] = mfma16(bq[j], a[i], acc[i][j]);
    }
#pragma unroll
    for (int i = 0; i < 2; ++i)
#pragma unroll
        for (int j = 0; j < 4; ++j) *(LAS f32x4*)(part + ((w * 8 + i * 4 + j) * 64 + lane) * 16) = acc[i][j];
}
__device__ __forceinline__ f32x4 skinny_reduce(const LAS unsigned char* part, int w, int lane) {
    f32x4 s = {0.f, 0.f, 0.f, 0.f};
#pragma unroll
    for (int p = 0; p < 8; ++p) s = s + *(const LAS f32x4*)(part + ((p * 8 + w) * 64 + lane) * 16);
    return s;
}
template <int K, int MODE>
__device__ __forceinline__ void skinny_resid(Frame& F, const bf16* A, const bf16* Bt, const float* basef, const bf16* baseb, bf16* outb, float* outf, float* ssq, float scale) {
    const int lane = F.lane, w = F.wave, m16 = lane & 15, kg = lane >> 4, wr = w >> 2, wc = w & 3;
    for (int t = F.bx; t < 256; t += F.G) {
        const int r0 = MP + 32 * (t >> 4), c0 = 64 * (t & 15);
        skinny_partial<K>(A, Bt, r0, c0, w, lane, F.ldv);
        WG_BARRIER();
        const f32x4 acc = skinny_reduce(F.ldv, w, lane);
        const int row = r0 + 16 * wr + m16;
        const size_t off = (size_t)row * D + c0 + 16 * wc + 4 * kg;
        f32x4 b;
        if (MODE == 0) b = *(const GAS f32x4*)(basef + off); else { const v2u p = *(const GAS v2u*)(baseb + off); b = (f32x4){bflo(p.x), bfhi(p.x), bflo(p.y), bfhi(p.y)}; }
        const f32x4 v = b + acc * scale;
        if (MODE == 2) *(GAS f32x4*)(outf + off) = v; else { v2u pk; pk.x = pk2(v[0], v[1]); pk.y = pk2(v[2], v[3]); *(GAS v2u*)(outb + off) = pk; }
        float s = (v[0] * v[0] + v[1] * v[1]) + (v[2] * v[2] + v[3] * v[3]);
        s += __shfl_xor(s, 16); s += __shfl_xor(s, 32);
        if (kg == 0) atomicAdd(ssq + row, s);
        WG_BARRIER();
    }
}
__device__ __forceinline__ void skinny_merge(Frame& F, const bf16* OA, const bf16* WPA, const bf16* OB, const bf16* WPB, const bf16* U, bf16* MG) {
    const int lane = F.lane, w = F.wave, m16 = lane & 15, kg = lane >> 4, wr = w >> 2, wc = w & 3;
    for (int t = F.bx; t < 256; t += F.G) {
        const int r0 = MP + 32 * (t >> 4), c0 = 64 * (t & 15);
        skinny_partial<512>(OA, WPA, r0, c0, w, lane, F.ldv);
        skinny_partial<D>(OB, WPB, r0, c0, w, lane, F.ldv + 65536);
        WG_BARRIER();
        const f32x4 aa = skinny_reduce(F.ldv, w, lane), ab = skinny_reduce(F.ldv + 65536, w, lane);
        const int row = r0 + 16 * wr + m16, col = c0 + 16 * wc + 4 * kg;
        const v2u ga = *(const GAS v2u*)(U + (size_t)row * NINP + U_GATE + col), gb = *(const GAS v2u*)(U + (size_t)row * NINP + U_GATE + D + col);
        v2u o; o.x = pk2(sigm(bflo(ga.x)) * aa[0] + sigm(bflo(gb.x)) * ab[0], sigm(bfhi(ga.x)) * aa[1] + sigm(bfhi(gb.x)) * ab[1]);
        o.y = pk2(sigm(bflo(ga.y)) * aa[2] + sigm(bflo(gb.y)) * ab[2], sigm(bfhi(ga.y)) * aa[3] + sigm(bfhi(gb.y)) * ab[3]);
        *(GAS v2u*)(MG + (size_t)row * D + col) = o;
        WG_BARRIER();
    }
}
__device__ __forceinline__ void skinny_ba(Frame& F, const bf16* X1B, const bf16* WIN, const float* ssq, float* BA) {
    const int lane = F.lane, m16 = lane & 15, kg = lane >> 4;
    for (int t = F.bx * NWAVES + F.wave; t < MT / 16; t += F.G * NWAVES) {
        const int row = 16 * t + m16;
        f32x4 acc = {0.f, 0.f, 0.f, 0.f}; { const bf16* ap = X1B + (size_t)row * D + 8 * kg; const bf16* bp = WIN + (size_t)(U_BA + m16) * D + 8 * kg;
#pragma unroll 16
            for (int kb = 0; kb < D / 32; ++kb) acc = mfma16(*(const GAS bf16x8*)(bp + 32 * kb), *(const GAS bf16x8*)(ap + 32 * kb), acc); }
        *(GAS f32x4*)(BA + (size_t)row * 16 + 4 * kg) = acc * rsqrtf(ssq[row] * (1.0f / D) + EPS);
    }
}

constexpr int GP_QR = 0, GP_KR = 17408, GP_KT = 34816, GP_KBG = 53248, GP_BVT = 71680, GP_GKK = 90112, GP_GQK = 107520, GP_TI = 124928, GP_TAB = 134144;
constexpr int GKP = 68;
__device__ __forceinline__ f32x4 mfma4(float a, float b, f32x4 c) { return __builtin_amdgcn_mfma_f32_16x16x4f32(a, b, c, 0, 0, 0); }
__device__ __forceinline__ f32x4 prod_ll(const LAS float* A, int ra, int ca, const LAS float* B, int rb, int cb, f32x4 c, int m16, int kg) {
    const f32x4 av = *(const LAS f32x4*)(A + (ra + m16) * GKP + ca + 4 * kg);
#pragma unroll
    for (int t = 0; t < 4; ++t) c = mfma4(av[t], B[(rb + 4 * kg + t) * GKP + cb + m16], c);
    return c;
}
__device__ __forceinline__ f32x4 prod_lr(const LAS float* A, int ra, int ca, f32x4 x, f32x4 c, int m16, int kg) {
    const f32x4 av = *(const LAS f32x4*)(A + (ra + m16) * GKP + ca + 4 * kg);
#pragma unroll
    for (int t = 0; t < 4; ++t) c = mfma4(av[t], x[t], c);
    return c;
}
__device__ __forceinline__ float softplusf(float x) { return x > 20.f ? x : log1pf(__expf(x)); }

struct PrepIn { v2u raw[19]; v4u zr0, zr1; f32x4 w0, w1, w2, w3; float bl, al; };
__device__ __forceinline__ void prep_fetch(Frame& F, int b, int h, int n, PrepIn& in) {
    const bf16* U = (const bf16*)(F.ws + WS_U); const float* BA = (const float*)(F.ws + WS_BA);
    const int tid = F.tid, row_base = b * SEQ + 64 * n;
    const int gz_t = tid >> 3, gz_c = (tid & 7) * 16;
    in.zr0 = *(const GAS v4u*)(U + (size_t)(row_base + gz_t) * NINP + U_Z + h * 128 + gz_c); in.zr1 = *(const GAS v4u*)(U + (size_t)(row_base + gz_t) * NINP + U_Z + h * 128 + gz_c + 8);
    const int cv_cq = tid & 31, cv_tq = (tid >> 5) & 3, cv_tensor = tid >> 7, cv_cw = cv_tensor * 1024 + h * 128 + 4 * cv_cq, cv_t0 = 16 * cv_tq;
    if (tid < 384) {
        in.w0 = *(const GAS f32x4*)(F.in[IN_CONVW] + cv_cw); in.w1 = *(const GAS f32x4*)(F.in[IN_CONVW] + 3072 + cv_cw); in.w2 = *(const GAS f32x4*)(F.in[IN_CONVW] + 2 * 3072 + cv_cw); in.w3 = *(const GAS f32x4*)(F.in[IN_CONVW] + 3 * 3072 + cv_cw);
#pragma unroll
        for (int i = 0; i < 19; ++i) { const int tok = 64 * n + cv_t0 - 3 + i; in.raw[i] = (v2u){0u, 0u}; if (tok >= 0) in.raw[i] = *(const GAS v2u*)(U + (size_t)(b * SEQ + tok) * NINP + U_QKVB + cv_cw); }
    }
    if (F.wave == 0) { in.bl = BA[(size_t)(row_base + F.lane) * 16 + h]; in.al = BA[(size_t)(row_base + F.lane) * 16 + 8 + h]; }
}
__device__ __forceinline__ void gdn_prep_unit(Frame& F, int b, int h, int n, PrepIn& in, bool has_next, int nb_, int nh_, int nn_, int abl) {
    LAS unsigned char* L = F.ldv;
    LAS float* TAB = (LAS float*)(L + GP_TAB);
    LAS float* GKK = (LAS float*)(L + GP_GKK);
    LAS float* GQK = (LAS float*)(L + GP_GQK);
    const bf16* U = (const bf16*)(F.ws + WS_U); const float* BA = (const float*)(F.ws + WS_BA);
    const int tid = F.tid, lane = F.lane, wave = F.wave;
    const int uidx = (b * 8 + h) * 64 + n;
    unsigned char* rec = F.ws + WS_REC + (size_t)uidx * REC_BYTES;
    const int row_base = b * SEQ + 64 * n;
    const int gz_t = tid >> 3, gz_c = (tid & 7) * 16;
    const int cv_cq = tid & 31, cv_tq = (tid >> 5) & 3, cv_tensor = tid >> 7, cv_c0 = 4 * cv_cq, cv_t0 = 16 * cv_tq;
    if (wave == 0) {
        const int t = lane; const float bl = in.bl, al = in.al;
        const float beta = sigm(bl); const float g = -__expf(F.in[IN_ALOG][h]) * softplusf(al + F.in[IN_DTB][h]);
        float gc = g;
#pragma unroll
        for (int o = 1; o < 64; o <<= 1) { const float v = __shfl_up(gc, o); if (lane >= o) gc += v; }
        const float gl = __shfl(gc, 63);
        TAB[t] = beta; TAB[64 + t] = gc; TAB[128 + t] = __expf(gc); TAB[192 + t] = __expf(gl - gc);
        if (lane == 0) ((float*)(F.ws + WS_GE))[uidx] = __expf(gl);
    }
    WG_BARRIER();
    if (tid < 384 && !(abl & 1)) {
        const int tensor = cv_tensor, c0 = cv_c0, t0 = cv_t0;
        f32x4 x[19];
#pragma unroll
        for (int i = 0; i < 19; ++i) x[i] = (f32x4){bflo(in.raw[i].x), bfhi(in.raw[i].x), bflo(in.raw[i].y), bfhi(in.raw[i].y)};
        const f32x4 w0 = in.w0, w1 = in.w1, w2 = in.w2, w3 = in.w3;
        unsigned tp[4][8];
#pragma unroll
        for (int i = 0; i < 16; ++i) { f32x4 y = w0 * x[i] + w1 * x[i + 1] + w2 * x[i + 2] + w3 * x[i + 3];
#pragma unroll
            for (int e = 0; e < 4; ++e) y[e] = siluf(y[e]);
            if (tensor == 2) y = y * TAB[t0 + i];
            if (tensor < 2) { v2u pk; pk.x = pk2(y[0], y[1]); pk.y = pk2(y[2], y[3]); *(LAS v2u*)(L + (tensor == 0 ? GP_QR : GP_KR) + (t0 + i) * 272 + 2 * c0) = pk; }
            if (tensor > 0) {
#pragma unroll
                for (int e = 0; e < 4; ++e) { const unsigned bq = f2bf(y[e]); if (i & 1) tp[e][i >> 1] |= bq << 16; else tp[e][i >> 1] = bq; } }
        }
        if (tensor > 0) {
#pragma unroll
            for (int e = 0; e < 4; ++e) { LAS unsigned char* dst = L + (tensor == 1 ? GP_KT : GP_BVT) + (c0 + e) * 144 + 2 * t0;
                *(LAS v4u*)dst = (v4u){tp[e][0], tp[e][1], tp[e][2], tp[e][3]}; *(LAS v4u*)(dst + 16) = (v4u){tp[e][4], tp[e][5], tp[e][6], tp[e][7]}; } }
    }
    WG_BARRIER();
    { const unsigned zi[8] = {in.zr0.x, in.zr0.y, in.zr0.z, in.zr0.w, in.zr1.x, in.zr1.y, in.zr1.z, in.zr1.w}; unsigned zo[8];
#pragma unroll
      for (int i = 0; i < 8; ++i) { const float za = bflo(zi[i]), zb = bfhi(zi[i]); const f32x2 nw2 = *(const GAS f32x2*)(F.in[IN_GNORM] + gz_c + 2 * i);
          zo[i] = pk2(za * sigm(za) * nw2[0], zb * sigm(zb) * nw2[1]); }
      *(GAS v4u*)(rec + 73728 + (gz_t * 128 + gz_c) * 2) = (v4u){zo[0], zo[1], zo[2], zo[3]}; *(GAS v4u*)(rec + 73728 + (gz_t * 128 + gz_c + 8) * 2) = (v4u){zo[4], zo[5], zo[6], zo[7]}; }
    if (has_next) prep_fetch(F, nb_, nh_, nn_, in);
    {
        const int m16 = lane & 15, kg = lane >> 4;
        if (!(abl & 2)) for (int job = wave; job < 24; job += 8) {
            int kind, it, jt;
            if (job < 20) { kind = job >= 10; int j = job % 10; it = 0; while (j > it) { j -= it + 1; ++it; } jt = j; }
            else { kind = 2; it = jt = job - 20; }
            const int abase = (kind == 2 ? GP_QR : GP_KR) + (16 * (kind == 1 ? jt : it) + m16) * 272 + 16 * kg;
            const int bbase = (kind == 0 ? GP_KR : GP_QR) + (16 * (kind == 0 ? jt : it) + m16) * 272 + 16 * kg;
            f32x4 acc = {0.f, 0.f, 0.f, 0.f};
#pragma unroll
            for (int kb = 0; kb < 4; ++kb) { const bf16x8 a = *(const LAS bf16x8*)(L + abase + 64 * kb), bb = *(const LAS bf16x8*)(L + bbase + 64 * kb); acc = mfma16(a, bb, acc); }
            if (kind == 0) {
#pragma unroll
                for (int jj = 0; jj < 4; ++jj) GKK[(16 * it + 4 * kg + jj) * GKP + 16 * jt + m16] = acc[jj];
            } else if (kind == 1) {
                *(LAS f32x4*)(GQK + (16 * it + m16) * 68 + 16 * jt + 4 * kg) = acc;
            } else {
#pragma unroll
                for (int jj = 0; jj < 4; ++jj) if (4 * kg + jj == m16) TAB[576 + 16 * it + m16] = acc[jj];
            }
        }
    }
    WG_BARRIER();
    if (tid < 64) {
        const int t = tid; const float rk = rsqrtf(GKK[t * GKP + t] + EPS), rq = rsqrtf(TAB[576 + t] + EPS) * 0.08838834764831845f;
        TAB[256 + t] = rk; TAB[320 + t] = rq; TAB[384 + t] = rq * TAB[128 + t]; TAB[448 + t] = rk * TAB[192 + t]; TAB[512 + t] = rk * TAB[t] * TAB[128 + t];
    }
    WG_BARRIER();
    if (!(abl & 4)) {
        for (int e = tid; e < 4096; e += 512) { const int i = e >> 6, j = e & 63;
            if (j < i) GKK[i * GKP + j] = TAB[i] * TAB[256 + i] * TAB[256 + j] * GKK[i * GKP + j] * __expf(TAB[64 + i] - TAB[64 + j]); }
        const int m16 = lane & 15, kg = lane >> 4;
        { const int it = wave >> 1, kb2 = wave & 1, i = 16 * it + m16; const float sc = TAB[320 + i], gi = TAB[64 + i];
          float o[8];
#pragma unroll
          for (int hlf = 0; hlf < 2; ++hlf) { const int j0 = 32 * kb2 + 16 * hlf + 4 * kg; const f32x4 g = *(const LAS f32x4*)(GQK + i * 68 + j0);
#pragma unroll
              for (int e = 0; e < 4; ++e) { const int j = j0 + e; o[4 * hlf + e] = (j <= i) ? sc * TAB[256 + j] * g[e] * __expf(gi - TAB[64 + j]) : 0.f; } }
          v4u w; w.x = pk2(o[0], o[1]); w.y = pk2(o[2], o[3]); w.z = pk2(o[4], o[5]); w.w = pk2(o[6], o[7]);
          *(GAS v4u*)(rec + 32768 + wave * 1024 + lane * 16) = w; }
#pragma unroll
        for (int r = 0; r < 2; ++r) { const int f = wave * 2 + r, mt = f >> 1, kb2 = f & 1, dk = 16 * mt + m16; float o[8];
#pragma unroll
            for (int hlf = 0; hlf < 2; ++hlf) { const int t0 = 32 * kb2 + 16 * hlf + 4 * kg; const v2u kk = *(const LAS v2u*)(L + GP_KT + dk * 144 + 2 * t0);
                o[4 * hlf + 0] = bflo(kk.x) * TAB[448 + t0]; o[4 * hlf + 1] = bfhi(kk.x) * TAB[448 + t0 + 1]; o[4 * hlf + 2] = bflo(kk.y) * TAB[448 + t0 + 2]; o[4 * hlf + 3] = bfhi(kk.y) * TAB[448 + t0 + 3]; }
            v4u w; w.x = pk2(o[0], o[1]); w.y = pk2(o[2], o[3]); w.z = pk2(o[4], o[5]); w.w = pk2(o[6], o[7]);
            *(GAS v4u*)(rec + 40960 + f * 1024 + lane * 16) = w; }
#pragma unroll
        for (int r = 0; r < 2; ++r) { const int f = wave * 2 + r, mtq = f >> 2, kb = f & 3, t = 16 * mtq + m16; const float sc = TAB[384 + t]; float o[8];
#pragma unroll
            for (int hlf = 0; hlf < 2; ++hlf) { const int d0 = 32 * kb + 16 * hlf + 4 * kg; const v2u qq = *(const LAS v2u*)(L + GP_QR + t * 272 + 2 * d0);
                o[4 * hlf + 0] = bflo(qq.x) * sc; o[4 * hlf + 1] = bfhi(qq.x) * sc; o[4 * hlf + 2] = bflo(qq.y) * sc; o[4 * hlf + 3] = bfhi(qq.y) * sc; }
            v4u w; w.x = pk2(o[0], o[1]); w.y = pk2(o[2], o[3]); w.z = pk2(o[4], o[5]); w.w = pk2(o[6], o[7]);
            *(GAS v4u*)(rec + ((4 + mtq) * 4 + kb) * 1024 + lane * 16) = w; }
        { const int dk = tid >> 2, t0 = (tid & 3) * 16; const v4u a = *(const LAS v4u*)(L + GP_KT + dk * 144 + 2 * t0), bq = *(const LAS v4u*)(L + GP_KT + dk * 144 + 2 * t0 + 16);
          const unsigned wi[8] = {a.x, a.y, a.z, a.w, bq.x, bq.y, bq.z, bq.w}; unsigned wo[8];
#pragma unroll
          for (int i = 0; i < 8; ++i) wo[i] = pk2(bflo(wi[i]) * TAB[512 + t0 + 2 * i], bfhi(wi[i]) * TAB[512 + t0 + 2 * i + 1]);
          *(LAS v4u*)(L + GP_KBG + dk * 144 + 2 * t0) = (v4u){wo[0], wo[1], wo[2], wo[3]}; *(LAS v4u*)(L + GP_KBG + dk * 144 + 2 * t0 + 16) = (v4u){wo[4], wo[5], wo[6], wo[7]}; }
    }
    WG_BARRIER();
    LAS float* TIF = GQK;
    if (!(abl & 8)) {
        const int m16 = lane & 15, kg = lane >> 4;
        if (wave == 0) {
            const LAS float* Ab = GKK + (16 * kg) * GKP + 16 * kg; float r[16];
#pragma unroll
            for (int i = 0; i < 16; ++i) { int lo_ = m16; asm volatile("" : "+v"(lo_)); float a = (lo_ == i) ? 1.f : 0.f;
#pragma unroll
                for (int j4 = 0; j4 < (i + 3) / 4; ++j4) { const f32x4 av = *(const LAS f32x4*)(Ab + i * GKP + 4 * j4);
#pragma unroll
                    for (int e = 0; e < 4; ++e) { const int j = 4 * j4 + e; if (j < i) a -= av[e] * r[j]; } }
                r[i] = a; }
#pragma unroll
            for (int i = 0; i < 16; ++i) TIF[(16 * kg + i) * GKP + 16 * kg + m16] = r[i];
        }
        WG_BARRIER();
        const f32x4 z4 = {0.f, 0.f, 0.f, 0.f};
        if (wave < 3) { const int i = wave + 1, j = wave;
            f32x4 X = prod_ll(GKK, 16 * i, 16 * j, TIF, 16 * j, 16 * j, z4, m16, kg);
            f32x4 T = prod_lr(TIF, 16 * i, 16 * i, X, z4, m16, kg);
#pragma unroll
            for (int jj = 0; jj < 4; ++jj) TIF[(16 * i + 4 * kg + jj) * GKP + 16 * j + m16] = -T[jj]; }
        WG_BARRIER();
        if (wave < 2) { const int i = wave + 2, j = wave;
            f32x4 Y = prod_ll(GKK, 16 * i, 16 * j, TIF, 16 * j, 16 * j, z4, m16, kg);
            Y = prod_ll(GKK, 16 * i, 16 * (j + 1), TIF, 16 * (j + 1), 16 * j, Y, m16, kg);
            f32x4 T = prod_lr(TIF, 16 * i, 16 * i, Y, z4, m16, kg);
#pragma unroll
            for (int jj = 0; jj < 4; ++jj) TIF[(16 * i + 4 * kg + jj) * GKP + 16 * j + m16] = -T[jj]; }
        WG_BARRIER();
        if (wave == 0) {
            f32x4 Y = prod_ll(GKK, 48, 0, TIF, 0, 0, z4, m16, kg);
            Y = prod_ll(GKK, 48, 16, TIF, 16, 0, Y, m16, kg);
            Y = prod_ll(GKK, 48, 32, TIF, 32, 0, Y, m16, kg);
            f32x4 T = prod_lr(TIF, 48, 48, Y, z4, m16, kg);
#pragma unroll
            for (int jj = 0; jj < 4; ++jj) TIF[(48 + 4 * kg + jj) * GKP + m16] = -T[jj]; }
        WG_BARRIER();
        { const int row = tid >> 3, cg = tid & 7; v4u o = {0u, 0u, 0u, 0u};
          if ((cg >> 1) <= (row >> 4)) { const f32x4 a = *(const LAS f32x4*)(TIF + row * GKP + 8 * cg), c = *(const LAS f32x4*)(TIF + row * GKP + 8 * cg + 4);
              o.x = pk2(a[0], a[1]); o.y = pk2(a[2], a[3]); o.z = pk2(c[0], c[1]); o.w = pk2(c[2], c[3]); }
          *(LAS v4u*)(L + GP_TI + row * 144 + 16 * cg) = o; }
    }
    WG_BARRIER();
    if (!(abl & 16)) {
        const int m16 = lane & 15, kg = lane >> 4;
#pragma unroll
        for (int it = 0; it < 4; ++it) {
            f32x4 au = {0.f, 0.f, 0.f, 0.f}, aw = {0.f, 0.f, 0.f, 0.f};
#pragma unroll
            for (int jb = 0; jb < 2; ++jb) {
                const bf16x8 ti = *(const LAS bf16x8*)(L + GP_TI + (16 * it + m16) * 144 + 64 * jb + 16 * kg);
                const bf16x8 bv = *(const LAS bf16x8*)(L + GP_BVT + (16 * wave + m16) * 144 + 64 * jb + 16 * kg);
                const bf16x8 kb = *(const LAS bf16x8*)(L + GP_KBG + (16 * wave + m16) * 144 + 64 * jb + 16 * kg);
                au = mfma16(ti, bv, au);
                aw = mfma16(kb, ti, aw);
            }
            v2u w; w.x = pk2(au[0], au[1]); w.y = pk2(au[2], au[3]);
            *(GAS v2u*)(rec + 57344 + ((wave * 4 + it) * 64 + lane) * 8) = w;
            v2u x; x.x = pk2(aw[0], aw[1]); x.y = pk2(aw[2], aw[3]);
            *(GAS v2u*)(rec + (it * 4 + (wave >> 1)) * 1024 + lane * 16 + (wave & 1) * 8) = x;
        }
    }
    WG_BARRIER();
}

constexpr int SC_BUF = 57344, SC_OT = 2 * SC_BUF, SC_OTB = 17408, SC_RED = SC_OT + 2 * SC_OTB;
static_assert(SC_RED + 2048 <= LDSCTL_OFF, "scan LDS map");
__device__ __forceinline__ void gdn_scan_chain(Frame& F, int bh) {
#ifdef NO_SCAN
    return;
#endif
    LAS unsigned char* L = F.ldv;
    const int tid = F.tid, lane = F.lane, w = F.wave, m16 = lane & 15, kg = lane >> 4;
    const int b = bh >> 3, h = bh & 7;
    const unsigned char* rec0 = F.ws + WS_REC + (size_t)(bh * 64) * REC_BYTES;
    if (w >= 4) {
        const int ht = tid - 256; bf16* OB = (bf16*)(F.ws + WS_OB);
        v4u st[14];
#pragma unroll
        for (int i = 0; i < 14; ++i) st[i] = *(const GAS v4u*)(rec0 + (size_t)(i * 256 + ht) * 16);
#pragma unroll
        for (int i = 0; i < 14; ++i) *(LAS v4u*)(L + (i * 256 + ht) * 16) = st[i];
#pragma unroll
        for (int i = 0; i < 14; ++i) st[i] = *(const GAS v4u*)(rec0 + REC_BYTES + (size_t)(i * 256 + ht) * 16);
        WG_BARRIER();
        for (int m = 0; m < 65; ++m) {
            if (m + 1 <= 63) { LAS unsigned char* nb = L + ((m + 1) & 1) * SC_BUF;
#pragma unroll
                for (int i = 0; i < 14; ++i) *(LAS v4u*)(nb + (i * 256 + ht) * 16) = st[i]; }
            if (m + 2 <= 63) { const unsigned char* rec = rec0 + (size_t)(m + 2) * REC_BYTES;
#pragma unroll
                for (int i = 0; i < 14; ++i) st[i] = *(const GAS v4u*)(rec + (size_t)(i * 256 + ht) * 16); }
            if (m >= 1) {
                const LAS unsigned char* ot = L + SC_OT + ((m - 1) & 1) * SC_OTB; const LAS float* RED = (const LAS float*)(L + SC_RED) + ((m - 1) & 1) * 256;
                const int row0 = b * SEQ + 64 * (m - 1); const unsigned char* gzt = rec0 + (size_t)(m - 1) * REC_BYTES + 73728;
                v4u gv[4];
#pragma unroll
                for (int r = 0; r < 4; ++r) gv[r] = *(const GAS v4u*)(gzt + (size_t)(ht + 256 * r) * 16);
#pragma unroll
                for (int r = 0; r < 4; ++r) { const int idx = ht + 256 * r, row = idx >> 4, ch = idx & 15;
                    const v4u ov = *(const LAS v4u*)(ot + row * 272 + ch * 16); const f32x4 r4 = *(const LAS f32x4*)(RED + row * 4);
                    const float rs = rsqrtf(((r4[0] + r4[1]) + (r4[2] + r4[3])) * (1.0f / 128.0f) + EPS);
                    v4u o; o.x = pk2(bflo(ov.x) * rs * bflo(gv[r].x), bfhi(ov.x) * rs * bfhi(gv[r].x)); o.y = pk2(bflo(ov.y) * rs * bflo(gv[r].y), bfhi(ov.y) * rs * bfhi(gv[r].y));
                    o.z = pk2(bflo(ov.z) * rs * bflo(gv[r].z), bfhi(ov.z) * rs * bfhi(gv[r].z)); o.w = pk2(bflo(ov.w) * rs * bflo(gv[r].w), bfhi(ov.w) * rs * bfhi(gv[r].w));
                    *(GAS v4u*)(OB + (size_t)(row0 + row) * D + h * 128 + ch * 8) = o; } }
            WG_BARRIER();
        }
    } else {
        const float* GE = (const float*)(F.ws + WS_GE) + bh * 64;
        f32x4 S[2][8], P[2][8];
#pragma unroll
        for (int hf = 0; hf < 2; ++hf)
#pragma unroll
            for (int i = 0; i < 8; ++i) { S[hf][i] = (f32x4){0.f, 0.f, 0.f, 0.f}; P[hf][i] = (f32x4){0.f, 0.f, 0.f, 0.f}; }
        WG_BARRIER();
        for (int m = 0; m < 65; ++m) {
            if (m <= 63) {
                const unsigned char* rec = rec0 + (size_t)m * REC_BYTES; const LAS unsigned char* buf = L + (m & 1) * SC_BUF;
                v2u ut[2][4];
#pragma unroll
                for (int hf = 0; hf < 2; ++hf)
#pragma unroll
                    for (int mt = 0; mt < 4; ++mt) ut[hf][mt] = *(const GAS v2u*)(rec + 57344 + (((2 * w + hf) * 4 + mt) * 64 + lane) * 8);
                const float ge = GE[m];
                bf16x8 Sb[2][4];
#pragma unroll
                for (int hf = 0; hf < 2; ++hf)
#pragma unroll
                    for (int kb = 0; kb < 4; ++kb) Sb[hf][kb] = pack8(S[hf][2 * kb], S[hf][2 * kb + 1]);
#pragma unroll
                for (int mt = 0; mt < 8; ++mt) { P[0][mt] = (f32x4){0.f, 0.f, 0.f, 0.f}; P[1][mt] = (f32x4){0.f, 0.f, 0.f, 0.f};
#pragma unroll
                    for (int kb = 0; kb < 4; ++kb) { const bf16x8 a = *(const LAS bf16x8*)(buf + (mt * 4 + kb) * 1024 + lane * 16); P[0][mt] = mfma16(a, Sb[0][kb], P[0][mt]); P[1][mt] = mfma16(a, Sb[1][kb], P[1][mt]); } }
                bf16x8 vb[2][2];
#pragma unroll
                for (int hf = 0; hf < 2; ++hf) { f32x4 vn[4];
#pragma unroll
                    for (int mt = 0; mt < 4; ++mt) { vn[mt][0] = bflo(ut[hf][mt].x) - P[hf][mt][0]; vn[mt][1] = bfhi(ut[hf][mt].x) - P[hf][mt][1]; vn[mt][2] = bflo(ut[hf][mt].y) - P[hf][mt][2]; vn[mt][3] = bfhi(ut[hf][mt].y) - P[hf][mt][3]; }
                    vb[hf][0] = pack8(vn[0], vn[1]); vb[hf][1] = pack8(vn[2], vn[3]); }
#pragma unroll
                for (int mt = 0; mt < 4; ++mt)
#pragma unroll
                    for (int kb2 = 0; kb2 < 2; ++kb2) { const bf16x8 a = *(const LAS bf16x8*)(buf + 32768 + (mt * 2 + kb2) * 1024 + lane * 16); P[0][4 + mt] = mfma16(a, vb[0][kb2], P[0][4 + mt]); P[1][4 + mt] = mfma16(a, vb[1][kb2], P[1][4 + mt]); }
#pragma unroll
                for (int mt = 0; mt < 8; ++mt) { S[0][mt] = S[0][mt] * ge; S[1][mt] = S[1][mt] * ge;
#pragma unroll
                    for (int kb2 = 0; kb2 < 2; ++kb2) { const bf16x8 a = *(const LAS bf16x8*)(buf + 40960 + (mt * 2 + kb2) * 1024 + lane * 16); S[0][mt] = mfma16(a, vb[0][kb2], S[0][mt]); S[1][mt] = mfma16(a, vb[1][kb2], S[1][mt]); } }
                LAS float* RED = (LAS float*)(L + SC_RED) + (m & 1) * 256; LAS unsigned char* ot = L + SC_OT + (m & 1) * SC_OTB;
#pragma unroll
                for (int mt = 0; mt < 4; ++mt)
#pragma unroll
                    for (int jj = 0; jj < 4; jj += 2) { const int t = 16 * mt + 4 * kg + jj;
#pragma unroll
                        for (int hf = 0; hf < 2; ++hf) { const unsigned pr = pk2(P[hf][4 + mt][jj], P[hf][4 + mt][jj + 1]);
                            *(LAS bf16*)(ot + t * 272 + (32 * w + 16 * hf + m16) * 2) = (bf16)(pr & 0xffffu); *(LAS bf16*)(ot + (t + 1) * 272 + (32 * w + 16 * hf + m16) * 2) = (bf16)(pr >> 16); } }
                float mine = 0.f;
#pragma unroll
                for (int mt = 0; mt < 4; ++mt)
#pragma unroll
                    for (int jj = 0; jj < 4; ++jj) { const float q = row_sum16(P[0][4 + mt][jj] * P[0][4 + mt][jj] + P[1][4 + mt][jj] * P[1][4 + mt][jj]); mine = (m16 == 4 * mt + jj) ? q : mine; }
                RED[(16 * (m16 >> 2) + 4 * kg + (m16 & 3)) * 4 + w] = mine;
            }
            WG_BARRIER();
        }
        float* so = F.out + O_SSMP + (size_t)bh * 16384;
#pragma unroll
        for (int hf = 0; hf < 2; ++hf)
#pragma unroll
            for (int mt = 0; mt < 8; ++mt)
#pragma unroll
                for (int jj = 0; jj < 4; ++jj) so[(16 * mt + 4 * kg + jj) * 128 + 32 * w + 16 * hf + m16] = S[hf][mt][jj];
    }
    WG_BARRIER();
}

__device__ __forceinline__ void gdn_sample_unit(Frame& F, int b, int h) {
    LAS float* L = (LAS float*)F.ldv;
    const int tid = F.tid, lane = F.lane, wave = F.wave;
    const bf16* U = (const bf16*)(F.ws + WS_U); const float* BA = (const float*)(F.ws + WS_BA);
    const int row0 = MP + 4 * b;
    const int dv = tid & 127, kq = tid >> 7;
    const float* S0 = F.in[IN_SSSM] + ((size_t)(b * 8 + h) * 128 + 32 * kq) * 128 + dv;
    float s[32];
#pragma unroll
    for (int i = 0; i < 32; ++i) s[i] = S0[(size_t)i * 128];
    LAS float* SC = L + 8704;
    if (tid < 4) { const float bl = BA[(size_t)(row0 + tid) * 16 + h], al = BA[(size_t)(row0 + tid) * 16 + 8 + h];
        SC[tid] = sigm(bl); SC[56 + tid] = -__expf(F.in[IN_ALOG][h]) * softplusf(al + F.in[IN_DTB][h]); }
    if (tid < 384) {
        const int tensor = tid >> 7, c = tid & 127, cw = tensor * 1024 + h * 128 + c, col = U_QKVB + cw;
        const float w0 = F.in[IN_CONVW][cw], w1 = F.in[IN_CONVW][3072 + cw], w2 = F.in[IN_CONVW][2 * 3072 + cw], w3 = F.in[IN_CONVW][3 * 3072 + cw];
        float x[7];
#pragma unroll
        for (int i = 0; i < 3; ++i) x[i] = F.in[IN_SCONV][((size_t)b * 3 + i) * 3072 + cw];
#pragma unroll
        for (int i = 0; i < 4; ++i) x[3 + i] = bf2f(U[(size_t)(row0 + i) * NINP + col]);
#pragma unroll
        for (int i = 0; i < 4; ++i) { const float v = w0 * x[i] + w1 * x[i + 1] + w2 * x[i + 2] + w3 * x[i + 3]; L[tensor * 512 + i * 128 + c] = siluf(v); }
    }
    WG_BARRIER();
    if (tid == 0) { float gc = 0.f;
#pragma unroll
        for (int i = 0; i < 4; ++i) { gc += SC[56 + i]; SC[4 + i] = gc; } SC[48] = __expf(gc); }
    { const int tensor = wave >> 2, s = wave & 3; const float a = L[tensor * 512 + s * 128 + lane], c2 = L[tensor * 512 + s * 128 + 64 + lane];
      const float ss = wave_sum(a * a + c2 * c2); if (lane == 0) SC[(tensor ? 8 : 12) + s] = rsqrtf(ss + EPS) * (tensor ? 1.f : 0.08838834764831845f); }
    WG_BARRIER();
#pragma unroll
    for (int r = 0; r < 4; ++r) { const int idx = 4 * wave + r, kind = idx >> 4, i = (idx >> 2) & 3, j = idx & 3;
        const LAS float* a = L + (kind ? 0 : 512) + i * 128; const LAS float* c2 = L + 512 + j * 128;
        const float d = wave_sum(a[lane] * c2[lane] + a[64 + lane] * c2[64 + lane]);
        if (lane == 0) SC[16 + idx] = d * SC[(kind ? 12 : 8) + i] * SC[8 + j]; }
    WG_BARRIER();
    float beta[4], gc[4], Ti[4][4], qkm[4][4];
#pragma unroll
    for (int i = 0; i < 4; ++i) { beta[i] = SC[i]; gc[i] = SC[4 + i]; }
    const float ge = SC[48];
    {
        float A[4][4];
#pragma unroll
        for (int i = 0; i < 4; ++i)
#pragma unroll
            for (int j = 0; j < 4; ++j) { const float dec = __expf(gc[i] - gc[j]); A[i][j] = (j < i) ? beta[i] * SC[16 + 4 * i + j] * dec : 0.f; qkm[i][j] = (j <= i) ? SC[32 + 4 * i + j] * dec : 0.f; }
#pragma unroll
        for (int i = 0; i < 4; ++i)
#pragma unroll
            for (int c = 0; c < 4; ++c) { float v = (i == c) ? 1.f : 0.f;
#pragma unroll
                for (int j = 0; j < 4; ++j) if (j < i) v -= A[i][j] * Ti[j][c];
                Ti[i][c] = v; }
    }
    { const int c = tid & 127, i = tid >> 7; float wv = 0.f, uv = 0.f;
#pragma unroll
      for (int j = 0; j < 4; ++j) { wv += Ti[i][j] * beta[j] * __expf(gc[j]) * SC[8 + j] * L[512 + j * 128 + c]; uv += Ti[i][j] * beta[j] * L[1024 + j * 128 + c]; }
      L[1536 + i * 128 + c] = wv; L[3072 + i * 128 + c] = uv;
      L[2048 + i * 128 + c] = L[i * 128 + c] * SC[12 + i] * __expf(gc[i]);
      L[2560 + i * 128 + c] = L[512 + i * 128 + c] * SC[8 + i] * __expf(gc[3] - gc[i]); }
    WG_BARRIER();
    float pw[4] = {0.f, 0.f, 0.f, 0.f}, pq[4] = {0.f, 0.f, 0.f, 0.f};
#pragma unroll
    for (int i = 0; i < 32; ++i)
#pragma unroll
        for (int c = 0; c < 4; ++c) { pw[c] += L[1536 + c * 128 + 32 * kq + i] * s[i]; pq[c] += L[2048 + c * 128 + 32 * kq + i] * s[i]; }
#pragma unroll
    for (int c = 0; c < 4; ++c) { L[3584 + (c * 4 + kq) * 128 + dv] = pw[c]; L[3584 + ((4 + c) * 4 + kq) * 128 + dv] = pq[c]; }
    WG_BARRIER();
    float vn[4], oo[4];
#pragma unroll
    for (int c = 0; c < 4; ++c) { const float ws_ = (L[3584 + (c * 4 + 0) * 128 + dv] + L[3584 + (c * 4 + 1) * 128 + dv]) + (L[3584 + (c * 4 + 2) * 128 + dv] + L[3584 + (c * 4 + 3) * 128 + dv]);
        vn[c] = L[3072 + c * 128 + dv] - ws_; }
#pragma unroll
    for (int c = 0; c < 4; ++c) { float o = (L[3584 + ((4 + c) * 4 + 0) * 128 + dv] + L[3584 + ((4 + c) * 4 + 1) * 128 + dv]) + (L[3584 + ((4 + c) * 4 + 2) * 128 + dv] + L[3584 + ((4 + c) * 4 + 3) * 128 + dv]);
#pragma unroll
        for (int j = 0; j < 4; ++j) o += qkm[c][j] * vn[j];
        oo[c] = o; }
    float* SO = F.out + O_SSMS + ((size_t)(b * 8 + h) * 128 + 32 * kq) * 128 + dv;
#pragma unroll
    for (int i = 0; i < 32; ++i) { float v = ge * s[i];
#pragma unroll
        for (int c = 0; c < 4; ++c) v += L[2560 + c * 128 + 32 * kq + i] * vn[c];
        SO[(size_t)i * 128] = v; }
    LAS float* RED = L + 8768;
    if (kq == 0) {
#pragma unroll
        for (int c = 0; c < 4; ++c) { const float q = wave_sum(oo[c] * oo[c]); if (lane == 0) RED[c * 2 + wave] = q; }
    }
    WG_BARRIER();
    if (kq == 0) {
        bf16* OB = (bf16*)(F.ws + WS_OB); const float nw = F.in[IN_GNORM][dv];
#pragma unroll
        for (int c = 0; c < 4; ++c) { const float rs = rsqrtf((RED[c * 2] + RED[c * 2 + 1]) * (1.0f / 128.0f) + EPS);
            const float z = bf2f(U[(size_t)(row0 + c) * NINP + U_Z + h * 128 + dv]);
            OB[(size_t)(row0 + c) * D + h * 128 + dv] = (bf16)f2bf(oo[c] * rs * nw * (z * sigm(z))); }
    }
    WG_BARRIER();
}

__device__ __forceinline__ void copy_map(Frame& F, int c, size_t& src, float*& dst) {
    constexpr int C0 = 65536, C1 = 262144, C2 = 1048576, CS = 65536, CCP = 4608;
    int r = c, srow, scol;
    if (r < C0 + C1 + C2) {
        int g, kl; if (r < C0) { g = 0; kl = 7; dst = F.out + O_KVP0; } else if (r < C0 + C1) { r -= C0; g = 1; kl = 9; dst = F.out + O_KVP1; } else { r -= C0 + C1; g = 2; kl = 11; dst = F.out + O_KVP2; }
        const int e8 = r & 15, hh = (r >> 4) & 3, kv = (r >> 6) & 1, rr = (r >> 7) & ((1 << kl) - 1), bb = r >> (7 + kl);
        srow = bb * SEQ + SEQ - (1 << kl) + rr; scol = (kv ? U_VA : U_KA) + (g * 4 + hh) * 128 + e8 * 8; dst += (size_t)r * 8;
    } else if ((r -= C0 + C1 + C2) < 3 * CS) {
        const int g = r >> 16; r &= 65535; dst = F.out + (g == 0 ? O_KVS0 : (g == 1 ? O_KVS1 : O_KVS2)) + (size_t)r * 8;
        const int e8 = r & 15, hh = (r >> 4) & 3, kv = (r >> 6) & 1, ss = (r >> 7) & 3, bb = r >> 9;
        srow = MP + 4 * bb + ss; scol = (kv ? U_VA : U_KA) + (g * 4 + hh) * 128 + e8 * 8;
    } else if ((r -= 3 * CS) < CCP) {
        const int ch8 = r % 384, i = (r / 384) % 3, bb = r / 1152; dst = F.out + O_CONVP + (size_t)r * 8;
        srow = bb * SEQ + SEQ - 3 + i; scol = U_QKVB + ch8 * 8;
    } else {
        r -= CCP; const int ch8 = r % 384, i = (r / 384) % 3, bb = r / 1152; dst = F.out + O_CONVS + (size_t)r * 8;
        srow = MP + 4 * bb + 1 + i; scol = U_QKVB + ch8 * 8;
    }
    src = (size_t)srow * NINP + scol;
}
constexpr int COPY_TOT = 65536 + 262144 + 1048576 + 3 * 65536 + 4608 + 147456, COPY_ITEMS = 512, COPY_PER = (COPY_TOT + COPY_ITEMS - 1) / COPY_ITEMS;
__device__ __forceinline__ void copy_item(Frame& F, int item) {
    const bf16* U = (const bf16*)(F.ws + WS_U);
    const int lo = item * COPY_PER, hi = (lo + COPY_PER < COPY_TOT) ? lo + COPY_PER : COPY_TOT;
    for (int c0 = lo + F.tid; c0 < hi; c0 += 4 * 512) {
        v4u v[4]; float* dst[4];
#pragma unroll
        for (int k = 0; k < 4; ++k) { const int c = c0 + k * 512; dst[k] = nullptr; v[k] = (v4u){0u, 0u, 0u, 0u}; if (c < hi) { size_t so; copy_map(F, c, so, dst[k]); v[k] = *(const GAS v4u*)(U + so); } }
#pragma unroll
        for (int k = 0; k < 4; ++k) if (dst[k]) { *(GAS f32x4*)dst[k] = (f32x4){bflo(v[k].x), bfhi(v[k].x), bflo(v[k].y), bfhi(v[k].y)}; *(GAS f32x4*)(dst[k] + 4) = (f32x4){bflo(v[k].z), bfhi(v[k].z), bflo(v[k].w), bfhi(v[k].w)}; }
    }
}

constexpr int AT_K = 0, AT_V = 69632;
__device__ __forceinline__ int at_off(int row, int ch) { return 256 * row + 16 * (ch ^ (((row & 3) << 2) | ((row >> 2) & 3))); }
__device__ __forceinline__ void tr_read10(unsigned a, bf16x4 (&lo)[5], bf16x4 (&hi)[5]) {
    asm volatile("ds_read_b64_tr_b16 %0, %10\n\tds_read_b64_tr_b16 %1, %10 offset:4096\n\tds_read_b64_tr_b16 %2, %10 offset:8192\n\tds_read_b64_tr_b16 %3, %10 offset:12288\n\t"
                 "ds_read_b64_tr_b16 %4, %10 offset:16384\n\tds_read_b64_tr_b16 %5, %10 offset:20480\n\tds_read_b64_tr_b16 %6, %10 offset:24576\n\tds_read_b64_tr_b16 %7, %10 offset:28672\n\t"
                 "ds_read_b64_tr_b16 %8, %10 offset:32768\n\tds_read_b64_tr_b16 %9, %10 offset:36864\n\ts_waitcnt lgkmcnt(0)"
                 : "=&v"(lo[0]), "=&v"(hi[0]), "=&v"(lo[1]), "=&v"(hi[1]), "=&v"(lo[2]), "=&v"(hi[2]), "=&v"(lo[3]), "=&v"(hi[3]), "=&v"(lo[4]), "=&v"(hi[4]) : "v"(a) : "memory"); }

struct AtDec { int h, b, g, dil, r, blk, hh; };
__device__ __forceinline__ AtDec at_decode(int unit) {
    AtDec d; d.h = unit & 3; const int rb = (unit >> 2) & 31; d.b = (unit >> 7) & 3; d.g = unit >> 9;
    d.dil = d.g == 0 ? 1 : (d.g == 1 ? 4 : 16); const int nb = 32 / d.dil; d.r = rb / nb; d.blk = rb % nb; d.hh = d.g * 4 + d.h; return d;
}
template <int WHICH>
__device__ __forceinline__ void at_issue(Frame& F, const AtDec& d) {
    LAS unsigned char* L = F.ldv; LAS unsigned char* Ls = F.lds;
    const int tid = F.tid, w = F.wave;
    constexpr int REG = WHICH ? AT_V : AT_K;
    const int t4 = tid >> 4, ch = (tid & 15) ^ (((t4 & 3) << 2) | ((t4 >> 2) & 3));
    const unsigned voff = (unsigned)(t4 * d.dil * NINP + ch * 8) * 2u;
    const char* ub = (const char*)(F.ws + WS_U) + ((size_t)(d.b * SEQ + (d.blk * 128 - 128) * d.dil + d.r) * NINP + (WHICH ? U_VA : U_KA) + d.hh * 128) * 2;
    const size_t slab = (size_t)32 * d.dil * NINP * 2;
#pragma unroll 1
    for (int it = 0; it < 8; ++it) {
        if (d.blk > 0 || it >= 4) __builtin_amdgcn_global_load_lds((const unsigned*)(ub + it * slab + voff), (LAS unsigned*)(Ls + REG + (it * 512 + w * 64) * 16), 16, 0, 0);
        else *(LAS v4u*)(L + REG + (tid + 512 * it) * 16) = (v4u){0u, 0u, 0u, 0u}; }
    if (tid < 256) *(LAS v4u*)(L + REG + (4096 + tid) * 16) = (v4u){0u, 0u, 0u, 0u};
}
__device__ __forceinline__ void attn_prompt_loop(Frame& F, int qh, int nunits, bool enabled, int abl) {
#ifdef NO_PATTN
    return;
#endif
    LAS unsigned char* L = F.ldv;
    const int lane = F.lane, w = F.wave, m16 = lane & 15, kg = lane >> 4;
    const bf16* U = (const bf16*)(F.ws + WS_U); bf16* OG = (bf16*)(F.ws + WS_OG); float* LSE = (float*)(F.ws + WS_LSE);
    int unit = (abl & 16) ? F.bx : q_next(F, qh);
    if (unit >= nunits || !enabled) { while (unit < nunits) unit = q_next(F, qh); return; }
    AtDec d = at_decode(unit);
    if (!(abl & 1)) { at_issue<0>(F, d); at_issue<1>(F, d); }
    for (;;) {
        const int nunit = (abl & 16) ? unit + F.G : q_next(F, qh); const bool more = nunit < nunits;
        AtDec dn = at_decode(more ? nunit : 0);
        const float slope = exp2f(-8.0f * (float)(d.hh + 1) / 12.0f) * (float)d.dil;
        const int qi = 16 * w + m16; const size_t qrow = (size_t)(d.b * SEQ + (d.blk * 128 + qi) * d.dil + d.r);
        bf16x8 qf[4];
#pragma unroll
        for (int kb = 0; kb < 4; ++kb) qf[kb] = *(const GAS bf16x8*)(U + qrow * NINP + U_QA + d.hh * 128 + 32 * kb + 8 * kg);
        asm volatile("s_waitcnt vmcnt(0)" ::: "memory");
        WG_BARRIER();
        f32x4 S[10];
        int kbase[4];
#pragma unroll
        for (int kb = 0; kb < 4; ++kb) kbase[kb] = AT_K + at_off(16 * w + m16, 4 * kb + kg);
#pragma unroll
        for (int kt = 0; kt < 9; ++kt) { S[kt] = (f32x4){0.f, 0.f, 0.f, 0.f};
            if (!(abl & 2)) {
#pragma unroll
            for (int kb = 0; kb < 4; ++kb) S[kt] = mfma16(*(const LAS bf16x8*)(L + kbase[kb] + kt * 4096), qf[kb], S[kt]); } }
        S[9] = (f32x4){0.f, 0.f, 0.f, 0.f};
        WG_BARRIER();
        if (more && !(abl & 1)) at_issue<0>(F, dn);
        const float sc = 0.08838834764831845f * 1.4426950408889634f, sl2 = slope * 1.4426950408889634f;
        float bj[4];
#pragma unroll
        for (int jj = 0; jj < 4; ++jj) bj[jj] = -sl2 * (float)(128 + m16 - 4 * kg - jj);
        float mx = -INFINITY;
#pragma unroll
        for (int kt = 0; kt < 9; ++kt) { const bool tile_ok = d.blk > 0 || (w + kt >= 8); const float tb = sl2 * (float)(16 * kt);
#pragma unroll
            for (int jj = 0; jj < 4; ++jj) { float v = S[kt][jj] * sc + (bj[jj] + tb);
                if (kt == 0) v = (m16 <= 4 * kg + jj) ? v : -INFINITY;
                if (kt == 8) v = (m16 >= 4 * kg + jj) ? v : -INFINITY;
                v = tile_ok ? v : -INFINITY; S[kt][jj] = v; mx = fmaxf(mx, v); } }
        mx = fmaxf(mx, __shfl_xor(mx, 16)); mx = fmaxf(mx, __shfl_xor(mx, 32));
        float sum = 0.f;
#pragma unroll
        for (int kt = 0; kt < 9; ++kt)
#pragma unroll
            for (int jj = 0; jj < 4; ++jj) { const float p = __builtin_amdgcn_exp2f(S[kt][jj] - mx); S[kt][jj] = p; sum += p; }
        sum += __shfl_xor(sum, 16); sum += __shfl_xor(sum, 32);
        bf16x8 pb[5];
#pragma unroll
        for (int kb2 = 0; kb2 < 5; ++kb2) pb[kb2] = pack8(S[2 * kb2], S[2 * kb2 + 1]);
        f32x4 O[8];
        const int rq = m16 >> 2, cq = m16 & 3;
        unsigned vbase[8];
#pragma unroll
        for (int dt = 0; dt < 8; ++dt) vbase[dt] = (unsigned)(AT_V + at_off(16 * w + 4 * kg + rq, 2 * dt + (cq >> 1)) + 8 * (cq & 1));
#pragma unroll
        for (int dt = 0; dt < 8; ++dt) { O[dt] = (f32x4){0.f, 0.f, 0.f, 0.f}; if (abl & 4) continue; bf16x4 lo[5], hi[5]; tr_read10(vbase[dt], lo, hi);
#pragma unroll
            for (int kb2 = 0; kb2 < 5; ++kb2) { bf16x8 vf; vf[0] = lo[kb2][0]; vf[1] = lo[kb2][1]; vf[2] = lo[kb2][2]; vf[3] = lo[kb2][3]; vf[4] = hi[kb2][0]; vf[5] = hi[kb2][1]; vf[6] = hi[kb2][2]; vf[7] = hi[kb2][3];
                O[dt] = mfma16(vf, pb[kb2], O[dt]); } }
        WG_BARRIER();
        if (more && !(abl & 1)) at_issue<1>(F, dn);
        const float inv = __builtin_amdgcn_rcpf(sum);
        if (!(abl & 8))
#pragma unroll
        for (int dt = 0; dt < 8; ++dt) { v2u o; o.x = pk2(O[dt][0] * inv, O[dt][1] * inv); o.y = pk2(O[dt][2] * inv, O[dt][3] * inv);
            *(GAS v2u*)(OG + qrow * 1536 + d.hh * 128 + 16 * dt + 4 * kg) = o; }
        if (kg == 0) LSE[qrow * 12 + d.hh] = (mx + log2f(sum)) * 0.6931471805599453f;
        if (!more) break;
        d = dn; unit = nunit;
    }
    WG_BARRIER();
}

__device__ __forceinline__ float half_sum(float v) { v = row_sum16(v); v += __shfl_xor(v, 16); return v; }
__device__ __forceinline__ void attn_sample_unit(Frame& F, int unit) {
#ifdef NO_SATTN
    return;
#endif
    const int lane = F.lane, w = F.wave;
    const bf16* U = (const bf16*)(F.ws + WS_U); bf16* OG = (bf16*)(F.ws + WS_OG); float* LSE = (float*)(F.ws + WS_LSE);
    const int b = unit & 127, g = unit >> 7;
    const int s = w & 3, h = 2 * (w >> 2) + (lane >> 5), dl = lane & 31, hh = g * 4 + h;
    const int dil = g == 0 ? 1 : (g == 1 ? 4 : 16), wb = g == 0 ? 128 : (g == 1 ? 512 : 2048);
    const float* cache = F.in[g == 0 ? IN_C128 : (g == 1 ? IN_C512 : IN_C2048)] + (size_t)b * wb * 1024 + h * 128 + 4 * dl;
    const float L2E = 1.4426950408889634f;
    const float sl2 = exp2f(-8.0f * (float)(hh + 1) / 12.0f) * (float)dil * L2E;
    const size_t qrow = (size_t)(MP + 4 * b + s);
    f32x4 q; { const v2u qq = *(const GAS v2u*)(U + qrow * NINP + U_QA + hh * 128 + 4 * dl); const float sc = 0.08838834764831845f * L2E;
        q = (f32x4){bflo(qq.x) * sc, bfhi(qq.x) * sc, bflo(qq.y) * sc, bfhi(qq.y) * sc}; }
    float m = -INFINITY, l = 0.f; f32x4 o = {0.f, 0.f, 0.f, 0.f};
    const int jn = (g == 0) ? s : 0;
    for (int j = 0; j <= jn; ++j) { const size_t kr = (size_t)(MP + 4 * b + s - dil * j) * NINP + hh * 128 + 4 * dl;
        const v2u kk = *(const GAS v2u*)(U + kr + U_KA), vv = *(const GAS v2u*)(U + kr + U_VA);
        const float sc = half_sum(bflo(kk.x) * q[0] + bfhi(kk.x) * q[1] + bflo(kk.y) * q[2] + bfhi(kk.y) * q[3]) - sl2 * (float)j;
        const float mn = fmaxf(m, sc), al = exp2f(m - mn), p = exp2f(sc - mn); m = mn; l = l * al + p;
        o = o * al + (f32x4){bflo(vv.x), bfhi(vv.x), bflo(vv.y), bfhi(vv.y)} * p; }
    f32x4 kA[8], vA[8], kB[8], vB[8];
#define SA_LOAD(KF, VF, BLK) do { _Pragma("unroll") for (int i = 0; i < 8; ++i) { const int j = jn + 1 + 8 * (BLK) + i; int idx = wb + s - dil * j; idx = idx < 0 ? 0 : idx; \
        KF[i] = *(const GAS f32x4*)(cache + (size_t)idx * 1024); VF[i] = *(const GAS f32x4*)(cache + (size_t)idx * 1024 + 512); } } while (0)
#define SA_COMP(KF, VF, BLK) do { float sc[8]; float mb = -INFINITY; \
        _Pragma("unroll") for (int i = 0; i < 8; ++i) { const int j = jn + 1 + 8 * (BLK) + i; \
            float d = half_sum(KF[i][0] * q[0] + KF[i][1] * q[1] + KF[i][2] * q[2] + KF[i][3] * q[3]) - sl2 * (float)j; \
            d = (j <= 128) ? d : -INFINITY; sc[i] = d; mb = fmaxf(mb, d); } \
        const float mn = fmaxf(m, mb), al = exp2f(m - mn); m = mn; l *= al; o = o * al; \
        _Pragma("unroll") for (int i = 0; i < 8; ++i) { const float p = exp2f(sc[i] - mn); l += p; o = o + VF[i] * p; } } while (0)
    SA_LOAD(kA, vA, 0);
    for (int blk = 0; blk < 16; blk += 2) {
        SA_LOAD(kB, vB, blk + 1);
        SA_COMP(kA, vA, blk);
        if (blk + 2 < 16) SA_LOAD(kA, vA, blk + 2);
        SA_COMP(kB, vB, blk + 1);
    }
#undef SA_LOAD
#undef SA_COMP
    const float inv = 1.0f / l;
    v2u ov; ov.x = pk2(o[0] * inv, o[1] * inv); ov.y = pk2(o[2] * inv, o[3] * inv);
    *(GAS v2u*)(OG + qrow * 1536 + hh * 128 + 4 * dl) = ov;
    if (dl == 0) LSE[qrow * 12 + hh] = (m + log2f(l)) * 0.6931471805599453f;
}

__device__ __forceinline__ void attn_merge(Frame& F) {
    const bf16* OG = (const bf16*)(F.ws + WS_OG); const float* LSE = (const float*)(F.ws + WS_LSE); bf16* OA = (bf16*)(F.ws + WS_OA);
    const long gt = (long)F.bx * 512 + F.tid, NT = (long)F.G * 512;
    for (long c = gt; c < (long)MT * 64; c += NT) {
        const int row = (int)(c >> 6), hs = (int)(c >> 4) & 3, e8 = (int)c & 15;
        const float l0 = LSE[(size_t)row * 12 + hs], l1 = LSE[(size_t)row * 12 + 4 + hs], l2 = LSE[(size_t)row * 12 + 8 + hs];
        const float m = fmaxf(l0, fmaxf(l1, l2)); float w0 = __expf(l0 - m), w1 = __expf(l1 - m), w2 = __expf(l2 - m); const float inv = 1.0f / (w0 + w1 + w2); w0 *= inv; w1 *= inv; w2 *= inv;
        const v4u a = *(const GAS v4u*)(OG + (size_t)row * 1536 + hs * 128 + e8 * 8), bq = *(const GAS v4u*)(OG + (size_t)row * 1536 + (4 + hs) * 128 + e8 * 8), cq = *(const GAS v4u*)(OG + (size_t)row * 1536 + (8 + hs) * 128 + e8 * 8);
        v4u o;
        o.x = pk2(w0 * bflo(a.x) + w1 * bflo(bq.x) + w2 * bflo(cq.x), w0 * bfhi(a.x) + w1 * bfhi(bq.x) + w2 * bfhi(cq.x));
        o.y = pk2(w0 * bflo(a.y) + w1 * bflo(bq.y) + w2 * bflo(cq.y), w0 * bfhi(a.y) + w1 * bfhi(bq.y) + w2 * bfhi(cq.y));
        o.z = pk2(w0 * bflo(a.z) + w1 * bflo(bq.z) + w2 * bflo(cq.z), w0 * bfhi(a.z) + w1 * bfhi(bq.z) + w2 * bfhi(cq.z));
        o.w = pk2(w0 * bflo(a.w) + w1 * bflo(bq.w) + w2 * bflo(cq.w), w0 * bfhi(a.w) + w1 * bfhi(bq.w) + w2 * bfhi(cq.w));
        *(GAS v4u*)(OA + (size_t)row * 512 + hs * 128 + e8 * 8) = o;
    }
}

#ifndef MK_N_LAUNCHES
#define MK_N_LAUNCHES 1
#endif
constexpr int N_PHASES = 12;
struct Args { const float* in[23]; float* out; unsigned char* ws; int ph_lo, ph_hi, sub, qi; };
static_assert(sizeof(Args) == 23 * 8 + 8 + 8 + 16, "Args has no padding");

#ifndef PH5_MASK
#define PH5_MASK 7
#endif
__device__ __forceinline__ void phase5(Frame& F, int qi, int sub) {
    if ((sub & 1) && F.bx < NB * 8) gdn_scan_chain(F, F.bx);
    if (F.bx >= 32 && F.bx < 96) for (;;) { const int u = q_next(F, 5 * qi); if (u >= 128) break; if (sub & 16) attn_sample_unit(F, 256 + u); }
    for (;;) { const int u = q_next(F, 5 * qi + 1); if (u >= DB * 8) break; if (sub & 32) gdn_sample_unit(F, u >> 3, u & 7); }
    for (;;) { const int u = q_next(F, 5 * qi + 2); if (u >= 256) break; if (sub & 2) attn_sample_unit(F, (u < 128) ? 128 + u : u - 128); }
    for (;;) { const int u = q_next(F, 5 * qi + 3); if (u >= COPY_ITEMS) break; if (sub & 64) copy_item(F, u); }
    attn_prompt_loop(F, 5 * qi + 4, 1536, (sub & 4) != 0, sub >> 8);
}
__global__ void __launch_bounds__(NWAVES * 64, 2) mk_fwd(Args args) {
    extern __shared__ __attribute__((aligned(16))) unsigned char lds[];
    Frame F;
    F.lds = (LAS unsigned char*)lds;
    { unsigned z = 0u; asm volatile("" : "+v"(z)); F.ldv = (LAS unsigned char*)lds + z; }
    F.MISC = (volatile LAS unsigned*)(F.lds + MISC_OFF);
    F.tid = threadIdx.x; F.lane = F.tid & 63; F.wave = __builtin_amdgcn_readfirstlane(F.tid >> 6);
    F.G = gridDim.x; F.bx = blockIdx.x;
    F.ws = args.ws; F.out = args.out; F.ctl = (gu32*)(args.ws + WS_CTL);
    F.in = args.in;
    for (int u = F.tid; u < (LDS_BYTES - LDSCTL_OFF) / 4; u += NWAVES * 64) ((LAS unsigned*)(F.lds + LDSCTL_OFF))[u] = 0u;
    __syncthreads();
    const bool one = (args.ph_hi - args.ph_lo) > 1;
    XcdBarrier bar; bar.bar = (unsigned*)(F.ctl + CW_BAR); bar.x = 0; bar.st = nullptr;
    if (one) bar = xcd_barrier_post((unsigned*)(F.ctl + CW_BAR), F.MISC + 8);
    const int lo = args.ph_lo, hi = args.ph_hi;
#ifndef PHASE_MASK
#define PHASE_MASK 0xFFF
#endif
#define IN(k) ((((PHASE_MASK) >> (k)) & 1) && lo <= (k) && (k) < hi)
#define SEAM(k) do { if (IN(k) && IN((k) + 1)) xcd_barrier(bar); } while (0)

    bf16* XB = (bf16*)(F.ws + WS_XB); bf16* ACT = (bf16*)(F.ws + WS_ACT); float* X1 = (float*)(F.ws + WS_X1); bf16* X1B = (bf16*)(F.ws + WS_X1B);
    bf16* UU = (bf16*)(F.ws + WS_U); float* BA = (float*)(F.ws + WS_BA); bf16* OB = (bf16*)(F.ws + WS_OB); bf16* OA = (bf16*)(F.ws + WS_OA);
    bf16* M1 = (bf16*)(F.ws + WS_M1); bf16* MG = (bf16*)(F.ws + WS_MG); float* X2 = (float*)(F.ws + WS_X2); bf16* X2B = (bf16*)(F.ws + WS_X2B);
    float* SSQ2 = (float*)(args.ws + WS_CTL) + CW_SSQ2; float* SSQ3 = (float*)(args.ws + WS_CTL) + CW_SSQ3; float* SSQ4 = (float*)(args.ws + WS_CTL) + CW_SSQ4;

#ifndef DUP_MASK
#define DUP_MASK 0
#endif
#define DUP(k) (((DUP_MASK) >> (k)) & 1)
    if (IN(0)) { p0_prologue(F); } SEAM(0);
    if (IN(1)) {
        pg8::Gemm g{XB, (const bf16*)(F.ws + WS_W1A), MT, NGU, D}; pg8::StaticOrder S; S.init(MT, NGU, F.G, F.bx);
        pg8::EpiSwiglu E{ACT, (const float*)(F.ws + WS_RSTD1), 0};
        pg8::gemm_phase<pg8::EpiSwiglu, pg8::StaticOrder, true, true>(F.lds + RING_OFF, g, S, E);
    } SEAM(1);
    if (IN(2)) {
        pg8::Gemm g{ACT, (const bf16*)(F.ws + WS_W1B), MP, D, FF}; pg8::StaticOrder S; S.init(MP, D, F.G, F.bx);
        pg8::EpiResidB<0> E{F.in[IN_XP], F.in[IN_XS] - (size_t)MP * D, nullptr, X1B, nullptr, SSQ2, 0.5f};
        pg8::gemm_phase<pg8::EpiResidB<0>, pg8::StaticOrder, true, true>(F.lds + RING_OFF, g, S, E);
        if (args.sub & 8) skinny_resid<FF, 0>(F, ACT, (const bf16*)(F.ws + WS_W1B), F.in[IN_XS] - (size_t)MP * D, nullptr, X1B, nullptr, SSQ2, 0.5f);
    } SEAM(2);
    if (IN(3)) {
        pg8::Gemm g{X1B, (const bf16*)(F.ws + WS_WIN), MT, U_BA, D}; pg8::StaticOrder S; S.init(MT, U_BA, F.G, F.bx);
        pg8::EpiU E{UU, BA, SSQ2};
        pg8::gemm_phase<pg8::EpiU, pg8::StaticOrder, true, true>(F.lds + RING_OFF, g, S, E);
        skinny_ba(F, X1B, (const bf16*)(F.ws + WS_WIN), SSQ2, BA);
    } SEAM(3);
    if (IN(4)) {
        if (args.sub & 1) { PrepIn pin; int i = F.bx;
            if (i < NREC) prep_fetch(F, (i & 31) >> 3, i & 7, i >> 5, pin);
            for (; i < NREC; i += F.G) { const int nx = i + F.G; gdn_prep_unit(F, (i & 31) >> 3, i & 7, i >> 5, pin, nx < NREC, (nx & 31) >> 3, nx & 7, nx >> 5, args.sub >> 8); } }
    } SEAM(4);
    if (IN(5)) {
        phase5(F, args.qi, args.sub);
    } SEAM(5);
    if (IN(6)) { attn_merge(F); } SEAM(6);
    if (IN(7)) {
        { pg8::Gemm g{OA, (const bf16*)(F.ws + WS_WPA), MP, D, 512}; pg8::StaticOrder S; S.init(MP, D, F.G, F.bx);
          pg8::EpiGate<0> E{UU, nullptr, M1};
          pg8::gemm_phase<pg8::EpiGate<0>, pg8::StaticOrder, true, true>(F.lds + RING_OFF, g, S, E); }
        { pg8::Gemm g{OB, (const bf16*)(F.ws + WS_WPB), MP, D, D}; pg8::StaticOrder S; S.init(MP, D, F.G, F.bx);
          pg8::EpiGate<1> E{UU, M1, MG};
          pg8::gemm_phase<pg8::EpiGate<1>, pg8::StaticOrder, true, true>(F.lds + RING_OFF, g, S, E); }
        if (args.sub & 8) skinny_merge(F, OA, (const bf16*)(F.ws + WS_WPA), OB, (const bf16*)(F.ws + WS_WPB), UU, MG);
    } SEAM(7);
    if (IN(8)) {
        pg8::Gemm g{MG, (const bf16*)(F.ws + WS_WOUT), MP, D, D}; pg8::StaticOrder S; S.init(MP, D, F.G, F.bx);
        pg8::EpiResidB<1> E{nullptr, nullptr, X1B, X2B, nullptr, SSQ3, 1.0f};
        pg8::gemm_phase<pg8::EpiResidB<1>, pg8::StaticOrder, true, true>(F.lds + RING_OFF, g, S, E);
        skinny_resid<D, 1>(F, MG, (const bf16*)(F.ws + WS_WOUT), nullptr, X1B, X2B, nullptr, SSQ3, 1.0f);
    } SEAM(8);
    if (IN(9)) {
        pg8::Gemm g{X2B, (const bf16*)(F.ws + WS_W2A), MT, NGU, D}; pg8::StaticOrder S; S.init(MT, NGU, F.G, F.bx);
        pg8::EpiSwiglu E{ACT, SSQ3, 1};
        pg8::gemm_phase<pg8::EpiSwiglu, pg8::StaticOrder, true, true>(F.lds + RING_OFF, g, S, E);
    } SEAM(9);
    if (IN(10)) {
        pg8::Gemm g{ACT, (const bf16*)(F.ws + WS_W2B), MP, D, FF}; pg8::StaticOrder S; S.init(MP, D, F.G, F.bx);
        pg8::EpiResidB<2> E{nullptr, nullptr, X2B, nullptr, F.out + O_Y, SSQ4, 0.5f};
        pg8::gemm_phase<pg8::EpiResidB<2>, pg8::StaticOrder, true, true>(F.lds + RING_OFF, g, S, E);
        skinny_resid<FF, 2>(F, ACT, (const bf16*)(F.ws + WS_W2B), nullptr, X2B, nullptr, F.out + O_Y, SSQ4, 0.5f);
    } SEAM(10);
    if (IN(11)) { final_norm(F); }
#undef IN
#undef SEAM
}

extern "C" void kernel_launch(void* const* d_in, const int* in_sizes, int n_in, void* d_out, int out_size, void* d_ws, size_t ws_size, hipStream_t stream) {
    static int grid = 0;
    if (grid == 0) {
        if (n_in != 23 || out_size != (int)O_END || ws_size < WS_END) { fprintf(stderr, "kernel_launch: unexpected sizes n_in %d out %d ws %zu (need %zu)\n", n_in, out_size, ws_size, (size_t)WS_END); grid = -1; return; }
        int dev = 0, cus = 0, per_cu = 0;
        if (hipGetDevice(&dev) != hipSuccess || hipDeviceGetAttribute(&cus, hipDeviceAttributeMultiprocessorCount, dev) != hipSuccess) { grid = -1; return; }
        if (hipFuncSetAttribute((const void*)mk_fwd, hipFuncAttributeMaxDynamicSharedMemorySize, LDS_BYTES) != hipSuccess) { fprintf(stderr, "kernel_launch: hipFuncSetAttribute failed\n"); grid = -1; return; }
        if (hipOccupancyMaxActiveBlocksPerMultiprocessor(&per_cu, (const void*)mk_fwd, NWAVES * 64, LDS_BYTES) != hipSuccess || per_cu < 1) { fprintf(stderr, "kernel_launch: occupancy query says %d\n", per_cu); per_cu = 1; }
        (void)hipGetLastError();
        grid = cus;
    }
    if (grid < 0) return;
    if (hipMemsetAsync((char*)d_ws + WS_CTL, 0, CTL_ZERO_BYTES, stream) != hipSuccess) return;
    Args a{};
    for (int i = 0; i < 23; ++i) a.in[i] = (const float*)d_in[i];
    a.out = (float*)d_out; a.ws = (unsigned char*)d_ws;
#if MK_N_LAUNCHES == 1
    a.ph_lo = 0; a.ph_hi = N_PHASES; a.sub = 127; a.qi = 0;
    hipLaunchKernelGGL(mk_fwd, dim3(grid), dim3(NWAVES * 64), LDS_BYTES, stream, a);
#ifdef EXTRA_MASK
    for (int p = 0; p < N_PHASES; ++p) if ((EXTRA_MASK >> p) & 1) { a.ph_lo = p; a.ph_hi = p + 1; a.sub = EXTRA_SUB; a.qi = 1; hipLaunchKernelGGL(mk_fwd, dim3(grid), dim3(NWAVES * 64), LDS_BYTES, stream, a); }
#endif
#else
    a.sub = 127; a.qi = 0;
    for (int p = 0; p < N_PHASES; ++p) { a.ph_lo = p; a.ph_hi = p + 1; hipLaunchKernelGGL(mk_fwd, dim3(grid), dim3(NWAVES * 64), LDS_BYTES, stream, a); }
#endif
}
```

```cpp
#include <hip/hip_runtime.h>
#include <cstdio>
#include <cstdint>
#define MK_N_LAUNCHES 1
namespace pg8 {
#define PG8_LAS __attribute__((address_space(3)))
typedef unsigned short bf16_t;
typedef short bf16x8 __attribute__((ext_vector_type(8)));
typedef float f32x4 __attribute__((ext_vector_type(4)));
typedef unsigned u32x4 __attribute__((ext_vector_type(4)));
constexpr int BM = 256, BK = 64, HALF = 128, HTB = HALF * BK * 2  , STAGE_BYTES = 8 * HTB, NXCD = 8, WGM = 8;

__host__ __device__ __forceinline__ int lds_byte(int r, int c) { const int st = (r >> 4) * 2 + (c >> 5), rr = r & 15, cc = c & 31, ob = rr * 64 + cc * 2; return st * 1024 + (ob ^ (((ob >> 9) & 1) << 5)); }
__host__ __device__ __forceinline__ void stage_rc(int b, int& R, int& C) { const int st = b / 1024, sb = b % 1024, swz = sb ^ (((sb >> 9) & 1) << 5); R = (st >> 1) * 16 + swz / 64; C = (st & 1) * 32 + (swz % 64) / 2; }
__host__ __device__ __forceinline__ int perm32(int rho) { const int n = rho >> 4, i = rho & 15; return 8 * (i >> 2) + 4 * n + (i & 3); }

struct Unit { int pm, pn; };
struct Gemm { const bf16_t* A; const bf16_t* Bt; int M, N, K; };
struct StaticOrder {
    int nM, nN, nwg, G, c;
    __host__ __device__ void init(int M, int N, int G_, int c_) { nM = M / BM; nN = N / BM; nwg = nM * nN; G = G_; c = c_; }
    __host__ __device__ bool next(int i, Unit& u) const {
        const long L = (long)i * G + c; if (L >= nwg) return false;
        int wgid = (int)L; { const int q = nwg / NXCD, r = nwg % NXCD, xcd = wgid % NXCD, off = wgid / NXCD; wgid = (xcd < r ? xcd * (q + 1) : r * (q + 1) + (xcd - r) * q) + off; }
        const int nig = WGM * nN, gid = wgid / nig, fm = gid * WGM, gsz = (nM - fm) < WGM ? (nM - fm) : WGM;
        u.pm = fm + ((wgid % nig) % gsz); u.pn = (wgid % nig) / gsz; return true;
    }
    __device__ __forceinline__ void a_ready(const Unit&) const {}
    __device__ __forceinline__ void done(const Unit&) const {}
};
__device__ __forceinline__ unsigned cvt_pk_bf16(float lo, float hi) { unsigned r; asm volatile("v_cvt_pk_bf16_f32 %0, %1, %2" : "=v"(r) : "v"(lo), "v"(hi)); return r; }
typedef float f32x2 __attribute__((ext_vector_type(2)));
template <class Epi, class Sched, bool ALIGN_EPI = false, bool SP2 = false>
__device__ __forceinline__ void gemm_phase(PG8_LAS unsigned char* lds, const Gemm g, const Sched& S, const Epi& E) {
    const int tid = threadIdx.x, wid = __builtin_amdgcn_readfirstlane(tid >> 6), lane = tid & 63, wr = wid >> 2, wc = wid & 3, fr = lane & 15, fq = lane >> 4;
    const int K = g.K, nt = K / BK;
    unsigned voffA[2], voffB[2];
#pragma unroll
    for (int i = 0; i < 2; ++i) { int R, C; stage_rc(tid * 16 + i * 8192, R, C); const int Rb = Epi::PERM ? ((R & ~31) + perm32(R & 31)) : R;
        voffA[i] = (unsigned)(R * K + C) * 2u; voffB[i] = (unsigned)(Rb * K + C) * 2u; }
    const size_t kstep = (size_t)(BK * 2);
    const size_t hstep = (size_t)HALF * K * 2;
    const size_t tstep = 2 * hstep;
    const unsigned ldsw = (unsigned)wid * 1024u;
    const int aoff = lds_byte(wr * 64 + fr, fq * 8), boff = lds_byte(wc * 32 + fr, fq * 8);
#define PG8_SA(b, h) (((b) * 2 + (h)) * HTB)
#define PG8_SB(b, h) ((4 + (b) * 2 + (h)) * HTB)
#define PG8_STAGE(bufoff, gbase, voff) do { _Pragma("unroll") for (int _i = 0; _i < 2; ++_i) \
        __builtin_amdgcn_global_load_lds((const unsigned*)((const char*)(gbase) + (voff)[_i]), (PG8_LAS unsigned*)(lds + (bufoff) + ldsw + _i * 8192), 16, 0, 0); } while (0)
#define PG8_LDA(dst, b, h) do { _Pragma("unroll") for (int m = 0; m < 4; ++m) _Pragma("unroll") for (int k = 0; k < 2; ++k) dst[m][k] = *(const PG8_LAS bf16x8*)(lds + PG8_SA(b, h) + aoff + m * 2048 + k * 1024); } while (0)
#define PG8_LDB(dst, b, h) do { _Pragma("unroll") for (int n = 0; n < 2; ++n) _Pragma("unroll") for (int k = 0; k < 2; ++k) dst[n][k] = *(const PG8_LAS bf16x8*)(lds + PG8_SB(b, h) + boff + n * 2048 + k * 1024); } while (0)
#define PG8_MMA(ai, bj, At, Bt) do { __builtin_amdgcn_s_setprio(1); _Pragma("unroll") for (int m = 0; m < 4; ++m) _Pragma("unroll") for (int n = 0; n < 2; ++n) _Pragma("unroll") for (int k = 0; k < 2; ++k) \
        acc[ai][bj][m][n] = __builtin_amdgcn_mfma_f32_16x16x32_bf16(Bt[n][k], At[m][k], acc[ai][bj][m][n], 0, 0, 0); __builtin_amdgcn_s_setprio(0); } while (0)
#define PG8_WAIT_V(n) asm volatile("s_waitcnt vmcnt(" #n ")" ::: "memory")
#define PG8_WAIT_L(n) asm volatile("s_waitcnt lgkmcnt(" #n ")" ::: "memory")
#define PG8_BAR __builtin_amdgcn_s_barrier()
#define PG8_SCHED __builtin_amdgcn_sched_barrier(0)
    Unit cur, nxt; int ui = 0;
    if (!S.next(0, cur)) return;
    f32x4 acc[2][2][4][2];
#pragma unroll
    for (int a = 0; a < 2; ++a)
#pragma unroll
        for (int b = 0; b < 2; ++b)
#pragma unroll
            for (int m = 0; m < 4; ++m)
#pragma unroll
                for (int n = 0; n < 2; ++n) acc[a][b][m][n] = (f32x4){0.f, 0.f, 0.f, 0.f};
    bf16x8 At[4][2], B0[2][2], B1[2][2];
    const char* cA = (const char*)g.A + (size_t)cur.pm * tstep; const char* cB = (const char*)g.Bt + (size_t)cur.pn * tstep;
    S.a_ready(cur);
    if constexpr (SP2) {
        PG8_STAGE(PG8_SB(0, 0), cB, voffB); PG8_STAGE(PG8_SB(0, 1), cB + hstep, voffB); PG8_STAGE(PG8_SA(0, 0), cA, voffA); PG8_STAGE(PG8_SA(0, 1), cA + hstep, voffA);
        if (wr == 1) PG8_BAR;
        PG8_WAIT_V(2); PG8_BAR;
        PG8_STAGE(PG8_SB(1, 0), cB + kstep, voffB); PG8_STAGE(PG8_SA(1, 0), cA + kstep, voffA); PG8_STAGE(PG8_SB(1, 1), cB + hstep + kstep, voffB);
        PG8_WAIT_V(6); PG8_BAR;
    } else {
        PG8_STAGE(PG8_SB(0, 0), cB, voffB); PG8_STAGE(PG8_SA(0, 0), cA, voffA); PG8_STAGE(PG8_SB(0, 1), cB + hstep, voffB); PG8_STAGE(PG8_SA(0, 1), cA + hstep, voffA);
        if (wr == 1) PG8_BAR;
        PG8_WAIT_V(4); PG8_BAR;
        PG8_STAGE(PG8_SB(1, 0), cB + kstep, voffB); PG8_STAGE(PG8_SA(1, 0), cA + kstep, voffA); PG8_STAGE(PG8_SB(1, 1), cB + hstep + kstep, voffB);
        PG8_WAIT_V(6); PG8_BAR;
    }
    for (;;) {
        const bool has_next = S.next(ui + 1, nxt);
        const char* nA = has_next ? (const char*)g.A + (size_t)nxt.pm * tstep : cA; const char* nB = has_next ? (const char*)g.Bt + (size_t)nxt.pn * tstep : cB;
        for (int t = 0; t < nt; t += 2) {
            const bool last = (t == nt - 2);
            const char* a1 = cA + (size_t)(t + 1) * kstep;
            const char* a2 = last ? nA : cA + (size_t)(t + 2) * kstep; const char* b2 = last ? nB : cB + (size_t)(t + 2) * kstep;
            const char* a3 = a2 + kstep; const char* b3 = b2 + kstep;
            if (last && has_next) S.a_ready(nxt);
            if constexpr (SP2) {
            PG8_LDB(B0, 0, 0); PG8_LDB(B1, 0, 1); PG8_SCHED; PG8_LDA(At, 0, 0); PG8_STAGE(PG8_SA(1, 1), a1 + hstep, voffA);
            PG8_WAIT_V(8); PG8_WAIT_L(0); PG8_BAR; PG8_MMA(0, 0, At, B0); PG8_MMA(0, 1, At, B1); PG8_BAR; PG8_SCHED;
            PG8_LDA(At, 0, 1); PG8_STAGE(PG8_SB(0, 0), b2, voffB); PG8_STAGE(PG8_SB(0, 1), b2 + hstep, voffB); PG8_STAGE(PG8_SA(0, 0), a2, voffA);
            PG8_WAIT_V(8); PG8_WAIT_L(0); PG8_BAR; PG8_MMA(1, 0, At, B0); PG8_MMA(1, 1, At, B1); PG8_BAR; PG8_SCHED;
            PG8_LDB(B0, 1, 0); PG8_LDB(B1, 1, 1); PG8_SCHED; PG8_LDA(At, 1, 0); PG8_STAGE(PG8_SA(0, 1), a2 + hstep, voffA);
            PG8_WAIT_V(8); PG8_WAIT_L(0); PG8_BAR; PG8_MMA(0, 0, At, B0); PG8_MMA(0, 1, At, B1); PG8_BAR; PG8_SCHED;
            PG8_LDA(At, 1, 1); PG8_STAGE(PG8_SB(1, 0), b3, voffB); PG8_STAGE(PG8_SB(1, 1), b3 + hstep, voffB); PG8_STAGE(PG8_SA(1, 0), a3, voffA);
            PG8_WAIT_V(8); PG8_WAIT_L(0); PG8_BAR; PG8_MMA(1, 0, At, B0); PG8_MMA(1, 1, At, B1); PG8_BAR; PG8_SCHED;
            } else {
            PG8_LDB(B0, 0, 0); PG8_SCHED; PG8_LDA(At, 0, 0); PG8_STAGE(PG8_SA(1, 1), a1 + hstep, voffA);
            PG8_WAIT_L(8); PG8_BAR; PG8_WAIT_L(0); PG8_MMA(0, 0, At, B0); PG8_BAR; PG8_SCHED;
            PG8_LDB(B1, 0, 1); PG8_STAGE(PG8_SB(0, 0), b2, voffB);
            PG8_BAR; PG8_WAIT_L(0); PG8_MMA(0, 1, At, B1); PG8_BAR;
            PG8_LDA(At, 0, 1); PG8_STAGE(PG8_SA(0, 0), a2, voffA);
            PG8_BAR; PG8_WAIT_L(0); PG8_MMA(1, 0, At, B0); PG8_BAR; PG8_SCHED;
            PG8_STAGE(PG8_SB(0, 1), b2 + hstep, voffB);
            PG8_WAIT_V(6); PG8_BAR; PG8_MMA(1, 1, At, B1); PG8_BAR;
            PG8_LDB(B0, 1, 0); PG8_SCHED; PG8_LDA(At, 1, 0); PG8_STAGE(PG8_SA(0, 1), a2 + hstep, voffA);
            PG8_WAIT_L(8); PG8_BAR; PG8_WAIT_L(0); PG8_MMA(0, 0, At, B0); PG8_BAR; PG8_SCHED;
            PG8_LDB(B1, 1, 1); PG8_STAGE(PG8_SB(1, 0), b3, voffB);
            PG8_BAR; PG8_WAIT_L(0); PG8_MMA(0, 1, At, B1); PG8_BAR;
            PG8_LDA(At, 1, 1); PG8_STAGE(PG8_SA(1, 0), a3, voffA);
            PG8_BAR; PG8_WAIT_L(0); PG8_MMA(1, 0, At, B0); PG8_BAR; PG8_SCHED;
            PG8_STAGE(PG8_SB(1, 1), b3 + hstep, voffB);
            PG8_WAIT_V(6); PG8_BAR; PG8_MMA(1, 1, At, B1); PG8_BAR;
            }
        }
        if constexpr (ALIGN_EPI) { if (wr == 0) PG8_BAR; }
        if constexpr (!Epi::AFTER_DRAIN) { E(acc, cur, wr, wc, fr, fq); S.done(cur); }
        if (!has_next) break;
#pragma unroll
        for (int a = 0; a < 2; ++a)
#pragma unroll
            for (int b = 0; b < 2; ++b)
#pragma unroll
                for (int m = 0; m < 4; ++m)
#pragma unroll
                    for (int n = 0; n < 2; ++n) acc[a][b][m][n] = (f32x4){0.f, 0.f, 0.f, 0.f};
        cur = nxt; cA = nA; cB = nB; ++ui;
        if constexpr (ALIGN_EPI) { if (wr == 1) PG8_BAR; }
    }
    PG8_WAIT_V(0);
    if constexpr (!ALIGN_EPI) { if (wr == 0) PG8_BAR; }
    PG8_BAR;
    if constexpr (Epi::AFTER_DRAIN) { E.fused(acc, cur, wr, wc, fr, fq, lds, wid, lane); S.done(cur); }
#undef PG8_SA
#undef PG8_SB
#undef PG8_STAGE
#undef PG8_LDA
#undef PG8_LDB
#undef PG8_MMA
#undef PG8_WAIT_V
#undef PG8_WAIT_L
#undef PG8_BAR
#undef PG8_SCHED
}
}

constexpr int D = 1024, MP = 16384, MS = 512, MT = MP + MS, FF = 2816, NGU = 2 * FF;
constexpr int SEQ = 4096, NB = 4, DB = 128, DS = 4;
constexpr int NIN = 10768, NINP = 11008;
constexpr int U_QA = 0, U_KA = 1536, U_VA = 3072, U_QKVB = 4608, U_Z = 7680, U_GATE = 8704, U_BA = 10752;
constexpr float EPS = 1e-6f;

namespace pg8 {
typedef unsigned u32x2 __attribute__((ext_vector_type(2)));
__device__ __forceinline__ float sigm(float x) { return __builtin_amdgcn_rcpf(1.f + __expf(-x)); }
__device__ __forceinline__ float bf2f(unsigned short b) { return __uint_as_float(((unsigned)b) << 16); }
__device__ __forceinline__ float bflo(unsigned w) { return __uint_as_float(w << 16); }
__device__ __forceinline__ float bfhi(unsigned w) { return __uint_as_float(w & 0xffff0000u); }

struct EpiSwiglu {
    static constexpr bool PERM = true, AFTER_DRAIN = false;
    bf16_t* O; const float* rs; int mode;
    __device__ __forceinline__ void operator()(const f32x4 (&acc)[2][2][4][2], const Unit& u, int wr, int wc, int fr, int fq) const {
        const int row0 = u.pm * BM + wr * 64 + fr, col0 = u.pn * 128 + wc * 32 + 8 * fq;
#pragma unroll
        for (int ai = 0; ai < 2; ++ai)
#pragma unroll
            for (int m = 0; m < 4; ++m) {
                const int row = row0 + ai * HALF + m * 16;
                float r = rs[row]; if (mode) r = rsqrtf(r * (1.0f / D) + EPS);
                float o[8];
#pragma unroll
                for (int n = 0; n < 2; ++n)
#pragma unroll
                    for (int j = 0; j < 4; ++j) { const float g = acc[ai][0][m][n][j] * r, up = acc[ai][1][m][n][j] * r; o[4 * n + j] = g * sigm(g) * up; }
                u32x4 w; w.x = cvt_pk_bf16(o[0], o[1]); w.y = cvt_pk_bf16(o[2], o[3]); w.z = cvt_pk_bf16(o[4], o[5]); w.w = cvt_pk_bf16(o[6], o[7]);
                *(u32x4*)(O + (size_t)row * FF + col0) = w;
            }
    }
};
struct EpiResid {
    static constexpr bool PERM = false, AFTER_DRAIN = false;
    const float* base; const float* base2; float* out; bf16_t* xb; float* ssq; float scale;
    __device__ __forceinline__ void operator()(const f32x4 (&acc)[2][2][4][2], const Unit& u, int wr, int wc, int fr, int fq) const {
        const int row0 = u.pm * BM + wr * 64 + fr, col0 = u.pn * BM + wc * 32 + 4 * fq;
        const float* base = (u.pm * BM < MP) ? this->base : base2;
#pragma unroll
        for (int ai = 0; ai < 2; ++ai)
#pragma unroll
            for (int m = 0; m < 4; ++m) {
                const int row = row0 + ai * HALF + m * 16; const size_t off = (size_t)row * D + col0; float s = 0.f;
#pragma unroll
                for (int bj = 0; bj < 2; ++bj)
#pragma unroll
                    for (int n = 0; n < 2; ++n) {
                        const f32x4 b = *(const f32x4*)(base + off + bj * HALF + n * 16); const f32x4 v = b + acc[ai][bj][m][n] * scale;
                        *(f32x4*)(out + off + bj * HALF + n * 16) = v;
                        if (xb) { u32x2 w; w.x = cvt_pk_bf16(v[0], v[1]); w.y = cvt_pk_bf16(v[2], v[3]); *(u32x2*)(xb + off + bj * HALF + n * 16) = w; }
                        s += (v[0] * v[0] + v[1] * v[1]) + (v[2] * v[2] + v[3] * v[3]);
                    }
                s += __shfl_xor(s, 16); s += __shfl_xor(s, 32);
                if (fq == 0) atomicAdd(ssq + row, s);
            }
    }
};
template <int MODE> struct EpiResidB {
    static constexpr bool PERM = true, AFTER_DRAIN = false;
    const float* basef; const float* basef2; const bf16_t* baseb; bf16_t* outb; float* outf; float* ssq; float scale;
    __device__ __forceinline__ void operator()(const f32x4 (&acc)[2][2][4][2], const Unit& u, int wr, int wc, int fr, int fq) const {
        const int row0 = u.pm * BM + wr * 64 + fr, col0 = u.pn * BM + wc * 32 + 8 * fq;
        const float* bf = (u.pm * BM < MP) ? basef : basef2;
#pragma unroll
        for (int ai = 0; ai < 2; ++ai)
#pragma unroll
            for (int m = 0; m < 4; ++m) {
                const int row = row0 + ai * HALF + m * 16; float s = 0.f;
#pragma unroll
                for (int bj = 0; bj < 2; ++bj) {
                    const size_t off = (size_t)row * D + col0 + bj * HALF; f32x4 b0, b1;
                    if (MODE == 0) { b0 = *(const f32x4*)(bf + off); b1 = *(const f32x4*)(bf + off + 4); }
                    else { const u32x4 p = *(const u32x4*)(baseb + off); b0 = (f32x4){bflo(p.x), bfhi(p.x), bflo(p.y), bfhi(p.y)}; b1 = (f32x4){bflo(p.z), bfhi(p.z), bflo(p.w), bfhi(p.w)}; }
                    const f32x4 v0 = b0 + acc[ai][bj][m][0] * scale, v1 = b1 + acc[ai][bj][m][1] * scale;
                    if (MODE == 2) { *(f32x4*)(outf + off) = v0; *(f32x4*)(outf + off + 4) = v1; }
                    else { u32x4 w; w.x = cvt_pk_bf16(v0[0], v0[1]); w.y = cvt_pk_bf16(v0[2], v0[3]); w.z = cvt_pk_bf16(v1[0], v1[1]); w.w = cvt_pk_bf16(v1[2], v1[3]); *(u32x4*)(outb + off) = w; }
                    s += ((v0[0] * v0[0] + v0[1] * v0[1]) + (v0[2] * v0[2] + v0[3] * v0[3])) + ((v1[0] * v1[0] + v1[1] * v1[1]) + (v1[2] * v1[2] + v1[3] * v1[3]));
                }
                s += __shfl_xor(s, 16); s += __shfl_xor(s, 32);
                if (fq == 0) atomicAdd(ssq + row, s);
            }
    }
};
struct EpiU {
    static constexpr bool PERM = true, AFTER_DRAIN = false;
    bf16_t* U; float* BA; const float* ssq;
    __device__ __forceinline__ void operator()(const f32x4 (&acc)[2][2][4][2], const Unit& u, int wr, int wc, int fr, int fq) const {
        const int row0 = u.pm * BM + wr * 64 + fr, col0 = u.pn * BM + wc * 32 + 8 * fq;
        const bool ba = (u.pn * BM == U_BA);
#pragma unroll
        for (int ai = 0; ai < 2; ++ai)
#pragma unroll
            for (int m = 0; m < 4; ++m) {
                const int row = row0 + ai * HALF + m * 16; const float r = rsqrtf(ssq[row] * (1.0f / D) + EPS);
                if (!ba) {
#pragma unroll
                    for (int bj = 0; bj < 2; ++bj) { const f32x4 v0 = acc[ai][bj][m][0] * r, v1 = acc[ai][bj][m][1] * r;
                        u32x4 w; w.x = cvt_pk_bf16(v0[0], v0[1]); w.y = cvt_pk_bf16(v0[2], v0[3]); w.z = cvt_pk_bf16(v1[0], v1[1]); w.w = cvt_pk_bf16(v1[2], v1[3]);
                        *(u32x4*)(U + (size_t)row * NINP + col0 + bj * HALF) = w; }
                } else if (wc == 0 && fq < 2) {
                    *(f32x4*)(BA + (size_t)row * 16 + 8 * fq) = acc[ai][0][m][0] * r; *(f32x4*)(BA + (size_t)row * 16 + 8 * fq + 4) = acc[ai][0][m][1] * r;
                }
            }
    }
};
template <int SECOND> struct EpiGate {
    static constexpr bool PERM = true, AFTER_DRAIN = false;
    const bf16_t* U; const bf16_t* M1; bf16_t* O;
    __device__ __forceinline__ void operator()(const f32x4 (&acc)[2][2][4][2], const Unit& u, int wr, int wc, int fr, int fq) const {
        const int row0 = u.pm * BM + wr * 64 + fr, col0 = u.pn * BM + wc * 32 + 8 * fq;
#pragma unroll
        for (int ai = 0; ai < 2; ++ai)
#pragma unroll
            for (int m = 0; m < 4; ++m) {
                const int row = row0 + ai * HALF + m * 16;
#pragma unroll
                for (int bj = 0; bj < 2; ++bj) {
                    const int col = col0 + bj * HALF;
                    const u32x4 g = *(const u32x4*)(U + (size_t)row * NINP + U_GATE + SECOND * D + col);
                    float o[8]; const f32x4 a0 = acc[ai][bj][m][0], a1 = acc[ai][bj][m][1];
                    o[0] = sigm(bflo(g.x)) * a0[0]; o[1] = sigm(bfhi(g.x)) * a0[1]; o[2] = sigm(bflo(g.y)) * a0[2]; o[3] = sigm(bfhi(g.y)) * a0[3];
                    o[4] = sigm(bflo(g.z)) * a1[0]; o[5] = sigm(bfhi(g.z)) * a1[1]; o[6] = sigm(bflo(g.w)) * a1[2]; o[7] = sigm(bfhi(g.w)) * a1[3];
                    if (SECOND) { const u32x4 p = *(const u32x4*)(M1 + (size_t)row * D + col);
                        o[0] += bflo(p.x); o[1] += bfhi(p.x); o[2] += bflo(p.y); o[3] += bfhi(p.y); o[4] += bflo(p.z); o[5] += bfhi(p.z); o[6] += bflo(p.w); o[7] += bfhi(p.w); }
                    u32x4 w; w.x = cvt_pk_bf16(o[0], o[1]); w.y = cvt_pk_bf16(o[2], o[3]); w.z = cvt_pk_bf16(o[4], o[5]); w.w = cvt_pk_bf16(o[6], o[7]);
                    *(u32x4*)(O + (size_t)row * D + col) = w;
                }
            }
    }
};
}

#define GAS __attribute__((address_space(1)))
#define LAS __attribute__((address_space(3)))
typedef unsigned short bf16;
typedef unsigned v4u __attribute__((ext_vector_type(4)));
typedef unsigned v2u __attribute__((ext_vector_type(2)));
typedef float f32x4 __attribute__((ext_vector_type(4)));
typedef float f32x2 __attribute__((ext_vector_type(2)));
typedef short bf16x8 __attribute__((ext_vector_type(8)));
typedef short bf16x4 __attribute__((ext_vector_type(4)));
typedef GAS unsigned gu32;
#define RLX_AGENT __ATOMIC_RELAXED, __HIP_MEMORY_SCOPE_AGENT
#define LDS_WAIT() asm volatile("s_waitcnt lgkmcnt(0)" ::: "memory")
#define VM_WAIT() asm volatile("s_waitcnt vmcnt(0)" ::: "memory")
__device__ __forceinline__ unsigned f2bf(float f) { unsigned u = __builtin_bit_cast(unsigned, f); return (u + 0x7fffu + ((u >> 16) & 1u)) >> 16; }
typedef __bf16 bf16x2_t __attribute__((ext_vector_type(2)));
__device__ __forceinline__ unsigned pk2(float lo, float hi) { const bf16x2_t v = __builtin_convertvector((f32x2){lo, hi}, bf16x2_t); return __builtin_bit_cast(unsigned, v); }
__device__ __forceinline__ float bf2f(unsigned short b) { return __uint_as_float(((unsigned)b) << 16); }
__device__ __forceinline__ float bflo(unsigned w) { return __uint_as_float(w << 16); }
__device__ __forceinline__ float bfhi(unsigned w) { return __uint_as_float(w & 0xffff0000u); }
__device__ __forceinline__ float sigm(float x) { return __builtin_amdgcn_rcpf(1.f + __expf(-x)); }
__device__ __forceinline__ float siluf(float x) { return x * __builtin_amdgcn_rcpf(1.f + __expf(-x)); }
__device__ __forceinline__ float wave_sum(float v) {
#pragma unroll
    for (int o = 1; o < 64; o <<= 1) v += __shfl_xor(v, o);
    return v;
}
__device__ __forceinline__ float wave_max(float v) {
#pragma unroll
    for (int o = 1; o < 64; o <<= 1) v = fmaxf(v, __shfl_xor(v, o));
    return v;
}
template <int CTRL> __device__ __forceinline__ float dpp_f(float v) { return __builtin_bit_cast(float, __builtin_amdgcn_update_dpp(0, __builtin_bit_cast(int, v), CTRL, 0xf, 0xf, true)); }
__device__ __forceinline__ float row_sum16(float v) { v += dpp_f<0xB1>(v); v += dpp_f<0x4E>(v); v += dpp_f<0x141>(v); v += dpp_f<0x140>(v); return v; }
__device__ __forceinline__ f32x4 mfma16(bf16x8 a, bf16x8 b, f32x4 c) { return __builtin_amdgcn_mfma_f32_16x16x32_bf16(a, b, c, 0, 0, 0); }
__device__ __forceinline__ bf16x8 pack8(f32x4 a, f32x4 b) {
    v4u w; w.x = pk2(a[0], a[1]); w.y = pk2(a[2], a[3]); w.z = pk2(b[0], b[1]); w.w = pk2(b[2], b[3]); return __builtin_bit_cast(bf16x8, w);
}
#define WG_BARRIER() do { asm volatile("s_waitcnt lgkmcnt(0)" ::: "memory"); __builtin_amdgcn_s_barrier(); asm volatile("" ::: "memory"); } while (0)
#define XB_TMO      128
#define XB_XCNT(j)  (256  + 64 * (j))
#define XB_XSUB(j)  (1280 + 64 * (j))
#define XB_XGEN(j)  (2304 + 64 * (j))
#define XB_TOP      3328
#define XB_TOPGEN   3392
#define XCD_BAR_WORDS 3456
#define XB_SPIN_CAP (1u << 18)

__device__ __forceinline__ unsigned xb_ld(unsigned* p)              { return __hip_atomic_load(p, __ATOMIC_RELAXED, __HIP_MEMORY_SCOPE_AGENT); }
__device__ __forceinline__ unsigned xb_add(unsigned* p, unsigned v) { return __hip_atomic_fetch_add(p, v, __ATOMIC_RELAXED, __HIP_MEMORY_SCOPE_AGENT); }
__device__ __forceinline__ unsigned xb_xcc_id() { return (unsigned)__builtin_amdgcn_s_getreg((3 << 11) | 20) & 0xFu; }
#define XB_SPIN(cond, bar) do { unsigned _sp = 0; while (cond) { __builtin_amdgcn_s_sleep(1); \
    if ((++_sp & 255u) == 0u) { if (xb_ld(&(bar)[XB_TMO])) break; if (_sp > XB_SPIN_CAP) { atomicAdd(&(bar)[XB_TMO], 1u); break; } } } } while (0)

struct XcdBarrier {
    unsigned* bar; unsigned x;
    volatile LAS unsigned* st;
};

__device__ __forceinline__ XcdBarrier xcd_barrier_post(unsigned* bar, volatile LAS unsigned* st) {
    XcdBarrier b; b.bar = bar; b.x = xb_xcc_id(); b.st = st;
    if (threadIdx.x == 0) (void)xb_add(&bar[XB_XCNT(b.x)], 1u);
    return b;
}
__device__ __forceinline__ void xcd_barrier_complete(unsigned* bar, unsigned x, unsigned& nloc, unsigned& nx) {
    const unsigned G = gridDim.x * gridDim.y * gridDim.z;
    unsigned sum, cnt, mine, sp = 0u;
    for (;;) {
        sum = 0u; cnt = 0u; mine = 0u;
#pragma unroll
        for (unsigned j = 0; j < 16; ++j) { const unsigned c = xb_ld(&bar[XB_XCNT(j)]); sum += c; cnt += (c > 0u) ? 1u : 0u; mine = (j == x) ? c : mine; }
        if (sum == G) break;
        __builtin_amdgcn_s_sleep(1);
        if ((++sp & 255u) == 0u) { if (xb_ld(&bar[XB_TMO])) break; if (sp > XB_SPIN_CAP) { atomicAdd(&bar[XB_TMO], 1u); break; } }
    }
    nloc = mine > 0u ? mine : 1u; nx = cnt > 0u ? cnt : 1u;
}

__device__ __forceinline__ void xcd_barrier(const XcdBarrier& b) {
    asm volatile("s_waitcnt vmcnt(0)" ::: "memory");
    __syncthreads();
    if (threadIdx.x == 0) {
        unsigned* bar = b.bar;
        __builtin_amdgcn_s_waitcnt(0);
        unsigned nloc = b.st[0], nx = b.st[1];
        if (nloc == 0u) { xcd_barrier_complete(bar, b.x, nloc, nx); b.st[0] = nloc; b.st[1] = nx; }
        const unsigned old = xb_add(&bar[XB_XSUB(b.x)], 1u);
        const unsigned gen = old / nloc;
        if (old + 1u == (gen + 1u) * nloc) {
            __builtin_amdgcn_fence(__ATOMIC_RELEASE, "agent");
            asm volatile("s_waitcnt vmcnt(0)" ::: "memory");
            const unsigned og = xb_add(&bar[XB_TOP], 1u);
            const unsigned tg = og / nx;
            if (og + 1u == (tg + 1u) * nx) xb_add(&bar[XB_TOPGEN], 1u);
            else XB_SPIN(xb_ld(&bar[XB_TOPGEN]) == tg, bar);
            __builtin_amdgcn_fence(__ATOMIC_ACQUIRE, "agent");
            xb_add(&bar[XB_XGEN(b.x)], 1u);
            asm volatile("s_waitcnt vmcnt(0)" ::: "memory");
        } else {
            XB_SPIN(xb_ld(&bar[XB_XGEN(b.x)]) == gen, bar);
            __builtin_amdgcn_fence(__ATOMIC_ACQUIRE, "agent");
            asm volatile("s_waitcnt vmcnt(0)" ::: "memory");
        }
    }
    __syncthreads();
}


constexpr size_t MiB = 1u << 20;
constexpr size_t al256(size_t x) { return (x + 255) & ~(size_t)255; }
constexpr size_t WS_CTL = 0, CTL_ZERO_BYTES = 1 * MiB;
constexpr size_t WS_W1A = 1 * MiB;
constexpr size_t WS_W1B = WS_W1A + (size_t)NGU * D * 2;
constexpr size_t WS_WIN = WS_W1B + (size_t)D * FF * 2;
constexpr size_t WS_WPA = WS_WIN + (size_t)NINP * D * 2;
constexpr size_t WS_WPB = WS_WPA + (size_t)D * 512 * 2;
constexpr size_t WS_WOUT = WS_WPB + (size_t)D * D * 2;
constexpr size_t WS_W2A = WS_WOUT + (size_t)D * D * 2;
constexpr size_t WS_W2B = WS_W2A + (size_t)NGU * D * 2;
constexpr size_t WS_XB = al256(WS_W2B + (size_t)D * FF * 2);
constexpr size_t WS_RSTD1 = WS_XB + (size_t)MT * D * 2;
constexpr size_t WS_ACT = al256(WS_RSTD1 + (size_t)MT * 4);
constexpr size_t WS_X1 = WS_ACT + (size_t)MT * FF * 2;
constexpr size_t WS_X1B = WS_X1 + (size_t)MT * D * 4;
constexpr size_t WS_U = WS_X1B + (size_t)MT * D * 2;
constexpr size_t WS_BA = WS_U + (size_t)MT * NINP * 2;
constexpr size_t REC_BYTES = 90112;
constexpr int NREC = NB * 8 * 64;
constexpr size_t WS_REC = WS_BA + (size_t)MT * 16 * 4;
constexpr size_t WS_GE = WS_REC + (size_t)NREC * REC_BYTES;
constexpr size_t WS_OB = al256(WS_GE + (size_t)NREC * 4);
constexpr size_t WS_OG = WS_OB + (size_t)MT * D * 2;
constexpr size_t WS_LSE = WS_OG + (size_t)MT * 1536 * 2;
constexpr size_t WS_OA = al256(WS_LSE + (size_t)MT * 12 * 4);
constexpr size_t WS_M1 = WS_OA + (size_t)MT * 512 * 2;
constexpr size_t WS_MG = WS_M1 + (size_t)MT * D * 2;
constexpr size_t WS_X2 = WS_MG + (size_t)MT * D * 2;
constexpr size_t WS_X2B = WS_X2 + (size_t)MT * D * 4;
constexpr size_t WS_END = WS_X2B + (size_t)MT * D * 2;
constexpr int CW_TMO = 0;
constexpr int CW_BAR = 4096;
constexpr int CW_Q = 8192;
constexpr int CW_SSQ2 = 16384, CW_SSQ3 = CW_SSQ2 + 17408, CW_SSQ4 = CW_SSQ3 + 17408;
static_assert((CW_SSQ4 + 17408) * 4 <= (int)CTL_ZERO_BYTES, "CTL words inside the memset region");

constexpr size_t O_Y = 0;
constexpr size_t O_KVP0 = (size_t)MT * D;
constexpr size_t O_KVP1 = O_KVP0 + 524288;
constexpr size_t O_KVP2 = O_KVP1 + 2097152;
constexpr size_t O_CONVP = O_KVP2 + 8388608;
constexpr size_t O_SSMP = O_CONVP + 36864;
constexpr size_t O_KVS0 = O_SSMP + 524288;
constexpr size_t O_KVS1 = O_KVS0 + 524288;
constexpr size_t O_KVS2 = O_KVS1 + 524288;
constexpr size_t O_CONVS = O_KVS2 + 524288;
constexpr size_t O_SSMS = O_CONVS + 1179648;
constexpr size_t O_END = O_SSMS + 16777216;

constexpr int NWAVES = 8;
constexpr int RING_OFF = 0;
constexpr int LDSCTL_OFF = 151552, MISC_OFF = LDSCTL_OFF + 320;
constexpr int LDS_BYTES = 155648;

struct Frame {
    LAS unsigned char* lds;
    LAS unsigned char* ldv;
    volatile LAS unsigned* MISC;
    gu32* ctl;
    int tid, lane, wave, G, bx;
    const float* const* in; float* out; unsigned char* ws;
};
__device__ __forceinline__ int q_next(Frame& F, int qi) {
    if (F.tid == 0) F.MISC[16] = __hip_atomic_fetch_add((unsigned*)(F.ctl + CW_Q + 64 * qi), 1u, __ATOMIC_RELAXED, __HIP_MEMORY_SCOPE_AGENT);
    __syncthreads();
    const int v = (int)F.MISC[16];
    __syncthreads();
    return v;
}

#define IN_XP 0
#define IN_XS 1
#define IN_C128 2
#define IN_C512 3
#define IN_C2048 4
#define IN_SCONV 5
#define IN_SSSM 6
#define IN_NF1 7
#define IN_W1GU 8
#define IN_W1D 9
#define IN_NMIX 10
#define IN_WIN 11
#define IN_CONVW 12
#define IN_ALOG 13
#define IN_DTB 14
#define IN_GNORM 15
#define IN_WPA 16
#define IN_WPB 17
#define IN_WOUT 18
#define IN_NF2 19
#define IN_W2GU 20
#define IN_W2D 21
#define IN_NOUT 22

template <class Map>
__device__ __forceinline__ void p0_transpose_item(const float* W, int K, int N, bf16* WT, const float* gain, LAS float* scr, int item, int lane, Map map) {
    const int nblk = (N + 31) / 32, kb = item / nblk, nb = item % nblk, k0 = 64 * kb, n0 = 32 * nb;
    const int nc = n0 + (lane & 31); const bool okc = nc < N;
    float wv[32];
#pragma unroll
    for (int i = 0; i < 32; ++i) { const int kk = 2 * i + (lane >> 5); wv[i] = okc ? W[(size_t)(k0 + kk) * N + nc] : 0.f; }
    if (gain) {
#pragma unroll
        for (int i = 0; i < 32; ++i) wv[i] *= gain[k0 + 2 * i + (lane >> 5)]; }
#pragma unroll
    for (int i = 0; i < 32; ++i) scr[(2 * i + (lane >> 5)) * 33 + (lane & 31)] = wv[i];
    LDS_WAIT(); asm volatile("" ::: "memory");
    const int c = lane & 7;
#pragma unroll
    for (int j = 0; j < 4; ++j) { const int n = (lane >> 3) + 8 * j; const LAS float* s = scr + (8 * c) * 33 + n;
        v4u o; o.x = pk2(s[0 * 33], s[1 * 33]); o.y = pk2(s[2 * 33], s[3 * 33]); o.z = pk2(s[4 * 33], s[5 * 33]); o.w = pk2(s[6 * 33], s[7 * 33]);
        if (n0 + n < N) *(GAS v4u*)(WT + (size_t)map(n0 + n) * K + k0 + 8 * c) = o; }
    LDS_WAIT(); asm volatile("" ::: "memory");
}
struct MapId { __device__ __forceinline__ int operator()(int c) const { return c; } };
struct MapGU { __device__ __forceinline__ int operator()(int c) const { return c < FF ? 256 * (c >> 7) + (c & 127) : 256 * ((c - FF) >> 7) + 128 + ((c - FF) & 127); } };
struct MapIn { __device__ __forceinline__ int operator()(int c) const { return c < 8704 ? c : (c < 8720 ? U_BA + (c - 8704) : c - 16); } };

__device__ __forceinline__ void p0_prologue(Frame& F) {
    LAS float* scr = (LAS float*)(F.ldv + RING_OFF + F.wave * 16384);
    const int gw = F.bx * NWAVES + F.wave, NGW = F.G * NWAVES;
    bf16* W1A = (bf16*)(F.ws + WS_W1A); bf16* W1B = (bf16*)(F.ws + WS_W1B); bf16* WIN = (bf16*)(F.ws + WS_WIN); bf16* WPA = (bf16*)(F.ws + WS_WPA);
    bf16* WPB = (bf16*)(F.ws + WS_WPB); bf16* WOUT = (bf16*)(F.ws + WS_WOUT); bf16* W2A = (bf16*)(F.ws + WS_W2A); bf16* W2B = (bf16*)(F.ws + WS_W2B);
    constexpr int I_GU = (D / 64) * (NGU / 32), I_DN = (FF / 64) * (D / 32), I_IN = (D / 64) * ((NIN + 31) / 32), I_PA = (512 / 64) * (D / 32), I_DD = (D / 64) * (D / 32);
    constexpr int NITEMS = 2 * I_GU + 2 * I_DN + I_IN + I_PA + 2 * I_DD;
    for (int it = gw; it < NITEMS; it += NGW) {
        int r = it;
        if (r < I_GU) { p0_transpose_item(F.in[IN_W1GU], D, NGU, W1A, F.in[IN_NF1], scr, r, F.lane, MapGU()); continue; } r -= I_GU;
        if (r < I_GU) { p0_transpose_item(F.in[IN_W2GU], D, NGU, W2A, F.in[IN_NF2], scr, r, F.lane, MapGU()); continue; } r -= I_GU;
        if (r < I_DN) { p0_transpose_item(F.in[IN_W1D], FF, D, W1B, nullptr, scr, r, F.lane, MapId()); continue; } r -= I_DN;
        if (r < I_DN) { p0_transpose_item(F.in[IN_W2D], FF, D, W2B, nullptr, scr, r, F.lane, MapId()); continue; } r -= I_DN;
        if (r < I_IN) { p0_transpose_item(F.in[IN_WIN], D, NIN, WIN, F.in[IN_NMIX], scr, r, F.lane, MapIn()); continue; } r -= I_IN;
        if (r < I_PA) { p0_transpose_item(F.in[IN_WPA], 512, D, WPA, nullptr, scr, r, F.lane, MapId()); continue; } r -= I_PA;
        if (r < I_DD) { p0_transpose_item(F.in[IN_WPB], D, D, WPB, nullptr, scr, r, F.lane, MapId()); continue; } r -= I_DD;
        p0_transpose_item(F.in[IN_WOUT], D, D, WOUT, nullptr, scr, r, F.lane, MapId());
    }
    { const int gt = F.bx * 512 + F.tid, NT = F.G * 512; GAS v4u* z = (GAS v4u*)(WIN + (size_t)NIN * D);
      for (int i = gt; i < (NINP - NIN) * D / 8; i += NT) z[i] = (v4u){0u, 0u, 0u, 0u}; }
    bf16* XB = (bf16*)(F.ws + WS_XB); float* RSTD1 = (float*)(F.ws + WS_RSTD1);
    for (int m0 = gw; m0 < MT; m0 += 2 * NGW) {
        f32x4 v[2][4]; float s[2];
#pragma unroll
        for (int r = 0; r < 2; ++r) { const int m = m0 + r * NGW; s[r] = 0.f;
            if (m < MT) { const float* xrow = (m < MP) ? F.in[IN_XP] + (size_t)m * D : F.in[IN_XS] + (size_t)(m - MP) * D; const GAS f32x4* xr = (const GAS f32x4*)xrow + F.lane;
#pragma unroll
                for (int j = 0; j < 4; ++j) v[r][j] = xr[64 * j]; } }
#pragma unroll
        for (int r = 0; r < 2; ++r) { const int m = m0 + r * NGW;
            if (m < MT) {
#pragma unroll
                for (int j = 0; j < 4; ++j) s[r] += (v[r][j].x * v[r][j].x + v[r][j].y * v[r][j].y) + (v[r][j].z * v[r][j].z + v[r][j].w * v[r][j].w);
                float t = row_sum16(s[r]); t += __shfl_xor(t, 16); t += __shfl_xor(t, 32);
                GAS v2u* o8 = (GAS v2u*)(XB + (size_t)m * D) + F.lane;
#pragma unroll
                for (int j = 0; j < 4; ++j) { v2u w; w.x = pk2(v[r][j].x, v[r][j].y); w.y = pk2(v[r][j].z, v[r][j].w); o8[64 * j] = w; }
                if (F.lane == 0) RSTD1[m] = rsqrtf(t * (1.0f / D) + EPS); } }
    }
}

__device__ __forceinline__ void final_norm(Frame& F) {
    const int gw = F.bx * NWAVES + F.wave, NGW = F.G * NWAVES;
    const float* ssq = (const float*)(F.ctl + CW_SSQ4); const GAS f32x4* nw = (const GAS f32x4*)F.in[IN_NOUT] + F.lane;
    f32x4 g[4];
#pragma unroll
    for (int j = 0; j < 4; ++j) g[j] = nw[64 * j];
    for (int m = gw; m < MT; m += NGW) {
        const float r = rsqrtf(ssq[m] * (1.0f / D) + EPS);
        GAS f32x4* xr = (GAS f32x4*)(F.out + O_Y + (size_t)m * D) + F.lane;
#pragma unroll
        for (int j = 0; j < 4; ++j) { f32x4 v = xr[64 * j]; xr[64 * j] = v * r * g[j]; }
    }
}

template <int K>
__device__ __forceinline__ void skinny_partial(const bf16* A, const bf16* Bt, int r0, int c0, int w, int lane, LAS unsigned char* part) {
    const int m16 = lane & 15, kg = lane >> 4;
    f32x4 acc[2][4];
#pragma unroll
    for (int i = 0; i < 2; ++i)
#pragma unroll
        for (int j = 0; j < 4; ++j) acc[i][j] = (f32x4){0.f, 0.f, 0.f, 0.f};
    const bf16* ap = A + (size_t)(r0 + m16) * K + w * (K / 8) + 8 * kg; const bf16* bp = Bt + (size_t)(c0 + m16) * K + w * (K / 8) + 8 * kg;
#pragma unroll 4
    for (int kb = 0; kb < K / 256; ++kb) {
        bf16x8 a[2], bq[4];
#pragma unroll
        for (int i = 0; i < 2; ++i) a[i] = *(const GAS bf16x8*)(ap + (size_t)16 * i * K + 32 * kb);
#pragma unroll
        for (int j = 0; j < 4; ++j) bq[j] = *(const GAS bf16x8*)(bp + (size_t)16 * j * K + 32 * kb);
#pragma unroll
        for (int i = 0; i < 2; ++i)
#pragma unroll
            for (int j = 0; j < 4; ++j) acc[i][j] = mfma16(bq[j], a[i], acc[i][j]);
    }
#pragma unroll
    for (int i = 0; i < 2; ++i)
#pragma unroll
        for (int j = 0; j < 4; ++j) *(LAS f32x4*)(part + ((w * 8 + i * 4 + j) * 64 + lane) * 16) = acc[i][j];
}
__device__ __forceinline__ f32x4 skinny_reduce(const LAS unsigned char* part, int w, int lane) {
    f32x4 s = {0.f, 0.f, 0.f, 0.f};
#pragma unroll
    for (int p = 0; p < 8; ++p) s = s + *(const LAS f32x4*)(part + ((p * 8 + w) * 64 + lane) * 16);
    return s;
}
template <int K, int MODE>
__device__ __forceinline__ void skinny_resid(Frame& F, const bf16* A, const bf16* Bt, const float* basef, const bf16* baseb, bf16* outb, float* outf, float* ssq, float scale) {
    const int lane = F.lane, w = F.wave, m16 = lane & 15, kg = lane >> 4, wr = w >> 2, wc = w & 3;
    for (int t = F.bx; t < 256; t += F.G) {
        const int r0 = MP + 32 * (t >> 4), c0 = 64 * (t & 15);
        skinny_partial<K>(A, Bt, r0, c0, w, lane, F.ldv);
        WG_BARRIER();
        const f32x4 acc = skinny_reduce(F.ldv, w, lane);
        const int row = r0 + 16 * wr + m16;
        const size_t off = (size_t)row * D + c0 + 16 * wc + 4 * kg;
        f32x4 b;
        if (MODE == 0) b = *(const GAS f32x4*)(basef + off); else { const v2u p = *(const GAS v2u*)(baseb + off); b = (f32x4){bflo(p.x), bfhi(p.x), bflo(p.y), bfhi(p.y)}; }
        const f32x4 v = b + acc * scale;
        if (MODE == 2) *(GAS f32x4*)(outf + off) = v; else { v2u pk; pk.x = pk2(v[0], v[1]); pk.y = pk2(v[2], v[3]); *(GAS v2u*)(outb + off) = pk; }
        float s = (v[0] * v[0] + v[1] * v[1]) + (v[2] * v[2] + v[3] * v[3]);
        s += __shfl_xor(s, 16); s += __shfl_xor(s, 32);
        if (kg == 0) atomicAdd(ssq + row, s);
        WG_BARRIER();
    }
}
__device__ __forceinline__ void skinny_merge(Frame& F, const bf16* OA, const bf16* WPA, const bf16* OB, const bf16* WPB, const bf16* U, bf16* MG) {
    const int lane = F.lane, w = F.wave, m16 = lane & 15, kg = lane >> 4, wr = w >> 2, wc = w & 3;
    for (int t = F.bx; t < 256; t += F.G) {
        const int r0 = MP + 32 * (t >> 4), c0 = 64 * (t & 15);
        skinny_partial<512>(OA, WPA, r0, c0, w, lane, F.ldv);
        skinny_partial<D>(OB, WPB, r0, c0, w, lane, F.ldv + 65536);
        WG_BARRIER();
        const f32x4 aa = skinny_reduce(F.ldv, w, lane), ab = skinny_reduce(F.ldv + 65536, w, lane);
        const int row = r0 + 16 * wr + m16, col = c0 + 16 * wc + 4 * kg;
        const v2u ga = *(const GAS v2u*)(U + (size_t)row * NINP + U_GATE + col), gb = *(const GAS v2u*)(U + (size_t)row * NINP + U_GATE + D + col);
        v2u o; o.x = pk2(sigm(bflo(ga.x)) * aa[0] + sigm(bflo(gb.x)) * ab[0], sigm(bfhi(ga.x)) * aa[1] + sigm(bfhi(gb.x)) * ab[1]);
        o.y = pk2(sigm(bflo(ga.y)) * aa[2] + sigm(bflo(gb.y)) * ab[2], sigm(bfhi(ga.y)) * aa[3] + sigm(bfhi(gb.y)) * ab[3]);
        *(GAS v2u*)(MG + (size_t)row * D + col) = o;
        WG_BARRIER();
    }
}
__device__ __forceinline__ void skinny_ba(Frame& F, const bf16* X1B, const bf16* WIN, const float* ssq, float* BA) {
    const int lane = F.lane, m16 = lane & 15, kg = lane >> 4;
    for (int t = F.bx * NWAVES + F.wave; t < MT / 16; t += F.G * NWAVES) {
        const int row = 16 * t + m16;
        f32x4 acc = {0.f, 0.f, 0.f, 0.f}; { const bf16* ap = X1B + (size_t)row * D + 8 * kg; const bf16* bp = WIN + (size_t)(U_BA + m16) * D + 8 * kg;
#pragma unroll 16
            for (int kb = 0; kb < D / 32; ++kb) acc = mfma16(*(const GAS bf16x8*)(bp + 32 * kb), *(const GAS bf16x8*)(ap + 32 * kb), acc); }
        *(GAS f32x4*)(BA + (size_t)row * 16 + 4 * kg) = acc * rsqrtf(ssq[row] * (1.0f / D) + EPS);
    }
}

constexpr int GP_QR = 0, GP_KR = 17408, GP_KT = 34816, GP_KBG = 53248, GP_BVT = 71680, GP_GKK = 90112, GP_GQK = 107520, GP_TI = 124928, GP_TAB = 134144;
constexpr int GKP = 68;
__device__ __forceinline__ f32x4 mfma4(float a, float b, f32x4 c) { return __builtin_amdgcn_mfma_f32_16x16x4f32(a, b, c, 0, 0, 0); }
__device__ __forceinline__ f32x4 prod_ll(const LAS float* A, int ra, int ca, const LAS float* B, int rb, int cb, f32x4 c, int m16, int kg) {
    const f32x4 av = *(const LAS f32x4*)(A + (ra + m16) * GKP + ca + 4 * kg);
#pragma unroll
    for (int t = 0; t < 4; ++t) c = mfma4(av[t], B[(rb + 4 * kg + t) * GKP + cb + m16], c);
    return c;
}
__device__ __forceinline__ f32x4 prod_lr(const LAS float* A, int ra, int ca, f32x4 x, f32x4 c, int m16, int kg) {
    const f32x4 av = *(const LAS f32x4*)(A + (ra + m16) * GKP + ca + 4 * kg);
#pragma unroll
    for (int t = 0; t < 4; ++t) c = mfma4(av[t], x[t], c);
    return c;
}
__device__ __forceinline__ float softplusf(float x) { return x > 20.f ? x : log1pf(__expf(x)); }

struct PrepIn { v2u raw[19]; v4u zr0, zr1; f32x4 w0, w1, w2, w3; float bl, al; };
__device__ __forceinline__ void prep_fetch(Frame& F, int b, int h, int n, PrepIn& in) {
    const bf16* U = (const bf16*)(F.ws + WS_U); const float* BA = (const float*)(F.ws + WS_BA);
    const int tid = F.tid, row_base = b * SEQ + 64 * n;
    const int gz_t = tid >> 3, gz_c = (tid & 7) * 16;
    in.zr0 = *(const GAS v4u*)(U + (size_t)(row_base + gz_t) * NINP + U_Z + h * 128 + gz_c); in.zr1 = *(const GAS v4u*)(U + (size_t)(row_base + gz_t) * NINP + U_Z + h * 128 + gz_c + 8);
    const int cv_cq = tid & 31, cv_tq = (tid >> 5) & 3, cv_tensor = tid >> 7, cv_cw = cv_tensor * 1024 + h * 128 + 4 * cv_cq, cv_t0 = 16 * cv_tq;
    if (tid < 384) {
        in.w0 = *(const GAS f32x4*)(F.in[IN_CONVW] + cv_cw); in.w1 = *(const GAS f32x4*)(F.in[IN_CONVW] + 3072 + cv_cw); in.w2 = *(const GAS f32x4*)(F.in[IN_CONVW] + 2 * 3072 + cv_cw); in.w3 = *(const GAS f32x4*)(F.in[IN_CONVW] + 3 * 3072 + cv_cw);
#pragma unroll
        for (int i = 0; i < 19; ++i) { const int tok = 64 * n + cv_t0 - 3 + i; in.raw[i] = (v2u){0u, 0u}; if (tok >= 0) in.raw[i] = *(const GAS v2u*)(U + (size_t)(b * SEQ + tok) * NINP + U_QKVB + cv_cw); }
    }
    if (F.wave == 7) { in.bl = BA[(size_t)(row_base + F.lane) * 16 + h]; in.al = BA[(size_t)(row_base + F.lane) * 16 + 8 + h]; }
}
__device__ __forceinline__ void gdn_prep_unit(Frame& F, int b, int h, int n, PrepIn& in, bool has_next, int nb_, int nh_, int nn_, int abl) {
    LAS unsigned char* L = F.ldv;
    LAS float* TAB = (LAS float*)(L + GP_TAB);
    LAS float* GKK = (LAS float*)(L + GP_GKK);
    LAS float* GQK = (LAS float*)(L + GP_GQK);
    const bf16* U = (const bf16*)(F.ws + WS_U); const float* BA = (const float*)(F.ws + WS_BA);
    const int tid = F.tid, lane = F.lane, wave = F.wave;
    const int uidx = (b * 8 + h) * 64 + n;
    unsigned char* rec = F.ws + WS_REC + (size_t)uidx * REC_BYTES;
    const int row_base = b * SEQ + 64 * n;
    const int gz_t = tid >> 3, gz_c = (tid & 7) * 16;
    const int cv_cq = tid & 31, cv_tq = (tid >> 5) & 3, cv_tensor = tid >> 7, cv_c0 = 4 * cv_cq, cv_t0 = 16 * cv_tq;
    if (wave == 7) {
        const int t = lane; const float bl = in.bl, al = in.al;
        const float beta = sigm(bl); const float g = -__expf(F.in[IN_ALOG][h]) * softplusf(al + F.in[IN_DTB][h]);
        float gc = g;
#pragma unroll
        for (int o = 1; o < 64; o <<= 1) { const float v = __shfl_up(gc, o); if (lane >= o) gc += v; }
        const float gl = __shfl(gc, 63);
        TAB[t] = beta; TAB[64 + t] = gc; TAB[128 + t] = __expf(gc); TAB[192 + t] = __expf(gl - gc);
        if (lane == 0) ((float*)(F.ws + WS_GE))[uidx] = __expf(gl);
    }
    if (tid < 384 && !(abl & 1)) {
        const int tensor = cv_tensor, c0 = cv_c0, t0 = cv_t0;
        f32x4 x[19];
#pragma unroll
        for (int i = 0; i < 19; ++i) x[i] = (f32x4){bflo(in.raw[i].x), bfhi(in.raw[i].x), bflo(in.raw[i].y), bfhi(in.raw[i].y)};
        const f32x4 w0 = in.w0, w1 = in.w1, w2 = in.w2, w3 = in.w3;
        unsigned tp[4][8];
#pragma unroll
        for (int i = 0; i < 16; ++i) { f32x4 y = w0 * x[i] + w1 * x[i + 1] + w2 * x[i + 2] + w3 * x[i + 3];
#pragma unroll
            for (int e = 0; e < 4; ++e) y[e] = siluf(y[e]);
            if (tensor < 2) { v2u pk; pk.x = pk2(y[0], y[1]); pk.y = pk2(y[2], y[3]); *(LAS v2u*)(L + (tensor == 0 ? GP_QR : GP_KR) + (t0 + i) * 272 + 2 * c0) = pk; }
            if (tensor > 0) {
#pragma unroll
                for (int e = 0; e < 4; ++e) { const unsigned bq = f2bf(y[e]); if (i & 1) tp[e][i >> 1] |= bq << 16; else tp[e][i >> 1] = bq; } }
        }
        if (tensor > 0) {
#pragma unroll
            for (int e = 0; e < 4; ++e) { LAS unsigned char* dst = L + (tensor == 1 ? GP_KT : GP_BVT) + (c0 + e) * 144 + 2 * t0;
                *(LAS v4u*)dst = (v4u){tp[e][0], tp[e][1], tp[e][2], tp[e][3]}; *(LAS v4u*)(dst + 16) = (v4u){tp[e][4], tp[e][5], tp[e][6], tp[e][7]}; } }
    }
    WG_BARRIER();
    { const unsigned zi[8] = {in.zr0.x, in.zr0.y, in.zr0.z, in.zr0.w, in.zr1.x, in.zr1.y, in.zr1.z, in.zr1.w}; unsigned zo[8];
#pragma unroll
      for (int i = 0; i < 8; ++i) { const float za = bflo(zi[i]), zb = bfhi(zi[i]); const f32x2 nw2 = *(const GAS f32x2*)(F.in[IN_GNORM] + gz_c + 2 * i);
          zo[i] = pk2(za * sigm(za) * nw2[0], zb * sigm(zb) * nw2[1]); }
      *(GAS v4u*)(rec + 73728 + (gz_t * 128 + gz_c) * 2) = (v4u){zo[0], zo[1], zo[2], zo[3]}; *(GAS v4u*)(rec + 73728 + (gz_t * 128 + gz_c + 8) * 2) = (v4u){zo[4], zo[5], zo[6], zo[7]}; }
    if (has_next) prep_fetch(F, nb_, nh_, nn_, in);
    {
        const int m16 = lane & 15, kg = lane >> 4;
        if (!(abl & 2)) for (int job = wave; job < 24; job += 8) {
            int kind, it, jt;
            if (job < 20) { kind = job >= 10; int j = job % 10; it = 0; while (j > it) { j -= it + 1; ++it; } jt = j; }
            else { kind = 2; it = jt = job - 20; }
            const int abase = (kind == 2 ? GP_QR : GP_KR) + (16 * (kind == 1 ? jt : it) + m16) * 272 + 16 * kg;
            const int bbase = (kind == 0 ? GP_KR : GP_QR) + (16 * (kind == 0 ? jt : it) + m16) * 272 + 16 * kg;
            f32x4 acc = {0.f, 0.f, 0.f, 0.f};
#pragma unroll
            for (int kb = 0; kb < 4; ++kb) { const bf16x8 a = *(const LAS bf16x8*)(L + abase + 64 * kb), bb = *(const LAS bf16x8*)(L + bbase + 64 * kb); acc = mfma16(a, bb, acc); }
            if (kind == 0) {
#pragma unroll
                for (int jj = 0; jj < 4; ++jj) GKK[(16 * it + 4 * kg + jj) * GKP + 16 * jt + m16] = acc[jj];
            } else if (kind == 1) {
                *(LAS f32x4*)(GQK + (16 * it + m16) * 68 + 16 * jt + 4 * kg) = acc;
            } else {
#pragma unroll
                for (int jj = 0; jj < 4; ++jj) if (4 * kg + jj == m16) TAB[576 + 16 * it + m16] = acc[jj];
            }
        }
    }
    WG_BARRIER();
    if (tid < 64) {
        const int t = tid; const float rk = rsqrtf(GKK[t * GKP + t] + EPS), rq = rsqrtf(TAB[576 + t] + EPS) * 0.08838834764831845f;
        TAB[256 + t] = rk; TAB[320 + t] = rq; TAB[384 + t] = rq * TAB[128 + t]; TAB[448 + t] = rk * TAB[192 + t]; TAB[512 + t] = rk * TAB[t] * TAB[128 + t];
    }
    WG_BARRIER();
    if (!(abl & 4)) {
        for (int e = tid; e < 4096; e += 512) { const int i = e >> 6, j = e & 63;
            if (j < i) GKK[i * GKP + j] = TAB[i] * TAB[256 + i] * TAB[256 + j] * GKK[i * GKP + j] * __expf(TAB[64 + i] - TAB[64 + j]); }
    }
    WG_BARRIER();
    LAS float* TIF = (LAS float*)(L + GP_KR);
    {
        const int m16 = lane & 15, kg = lane >> 4;
        if (wave == 0) { if (!(abl & 8)) {
            { const LAS float* Ab = GKK + (16 * kg) * GKP + 16 * kg; float r[16];
#pragma unroll
              for (int i = 0; i < 16; ++i) { int lo_ = m16; asm volatile("" : "+v"(lo_)); float a = (lo_ == i) ? 1.f : 0.f;
#pragma unroll
                  for (int j4 = 0; j4 < (i + 3) / 4; ++j4) { const f32x4 av = *(const LAS f32x4*)(Ab + i * GKP + 4 * j4);
#pragma unroll
                      for (int e = 0; e < 4; ++e) { const int j = 4 * j4 + e; if (j < i) a -= av[e] * r[j]; } }
                  r[i] = a; }
#pragma unroll
              for (int i = 0; i < 16; ++i) TIF[(16 * kg + i) * GKP + 16 * kg + m16] = r[i]; }
            const f32x4 z4 = {0.f, 0.f, 0.f, 0.f};
#pragma unroll
            for (int i = 1; i < 4; ++i) { const int j = i - 1;
                f32x4 X = prod_ll(GKK, 16 * i, 16 * j, TIF, 16 * j, 16 * j, z4, m16, kg);
                f32x4 T = prod_lr(TIF, 16 * i, 16 * i, X, z4, m16, kg);
#pragma unroll
                for (int jj = 0; jj < 4; ++jj) TIF[(16 * i + 4 * kg + jj) * GKP + 16 * j + m16] = -T[jj]; }
#pragma unroll
            for (int i = 2; i < 4; ++i) { const int j = i - 2;
                f32x4 Y = prod_ll(GKK, 16 * i, 16 * j, TIF, 16 * j, 16 * j, z4, m16, kg);
                Y = prod_ll(GKK, 16 * i, 16 * (j + 1), TIF, 16 * (j + 1), 16 * j, Y, m16, kg);
                f32x4 T = prod_lr(TIF, 16 * i, 16 * i, Y, z4, m16, kg);
#pragma unroll
                for (int jj = 0; jj < 4; ++jj) TIF[(16 * i + 4 * kg + jj) * GKP + 16 * j + m16] = -T[jj]; }
            {
                f32x4 Y = prod_ll(GKK, 48, 0, TIF, 0, 0, z4, m16, kg);
                Y = prod_ll(GKK, 48, 16, TIF, 16, 0, Y, m16, kg);
                Y = prod_ll(GKK, 48, 32, TIF, 32, 0, Y, m16, kg);
                f32x4 T = prod_lr(TIF, 48, 48, Y, z4, m16, kg);
#pragma unroll
                for (int jj = 0; jj < 4; ++jj) TIF[(48 + 4 * kg + jj) * GKP + m16] = -T[jj]; }
        } } else if (!(abl & 4)) {
            for (int job = wave - 1; job < 40; job += 7) {
                float o[8]; unsigned char* dst;
                if (job < 8) {
                    const int it = job >> 1, kb2 = job & 1, i = 16 * it + m16; const float sc = TAB[320 + i], gi = TAB[64 + i];
#pragma unroll
                    for (int hlf = 0; hlf < 2; ++hlf) { const int j0 = 32 * kb2 + 16 * hlf + 4 * kg; const f32x4 g = *(const LAS f32x4*)(GQK + i * 68 + j0);
#pragma unroll
                        for (int e = 0; e < 4; ++e) { const int j = j0 + e; o[4 * hlf + e] = (j <= i) ? sc * TAB[256 + j] * g[e] * __expf(gi - TAB[64 + j]) : 0.f; } }
                    dst = rec + 32768 + job * 1024;
                } else if (job < 24) {
                    const int f = job - 8, mt = f >> 1, kb2 = f & 1, dk = 16 * mt + m16;
#pragma unroll
                    for (int hlf = 0; hlf < 2; ++hlf) { const int t0 = 32 * kb2 + 16 * hlf + 4 * kg; const v2u kk = *(const LAS v2u*)(L + GP_KT + dk * 144 + 2 * t0);
                        o[4 * hlf + 0] = bflo(kk.x) * TAB[448 + t0]; o[4 * hlf + 1] = bfhi(kk.x) * TAB[448 + t0 + 1]; o[4 * hlf + 2] = bflo(kk.y) * TAB[448 + t0 + 2]; o[4 * hlf + 3] = bfhi(kk.y) * TAB[448 + t0 + 3]; }
                    dst = rec + 40960 + f * 1024;
                } else {
                    const int f = job - 24, mtq = f >> 2, kb = f & 3, t = 16 * mtq + m16; const float sc = TAB[384 + t];
#pragma unroll
                    for (int hlf = 0; hlf < 2; ++hlf) { const int d0 = 32 * kb + 16 * hlf + 4 * kg; const v2u qq = *(const LAS v2u*)(L + GP_QR + t * 272 + 2 * d0);
                        o[4 * hlf + 0] = bflo(qq.x) * sc; o[4 * hlf + 1] = bfhi(qq.x) * sc; o[4 * hlf + 2] = bflo(qq.y) * sc; o[4 * hlf + 3] = bfhi(qq.y) * sc; }
                    dst = rec + ((4 + mtq) * 4 + kb) * 1024;
                }
                v4u wv; wv.x = pk2(o[0], o[1]); wv.y = pk2(o[2], o[3]); wv.z = pk2(o[4], o[5]); wv.w = pk2(o[6], o[7]);
                *(GAS v4u*)(dst + lane * 16) = wv;
            }
            for (int q = tid - 64; q < 1024; q += 448) { const int isv = q >> 9, row = (q & 511) >> 2, t0 = (q & 3) * 16, tb = isv ? 0 : 512;
                const LAS unsigned char* src = L + (isv ? GP_BVT : GP_KT) + row * 144 + 2 * t0; LAS unsigned char* dstl = L + (isv ? GP_BVT : GP_KBG) + row * 144 + 2 * t0;
                const v4u a = *(const LAS v4u*)src, bq = *(const LAS v4u*)(src + 16);
                const unsigned wi[8] = {a.x, a.y, a.z, a.w, bq.x, bq.y, bq.z, bq.w}; unsigned wo[8];
#pragma unroll
                for (int i = 0; i < 8; ++i) wo[i] = pk2(bflo(wi[i]) * TAB[tb + t0 + 2 * i], bfhi(wi[i]) * TAB[tb + t0 + 2 * i + 1]);
                *(LAS v4u*)dstl = (v4u){wo[0], wo[1], wo[2], wo[3]}; *(LAS v4u*)(dstl + 16) = (v4u){wo[4], wo[5], wo[6], wo[7]}; }
        }
        WG_BARRIER();
        { const int row = tid >> 3, cg = tid & 7; v4u o = {0u, 0u, 0u, 0u};
          if ((cg >> 1) <= (row >> 4)) { const f32x4 a = *(const LAS f32x4*)(TIF + row * GKP + 8 * cg), c = *(const LAS f32x4*)(TIF + row * GKP + 8 * cg + 4);
              o.x = pk2(a[0], a[1]); o.y = pk2(a[2], a[3]); o.z = pk2(c[0], c[1]); o.w = pk2(c[2], c[3]); }
          *(LAS v4u*)(L + GP_TI + row * 144 + 16 * cg) = o; }
    }
    WG_BARRIER();
    if (!(abl & 16)) {
        const int m16 = lane & 15, kg = lane >> 4;
#pragma unroll
        for (int it = 0; it < 4; ++it) {
            f32x4 au = {0.f, 0.f, 0.f, 0.f}, aw = {0.f, 0.f, 0.f, 0.f};
#pragma unroll
            for (int jb = 0; jb < 2; ++jb) {
                const bf16x8 ti = *(const LAS bf16x8*)(L + GP_TI + (16 * it + m16) * 144 + 64 * jb + 16 * kg);
                const bf16x8 bv = *(const LAS bf16x8*)(L + GP_BVT + (16 * wave + m16) * 144 + 64 * jb + 16 * kg);
                const bf16x8 kb = *(const LAS bf16x8*)(L + GP_KBG + (16 * wave + m16) * 144 + 64 * jb + 16 * kg);
                au = mfma16(ti, bv, au);
                aw = mfma16(kb, ti, aw);
            }
            v2u w; w.x = pk2(au[0], au[1]); w.y = pk2(au[2], au[3]);
            *(GAS v2u*)(rec + 57344 + ((wave * 4 + it) * 64 + lane) * 8) = w;
            v2u x; x.x = pk2(aw[0], aw[1]); x.y = pk2(aw[2], aw[3]);
            *(GAS v2u*)(rec + (it * 4 + (wave >> 1)) * 1024 + lane * 16 + (wave & 1) * 8) = x;
        }
    }
    WG_BARRIER();
}

constexpr int SC_BUF = 57344, SC_OT = 2 * SC_BUF, SC_OTB = 17408, SC_RED = SC_OT + 2 * SC_OTB;
static_assert(SC_RED + 2048 <= LDSCTL_OFF, "scan LDS map");
__device__ __forceinline__ void gdn_scan_chain(Frame& F, int bh) {
#ifdef NO_SCAN
    return;
#endif
    LAS unsigned char* L = F.ldv;
    const int tid = F.tid, lane = F.lane, w = F.wave, m16 = lane & 15, kg = lane >> 4;
    const int b = bh >> 3, h = bh & 7;
    const unsigned char* rec0 = F.ws + WS_REC + (size_t)(bh * 64) * REC_BYTES;
    if (w >= 4) {
        const int ht = tid - 256; bf16* OB = (bf16*)(F.ws + WS_OB);
        v4u st[14];
#pragma unroll
        for (int i = 0; i < 14; ++i) st[i] = *(const GAS v4u*)(rec0 + (size_t)(i * 256 + ht) * 16);
#pragma unroll
        for (int i = 0; i < 14; ++i) *(LAS v4u*)(L + (i * 256 + ht) * 16) = st[i];
#pragma unroll
        for (int i = 0; i < 14; ++i) st[i] = *(const GAS v4u*)(rec0 + REC_BYTES + (size_t)(i * 256 + ht) * 16);
        WG_BARRIER();
        for (int m = 0; m < 65; ++m) {
            if (m + 1 <= 63) { LAS unsigned char* nb = L + ((m + 1) & 1) * SC_BUF;
#pragma unroll
                for (int i = 0; i < 14; ++i) *(LAS v4u*)(nb + (i * 256 + ht) * 16) = st[i]; }
            if (m + 2 <= 63) { const unsigned char* rec = rec0 + (size_t)(m + 2) * REC_BYTES;
#pragma unroll
                for (int i = 0; i < 14; ++i) st[i] = *(const GAS v4u*)(rec + (size_t)(i * 256 + ht) * 16); }
            if (m >= 1) {
                const LAS unsigned char* ot = L + SC_OT + ((m - 1) & 1) * SC_OTB; const LAS float* RED = (const LAS float*)(L + SC_RED) + ((m - 1) & 1) * 256;
                const int row0 = b * SEQ + 64 * (m - 1); const unsigned char* gzt = rec0 + (size_t)(m - 1) * REC_BYTES + 73728;
                v4u gv[4];
#pragma unroll
                for (int r = 0; r < 4; ++r) gv[r] = *(const GAS v4u*)(gzt + (size_t)(ht + 256 * r) * 16);
#pragma unroll
                for (int r = 0; r < 4; ++r) { const int idx = ht + 256 * r, row = idx >> 4, ch = idx & 15;
                    const v4u ov = *(const LAS v4u*)(ot + row * 272 + ch * 16); const f32x4 r4 = *(const LAS f32x4*)(RED + row * 4);
                    const float rs = rsqrtf(((r4[0] + r4[1]) + (r4[2] + r4[3])) * (1.0f / 128.0f) + EPS);
                    v4u o; o.x = pk2(bflo(ov.x) * rs * bflo(gv[r].x), bfhi(ov.x) * rs * bfhi(gv[r].x)); o.y = pk2(bflo(ov.y) * rs * bflo(gv[r].y), bfhi(ov.y) * rs * bfhi(gv[r].y));
                    o.z = pk2(bflo(ov.z) * rs * bflo(gv[r].z), bfhi(ov.z) * rs * bfhi(gv[r].z)); o.w = pk2(bflo(ov.w) * rs * bflo(gv[r].w), bfhi(ov.w) * rs * bfhi(gv[r].w));
                    *(GAS v4u*)(OB + (size_t)(row0 + row) * D + h * 128 + ch * 8) = o; } }
            WG_BARRIER();
        }
    } else {
        const float* GE = (const float*)(F.ws + WS_GE) + bh * 64;
        f32x4 S[2][8], P[2][8];
#pragma unroll
        for (int hf = 0; hf < 2; ++hf)
#pragma unroll
            for (int i = 0; i < 8; ++i) { S[hf][i] = (f32x4){0.f, 0.f, 0.f, 0.f}; P[hf][i] = (f32x4){0.f, 0.f, 0.f, 0.f}; }
        WG_BARRIER();
        for (int m = 0; m < 65; ++m) {
            if (m <= 63) {
                const unsigned char* rec = rec0 + (size_t)m * REC_BYTES; const LAS unsigned char* buf = L + (m & 1) * SC_BUF;
                v2u ut[2][4];
#pragma unroll
                for (int hf = 0; hf < 2; ++hf)
#pragma unroll
                    for (int mt = 0; mt < 4; ++mt) ut[hf][mt] = *(const GAS v2u*)(rec + 57344 + (((2 * w + hf) * 4 + mt) * 64 + lane) * 8);
                const float ge = GE[m];
                bf16x8 Sb[2][4];
#pragma unroll
                for (int hf = 0; hf < 2; ++hf)
#pragma unroll
                    for (int kb = 0; kb < 4; ++kb) Sb[hf][kb] = pack8(S[hf][2 * kb], S[hf][2 * kb + 1]);
#pragma unroll
                for (int mt = 0; mt < 8; ++mt) { P[0][mt] = (f32x4){0.f, 0.f, 0.f, 0.f}; P[1][mt] = (f32x4){0.f, 0.f, 0.f, 0.f};
#pragma unroll
                    for (int kb = 0; kb < 4; ++kb) { const bf16x8 a = *(const LAS bf16x8*)(buf + (mt * 4 + kb) * 1024 + lane * 16); P[0][mt] = mfma16(a, Sb[0][kb], P[0][mt]); P[1][mt] = mfma16(a, Sb[1][kb], P[1][mt]); } }
                bf16x8 vb[2][2];
#pragma unroll
                for (int hf = 0; hf < 2; ++hf) { f32x4 vn[4];
#pragma unroll
                    for (int mt = 0; mt < 4; ++mt) { vn[mt][0] = bflo(ut[hf][mt].x) - P[hf][mt][0]; vn[mt][1] = bfhi(ut[hf][mt].x) - P[hf][mt][1]; vn[mt][2] = bflo(ut[hf][mt].y) - P[hf][mt][2]; vn[mt][3] = bfhi(ut[hf][mt].y) - P[hf][mt][3]; }
                    vb[hf][0] = pack8(vn[0], vn[1]); vb[hf][1] = pack8(vn[2], vn[3]); }
#pragma unroll
                for (int mt = 0; mt < 4; ++mt)
#pragma unroll
                    for (int kb2 = 0; kb2 < 2; ++kb2) { const bf16x8 a = *(const LAS bf16x8*)(buf + 32768 + (mt * 2 + kb2) * 1024 + lane * 16); P[0][4 + mt] = mfma16(a, vb[0][kb2], P[0][4 + mt]); P[1][4 + mt] = mfma16(a, vb[1][kb2], P[1][4 + mt]); }
#pragma unroll
                for (int mt = 0; mt < 8; ++mt) { S[0][mt] = S[0][mt] * ge; S[1][mt] = S[1][mt] * ge;
#pragma unroll
                    for (int kb2 = 0; kb2 < 2; ++kb2) { const bf16x8 a = *(const LAS bf16x8*)(buf + 40960 + (mt * 2 + kb2) * 1024 + lane * 16); S[0][mt] = mfma16(a, vb[0][kb2], S[0][mt]); S[1][mt] = mfma16(a, vb[1][kb2], S[1][mt]); } }
                LAS float* RED = (LAS float*)(L + SC_RED) + (m & 1) * 256; LAS unsigned char* ot = L + SC_OT + (m & 1) * SC_OTB;
#pragma unroll
                for (int mt = 0; mt < 4; ++mt)
#pragma unroll
                    for (int jj = 0; jj < 4; jj += 2) { const int t = 16 * mt + 4 * kg + jj;
#pragma unroll
                        for (int hf = 0; hf < 2; ++hf) { const unsigned pr = pk2(P[hf][4 + mt][jj], P[hf][4 + mt][jj + 1]);
                            *(LAS bf16*)(ot + t * 272 + (32 * w + 16 * hf + m16) * 2) = (bf16)(pr & 0xffffu); *(LAS bf16*)(ot + (t + 1) * 272 + (32 * w + 16 * hf + m16) * 2) = (bf16)(pr >> 16); } }
                float mine = 0.f;
#pragma unroll
                for (int mt = 0; mt < 4; ++mt)
#pragma unroll
                    for (int jj = 0; jj < 4; ++jj) { const float q = row_sum16(P[0][4 + mt][jj] * P[0][4 + mt][jj] + P[1][4 + mt][jj] * P[1][4 + mt][jj]); mine = (m16 == 4 * mt + jj) ? q : mine; }
                RED[(16 * (m16 >> 2) + 4 * kg + (m16 & 3)) * 4 + w] = mine;
            }
            WG_BARRIER();
        }
        float* so = F.out + O_SSMP + (size_t)bh * 16384;
#pragma unroll
        for (int hf = 0; hf < 2; ++hf)
#pragma unroll
            for (int mt = 0; mt < 8; ++mt)
#pragma unroll
                for (int jj = 0; jj < 4; ++jj) so[(16 * mt + 4 * kg + jj) * 128 + 32 * w + 16 * hf + m16] = S[hf][mt][jj];
    }
    WG_BARRIER();
}

__device__ __forceinline__ void gdn_sample_unit(Frame& F, int b, int h) {
    LAS float* L = (LAS float*)F.ldv;
    const int tid = F.tid, lane = F.lane, wave = F.wave;
    const bf16* U = (const bf16*)(F.ws + WS_U); const float* BA = (const float*)(F.ws + WS_BA);
    const int row0 = MP + 4 * b;
    const int dv = tid & 127, kq = tid >> 7;
    const float* S0 = F.in[IN_SSSM] + ((size_t)(b * 8 + h) * 128 + 32 * kq) * 128 + dv;
    float s[32];
#pragma unroll
    for (int i = 0; i < 32; ++i) s[i] = S0[(size_t)i * 128];
    LAS float* SC = L + 8704;
    if (tid < 4) { const float bl = BA[(size_t)(row0 + tid) * 16 + h], al = BA[(size_t)(row0 + tid) * 16 + 8 + h];
        SC[tid] = sigm(bl); SC[56 + tid] = -__expf(F.in[IN_ALOG][h]) * softplusf(al + F.in[IN_DTB][h]); }
    if (tid < 384) {
        const int tensor = tid >> 7, c = tid & 127, cw = tensor * 1024 + h * 128 + c, col = U_QKVB + cw;
        const float w0 = F.in[IN_CONVW][cw], w1 = F.in[IN_CONVW][3072 + cw], w2 = F.in[IN_CONVW][2 * 3072 + cw], w3 = F.in[IN_CONVW][3 * 3072 + cw];
        float x[7];
#pragma unroll
        for (int i = 0; i < 3; ++i) x[i] = F.in[IN_SCONV][((size_t)b * 3 + i) * 3072 + cw];
#pragma unroll
        for (int i = 0; i < 4; ++i) x[3 + i] = bf2f(U[(size_t)(row0 + i) * NINP + col]);
#pragma unroll
        for (int i = 0; i < 4; ++i) { const float v = w0 * x[i] + w1 * x[i + 1] + w2 * x[i + 2] + w3 * x[i + 3]; L[tensor * 512 + i * 128 + c] = siluf(v); }
    }
    WG_BARRIER();
    if (tid == 0) { float gc = 0.f;
#pragma unroll
        for (int i = 0; i < 4; ++i) { gc += SC[56 + i]; SC[4 + i] = gc; } SC[48] = __expf(gc); }
    { const int tensor = wave >> 2, s = wave & 3; const float a = L[tensor * 512 + s * 128 + lane], c2 = L[tensor * 512 + s * 128 + 64 + lane];
      const float ss = wave_sum(a * a + c2 * c2); if (lane == 0) SC[(tensor ? 8 : 12) + s] = rsqrtf(ss + EPS) * (tensor ? 1.f : 0.08838834764831845f); }
    WG_BARRIER();
#pragma unroll
    for (int r = 0; r < 4; ++r) { const int idx = 4 * wave + r, kind = idx >> 4, i = (idx >> 2) & 3, j = idx & 3;
        const LAS float* a = L + (kind ? 0 : 512) + i * 128; const LAS float* c2 = L + 512 + j * 128;
        const float d = wave_sum(a[lane] * c2[lane] + a[64 + lane] * c2[64 + lane]);
        if (lane == 0) SC[16 + idx] = d * SC[(kind ? 12 : 8) + i] * SC[8 + j]; }
    WG_BARRIER();
    float beta[4], gc[4], Ti[4][4], qkm[4][4];
#pragma unroll
    for (int i = 0; i < 4; ++i) { beta[i] = SC[i]; gc[i] = SC[4 + i]; }
    const float ge = SC[48];
    {
        float A[4][4];
#pragma unroll
        for (int i = 0; i < 4; ++i)
#pragma unroll
            for (int j = 0; j < 4; ++j) { const float dec = __expf(gc[i] - gc[j]); A[i][j] = (j < i) ? beta[i] * SC[16 + 4 * i + j] * dec : 0.f; qkm[i][j] = (j <= i) ? SC[32 + 4 * i + j] * dec : 0.f; }
#pragma unroll
        for (int i = 0; i < 4; ++i)
#pragma unroll
            for (int c = 0; c < 4; ++c) { float v = (i == c) ? 1.f : 0.f;
#pragma unroll
                for (int j = 0; j < 4; ++j) if (j < i) v -= A[i][j] * Ti[j][c];
                Ti[i][c] = v; }
    }
    { const int c = tid & 127, i = tid >> 7; float wv = 0.f, uv = 0.f;
#pragma unroll
      for (int j = 0; j < 4; ++j) { wv += Ti[i][j] * beta[j] * __expf(gc[j]) * SC[8 + j] * L[512 + j * 128 + c]; uv += Ti[i][j] * beta[j] * L[1024 + j * 128 + c]; }
      L[1536 + i * 128 + c] = wv; L[3072 + i * 128 + c] = uv;
      L[2048 + i * 128 + c] = L[i * 128 + c] * SC[12 + i] * __expf(gc[i]);
      L[2560 + i * 128 + c] = L[512 + i * 128 + c] * SC[8 + i] * __expf(gc[3] - gc[i]); }
    WG_BARRIER();
    float pw[4] = {0.f, 0.f, 0.f, 0.f}, pq[4] = {0.f, 0.f, 0.f, 0.f};
#pragma unroll
    for (int i = 0; i < 32; ++i)
#pragma unroll
        for (int c = 0; c < 4; ++c) { pw[c] += L[1536 + c * 128 + 32 * kq + i] * s[i]; pq[c] += L[2048 + c * 128 + 32 * kq + i] * s[i]; }
#pragma unroll
    for (int c = 0; c < 4; ++c) { L[3584 + (c * 4 + kq) * 128 + dv] = pw[c]; L[3584 + ((4 + c) * 4 + kq) * 128 + dv] = pq[c]; }
    WG_BARRIER();
    float vn[4], oo[4];
#pragma unroll
    for (int c = 0; c < 4; ++c) { const float ws_ = (L[3584 + (c * 4 + 0) * 128 + dv] + L[3584 + (c * 4 + 1) * 128 + dv]) + (L[3584 + (c * 4 + 2) * 128 + dv] + L[3584 + (c * 4 + 3) * 128 + dv]);
        vn[c] = L[3072 + c * 128 + dv] - ws_; }
#pragma unroll
    for (int c = 0; c < 4; ++c) { float o = (L[3584 + ((4 + c) * 4 + 0) * 128 + dv] + L[3584 + ((4 + c) * 4 + 1) * 128 + dv]) + (L[3584 + ((4 + c) * 4 + 2) * 128 + dv] + L[3584 + ((4 + c) * 4 + 3) * 128 + dv]);
#pragma unroll
        for (int j = 0; j < 4; ++j) o += qkm[c][j] * vn[j];
        oo[c] = o; }
    float* SO = F.out + O_SSMS + ((size_t)(b * 8 + h) * 128 + 32 * kq) * 128 + dv;
#pragma unroll
    for (int i = 0; i < 32; ++i) { float v = ge * s[i];
#pragma unroll
        for (int c = 0; c < 4; ++c) v += L[2560 + c * 128 + 32 * kq + i] * vn[c];
        SO[(size_t)i * 128] = v; }
    LAS float* RED = L + 8768;
    if (kq == 0) {
#pragma unroll
        for (int c = 0; c < 4; ++c) { const float q = wave_sum(oo[c] * oo[c]); if (lane == 0) RED[c * 2 + wave] = q; }
    }
    WG_BARRIER();
    if (kq == 0) {
        bf16* OB = (bf16*)(F.ws + WS_OB); const float nw = F.in[IN_GNORM][dv];
#pragma unroll
        for (int c = 0; c < 4; ++c) { const float rs = rsqrtf((RED[c * 2] + RED[c * 2 + 1]) * (1.0f / 128.0f) + EPS);
            const float z = bf2f(U[(size_t)(row0 + c) * NINP + U_Z + h * 128 + dv]);
            OB[(size_t)(row0 + c) * D + h * 128 + dv] = (bf16)f2bf(oo[c] * rs * nw * (z * sigm(z))); }
    }
    WG_BARRIER();
}

__device__ __forceinline__ void copy_map(Frame& F, int c, size_t& src, float*& dst) {
    constexpr int C0 = 65536, C1 = 262144, C2 = 1048576, CS = 65536, CCP = 4608;
    int r = c, srow, scol;
    if (r < C0 + C1 + C2) {
        int g, kl; if (r < C0) { g = 0; kl = 7; dst = F.out + O_KVP0; } else if (r < C0 + C1) { r -= C0; g = 1; kl = 9; dst = F.out + O_KVP1; } else { r -= C0 + C1; g = 2; kl = 11; dst = F.out + O_KVP2; }
        const int e8 = r & 15, hh = (r >> 4) & 3, kv = (r >> 6) & 1, rr = (r >> 7) & ((1 << kl) - 1), bb = r >> (7 + kl);
        srow = bb * SEQ + SEQ - (1 << kl) + rr; scol = (kv ? U_VA : U_KA) + (g * 4 + hh) * 128 + e8 * 8; dst += (size_t)r * 8;
    } else if ((r -= C0 + C1 + C2) < 3 * CS) {
        const int g = r >> 16; r &= 65535; dst = F.out + (g == 0 ? O_KVS0 : (g == 1 ? O_KVS1 : O_KVS2)) + (size_t)r * 8;
        const int e8 = r & 15, hh = (r >> 4) & 3, kv = (r >> 6) & 1, ss = (r >> 7) & 3, bb = r >> 9;
        srow = MP + 4 * bb + ss; scol = (kv ? U_VA : U_KA) + (g * 4 + hh) * 128 + e8 * 8;
    } else if ((r -= 3 * CS) < CCP) {
        const int ch8 = r % 384, i = (r / 384) % 3, bb = r / 1152; dst = F.out + O_CONVP + (size_t)r * 8;
        srow = bb * SEQ + SEQ - 3 + i; scol = U_QKVB + ch8 * 8;
    } else {
        r -= CCP; const int ch8 = r % 384, i = (r / 384) % 3, bb = r / 1152; dst = F.out + O_CONVS + (size_t)r * 8;
        srow = MP + 4 * bb + 1 + i; scol = U_QKVB + ch8 * 8;
    }
    src = (size_t)srow * NINP + scol;
}
constexpr int COPY_TOT = 65536 + 262144 + 1048576 + 3 * 65536 + 4608 + 147456, COPY_ITEMS = 512, COPY_PER = (COPY_TOT + COPY_ITEMS - 1) / COPY_ITEMS;
__device__ __forceinline__ void copy_item(Frame& F, int item) {
    const bf16* U = (const bf16*)(F.ws + WS_U);
    const int lo = item * COPY_PER, hi = (lo + COPY_PER < COPY_TOT) ? lo + COPY_PER : COPY_TOT;
    for (int c0 = lo + F.tid; c0 < hi; c0 += 4 * 512) {
        v4u v[4]; float* dst[4];
#pragma unroll
        for (int k = 0; k < 4; ++k) { const int c = c0 + k * 512; dst[k] = nullptr; v[k] = (v4u){0u, 0u, 0u, 0u}; if (c < hi) { size_t so; copy_map(F, c, so, dst[k]); v[k] = *(const GAS v4u*)(U + so); } }
#pragma unroll
        for (int k = 0; k < 4; ++k) if (dst[k]) { *(GAS f32x4*)dst[k] = (f32x4){bflo(v[k].x), bfhi(v[k].x), bflo(v[k].y), bfhi(v[k].y)}; *(GAS f32x4*)(dst[k] + 4) = (f32x4){bflo(v[k].z), bfhi(v[k].z), bflo(v[k].w), bfhi(v[k].w)}; }
    }
}

constexpr int AT_K = 0, AT_V = 69632;
__device__ __forceinline__ int at_off(int row, int ch) { return 256 * row + 16 * (ch ^ (((row & 3) << 2) | ((row >> 2) & 3))); }
__device__ __forceinline__ void tr_read10(unsigned a, bf16x4 (&lo)[5], bf16x4 (&hi)[5]) {
    asm volatile("ds_read_b64_tr_b16 %0, %10\n\tds_read_b64_tr_b16 %1, %10 offset:4096\n\tds_read_b64_tr_b16 %2, %10 offset:8192\n\tds_read_b64_tr_b16 %3, %10 offset:12288\n\t"
                 "ds_read_b64_tr_b16 %4, %10 offset:16384\n\tds_read_b64_tr_b16 %5, %10 offset:20480\n\tds_read_b64_tr_b16 %6, %10 offset:24576\n\tds_read_b64_tr_b16 %7, %10 offset:28672\n\t"
                 "ds_read_b64_tr_b16 %8, %10 offset:32768\n\tds_read_b64_tr_b16 %9, %10 offset:36864\n\ts_waitcnt lgkmcnt(0)"
                 : "=&v"(lo[0]), "=&v"(hi[0]), "=&v"(lo[1]), "=&v"(hi[1]), "=&v"(lo[2]), "=&v"(hi[2]), "=&v"(lo[3]), "=&v"(hi[3]), "=&v"(lo[4]), "=&v"(hi[4]) : "v"(a) : "memory"); }

struct AtDec { int h, b, g, dil, r, blk, hh; };
__device__ __forceinline__ AtDec at_decode(int unit) {
    AtDec d; d.h = unit & 3; const int rb = (unit >> 2) & 31; d.b = (unit >> 7) & 3; d.g = unit >> 9;
    d.dil = d.g == 0 ? 1 : (d.g == 1 ? 4 : 16); const int nb = 32 / d.dil; d.r = rb / nb; d.blk = rb % nb; d.hh = d.g * 4 + d.h; return d;
}
template <int WHICH>
__device__ __forceinline__ void at_issue(Frame& F, const AtDec& d) {
    LAS unsigned char* L = F.ldv; LAS unsigned char* Ls = F.lds;
    const int tid = F.tid, w = F.wave;
    constexpr int REG = WHICH ? AT_V : AT_K;
    const int t4 = tid >> 4, ch = (tid & 15) ^ (((t4 & 3) << 2) | ((t4 >> 2) & 3));
    const unsigned voff = (unsigned)(t4 * d.dil * NINP + ch * 8) * 2u;
    const char* ub = (const char*)(F.ws + WS_U) + ((size_t)(d.b * SEQ + (d.blk * 128 - 128) * d.dil + d.r) * NINP + (WHICH ? U_VA : U_KA) + d.hh * 128) * 2;
    const size_t slab = (size_t)32 * d.dil * NINP * 2;
#pragma unroll 1
    for (int it = 0; it < 8; ++it) {
        if (d.blk > 0 || it >= 4) __builtin_amdgcn_global_load_lds((const unsigned*)(ub + it * slab + voff), (LAS unsigned*)(Ls + REG + (it * 512 + w * 64) * 16), 16, 0, 0);
        else *(LAS v4u*)(L + REG + (tid + 512 * it) * 16) = (v4u){0u, 0u, 0u, 0u}; }
    if (tid < 256) *(LAS v4u*)(L + REG + (4096 + tid) * 16) = (v4u){0u, 0u, 0u, 0u};
}
__device__ __forceinline__ void attn_prompt_loop(Frame& F, int qh, int nunits, bool enabled, int abl) {
#ifdef NO_PATTN
    return;
#endif
    LAS unsigned char* L = F.ldv;
    const int lane = F.lane, w = F.wave, m16 = lane & 15, kg = lane >> 4;
    const bf16* U = (const bf16*)(F.ws + WS_U); bf16* OG = (bf16*)(F.ws + WS_OG); float* LSE = (float*)(F.ws + WS_LSE);
    int unit = (abl & 16) ? F.bx : q_next(F, qh);
    if (unit >= nunits || !enabled) { while (unit < nunits) unit = q_next(F, qh); return; }
    AtDec d = at_decode(unit);
    if (!(abl & 1)) { at_issue<0>(F, d); at_issue<1>(F, d); }
    for (;;) {
        const int nunit = (abl & 16) ? unit + F.G : q_next(F, qh); const bool more = nunit < nunits;
        AtDec dn = at_decode(more ? nunit : 0);
        const float slope = exp2f(-8.0f * (float)(d.hh + 1) / 12.0f) * (float)d.dil;
        const int qi = 16 * w + m16; const size_t qrow = (size_t)(d.b * SEQ + (d.blk * 128 + qi) * d.dil + d.r);
        bf16x8 qf[4];
#pragma unroll
        for (int kb = 0; kb < 4; ++kb) qf[kb] = *(const GAS bf16x8*)(U + qrow * NINP + U_QA + d.hh * 128 + 32 * kb + 8 * kg);
        asm volatile("s_waitcnt vmcnt(0)" ::: "memory");
        WG_BARRIER();
        f32x4 S[10];
        int kbase[4];
#pragma unroll
        for (int kb = 0; kb < 4; ++kb) kbase[kb] = AT_K + at_off(16 * w + m16, 4 * kb + kg);
#pragma unroll
        for (int kt = 0; kt < 9; ++kt) { S[kt] = (f32x4){0.f, 0.f, 0.f, 0.f};
            if (!(abl & 2)) {
#pragma unroll
            for (int kb = 0; kb < 4; ++kb) S[kt] = mfma16(*(const LAS bf16x8*)(L + kbase[kb] + kt * 4096), qf[kb], S[kt]); } }
        S[9] = (f32x4){0.f, 0.f, 0.f, 0.f};
        WG_BARRIER();
        if (more && !(abl & 1)) at_issue<0>(F, dn);
        const float sc = 0.08838834764831845f * 1.4426950408889634f, sl2 = slope * 1.4426950408889634f;
        float bj[4];
#pragma unroll
        for (int jj = 0; jj < 4; ++jj) bj[jj] = -sl2 * (float)(128 + m16 - 4 * kg - jj);
        float mx = -INFINITY;
#pragma unroll
        for (int kt = 0; kt < 9; ++kt) { const bool tile_ok = d.blk > 0 || (w + kt >= 8); const float tb = sl2 * (float)(16 * kt);
#pragma unroll
            for (int jj = 0; jj < 4; ++jj) { float v = S[kt][jj] * sc + (bj[jj] + tb);
                if (kt == 0) v = (m16 <= 4 * kg + jj) ? v : -INFINITY;
                if (kt == 8) v = (m16 >= 4 * kg + jj) ? v : -INFINITY;
                v = tile_ok ? v : -INFINITY; S[kt][jj] = v; mx = fmaxf(mx, v); } }
        mx = fmaxf(mx, __shfl_xor(mx, 16)); mx = fmaxf(mx, __shfl_xor(mx, 32));
        float sum = 0.f;
#pragma unroll
        for (int kt = 0; kt < 9; ++kt)
#pragma unroll
            for (int jj = 0; jj < 4; ++jj) { const float p = __builtin_amdgcn_exp2f(S[kt][jj] - mx); S[kt][jj] = p; sum += p; }
        sum += __shfl_xor(sum, 16); sum += __shfl_xor(sum, 32);
        bf16x8 pb[5];
#pragma unroll
        for (int kb2 = 0; kb2 < 5; ++kb2) pb[kb2] = pack8(S[2 * kb2], S[2 * kb2 + 1]);
        f32x4 O[8];
        const int rq = m16 >> 2, cq = m16 & 3;
        unsigned vbase[8];
#pragma unroll
        for (int dt = 0; dt < 8; ++dt) vbase[dt] = (unsigned)(AT_V + at_off(16 * w + 4 * kg + rq, 2 * dt + (cq >> 1)) + 8 * (cq & 1));
#pragma unroll
        for (int dt = 0; dt < 8; ++dt) { O[dt] = (f32x4){0.f, 0.f, 0.f, 0.f}; if (abl & 4) continue; bf16x4 lo[5], hi[5]; tr_read10(vbase[dt], lo, hi);
#pragma unroll
            for (int kb2 = 0; kb2 < 5; ++kb2) { bf16x8 vf; vf[0] = lo[kb2][0]; vf[1] = lo[kb2][1]; vf[2] = lo[kb2][2]; vf[3] = lo[kb2][3]; vf[4] = hi[kb2][0]; vf[5] = hi[kb2][1]; vf[6] = hi[kb2][2]; vf[7] = hi[kb2][3];
                O[dt] = mfma16(vf, pb[kb2], O[dt]); } }
        WG_BARRIER();
        if (more && !(abl & 1)) at_issue<1>(F, dn);
        const float inv = __builtin_amdgcn_rcpf(sum);
        if (!(abl & 8))
#pragma unroll
        for (int dt = 0; dt < 8; ++dt) { v2u o; o.x = pk2(O[dt][0] * inv, O[dt][1] * inv); o.y = pk2(O[dt][2] * inv, O[dt][3] * inv);
            *(GAS v2u*)(OG + qrow * 1536 + d.hh * 128 + 16 * dt + 4 * kg) = o; }
        if (kg == 0) LSE[qrow * 12 + d.hh] = (mx + log2f(sum)) * 0.6931471805599453f;
        if (!more) break;
        d = dn; unit = nunit;
    }
    WG_BARRIER();
}

__device__ __forceinline__ float half_sum(float v) { v = row_sum16(v); v += __shfl_xor(v, 16); return v; }
__device__ __forceinline__ void attn_sample_unit(Frame& F, int unit) {
#ifdef NO_SATTN
    return;
#endif
    const int lane = F.lane, w = F.wave;
    const bf16* U = (const bf16*)(F.ws + WS_U); bf16* OG = (bf16*)(F.ws + WS_OG); float* LSE = (float*)(F.ws + WS_LSE);
    const int b = unit & 127, g = unit >> 7;
    const int s = w & 3, h = 2 * (w >> 2) + (lane >> 5), dl = lane & 31, hh = g * 4 + h;
    const int dil = g == 0 ? 1 : (g == 1 ? 4 : 16), wb = g == 0 ? 128 : (g == 1 ? 512 : 2048);
    const float* cache = F.in[g == 0 ? IN_C128 : (g == 1 ? IN_C512 : IN_C2048)] + (size_t)b * wb * 1024 + h * 128 + 4 * dl;
    const float L2E = 1.4426950408889634f;
    const float sl2 = exp2f(-8.0f * (float)(hh + 1) / 12.0f) * (float)dil * L2E;
    const size_t qrow = (size_t)(MP + 4 * b + s);
    f32x4 q; { const v2u qq = *(const GAS v2u*)(U + qrow * NINP + U_QA + hh * 128 + 4 * dl); const float sc = 0.08838834764831845f * L2E;
        q = (f32x4){bflo(qq.x) * sc, bfhi(qq.x) * sc, bflo(qq.y) * sc, bfhi(qq.y) * sc}; }
    float m = -INFINITY, l = 0.f; f32x4 o = {0.f, 0.f, 0.f, 0.f};
    const int jn = (g == 0) ? s : 0;
    for (int j = 0; j <= jn; ++j) { const size_t kr = (size_t)(MP + 4 * b + s - dil * j) * NINP + hh * 128 + 4 * dl;
        const v2u kk = *(const GAS v2u*)(U + kr + U_KA), vv = *(const GAS v2u*)(U + kr + U_VA);
        const float sc = half_sum(bflo(kk.x) * q[0] + bfhi(kk.x) * q[1] + bflo(kk.y) * q[2] + bfhi(kk.y) * q[3]) - sl2 * (float)j;
        const float mn = fmaxf(m, sc), al = exp2f(m - mn), p = exp2f(sc - mn); m = mn; l = l * al + p;
        o = o * al + (f32x4){bflo(vv.x), bfhi(vv.x), bflo(vv.y), bfhi(vv.y)} * p; }
    f32x4 kA[8], vA[8], kB[8], vB[8];
#define SA_LOAD(KF, VF, BLK) do { _Pragma("unroll") for (int i = 0; i < 8; ++i) { const int j = jn + 1 + 8 * (BLK) + i; int idx = wb + s - dil * j; idx = idx < 0 ? 0 : idx; \
        KF[i] = *(const GAS f32x4*)(cache + (size_t)idx * 1024); VF[i] = *(const GAS f32x4*)(cache + (size_t)idx * 1024 + 512); } } while (0)
#define SA_COMP(KF, VF, BLK) do { float sc[8]; float mb = -INFINITY; \
        _Pragma("unroll") for (int i = 0; i < 8; ++i) { const int j = jn + 1 + 8 * (BLK) + i; \
            float d = half_sum(KF[i][0] * q[0] + KF[i][1] * q[1] + KF[i][2] * q[2] + KF[i][3] * q[3]) - sl2 * (float)j; \
            d = (j <= 128) ? d : -INFINITY; sc[i] = d; mb = fmaxf(mb, d); } \
        const float mn = fmaxf(m, mb), al = exp2f(m - mn); m = mn; l *= al; o = o * al; \
        _Pragma("unroll") for (int i = 0; i < 8; ++i) { const float p = exp2f(sc[i] - mn); l += p; o = o + VF[i] * p; } } while (0)
    SA_LOAD(kA, vA, 0);
    for (int blk = 0; blk < 16; blk += 2) {
        SA_LOAD(kB, vB, blk + 1);
        SA_COMP(kA, vA, blk);
        if (blk + 2 < 16) SA_LOAD(kA, vA, blk + 2);
        SA_COMP(kB, vB, blk + 1);
    }
#undef SA_LOAD
#undef SA_COMP
    const float inv = 1.0f / l;
    v2u ov; ov.x = pk2(o[0] * inv, o[1] * inv); ov.y = pk2(o[2] * inv, o[3] * inv);
    *(GAS v2u*)(OG + qrow * 1536 + hh * 128 + 4 * dl) = ov;
    if (dl == 0) LSE[qrow * 12 + hh] = (m + log2f(l)) * 0.6931471805599453f;
}

__device__ __forceinline__ void attn_merge(Frame& F) {
    const bf16* OG = (const bf16*)(F.ws + WS_OG); const float* LSE = (const float*)(F.ws + WS_LSE); bf16* OA = (bf16*)(F.ws + WS_OA);
    const long gt = (long)F.bx * 512 + F.tid, NT = (long)F.G * 512;
    for (long c = gt; c < (long)MT * 64; c += NT) {
        const int row = (int)(c >> 6), hs = (int)(c >> 4) & 3, e8 = (int)c & 15;
        const float l0 = LSE[(size_t)row * 12 + hs], l1 = LSE[(size_t)row * 12 + 4 + hs], l2 = LSE[(size_t)row * 12 + 8 + hs];
        const float m = fmaxf(l0, fmaxf(l1, l2)); float w0 = __expf(l0 - m), w1 = __expf(l1 - m), w2 = __expf(l2 - m); const float inv = 1.0f / (w0 + w1 + w2); w0 *= inv; w1 *= inv; w2 *= inv;
        const v4u a = *(const GAS v4u*)(OG + (size_t)row * 1536 + hs * 128 + e8 * 8), bq = *(const GAS v4u*)(OG + (size_t)row * 1536 + (4 + hs) * 128 + e8 * 8), cq = *(const GAS v4u*)(OG + (size_t)row * 1536 + (8 + hs) * 128 + e8 * 8);
        v4u o;
        o.x = pk2(w0 * bflo(a.x) + w1 * bflo(bq.x) + w2 * bflo(cq.x), w0 * bfhi(a.x) + w1 * bfhi(bq.x) + w2 * bfhi(cq.x));
        o.y = pk2(w0 * bflo(a.y) + w1 * bflo(bq.y) + w2 * bflo(cq.y), w0 * bfhi(a.y) + w1 * bfhi(bq.y) + w2 * bfhi(cq.y));
        o.z = pk2(w0 * bflo(a.z) + w1 * bflo(bq.z) + w2 * bflo(cq.z), w0 * bfhi(a.z) + w1 * bfhi(bq.z) + w2 * bfhi(cq.z));
        o.w = pk2(w0 * bflo(a.w) + w1 * bflo(bq.w) + w2 * bflo(cq.w), w0 * bfhi(a.w) + w1 * bfhi(bq.w) + w2 * bfhi(cq.w));
        *(GAS v4u*)(OA + (size_t)row * 512 + hs * 128 + e8 * 8) = o;
    }
}

#ifndef MK_N_LAUNCHES
#define MK_N_LAUNCHES 1
#endif
constexpr int N_PHASES = 12;
struct Args { const float* in[23]; float* out; unsigned char* ws; int ph_lo, ph_hi, sub, qi; };
static_assert(sizeof(Args) == 23 * 8 + 8 + 8 + 16, "Args has no padding");

#ifndef PH5_MASK
#define PH5_MASK 7
#endif
__device__ __forceinline__ void phase5(Frame& F, int qi, int sub) {
    if ((sub & 1) && F.bx < NB * 8) gdn_scan_chain(F, F.bx);
    if (F.bx >= 32 && F.bx < 96) for (;;) { const int u = q_next(F, 5 * qi); if (u >= 128) break; if (sub & 16) attn_sample_unit(F, 256 + u); }
    for (;;) { const int u = q_next(F, 5 * qi + 1); if (u >= DB * 8) break; if (sub & 32) gdn_sample_unit(F, u >> 3, u & 7); }
    for (;;) { const int u = q_next(F, 5 * qi + 2); if (u >= 256) break; if (sub & 2) attn_sample_unit(F, (u < 128) ? 128 + u : u - 128); }
    for (;;) { const int u = q_next(F, 5 * qi + 3); if (u >= COPY_ITEMS) break; if (sub & 64) copy_item(F, u); }
    attn_prompt_loop(F, 5 * qi + 4, 1536, (sub & 4) != 0, sub >> 8);
}
__global__ void __launch_bounds__(NWAVES * 64, 2) mk_fwd(Args args) {
    extern __shared__ __attribute__((aligned(16))) unsigned char lds[];
    Frame F;
    F.lds = (LAS unsigned char*)lds;
    { unsigned z = 0u; asm volatile("" : "+v"(z)); F.ldv = (LAS unsigned char*)lds + z; }
    F.MISC = (volatile LAS unsigned*)(F.lds + MISC_OFF);
    F.tid = threadIdx.x; F.lane = F.tid & 63; F.wave = __builtin_amdgcn_readfirstlane(F.tid >> 6);
    F.G = gridDim.x; F.bx = blockIdx.x;
    F.ws = args.ws; F.out = args.out; F.ctl = (gu32*)(args.ws + WS_CTL);
    F.in = args.in;
    for (int u = F.tid; u < (LDS_BYTES - LDSCTL_OFF) / 4; u += NWAVES * 64) ((LAS unsigned*)(F.lds + LDSCTL_OFF))[u] = 0u;
    __syncthreads();
    const bool one = (args.ph_hi - args.ph_lo) > 1;
    XcdBarrier bar; bar.bar = (unsigned*)(F.ctl + CW_BAR); bar.x = 0; bar.st = nullptr;
    if (one) bar = xcd_barrier_post((unsigned*)(F.ctl + CW_BAR), F.MISC + 8);
    const int lo = args.ph_lo, hi = args.ph_hi;
#ifndef PHASE_MASK
#define PHASE_MASK 0xFFF
#endif
#define IN(k) ((((PHASE_MASK) >> (k)) & 1) && lo <= (k) && (k) < hi)
#define SEAM(k) do { if (IN(k) && IN((k) + 1)) xcd_barrier(bar); } while (0)

    bf16* XB = (bf16*)(F.ws + WS_XB); bf16* ACT = (bf16*)(F.ws + WS_ACT); float* X1 = (float*)(F.ws + WS_X1); bf16* X1B = (bf16*)(F.ws + WS_X1B);
    bf16* UU = (bf16*)(F.ws + WS_U); float* BA = (float*)(F.ws + WS_BA); bf16* OB = (bf16*)(F.ws + WS_OB); bf16* OA = (bf16*)(F.ws + WS_OA);
    bf16* M1 = (bf16*)(F.ws + WS_M1); bf16* MG = (bf16*)(F.ws + WS_MG); float* X2 = (float*)(F.ws + WS_X2); bf16* X2B = (bf16*)(F.ws + WS_X2B);
    float* SSQ2 = (float*)(args.ws + WS_CTL) + CW_SSQ2; float* SSQ3 = (float*)(args.ws + WS_CTL) + CW_SSQ3; float* SSQ4 = (float*)(args.ws + WS_CTL) + CW_SSQ4;

#ifndef DUP_MASK
#define DUP_MASK 0
#endif
#define DUP(k) (((DUP_MASK) >> (k)) & 1)
    if (IN(0)) { p0_prologue(F); } SEAM(0);
    if (IN(1)) {
        pg8::Gemm g{XB, (const bf16*)(F.ws + WS_W1A), MT, NGU, D}; pg8::StaticOrder S; S.init(MT, NGU, F.G, F.bx);
        pg8::EpiSwiglu E{ACT, (const float*)(F.ws + WS_RSTD1), 0};
        pg8::gemm_phase<pg8::EpiSwiglu, pg8::StaticOrder, true, true>(F.lds + RING_OFF, g, S, E);
    } SEAM(1);
    if (IN(2)) {
        pg8::Gemm g{ACT, (const bf16*)(F.ws + WS_W1B), MP, D, FF}; pg8::StaticOrder S; S.init(MP, D, F.G, F.bx);
        pg8::EpiResidB<0> E{F.in[IN_XP], F.in[IN_XS] - (size_t)MP * D, nullptr, X1B, nullptr, SSQ2, 0.5f};
        pg8::gemm_phase<pg8::EpiResidB<0>, pg8::StaticOrder, true, true>(F.lds + RING_OFF, g, S, E);
        if (args.sub & 8) skinny_resid<FF, 0>(F, ACT, (const bf16*)(F.ws + WS_W1B), F.in[IN_XS] - (size_t)MP * D, nullptr, X1B, nullptr, SSQ2, 0.5f);
    } SEAM(2);
    if (IN(3)) {
        pg8::Gemm g{X1B, (const bf16*)(F.ws + WS_WIN), MT, U_BA, D}; pg8::StaticOrder S; S.init(MT, U_BA, F.G, F.bx);
        pg8::EpiU E{UU, BA, SSQ2};
        pg8::gemm_phase<pg8::EpiU, pg8::StaticOrder, true, true>(F.lds + RING_OFF, g, S, E);
        skinny_ba(F, X1B, (const bf16*)(F.ws + WS_WIN), SSQ2, BA);
    } SEAM(3);
    if (IN(4)) {
        if (args.sub & 1) { PrepIn pin; int i = F.bx;
            if (i < NREC) prep_fetch(F, (i & 31) >> 3, i & 7, i >> 5, pin);
            for (; i < NREC; i += F.G) { const int nx = i + F.G; gdn_prep_unit(F, (i & 31) >> 3, i & 7, i >> 5, pin, nx < NREC, (nx & 31) >> 3, nx & 7, nx >> 5, args.sub >> 8); } }
    } SEAM(4);
    if (IN(5)) {
        phase5(F, args.qi, args.sub);
    } SEAM(5);
    if (IN(6)) { attn_merge(F); } SEAM(6);
    if (IN(7)) {
        { pg8::Gemm g{OA, (const bf16*)(F.ws + WS_WPA), MP, D, 512}; pg8::StaticOrder S; S.init(MP, D, F.G, F.bx);
          pg8::EpiGate<0> E{UU, nullptr, M1};
          pg8::gemm_phase<pg8::EpiGate<0>, pg8::StaticOrder, true, true>(F.lds + RING_OFF, g, S, E); }
        { pg8::Gemm g{OB, (const bf16*)(F.ws + WS_WPB), MP, D, D}; pg8::StaticOrder S; S.init(MP, D, F.G, F.bx);
          pg8::EpiGate<1> E{UU, M1, MG};
          pg8::gemm_phase<pg8::EpiGate<1>, pg8::StaticOrder, true, true>(F.lds + RING_OFF, g, S, E); }
        if (args.sub & 8) skinny_merge(F, OA, (const bf16*)(F.ws + WS_WPA), OB, (const bf16*)(F.ws + WS_WPB), UU, MG);
    } SEAM(7);
    if (IN(8)) {
        pg8::Gemm g{MG, (const bf16*)(F.ws + WS_WOUT), MP, D, D}; pg8::StaticOrder S; S.init(MP, D, F.G, F.bx);
        pg8::EpiResidB<1> E{nullptr, nullptr, X1B, X2B, nullptr, SSQ3, 1.0f};
        pg8::gemm_phase<pg8::EpiResidB<1>, pg8::StaticOrder, true, true>(F.lds + RING_OFF, g, S, E);
        skinny_resid<D, 1>(F, MG, (const bf16*)(F.ws + WS_WOUT), nullptr, X1B, X2B, nullptr, SSQ3, 1.0f);
    } SEAM(8);
    if (IN(9)) {
        pg8::Gemm g{X2B, (const bf16*)(F.ws + WS_W2A), MT, NGU, D}; pg8::StaticOrder S; S.init(MT, NGU, F.G, F.bx);
        pg8::EpiSwiglu E{ACT, SSQ3, 1};
        pg8::gemm_phase<pg8::EpiSwiglu, pg8::StaticOrder, true, true>(F.lds + RING_OFF, g, S, E);
    } SEAM(9);
    if (IN(10)) {
        pg8::Gemm g{ACT, (const bf16*)(F.ws + WS_W2B), MP, D, FF}; pg8::StaticOrder S; S.init(MP, D, F.G, F.bx);
        pg8::EpiResidB<2> E{nullptr, nullptr, X2B, nullptr, F.out + O_Y, SSQ4, 0.5f};
        pg8::gemm_phase<pg8::EpiResidB<2>, pg8::StaticOrder, true, true>(F.lds + RING_OFF, g, S, E);
        skinny_resid<FF, 2>(F, ACT, (const bf16*)(F.ws + WS_W2B), nullptr, X2B, nullptr, F.out + O_Y, SSQ4, 0.5f);
    } SEAM(10);
    if (IN(11)) { final_norm(F); }
#undef IN
#undef SEAM
}

extern "C" void kernel_launch(void* const* d_in, const int* in_sizes, int n_in, void* d_out, int out_size, void* d_ws, size_t ws_size, hipStream_t stream) {
    static int grid = 0;
    if (grid == 0) {
        if (n_in != 23 || out_size != (int)O_END || ws_size < WS_END) { fprintf(stderr, "kernel_launch: unexpected sizes n_in %d out %d ws %zu (need %zu)\n", n_in, out_size, ws_size, (size_t)WS_END); grid = -1; return; }
        int dev = 0, cus = 0, per_cu = 0;
        if (hipGetDevice(&dev) != hipSuccess || hipDeviceGetAttribute(&cus, hipDeviceAttributeMultiprocessorCount, dev) != hipSuccess) { grid = -1; return; }
        if (hipFuncSetAttribute((const void*)mk_fwd, hipFuncAttributeMaxDynamicSharedMemorySize, LDS_BYTES) != hipSuccess) { fprintf(stderr, "kernel_launch: hipFuncSetAttribute failed\n"); grid = -1; return; }
        if (hipOccupancyMaxActiveBlocksPerMultiprocessor(&per_cu, (const void*)mk_fwd, NWAVES * 64, LDS_BYTES) != hipSuccess || per_cu < 1) { fprintf(stderr, "kernel_launch: occupancy query says %d\n", per_cu); per_cu = 1; }
        (void)hipGetLastError();
        grid = cus;
    }
    if (grid < 0) return;
    if (hipMemsetAsync((char*)d_ws + WS_CTL, 0, CTL_ZERO_BYTES, stream) != hipSuccess) return;
    Args a{};
    for (int i = 0; i < 23; ++i) a.in[i] = (const float*)d_in[i];
    a.out = (float*)d_out; a.ws = (unsigned char*)d_ws;
#if MK_N_LAUNCHES == 1
    a.ph_lo = 0; a.ph_hi = N_PHASES; a.sub = 127; a.qi = 0;
    hipLaunchKernelGGL(mk_fwd, dim3(grid), dim3(NWAVES * 64), LDS_BYTES, stream, a);
#ifdef EXTRA_MASK
    for (int p = 0; p < N_PHASES; ++p) if ((EXTRA_MASK >> p) & 1) { a.ph_lo = p; a.ph_hi = p + 1; a.sub = EXTRA_SUB; a.qi = 1; hipLaunchKernelGGL(mk_fwd, dim3(grid), dim3(NWAVES * 64), LDS_BYTES, stream, a); }
#endif
#else
    a.sub = 127; a.qi = 0;
    for (int p = 0; p < N_PHASES; ++p) { a.ph_lo = p; a.ph_hi = p + 1; hipLaunchKernelGGL(mk_fwd, dim3(grid), dim3(NWAVES * 64), LDS_BYTES, stream, a); }
#endif
}
```
